# Optimizing an MI355X kernel written in HIP

```python
import math
import jax, jax.numpy as jnp
from jax import lax
import numpy as np

D_MODEL = 1024
BATCH = 1
SEQ = 16384
DEPTH = 4

GRID_W = 64
N_META = 16
EPS = 1e-6
ATTN_HEADS = 8
ATTN_KV_HEADS = 2
HEAD_DIM = 128
KV_REP = ATTN_HEADS // ATTN_KV_HEADS
ROPE_AXIS_DIM = HEAD_DIM // 2
ROPE_THETA = 10000.0
Q_BLOCK = 128
ATTN_WIDTH = ATTN_HEADS * HEAD_DIM
KV_WIDTH = ATTN_KV_HEADS * HEAD_DIM
S5_WIDTH = D_MODEL
S5_GROUP = 16
S5_GROUPS = S5_WIDTH // S5_GROUP
S5_STATE = 64
EVEN_IN_WIDTH = 2 * ATTN_WIDTH + 2 * KV_WIDTH + 2 * S5_WIDTH
EVEN_SPLITS = (ATTN_WIDTH, ATTN_WIDTH + KV_WIDTH, ATTN_WIDTH + 2 * KV_WIDTH,
               2 * ATTN_WIDTH + 2 * KV_WIDTH, 2 * ATTN_WIDTH + 2 * KV_WIDTH + S5_WIDTH)
MLSTM_WIDTH = 2 * D_MODEL
MLSTM_HEADS = 8
MLSTM_HEAD_V = MLSTM_WIDTH // MLSTM_HEADS
MLSTM_HEAD_QK = MLSTM_HEAD_V // 2
CONV_W = 5
CHUNK = 64
PAD_FRONT = CHUNK - N_META
NEG_BIG = -1e9
N_EVEN = (DEPTH + 1) // 2
N_ODD = DEPTH // 2

kernel_name = 'hybrid_attn_s5_mlstm_encoder'


def rms_norm(x, g):
    xf = x.astype(jnp.float32)
    y = xf * lax.rsqrt(jnp.mean(xf * xf, axis=-1, keepdims=True) + EPS)
    return (y * g.astype(jnp.float32)).astype(x.dtype)


def axial_rope_tables(n_real):
    rows = n_real // GRID_W
    row = jnp.repeat(jnp.arange(rows, dtype=jnp.float32), GRID_W)
    col = jnp.tile(jnp.arange(GRID_W, dtype=jnp.float32), rows)
    meta = jnp.zeros((N_META,), jnp.float32)
    row = jnp.concatenate([meta, row])
    col = jnp.concatenate([meta, col])
    freqs = ROPE_THETA ** (-jnp.arange(0, ROPE_AXIS_DIM, 2, dtype=jnp.float32) / ROPE_AXIS_DIM)
    ang_r = row[:, None] * freqs[None]
    ang_c = col[:, None] * freqs[None]
    shp = lambda a: a[None, :, None, :]
    return shp(jnp.cos(ang_r)), shp(jnp.sin(ang_r)), shp(jnp.cos(ang_c)), shp(jnp.sin(ang_c))


def apply_axial_rope(x, tabs):
    cos_r, sin_r, cos_c, sin_c = tabs
    xf = x.astype(jnp.float32)

    def rot(xs, cos, sin):
        half = xs.shape[-1] // 2
        x1, x2 = xs[..., :half], xs[..., half:]
        return jnp.concatenate([x1 * cos - x2 * sin, x2 * cos + x1 * sin], axis=-1)

    out = jnp.concatenate([rot(xf[..., :ROPE_AXIS_DIM], cos_r, sin_r),
                           rot(xf[..., ROPE_AXIS_DIM:], cos_c, sin_c)], axis=-1)
    return out.astype(x.dtype)


def block_attention(q, k, v):
    b, l = q.shape[0], q.shape[1]
    n_blocks = -(-l // Q_BLOCK)
    pad = n_blocks * Q_BLOCK - l
    qp = jnp.pad(q, ((0, 0), (0, pad), (0, 0), (0, 0)))
    qb = qp.reshape(b, n_blocks, Q_BLOCK, ATTN_KV_HEADS, KV_REP, HEAD_DIM).transpose(1, 0, 3, 4, 2, 5)
    kt = k.transpose(0, 2, 1, 3)
    vt = v.transpose(0, 2, 1, 3)
    scale = HEAD_DIM ** -0.5

    def one_block(qblk):
        s = jnp.einsum('bgrqd,bgkd->bgrqk', qblk, kt).astype(jnp.float32) * scale
        p = jax.nn.softmax(s, axis=-1).astype(vt.dtype)
        return jnp.einsum('bgrqk,bgkd->bgrqd', p, vt)

    o = lax.map(one_block, qb)
    o = o.transpose(1, 0, 4, 2, 3, 5).reshape(b, n_blocks * Q_BLOCK, ATTN_WIDTH)
    return o[:, :l]


def _linear_combine(e1, e2):
    a1, b1 = e1
    a2, b2 = e2
    return a1 * a2, a2 * b1 + b2


def s5_bidirectional(u, a_re, a_im, log_dt, b_re, b_im, c_re, c_im, d_skip, w_glu, b_glu):
    bsz, l, _ = u.shape
    f32 = jnp.float32
    uf = u.astype(f32)
    ug = uf.reshape(bsz, l, S5_GROUPS, S5_GROUP)
    y = uf * d_skip.astype(f32)
    for direction, reverse in ((0, False), (1, True)):
        a = lax.complex(a_re[direction].astype(f32), a_im[direction].astype(f32))
        dt = jnp.exp(log_dt[direction].astype(f32))[:, None]
        a_bar = jnp.exp(a * dt)
        b_bar = ((a_bar - 1.0) / a)[..., None] * lax.complex(b_re[direction].astype(f32),
                                                           b_im[direction].astype(f32))
        bu = jnp.einsum('blgp,gnp->blgn', ug.astype(jnp.complex64), b_bar)
        a_seq = jnp.broadcast_to(a_bar, bu.shape)
        _, states = lax.associative_scan(_linear_combine, (a_seq, bu), axis=1, reverse=reverse)
        c = lax.complex(c_re[direction].astype(f32), c_im[direction].astype(f32))
        y = y + jnp.einsum('blgn,gpn->blgp', states, c).real.reshape(bsz, l, S5_WIDTH)
    y = jax.nn.gelu(y)
    y = y * jax.nn.sigmoid(y @ w_glu.astype(f32) + b_glu.astype(f32))
    return y.astype(u.dtype)


def mlstm_chunkwise(q, k, v, log_i, log_f):
    bsz, nh, t, dk = q.shape
    dv = v.shape[-1]
    nc = t // CHUNK
    q = q.reshape(bsz, nh, nc, CHUNK, dk) * (dk ** -0.5)
    k = k.reshape(bsz, nh, nc, CHUNK, dk)
    v = v.reshape(bsz, nh, nc, CHUNK, dv)
    li = log_i.reshape(bsz, nh, nc, CHUNK)
    lf = log_f.reshape(bsz, nh, nc, CHUNK)
    b = jnp.cumsum(lf, axis=-1)
    b_last = b[..., -1]
    g = b_last[..., None] - b + li
    g_max = jnp.max(g, axis=-1)

    def step(carry, xs):
        c_st, n_st, m_st = carry
        k_c, v_c, g_c, gmax_c, bl_c = xs
        m_new = jnp.maximum(bl_c + m_st, gmax_c)
        decay = jnp.exp(bl_c + m_st - m_new)
        w = jnp.exp(g_c - m_new[..., None])
        c_new = decay[..., None, None] * c_st + jnp.einsum('bhs,bhsv,bhsk->bhvk', w, v_c, k_c)
        n_new = decay[..., None] * n_st + jnp.einsum('bhs,bhsk->bhk', w, k_c)
        return (c_new, n_new, m_new), (c_st, n_st, m_st)

    init = (jnp.zeros((bsz, nh, dv, dk), jnp.float32), jnp.zeros((bsz, nh, dk), jnp.float32),
            jnp.zeros((bsz, nh), jnp.float32))
    xs = (jnp.moveaxis(k, 2, 0), jnp.moveaxis(v, 2, 0), jnp.moveaxis(g, 2, 0),
          jnp.moveaxis(g_max, 2, 0), jnp.moveaxis(b_last, 2, 0))
    _, (c_prev, n_prev, m_prev) = lax.scan(step, init, xs)
    m_prev = jnp.moveaxis(m_prev, 0, 2)

    d = b[..., :, None] - b[..., None, :] + li[..., None, :]
    causal_in_chunk = jnp.tril(jnp.ones((CHUNK, CHUNK), dtype=bool))
    d = jnp.where(causal_in_chunk, d, -jnp.inf)
    inter_log = b + m_prev[..., None]
    m_t = jnp.maximum(jnp.max(d, axis=-1), inter_log)
    sw = jnp.exp(d - m_t[..., None]) * jnp.einsum('bhntd,bhnsd->bhnts', q, k)
    inter_scale = jnp.exp(inter_log - m_t)
    num = jnp.einsum('bhnts,bhnsv->bhntv', sw, v) + \
        inter_scale[..., None] * jnp.einsum('nbhvk,bhntk->bhntv', c_prev, q)
    den = jnp.sum(sw, axis=-1) + inter_scale * jnp.einsum('nbhk,bhntk->bhnt', n_prev, q)
    h = num / jnp.maximum(jnp.abs(den), jnp.exp(-m_t))[..., None]
    return h.reshape(bsz, nh, t, dv)


def attn_s5_layer(h, tabs, w_in, q_norm, k_norm, a_re, a_im, log_dt, b_re, b_im, c_re, c_im,
                  d_skip, w_glu, b_glu, w_out):
    bsz, l, _ = h.shape
    proj = h @ w_in
    q, k, v, gate_a, u, gate_b = jnp.split(proj, EVEN_SPLITS, axis=-1)
    q = apply_axial_rope(rms_norm(q.reshape(bsz, l, ATTN_HEADS, HEAD_DIM), q_norm), tabs)
    k = apply_axial_rope(rms_norm(k.reshape(bsz, l, ATTN_KV_HEADS, HEAD_DIM), k_norm), tabs)
    v = v.reshape(bsz, l, ATTN_KV_HEADS, HEAD_DIM)
    y_a = block_attention(q, k, v) * jax.nn.silu(gate_a)
    y_b = s5_bidirectional(u, a_re, a_im, log_dt, b_re, b_im, c_re, c_im, d_skip, w_glu, b_glu) \
        * jax.nn.silu(gate_b)
    return jnp.concatenate([y_a, y_b], axis=-1) @ w_out


def mlstm_layer(h, w_in, conv_w, conv_b, w_q, w_k, w_v, w_igate, b_igate, w_fgate, b_fgate,
                w_ogate, b_ogate, head_norm, skip, w_out):
    bsz, l, _ = h.shape
    f32 = jnp.float32
    proj = h @ w_in
    xm, z = jnp.split(proj, [MLSTM_WIDTH], axis=-1)
    conv = lax.conv_general_dilated(xm, conv_w[:, None, :].astype(xm.dtype), window_strides=(1,),
                                    padding=[(CONV_W // 2, CONV_W // 2)],
                                    dimension_numbers=('NWC', 'WIO', 'NWC'),
                                    feature_group_count=MLSTM_WIDTH)
    xc = jax.nn.silu(conv + conv_b)
    xch = xc.reshape(bsz, l, MLSTM_HEADS, MLSTM_HEAD_V)
    q = jnp.einsum('blhc,hcd->bhld', xch, w_q).astype(f32)
    k = jnp.einsum('blhc,hcd->bhld', xch, w_k).astype(f32)
    v = jnp.einsum('blhc,hcd->bhld', xm.reshape(bsz, l, MLSTM_HEADS, MLSTM_HEAD_V), w_v).astype(f32)
    li = (jnp.einsum('blc,dch->dbhl', xc, w_igate) + b_igate[:, None, :, None]).astype(f32)
    lf = jax.nn.log_sigmoid((jnp.einsum('blc,dch->dbhl', xc, w_fgate)
                             + b_fgate[:, None, :, None]).astype(f32))
    pad4 = ((0, 0), (0, 0), (PAD_FRONT, 0), (0, 0))
    pad3 = ((0, 0), (0, 0), (PAD_FRONT, 0))
    q, k, v = jnp.pad(q, pad4), jnp.pad(k, pad4), jnp.pad(v, pad4)
    li_f, li_b = jnp.pad(li[0], pad3, constant_values=NEG_BIG), jnp.pad(li[1], pad3, constant_values=NEG_BIG)
    lf_f, lf_b = jnp.pad(lf[0], pad3), jnp.pad(lf[1], pad3)
    flip = lambda a: jnp.flip(a, axis=2)
    h_f = mlstm_chunkwise(q, k, v, li_f, lf_f)
    h_b = flip(mlstm_chunkwise(flip(q), flip(k), flip(v), flip(li_b), flip(lf_b)))
    cell = (h_f + h_b)[:, :, PAD_FRONT:].transpose(0, 2, 1, 3)
    cell = rms_norm(cell, head_norm.reshape(MLSTM_HEADS, MLSTM_HEAD_V)).reshape(bsz, l, MLSTM_WIDTH)
    o = jax.nn.sigmoid(xc @ w_ogate + b_ogate)
    hh = o * cell.astype(xc.dtype) + skip * xc
    return (hh * jax.nn.silu(z)) @ w_out


def setup_inputs(seed: int = 0) -> dict:
    key = jax.random.key(seed)
    ks = iter(jax.random.split(key, 48))
    nrm = lambda shape, scale: jax.random.normal(next(ks), shape, jnp.float32) * scale
    gain = lambda shape: 1.0 + nrm(shape, 0.05)
    a_im0 = jnp.pi * jnp.arange(S5_STATE, dtype=jnp.float32)
    return {
        'x': nrm((BATCH, SEQ, D_MODEL), 1.0),
        'meta_tokens': nrm((N_META, D_MODEL), 1.0),
        'norm_pre': gain((DEPTH, D_MODEL)),
        'norm_post': gain((DEPTH, D_MODEL)),
        'w_in_even': nrm((N_EVEN, D_MODEL, EVEN_IN_WIDTH), D_MODEL ** -0.5),
        'q_norm': gain((N_EVEN, HEAD_DIM)),
        'k_norm': gain((N_EVEN, HEAD_DIM)),
        'ssm_a_re': -0.5 + nrm((N_EVEN, 2, S5_GROUPS, S5_STATE), 0.01),
        'ssm_a_im': a_im0 + nrm((N_EVEN, 2, S5_GROUPS, S5_STATE), 0.01),
        'ssm_log_dt': jax.random.uniform(next(ks), (N_EVEN, 2, S5_GROUPS), jnp.float32,
                                         math.log(1e-3), math.log(1e-1)),
        'ssm_b_re': nrm((N_EVEN, 2, S5_GROUPS, S5_STATE, S5_GROUP), (2 * S5_GROUP) ** -0.5),
        'ssm_b_im': nrm((N_EVEN, 2, S5_GROUPS, S5_STATE, S5_GROUP), (2 * S5_GROUP) ** -0.5),
        'ssm_c_re': nrm((N_EVEN, 2, S5_GROUPS, S5_GROUP, S5_STATE), S5_STATE ** -0.5),
        'ssm_c_im': nrm((N_EVEN, 2, S5_GROUPS, S5_GROUP, S5_STATE), S5_STATE ** -0.5),
        'ssm_d': nrm((N_EVEN, S5_WIDTH), 1.0),
        'w_glu': nrm((N_EVEN, S5_WIDTH, S5_WIDTH), S5_WIDTH ** -0.5),
        'b_glu': nrm((N_EVEN, S5_WIDTH), 0.02),
        'w_out_even': nrm((N_EVEN, ATTN_WIDTH + S5_WIDTH, D_MODEL), (ATTN_WIDTH + S5_WIDTH) ** -0.5),
        'w_in_odd': nrm((N_ODD, D_MODEL, 2 * MLSTM_WIDTH), D_MODEL ** -0.5),
        'conv_w': nrm((N_ODD, CONV_W, MLSTM_WIDTH), CONV_W ** -0.5),
        'conv_b': nrm((N_ODD, MLSTM_WIDTH), 0.02),
        'w_q': nrm((N_ODD, MLSTM_HEADS, MLSTM_HEAD_V, MLSTM_HEAD_QK), MLSTM_HEAD_V ** -0.5),
        'w_k': nrm((N_ODD, MLSTM_HEADS, MLSTM_HEAD_V, MLSTM_HEAD_QK), MLSTM_HEAD_V ** -0.5),
        'w_v': nrm((N_ODD, MLSTM_HEADS, MLSTM_HEAD_V, MLSTM_HEAD_V), MLSTM_HEAD_V ** -0.5),
        'w_igate': nrm((N_ODD, 2, MLSTM_WIDTH, MLSTM_HEADS), MLSTM_WIDTH ** -0.5),
        'b_igate': nrm((N_ODD, 2, MLSTM_HEADS), 0.1),
        'w_fgate': nrm((N_ODD, 2, MLSTM_WIDTH, MLSTM_HEADS), MLSTM_WIDTH ** -0.5),
        'b_fgate': jnp.linspace(3.0, 6.0, MLSTM_HEADS, dtype=jnp.float32) + nrm((N_ODD, 2, MLSTM_HEADS), 0.1),
        'w_ogate': nrm((N_ODD, MLSTM_WIDTH, MLSTM_WIDTH), MLSTM_WIDTH ** -0.5),
        'b_ogate': nrm((N_ODD, MLSTM_WIDTH), 0.02),
        'head_norm': gain((N_ODD, MLSTM_WIDTH)),
        'mlstm_skip': gain((N_ODD, MLSTM_WIDTH)),
        'w_out_odd': nrm((N_ODD, MLSTM_WIDTH, D_MODEL), MLSTM_WIDTH ** -0.5),
    }


def reference(x, meta_tokens, norm_pre, norm_post, w_in_even, q_norm, k_norm, ssm_a_re, ssm_a_im,
              ssm_log_dt, ssm_b_re, ssm_b_im, ssm_c_re, ssm_c_im, ssm_d, w_glu, b_glu, w_out_even,
              w_in_odd, conv_w, conv_b, w_q, w_k, w_v, w_igate, b_igate, w_fgate, b_fgate,
              w_ogate, b_ogate, head_norm, mlstm_skip, w_out_odd):
    bsz, n_real, _ = x.shape
    meta = jnp.broadcast_to(meta_tokens[None].astype(x.dtype), (bsz, N_META, D_MODEL))
    h_res = jnp.concatenate([meta, x], axis=1)
    tabs = axial_rope_tables(n_real)
    for layer in range(DEPTH):
        i = layer // 2
        h = rms_norm(h_res, norm_pre[layer])
        if layer % 2 == 0:
            y = attn_s5_layer(h, tabs, w_in_even[i], q_norm[i], k_norm[i], ssm_a_re[i], ssm_a_im[i],
                              ssm_log_dt[i], ssm_b_re[i], ssm_b_im[i], ssm_c_re[i], ssm_c_im[i],
                              ssm_d[i], w_glu[i], b_glu[i], w_out_even[i])
        else:
            y = mlstm_layer(h, w_in_odd[i], conv_w[i], conv_b[i], w_q[i], w_k[i], w_v[i],
                            w_igate[i], b_igate[i], w_fgate[i], b_fgate[i], w_ogate[i], b_ogate[i],
                            head_norm[i], mlstm_skip[i], w_out_odd[i])
        h_res = h_res + rms_norm(y, norm_post[layer])
    return h_res[:, N_META:]
```

```cpp
#include <hip/hip_runtime.h>
#include <cstdio>
#include <cstdint>

#define DI __device__ __forceinline__
#define GAS __attribute__((address_space(1)))
#define LAS __attribute__((address_space(3)))
typedef unsigned short bf16;
typedef short bf16x8 __attribute__((ext_vector_type(8)));
typedef float f32x4 __attribute__((ext_vector_type(4)));
typedef float f32x2 __attribute__((ext_vector_type(2)));
typedef float f32x16 __attribute__((ext_vector_type(16)));
typedef unsigned u32x4 __attribute__((ext_vector_type(4)));
typedef unsigned u32x2 __attribute__((ext_vector_type(2)));
typedef short s16x4 __attribute__((ext_vector_type(4)));

constexpr int DM = 1024, SEQ = 16384, NMETA = 16, LTOK = 16400;
constexpr int KVROWS = 16448;
constexpr int NPOS = 16448;
constexpr int NWAVES = 8, NTHR = 512;
constexpr float EPS = 1e-6f;

DI float bf2f(bf16 b) { return __uint_as_float(((unsigned)b) << 16); }
DI float bflo(unsigned w) { return __uint_as_float(w << 16); }
DI float bfhi(unsigned w) { return __uint_as_float(w & 0xffff0000u); }
typedef __bf16 bf16x2_t __attribute__((ext_vector_type(2)));
DI unsigned cvt_pk_bf16(float lo, float hi) { bf16x2_t v = {(__bf16)lo, (__bf16)hi}; return __builtin_bit_cast(unsigned, v); }
DI bf16 f2bf(float f) { return (bf16)(cvt_pk_bf16(f, 0.f) & 0xffffu); }
DI float fexp(float x) { return __builtin_amdgcn_exp2f(x * 1.4426950408889634f); }
DI float silu_f(float x) { return x * __builtin_amdgcn_rcpf(1.f + __expf(-x)); }
DI float sigmoid_f(float x) { return __builtin_amdgcn_rcpf(1.f + __expf(-x)); }
DI float gelu_tanh_f(float v) { const float z = 0.7978845608028654f * (v + 0.044715f * v * v * v); const float t = 1.f - 2.f * __builtin_amdgcn_rcpf(1.f + __expf(2.f * z)); return 0.5f * v * (1.f + t); }
DI float wave_sum(float v) {
#pragma unroll
    for (int o = 1; o < 64; o <<= 1) v += __shfl_xor(v, o);
    return v;
}
DI void unpack8(u32x4 w, float (&v)[8]) { v[0] = bflo(w.x); v[1] = bfhi(w.x); v[2] = bflo(w.y); v[3] = bfhi(w.y); v[4] = bflo(w.z); v[5] = bfhi(w.z); v[6] = bflo(w.w); v[7] = bfhi(w.w); }
DI u32x4 pack8(const float (&v)[8]) { u32x4 w; w.x = cvt_pk_bf16(v[0], v[1]); w.y = cvt_pk_bf16(v[2], v[3]); w.z = cvt_pk_bf16(v[4], v[5]); w.w = cvt_pk_bf16(v[6], v[7]); return w; }
DI u32x4 pack8v(f32x4 a, f32x4 b) { u32x4 w; w.x = cvt_pk_bf16(a[0], a[1]); w.y = cvt_pk_bf16(a[2], a[3]); w.z = cvt_pk_bf16(b[0], b[1]); w.w = cvt_pk_bf16(b[2], b[3]); return w; }
template <class T> DI void lnd(T*& p) { GAS T* q = (GAS T*)p; asm volatile("" : "+s"(q)); p = (T*)q; }
#define LDS_WAIT() asm volatile("s_waitcnt lgkmcnt(0)" ::: "memory")
#define VM_WAIT() asm volatile("s_waitcnt vmcnt(0)" ::: "memory")
#define MFMA16(a, b, c) __builtin_amdgcn_mfma_f32_16x16x32_bf16((a), (b), (c), 0, 0, 0)
#define MFMA32(a, b, c) __builtin_amdgcn_mfma_f32_32x32x16_bf16((a), (b), (c), 0, 0, 0)

namespace pg8 {
constexpr int BM = 256, BK = 64, HALF = 128, HTB = HALF * BK * 2, STAGE_BYTES = 8 * HTB, NXCD = 8, WGM = 8;
__host__ __device__ __forceinline__ int lds_byte(int r, int c) { const int st = (r >> 4) * 2 + (c >> 5), rr = r & 15, cc = c & 31, ob = rr * 64 + cc * 2; return st * 1024 + (ob ^ (((ob >> 9) & 1) << 5)); }
__host__ __device__ __forceinline__ void stage_rc(int b, int& R, int& C) { const int st = b / 1024, sb = b % 1024, swz = sb ^ (((sb >> 9) & 1) << 5); R = (st >> 1) * 16 + swz / 64; C = (st & 1) * 32 + (swz % 64) / 2; }
__host__ __device__ __forceinline__ int perm32(int rho) { const int n = rho >> 4, i = rho & 15; return 8 * (i >> 2) + 4 * n + (i & 3); }

struct Unit { int pm, pn; };
struct Gemm { const bf16* A; const bf16* Bt; };

template <int NN> struct StaticOrder {
    static constexpr int nM = 64, nN = NN, nwg = nM * nN;
    int G, c;
    __device__ void init(int G_, int c_) { G = G_; c = c_; }
    __device__ bool next(int i, Unit& u) const {
        const long L = (long)i * G + c; if (L >= nwg) return false;
        int wgid = (int)L; { const int q = nwg / NXCD, r = nwg % NXCD, xcd = wgid % NXCD, off = wgid / NXCD; wgid = (xcd < r ? xcd * (q + 1) : r * (q + 1) + (xcd - r) * q) + off; }
        const int nig = WGM * nN, gid = wgid / nig, fm = gid * WGM, gsz = (nM - fm) < WGM ? (nM - fm) : WGM;
        u.pm = fm + ((wgid % nig) % gsz); u.pn = (wgid % nig) / gsz; return true;
    }
};

template <class F> struct EpiT {
    static constexpr bool PERM = true;
    F f;
    DI void operator()(const f32x4 (&acc)[2][2][4][2], const Unit& u, int wr, int wc, int fr, int fq) const {
        const int row0 = u.pm * BM + wr * 64 + fr, col0 = u.pn * BM + wc * 32 + 8 * fq;
#pragma unroll
        for (int ai = 0; ai < 2; ++ai)
#pragma unroll
            for (int m = 0; m < 4; ++m)
#pragma unroll
                for (int bj = 0; bj < 2; ++bj) f.op8(row0 + ai * HALF + m * 16, col0 + bj * HALF, acc[ai][bj][m][0], acc[ai][bj][m][1]);
    }
};

template <class Epi, class Sched, int LDA, int LDB, int KK, int APN>
DI void gemm_phase(LAS unsigned char* lds, const Gemm g, const Sched& S, const Epi& E) {
    int tid = threadIdx.x; asm volatile("" : "+v"(tid));
    const int wid = __builtin_amdgcn_readfirstlane(tid >> 6), lane = tid & 63, wr = wid >> 2, wc = wid & 3, fr = lane & 15, fq = lane >> 4;
    constexpr int nt = KK / BK;
    unsigned voffA[2], voffB[2];
#pragma unroll
    for (int i = 0; i < 2; ++i) { int R, C; stage_rc(tid * 16 + i * 8192, R, C); const int Rb = Epi::PERM ? ((R & ~31) + perm32(R & 31)) : R;
        voffA[i] = (unsigned)(R * LDA + C) * 2u; voffB[i] = (unsigned)(Rb * LDB + C) * 2u; }
    constexpr size_t kstep = (size_t)(BK * 2);
    constexpr size_t hstepA = (size_t)HALF * LDA * 2, hstepB = (size_t)HALF * LDB * 2;
    constexpr size_t tstepA = 2 * hstepA, tstepB = 2 * hstepB;
    constexpr size_t pnstepA = (size_t)APN * 2;
    const unsigned ldsw = (unsigned)wid * 1024u;
    const int aoff = lds_byte(wr * 64 + fr, fq * 8), boff = lds_byte(wc * 32 + fr, fq * 8);
#define PG8_SA(b, h) (((b) * 2 + (h)) * HTB)
#define PG8_SB(b, h) ((4 + (b) * 2 + (h)) * HTB)
#define PG8_STAGE(bufoff, gbase, voff) do { _Pragma("unroll") for (int _i = 0; _i < 2; ++_i) \
        __builtin_amdgcn_global_load_lds((const unsigned*)((const char*)(gbase) + (voff)[_i]), (LAS unsigned*)(lds + (bufoff) + ldsw + _i * 8192), 16, 0, 0); } while (0)
#define PG8_LDA(dst, b, h) do { _Pragma("unroll") for (int m = 0; m < 4; ++m) _Pragma("unroll") for (int k = 0; k < 2; ++k) dst[m][k] = *(const LAS bf16x8*)(lds + PG8_SA(b, h) + aoff + m * 2048 + k * 1024); } while (0)
#define PG8_LDB(dst, b, h) do { _Pragma("unroll") for (int n = 0; n < 2; ++n) _Pragma("unroll") for (int k = 0; k < 2; ++k) dst[n][k] = *(const LAS bf16x8*)(lds + PG8_SB(b, h) + boff + n * 2048 + k * 1024); } while (0)
#define PG8_MMA(ai, bj, At, Bt) do { __builtin_amdgcn_s_setprio(1); _Pragma("unroll") for (int m = 0; m < 4; ++m) _Pragma("unroll") for (int n = 0; n < 2; ++n) _Pragma("unroll") for (int k = 0; k < 2; ++k) \
        acc[ai][bj][m][n] = __builtin_amdgcn_mfma_f32_16x16x32_bf16(Bt[n][k], At[m][k], acc[ai][bj][m][n], 0, 0, 0); __builtin_amdgcn_s_setprio(0); } while (0)
#define PG8_WAIT_V(n) asm volatile("s_waitcnt vmcnt(" #n ")" ::: "memory")
#define PG8_WAIT_L(n) asm volatile("s_waitcnt lgkmcnt(" #n ")" ::: "memory")
#define PG8_BAR __builtin_amdgcn_s_barrier()
#define PG8_SCHED __builtin_amdgcn_sched_barrier(0)
    Unit cur, nxt; int ui = 0;
    if (!S.next(0, cur)) return;
    const bf16* gA = g.A; const bf16* gB = g.Bt;
    asm volatile("" : "+s"(gA), "+s"(gB));
    f32x4 acc[2][2][4][2];
#pragma unroll
    for (int a = 0; a < 2; ++a)
#pragma unroll
        for (int b = 0; b < 2; ++b)
#pragma unroll
            for (int m = 0; m < 4; ++m)
#pragma unroll
                for (int n = 0; n < 2; ++n) acc[a][b][m][n] = (f32x4){0.f, 0.f, 0.f, 0.f};
    bf16x8 At[4][2], B0[2][2], B1[2][2];
    const char* cA = (const char*)gA + (size_t)cur.pm * tstepA + (size_t)cur.pn * pnstepA; const char* cB = (const char*)gB + (size_t)cur.pn * tstepB;
    PG8_STAGE(PG8_SB(0, 0), cB, voffB); PG8_STAGE(PG8_SB(0, 1), cB + hstepB, voffB); PG8_STAGE(PG8_SA(0, 0), cA, voffA); PG8_STAGE(PG8_SA(0, 1), cA + hstepA, voffA);
    if (wr == 1) PG8_BAR;
    PG8_WAIT_V(2); PG8_BAR;
    PG8_STAGE(PG8_SB(1, 0), cB + kstep, voffB); PG8_STAGE(PG8_SA(1, 0), cA + kstep, voffA); PG8_STAGE(PG8_SB(1, 1), cB + hstepB + kstep, voffB);
    PG8_WAIT_V(6); PG8_BAR;
    for (;;) {
        const bool has_next = S.next(ui + 1, nxt);
        const char* nA = has_next ? (const char*)gA + (size_t)nxt.pm * tstepA + (size_t)nxt.pn * pnstepA : cA; const char* nB = has_next ? (const char*)gB + (size_t)nxt.pn * tstepB : cB;
#pragma unroll 1
        for (int t = 0; t < nt; t += 2) {
            const bool last = (t == nt - 2);
            const char* a1 = cA + (size_t)(t + 1) * kstep;
            const char* a2 = last ? nA : cA + (size_t)(t + 2) * kstep; const char* b2 = last ? nB : cB + (size_t)(t + 2) * kstep;
            const char* a3 = a2 + kstep; const char* b3 = b2 + kstep;
            PG8_LDB(B0, 0, 0); PG8_LDB(B1, 0, 1); PG8_SCHED; PG8_LDA(At, 0, 0); PG8_STAGE(PG8_SA(1, 1), a1 + hstepA, voffA);
            PG8_WAIT_V(8); PG8_WAIT_L(0); PG8_BAR; PG8_MMA(0, 0, At, B0); PG8_MMA(0, 1, At, B1); PG8_BAR; PG8_SCHED;
            PG8_LDA(At, 0, 1); PG8_STAGE(PG8_SB(0, 0), b2, voffB); PG8_STAGE(PG8_SB(0, 1), b2 + hstepB, voffB); PG8_STAGE(PG8_SA(0, 0), a2, voffA);
            PG8_WAIT_V(8); PG8_WAIT_L(0); PG8_BAR; PG8_MMA(1, 0, At, B0); PG8_MMA(1, 1, At, B1); PG8_BAR; PG8_SCHED;
            PG8_LDB(B0, 1, 0); PG8_LDB(B1, 1, 1); PG8_SCHED; PG8_LDA(At, 1, 0); PG8_STAGE(PG8_SA(0, 1), a2 + hstepA, voffA);
            PG8_WAIT_V(8); PG8_WAIT_L(0); PG8_BAR; PG8_MMA(0, 0, At, B0); PG8_MMA(0, 1, At, B1); PG8_BAR; PG8_SCHED;
            PG8_LDA(At, 1, 1); PG8_STAGE(PG8_SB(1, 0), b3, voffB); PG8_STAGE(PG8_SB(1, 1), b3 + hstepB, voffB); PG8_STAGE(PG8_SA(1, 0), a3, voffA);
            PG8_WAIT_V(8); PG8_WAIT_L(0); PG8_BAR; PG8_MMA(1, 0, At, B0); PG8_MMA(1, 1, At, B1); PG8_BAR; PG8_SCHED;
        }
        if (wr == 0) PG8_BAR;
        E(acc, cur, wr, wc, fr, fq);
        if (!has_next) break;
#pragma unroll
        for (int a = 0; a < 2; ++a)
#pragma unroll
            for (int b = 0; b < 2; ++b)
#pragma unroll
                for (int m = 0; m < 4; ++m)
#pragma unroll
                    for (int n = 0; n < 2; ++n) acc[a][b][m][n] = (f32x4){0.f, 0.f, 0.f, 0.f};
        cur = nxt; cA = nA; cB = nB; ++ui;
        if (wr == 1) PG8_BAR;
    }
    PG8_WAIT_V(0);
    PG8_BAR;
#undef PG8_SA
#undef PG8_SB
#undef PG8_STAGE
#undef PG8_LDA
#undef PG8_LDB
#undef PG8_MMA
#undef PG8_WAIT_V
#undef PG8_WAIT_L
#undef PG8_BAR
#undef PG8_SCHED
}
}

template <class F>
DI void gemm_tail(const bf16* A, int lda, const bf16* Bt, int ldb, int K, int N, int a_pn_step, const F& f, int row_base, int gw, int ngw, int lane) {
    const int i16 = lane & 15, kq = lane >> 4;
    for (int task = gw; task < N / 32; task += ngw) {
        const int n0 = task * 32, pn = n0 >> 8;
        const bf16* ap = A + (size_t)i16 * lda + (size_t)pn * a_pn_step + 8 * kq;
        const bf16* b0p = Bt + (size_t)(n0 + 8 * (i16 >> 2) + (i16 & 3)) * ldb + 8 * kq;
        const bf16* b1p = b0p + (size_t)4 * ldb;
        f32x4 acc0 = {0.f, 0.f, 0.f, 0.f}, acc1 = {0.f, 0.f, 0.f, 0.f};
        for (int k0 = 0; k0 < K; k0 += 32) {
            const bf16x8 a = *(const bf16x8*)(ap + k0), b0 = *(const bf16x8*)(b0p + k0), b1 = *(const bf16x8*)(b1p + k0);
            acc0 = MFMA16(b0, a, acc0); acc1 = MFMA16(b1, a, acc1);
        }
        f.op8(row_base + i16, n0 + 8 * kq, acc0, acc1);
    }
}

constexpr size_t SLOT = (size_t)LTOK * 1024 * 2;
constexpr size_t WS_SLOT0 = 0;
constexpr size_t WS_WREG = 7 * SLOT;
constexpr size_t WREG_BYTES = 23199744;
constexpr size_t WS_MISC = WS_WREG + WREG_BYTES;
constexpr size_t MS_CTL = 0;
constexpr size_t MS_GI = 65536;
constexpr size_t MS_GF = MS_GI + (size_t)2 * 8 * NPOS * 4;
constexpr size_t MS_RSTD = MS_GF + (size_t)2 * 8 * NPOS * 4;
constexpr size_t MS_CELLM = MS_RSTD + (size_t)LTOK * 8 * 4;
constexpr size_t MS_VM = MS_CELLM + 16 * 2048 * 2;
constexpr size_t MS_ROPE = MS_VM + 16 * 2048 * 2;
constexpr size_t MS_END = MS_ROPE + 256 * 32 * 8;
constexpr size_t WS_NEED = WS_MISC + MS_END;
constexpr size_t WE_IN = 0, WE_GLU = WE_IN + (size_t)4608 * 1024 * 2, WE_OUT = WE_GLU + (size_t)1024 * 1024 * 2;
constexpr size_t WO_IN = 0, WO_Z = WO_IN + (size_t)2048 * 1024 * 2, WO_QK = WO_Z + (size_t)2048 * 1024 * 2, WO_V = WO_QK + (size_t)2048 * 256 * 2,
                 WO_G = WO_V + (size_t)2048 * 256 * 2, WO_OG = WO_G + (size_t)32 * 2048 * 2, WO_OUT = WO_OG + (size_t)2048 * 2048 * 2;
static_assert(WO_OUT + (size_t)1024 * 2048 * 2 == WREG_BYTES, "odd weight region");
constexpr size_t DO_EX = 0;
constexpr size_t DO_HCAT = DO_EX + (size_t)1025 * 64 * 256 * 2;
constexpr size_t DO_MG = DO_HCAT + (size_t)64 * 256 * 256 * 2;
constexpr size_t DO_APOW = DO_MG + (size_t)64 * 256 * 512 * 2;
constexpr size_t DO_BB = DO_APOW + (size_t)2 * 64 * 64 * 17 * 8;
constexpr size_t DO_KTAB = DO_BB + (size_t)2 * 64 * 64 * 16 * 8;
static_assert(DO_KTAB + (size_t)2 * 64 * 16 * 256 * 4 <= (size_t)SEQ * 1024 * 4, "d_out scratch map");

constexpr int CW_BAR = 1024;
constexpr int CW_CHK = 8192;
constexpr int LDS_TOTAL = 160 * 1024;
constexpr int LDS_MISC = LDS_TOTAL - 64;

#define XB_TMO      128
#define XB_XCNT(j)  (256  + 64 * (j))
#define XB_XSUB(j)  (1280 + 64 * (j))
#define XB_XGEN(j)  (2304 + 64 * (j))
#define XB_TOP      3328
#define XB_TOPGEN   3392
#define XCD_BAR_WORDS 3456
#define XB_SPIN_CAP (1u << 21)
DI unsigned xb_ld(unsigned* p)              { return __hip_atomic_load(p, __ATOMIC_RELAXED, __HIP_MEMORY_SCOPE_AGENT); }
DI unsigned xb_add(unsigned* p, unsigned v) { return __hip_atomic_fetch_add(p, v, __ATOMIC_RELAXED, __HIP_MEMORY_SCOPE_AGENT); }
DI unsigned xb_xcc_id() { return (unsigned)__builtin_amdgcn_s_getreg((3 << 11) | 20) & 0xFu; }
#define XB_SPIN(cond, bar) do { unsigned _sp = 0; while (cond) { __builtin_amdgcn_s_sleep(1); \
    if ((++_sp & 255u) == 0u) { if (xb_ld(&(bar)[XB_TMO])) break; if (_sp > XB_SPIN_CAP) { atomicAdd(&(bar)[XB_TMO], 1u); break; } } } } while (0)
struct XcdBarrier { unsigned* bar; unsigned x; volatile LAS unsigned* st; };
DI XcdBarrier xcd_barrier_post(unsigned* bar, volatile LAS unsigned* st) {
    XcdBarrier b; b.bar = bar; b.x = xb_xcc_id(); b.st = st;
    if (threadIdx.x == 0) (void)xb_add(&bar[XB_XCNT(b.x)], 1u);
    return b;
}
DI void xcd_barrier_complete(unsigned* bar, unsigned x, unsigned& nloc, unsigned& nx) {
    const unsigned G = gridDim.x * gridDim.y * gridDim.z;
    unsigned sum, cnt, mine, sp = 0u;
    for (;;) {
        sum = 0u; cnt = 0u; mine = 0u;
#pragma unroll
        for (unsigned j = 0; j < 16; ++j) { const unsigned c = xb_ld(&bar[XB_XCNT(j)]); sum += c; cnt += (c > 0u) ? 1u : 0u; mine = (j == x) ? c : mine; }
        if (sum == G) break;
        __builtin_amdgcn_s_sleep(1);
        if ((++sp & 255u) == 0u) { if (xb_ld(&bar[XB_TMO])) break; if (sp > XB_SPIN_CAP) { atomicAdd(&bar[XB_TMO], 1u); break; } }
    }
    nloc = mine > 0u ? mine : 1u; nx = cnt > 0u ? cnt : 1u;
}
DI void xcd_barrier(const XcdBarrier& b) {
    asm volatile("s_waitcnt vmcnt(0)" ::: "memory");
    __syncthreads();
    if (threadIdx.x == 0) {
        unsigned* bar = b.bar;
        __builtin_amdgcn_s_waitcnt(0);
        unsigned nloc = b.st[0], nx = b.st[1];
        if (nloc == 0u) { xcd_barrier_complete(bar, b.x, nloc, nx); b.st[0] = nloc; b.st[1] = nx; }
        const unsigned old = xb_add(&bar[XB_XSUB(b.x)], 1u);
        const unsigned gen = old / nloc;
        if (old + 1u == (gen + 1u) * nloc) {
            __builtin_amdgcn_fence(__ATOMIC_RELEASE, "agent");
            asm volatile("s_waitcnt vmcnt(0)" ::: "memory");
            const unsigned og = xb_add(&bar[XB_TOP], 1u);
            const unsigned tg = og / nx;
            if (og + 1u == (tg + 1u) * nx) xb_add(&bar[XB_TOPGEN], 1u);
            else XB_SPIN(xb_ld(&bar[XB_TOPGEN]) == tg, bar);
            __builtin_amdgcn_fence(__ATOMIC_ACQUIRE, "agent");
            xb_add(&bar[XB_XGEN(b.x)], 1u);
            asm volatile("s_waitcnt vmcnt(0)" ::: "memory");
        } else {
            XB_SPIN(xb_ld(&bar[XB_XGEN(b.x)]) == gen, bar);
            __builtin_amdgcn_fence(__ATOMIC_ACQUIRE, "agent");
            asm volatile("s_waitcnt vmcnt(0)" ::: "memory");
        }
    }
    __syncthreads();
}

struct Params { const float* in[33]; float* out; unsigned char* ws; int ph_lo, ph_hi, use_bar, pad; };
enum { I_X = 0, I_META, I_NPRE, I_NPOST, I_WINE, I_QN, I_KN, I_ARE, I_AIM, I_LDT, I_BRE, I_BIM, I_CRE, I_CIM, I_SSMD, I_WGLU, I_BGLU, I_WOUTE,
       I_WINO, I_CONVW, I_CONVB, I_WQ, I_WK, I_WV, I_WIG, I_BIG, I_WFG, I_BFG, I_WOG, I_BOG, I_HN, I_SKIP, I_WOUTO };

struct Ctx {
    LAS unsigned char* lds;
    int tid, lane, wave, G, bid;
    int gw, ngw;
    int gws;
    const float* const* in; float* out; unsigned char* ws; unsigned char* dob;
    DI bf16* slot(int i) const { return (bf16*)(ws + WS_SLOT0 + (size_t)i * SLOT); }
    DI Ctx fresh() const { Ctx P = *this; asm volatile("" : "+v"(P.tid)); P.lane = P.tid & 63; P.wave = __builtin_amdgcn_readfirstlane(P.tid >> 6);
        asm volatile("" : "+s"(P.G)); P.ngw = P.G * NWAVES; P.gw = P.bid * NWAVES + P.wave; P.gws = P.wave * P.G + P.bid; lnd(P.ws); lnd(P.dob); lnd(P.out); return P; }
    DI unsigned char* wreg() const { return ws + WS_WREG; }
    DI unsigned char* misc() const { return ws + WS_MISC; }
};

DI void transpose_item(const float* W, int ldw, int N, bf16* WT, int ldo, int row_off, LAS float* scr, int item, int lane) {
    const int nblk = N / 32, kb = item / nblk, nb = item % nblk, k0 = 64 * kb, n0 = 32 * nb;
#pragma unroll 8
    for (int i = 0; i < 32; ++i) { const int kk = 2 * i + (lane >> 5); scr[kk * 33 + (lane & 31)] = W[(size_t)(k0 + kk) * ldw + n0 + (lane & 31)]; }
    LDS_WAIT(); asm volatile("" ::: "memory");
    const int c = lane & 7;
#pragma unroll
    for (int j = 0; j < 4; ++j) { const int n = (lane >> 3) + 8 * j; const LAS float* s = scr + (8 * c) * 33 + n;
        u32x4 o; o.x = cvt_pk_bf16(s[0 * 33], s[1 * 33]); o.y = cvt_pk_bf16(s[2 * 33], s[3 * 33]); o.z = cvt_pk_bf16(s[4 * 33], s[5 * 33]); o.w = cvt_pk_bf16(s[6 * 33], s[7 * 33]);
        *(u32x4*)(WT + (size_t)(row_off + n0 + n) * ldo + k0 + 8 * c) = o; }
    LDS_WAIT(); asm volatile("" ::: "memory");
}

DI void convert_even_weights(const Ctx& C, int li) {
    LAS float* scr = (LAS float*)(C.lds + C.wave * 8704);
    unsigned char* wr = C.wreg();
    { const int n = (1024 / 64) * (4608 / 32); for (int it = C.gw; it < n; it += C.ngw) transpose_item(C.in[I_WINE] + (size_t)li * 1024 * 4608, 4608, 4608, (bf16*)(wr + WE_IN), 1024, 0, scr, it, C.lane); }
    { const int n = (1024 / 64) * (1024 / 32); for (int it = C.gw; it < n; it += C.ngw) transpose_item(C.in[I_WGLU] + (size_t)li * 1024 * 1024, 1024, 1024, (bf16*)(wr + WE_GLU), 1024, 0, scr, it, C.lane); }
    { const int n = (2048 / 64) * (1024 / 32); for (int it = C.gw; it < n; it += C.ngw) transpose_item(C.in[I_WOUTE] + (size_t)li * 2048 * 1024, 1024, 1024, (bf16*)(wr + WE_OUT), 2048, 0, scr, it, C.lane); }
}
DI void convert_odd_weights(const Ctx& C, int li) {
    LAS float* scr = (LAS float*)(C.lds + C.wave * 8704);
    unsigned char* wr = C.wreg();
    const float* win = C.in[I_WINO] + (size_t)li * 1024 * 4096;
    { const int n = (1024 / 64) * (2048 / 32);
      for (int it = C.gw; it < n; it += C.ngw) transpose_item(win, 4096, 2048, (bf16*)(wr + WO_IN), 1024, 0, scr, it, C.lane);
      for (int it = C.gw; it < n; it += C.ngw) transpose_item(win + 2048, 4096, 2048, (bf16*)(wr + WO_Z), 1024, 0, scr, it, C.lane); }
    { const int nq = (256 / 64) * (128 / 32), nv = (256 / 64) * (256 / 32);
      for (int it = C.gw; it < 8 * nq; it += C.ngw) { const int h = it / nq, r = it % nq;
          transpose_item(C.in[I_WQ] + ((size_t)li * 8 + h) * 256 * 128, 128, 128, (bf16*)(wr + WO_QK), 256, h * 256, scr, r, C.lane);
          transpose_item(C.in[I_WK] + ((size_t)li * 8 + h) * 256 * 128, 128, 128, (bf16*)(wr + WO_QK), 256, h * 256 + 128, scr, r, C.lane); }
      for (int it = C.gw; it < 8 * nv; it += C.ngw) { const int h = it / nv, r = it % nv;
          transpose_item(C.in[I_WV] + ((size_t)li * 8 + h) * 256 * 256, 256, 256, (bf16*)(wr + WO_V), 256, h * 256, scr, r, C.lane); } }
    { const int n = (2048 / 64) * (2048 / 32);
      for (int it = C.gw; it < n; it += C.ngw) transpose_item(C.in[I_WOG] + (size_t)li * 2048 * 2048, 2048, 2048, (bf16*)(wr + WO_OG), 2048, 0, scr, it, C.lane); }
    { const int n = (2048 / 64) * (1024 / 32);
      for (int it = C.gw; it < n; it += C.ngw) transpose_item(C.in[I_WOUTO] + (size_t)li * 2048 * 1024, 1024, 1024, (bf16*)(wr + WO_OUT), 2048, 0, scr, it, C.lane); }
    { bf16* wg = (bf16*)(wr + WO_G); const float* wi = C.in[I_WIG] + (size_t)li * 2 * 2048 * 8; const float* wf = C.in[I_WFG] + (size_t)li * 2 * 2048 * 8;
      for (int i = C.gw * 64 + C.lane; i < 32 * 2048; i += C.ngw * 64) { const int n = i >> 11, c = i & 2047, ty = n >> 4, d = (n >> 3) & 1, h = n & 7;
          wg[i] = f2bf((ty ? wf : wi)[((size_t)d * 2048 + c) * 8 + h]); } }
}

DI void load_row_bf16(const bf16* p, int lane, float (&v)[16]) {
    const u32x4 a = *(const u32x4*)(p + 8 * lane), b = *(const u32x4*)(p + 512 + 8 * lane);
    float t[8]; unpack8(a, t);
#pragma unroll
    for (int i = 0; i < 8; ++i) v[i] = t[i];
    unpack8(b, t);
#pragma unroll
    for (int i = 0; i < 8; ++i) v[8 + i] = t[i];
}
DI void load_row_f32(const float* p, int lane, float (&v)[16]) {
    const f32x4 a = *(const f32x4*)(p + 8 * lane), b = *(const f32x4*)(p + 8 * lane + 4), c = *(const f32x4*)(p + 512 + 8 * lane), d = *(const f32x4*)(p + 512 + 8 * lane + 4);
#pragma unroll
    for (int i = 0; i < 4; ++i) { v[i] = a[i]; v[4 + i] = b[i]; v[8 + i] = c[i]; v[12 + i] = d[i]; }
}
DI void store_row_bf16(bf16* p, int lane, const float (&v)[16]) {
    float t[8];
#pragma unroll
    for (int i = 0; i < 8; ++i) t[i] = v[i];
    *(u32x4*)(p + 8 * lane) = pack8(t);
#pragma unroll
    for (int i = 0; i < 8; ++i) t[i] = v[8 + i];
    *(u32x4*)(p + 512 + 8 * lane) = pack8(t);
}
DI void round_bf16_16(float (&v)[16]) {
#pragma unroll
    for (int i = 0; i < 16; i += 2) { const unsigned w = cvt_pk_bf16(v[i], v[i + 1]); v[i] = bflo(w); v[i + 1] = bfhi(w); }
}
DI void rms_row(const float (&v)[16], const float* g, int lane, float (&o)[16]) {
    float s = 0.f;
#pragma unroll
    for (int i = 0; i < 16; ++i) s += v[i] * v[i];
    s = wave_sum(s);
    const float r = rsqrtf(s * (1.f / 1024.f) + EPS);
    float gg[16]; load_row_f32(g, lane, gg);
#pragma unroll
    for (int i = 0; i < 16; ++i) o[i] = v[i] * r * gg[i];
}

DI void phase_init_rows(const Ctx& C, bf16* resid, bf16* hdst) {
    for (int r = C.gw; r < LTOK; r += C.ngw) {
        float v[16], o[16];
        if (r < SEQ) load_row_f32(C.in[I_X] + (size_t)r * 1024, C.lane, v); else load_row_f32(C.in[I_META] + (size_t)(r - SEQ) * 1024, C.lane, v);
        round_bf16_16(v);
        store_row_bf16(resid + (size_t)r * 1024, C.lane, v);
        rms_row(v, C.in[I_NPRE], C.lane, o);
        store_row_bf16(hdst + (size_t)r * 1024, C.lane, o);
    }
}
DI void phase_post_rows(const Ctx& C, const bf16* y, bf16* resid, bf16* hdst, int layer) {
    for (int r = C.gw; r < LTOK; r += C.ngw) {
        float v[16], o[16], rs[16];
        load_row_bf16(y + (size_t)r * 1024, C.lane, v);
        rms_row(v, C.in[I_NPOST] + (size_t)layer * 1024, C.lane, o);
        load_row_bf16(resid + (size_t)r * 1024, C.lane, rs);
#pragma unroll
        for (int i = 0; i < 16; ++i) rs[i] += o[i];
        if (layer == 3) {
            if (r < SEQ) { float* op = C.out + (size_t)r * 1024;
                *(f32x4*)(op + 8 * C.lane) = (f32x4){rs[0], rs[1], rs[2], rs[3]}; *(f32x4*)(op + 8 * C.lane + 4) = (f32x4){rs[4], rs[5], rs[6], rs[7]};
                *(f32x4*)(op + 512 + 8 * C.lane) = (f32x4){rs[8], rs[9], rs[10], rs[11]}; *(f32x4*)(op + 512 + 8 * C.lane + 4) = (f32x4){rs[12], rs[13], rs[14], rs[15]}; }
        } else {
            round_bf16_16(rs);
            store_row_bf16(resid + (size_t)r * 1024, C.lane, rs);
            rms_row(rs, C.in[I_NPRE] + (size_t)(layer + 1) * 1024, C.lane, o);
            store_row_bf16(hdst + (size_t)r * 1024, C.lane, o);
        }
    }
}
DI void phase_renorm_rows(const Ctx& C, const bf16* resid, bf16* hdst, int layer) {
    for (int r = C.gw; r < LTOK; r += C.ngw) {
        float v[16], o[16];
        load_row_bf16(resid + (size_t)r * 1024, C.lane, v);
        rms_row(v, C.in[I_NPRE] + (size_t)layer * 1024, C.lane, o);
        store_row_bf16(hdst + (size_t)r * 1024, C.lane, o);
    }
}
DI void phase_rope_table(const Ctx& C) {
    f32x2* tab = (f32x2*)(C.misc() + MS_ROPE);
    for (int i = C.gw * 64 + C.lane; i < 256 * 32; i += C.ngw * 64) { const int pos = i >> 5, j = i & 31;
        const float f = fexp(-(float)j * (9.210340371976184f / 32.f));
        float rev = (float)pos * f * 0.15915494309189535f; rev -= rintf(rev);
        tab[i] = (f32x2){__builtin_amdgcn_cosf(rev), __builtin_amdgcn_sinf(rev)}; }
}

DI void store8(bf16* dst, f32x4 a, f32x4 b) { *(u32x4*)dst = pack8v(a, b); }
DI f32x4 silu4(f32x4 v) { return (f32x4){silu_f(v[0]), silu_f(v[1]), silu_f(v[2]), silu_f(v[3])}; }
struct FEvenIn {
    bf16 *YAB, *Kb, *Vb, *GA, *U;
    DI void launder() { lnd(YAB); lnd(Kb); lnd(Vb); lnd(GA); lnd(U); }
    DI void op8(int row, int col, f32x4 a, f32x4 b) const {
        bf16* dst; bool act = false;
        if (col < 1024) dst = YAB + (size_t)row * 2048 + col;
        else if (col < 1280) dst = Kb + (size_t)row * 256 + (col - 1024);
        else if (col < 1536) dst = Vb + (size_t)row * 256 + (col - 1280);
        else if (col < 2560) { dst = GA + (size_t)row * 1024 + (col - 1536); act = true; }
        else if (col < 3584) dst = U + (size_t)row * 1024 + (col - 2560);
        else { dst = YAB + (size_t)row * 2048 + 1024 + (col - 3584); act = true; }
        if (act) { a = silu4(a); b = silu4(b); }
        store8(dst, a, b);
    }
};
struct FPlain { bf16* O; int ldo; DI void launder() { lnd(O); } DI void op8(int row, int col, f32x4 a, f32x4 b) const { store8(O + (size_t)row * ldo + col, a, b); } };
struct FSilu { bf16* O; int ldo; DI void launder() { lnd(O); } DI void op8(int row, int col, f32x4 a, f32x4 b) const { store8(O + (size_t)row * ldo + col, silu4(a), silu4(b)); } };
struct FGlu {
    const bf16* YG; bf16* YAB; const float* bias;
    DI void launder() { lnd(YG); lnd(YAB); lnd(bias); }
    DI void op8(int row, int col, f32x4 a, f32x4 b) const {
        float yg[8], gb[8], o[8]; unpack8(*(const u32x4*)(YG + (size_t)row * 1024 + col), yg);
        bf16* dst = YAB + (size_t)row * 2048 + 1024 + col; unpack8(*(const u32x4*)dst, gb);
        const f32x4 b0 = *(const f32x4*)(bias + col), b1 = *(const f32x4*)(bias + col + 4);
#pragma unroll
        for (int j = 0; j < 4; ++j) { o[j] = yg[j] * sigmoid_f(a[j] + b0[j]) * gb[j]; o[4 + j] = yg[4 + j] * sigmoid_f(b[j] + b1[j]) * gb[4 + j]; }
        *(u32x4*)dst = pack8(o);
    }
};
struct FQK {
    bf16 *Q, *Kd;
    DI void launder() { lnd(Q); lnd(Kd); }
    DI void op8(int row, int col, f32x4 a, f32x4 b) const { const int h = col >> 8, w = col & 255;
        bf16* dst = (w < 128) ? Q + (size_t)row * 1024 + h * 128 + w : Kd + (size_t)row * 1024 + h * 128 + (w - 128);
        store8(dst, a, b); }
};
struct FVrow {
    bf16 *V, *VM;
    DI void launder() { lnd(V); lnd(VM); }
    DI void op8(int row, int col, f32x4 a, f32x4 b) const { bf16* dst = (row < SEQ) ? V + (size_t)row * 2048 + col : VM + (size_t)(row - SEQ) * 2048 + col; store8(dst, a, b); }
};
struct FOgate {
    const bf16 *CELL, *CELLM, *XC, *SZ; bf16* HZ; const float *bo, *hn, *skip, *rstd;
    DI void launder() { lnd(CELL); lnd(CELLM); lnd(XC); lnd(SZ); lnd(HZ); lnd(bo); lnd(hn); lnd(skip); lnd(rstd); }
    DI void op8(int row, int col, f32x4 a, f32x4 b) const {
        const bf16* cp = (row < SEQ) ? CELL + (size_t)row * 2048 + col : CELLM + (size_t)(row - SEQ) * 2048 + col;
        float ce[8], xc[8], sz[8], o[8]; unpack8(*(const u32x4*)cp, ce); unpack8(*(const u32x4*)(XC + (size_t)row * 2048 + col), xc); unpack8(*(const u32x4*)(SZ + (size_t)row * 2048 + col), sz);
        const float rs = rstd[(size_t)row * 8 + (col >> 8)];
        const f32x4 b0 = *(const f32x4*)(bo + col), b1 = *(const f32x4*)(bo + col + 4), h0 = *(const f32x4*)(hn + col), h1 = *(const f32x4*)(hn + col + 4), s0 = *(const f32x4*)(skip + col), s1 = *(const f32x4*)(skip + col + 4);
#pragma unroll
        for (int j = 0; j < 4; ++j) {
            o[j] = (sigmoid_f(a[j] + b0[j]) * (ce[j] * rs * h0[j]) + s0[j] * xc[j]) * sz[j];
            o[4 + j] = (sigmoid_f(b[j] + b1[j]) * (ce[4 + j] * rs * h1[j]) + s1[j] * xc[4 + j]) * sz[4 + j]; }
        *(u32x4*)(HZ + (size_t)row * 2048 + col) = pack8(o);
    }
};

template <int LDA, int LDB, int KK, int NN, int APN, class F>
DI void run_gemm(const Ctx& C, const bf16* A, const bf16* Bt, const F& f0) {
    F f = f0; f.launder(); lnd(A); lnd(Bt);
    gemm_tail<F>(A + (size_t)SEQ * LDA, LDA, Bt, LDB, KK, NN, APN, f, SEQ, C.gws, C.ngw, C.lane);
    pg8::Gemm g{A, Bt};
    pg8::StaticOrder<NN / 256> S; S.init(C.G, C.bid);
    pg8::EpiT<F> E{f};
    pg8::gemm_phase<pg8::EpiT<F>, pg8::StaticOrder<NN / 256>, LDA, LDB, KK, APN>(C.lds, g, S, E);
}

DI void phase_qk_norm_rope(const Ctx& C, bf16* YAB, bf16* Kb, const float* qn, const float* kn) {
    const f32x2* tab = (const f32x2*)(C.misc() + MS_ROPE);
    const int sub = C.lane & 15, grp = C.lane >> 4;
    const int nitems = LTOK * 10;
    for (int it0 = C.gw * 4; it0 < nitems; it0 += C.ngw * 4) {
        const int it = it0 + grp; const bool ok = it < nitems; const int itc = ok ? it : nitems - 1;
        const int row = itc / 10, hs = itc % 10;
        bf16* p = (hs < 8) ? YAB + (size_t)row * 2048 + hs * 128 + sub * 8 : Kb + (size_t)row * 256 + (hs - 8) * 128 + sub * 8;
        const float* g = ((hs < 8) ? qn : kn) + sub * 8;
        float v[8]; unpack8(*(const u32x4*)p, v);
        float s = 0.f;
#pragma unroll
        for (int e = 0; e < 8; ++e) s += v[e] * v[e];
        s += __shfl_xor(s, 1); s += __shfl_xor(s, 2); s += __shfl_xor(s, 4); s += __shfl_xor(s, 8);
        const float r = rsqrtf(s * (1.f / 128.f) + EPS);
        const f32x4 g0 = *(const f32x4*)g, g1 = *(const f32x4*)(g + 4);
#pragma unroll
        for (int e = 0; e < 4; ++e) { v[e] = v[e] * r * g0[e]; v[4 + e] = v[4 + e] * r * g1[e]; }
        int pos = 0;
        if (row < SEQ) pos = (sub < 8) ? (row >> 6) : (row & 63);
        const bool first = (sub & 4) == 0;
        float o[8];
#pragma unroll
        for (int e = 0; e < 8; ++e) {
            const float other = __shfl_xor(v[e], 4);
            const f32x2 cs = tab[pos * 32 + (sub & 3) * 8 + e];
            o[e] = first ? (v[e] * cs.x - other * cs.y) : (v[e] * cs.x + other * cs.y);
        }
        if (ok) *(u32x4*)p = pack8(o);
    }
}

namespace att {
constexpr int D = 128, NW = 8, QBLK = 32, KVBLK = 64;
constexpr float SCALE = 0.088388347648318440f;
constexpr float THR = 8.f;
constexpr int LDQ = 2048, LDK = 256, LDG = 1024;
constexpr size_t SHM_V = KVBLK * D * 2, SHM_K = KVBLK * D * 2, SHM_ATTN = 2 * SHM_V + 2 * SHM_K + NW * 64 * 4;
constexpr int NT_C = KVROWS / KVBLK;
#define KSWZ(row, colB) ((row) * 256 + ((colB) ^ (((row) & 7) << 4)))
#define SBAR() __builtin_amdgcn_sched_barrier(0)
DI int crow(int r, int hi) { return (r & 3) + 8 * (r >> 2) + 4 * hi; }
DI void partialSM(f32x16& p0, f32x16& p1, float& m_reg, float& mn, float& alpha) {
  constexpr float Cc = SCALE * 1.4426950408889634f;
  float pmax = p0[0];
#pragma unroll
  for (int r = 1; r < 16; ++r) pmax = fmaxf(pmax, p0[r]);
#pragma unroll
  for (int r = 0; r < 16; ++r) pmax = fmaxf(pmax, p1[r]);
  { auto rr = __builtin_amdgcn_permlane32_swap(__float_as_uint(pmax), __float_as_uint(pmax), false, false);
    pmax = fmaxf(__uint_as_float(rr[0]), __uint_as_float(rr[1])); }
  if (__builtin_expect(__all(pmax - m_reg <= THR / SCALE), 1)) { mn = m_reg; alpha = 1.f; }
  else { mn = fmaxf(m_reg, pmax); alpha = __builtin_amdgcn_exp2f((m_reg - mn) * Cc); m_reg = mn; }
  const float mnC = -mn * Cc;
#pragma unroll
  for (int r = 0; r < 16; ++r) p0[r] = fmaf(p0[r], Cc, mnC);
#pragma unroll
  for (int r = 0; r < 16; ++r) p1[r] = fmaf(p1[r], Cc, mnC);
#pragma unroll
  for (int r = 0; r < 16; ++r) p0[r] = __builtin_amdgcn_exp2f(p0[r]);
}
DI void finishSM(f32x16& p0, f32x16& p1, float alpha, float& l_reg, bf16x8& pa0, bf16x8& pa1, bf16x8& pa2, bf16x8& pa3) {
#pragma unroll
  for (int r = 0; r < 16; ++r) p1[r] = __builtin_amdgcn_exp2f(p1[r]);
  float ps = 0;
#pragma unroll
  for (int r = 0; r < 16; ++r) ps += p0[r];
#pragma unroll
  for (int r = 0; r < 16; ++r) ps += p1[r];
  { auto rr = __builtin_amdgcn_permlane32_swap(__float_as_uint(ps), __float_as_uint(ps), false, false);
    ps = __uint_as_float(rr[0]) + __uint_as_float(rr[1]); }
  l_reg = l_reg * alpha + ps;
#define PK4(P, BASE, OUT) do { unsigned a0 = cvt_pk_bf16(P[BASE + 0], P[BASE + 1]), a1 = cvt_pk_bf16(P[BASE + 2], P[BASE + 3]);   \
    unsigned b0 = cvt_pk_bf16(P[BASE + 4], P[BASE + 5]), b1 = cvt_pk_bf16(P[BASE + 6], P[BASE + 7]);                              \
    auto r0 = __builtin_amdgcn_permlane32_swap(a0, b0, false, false); auto r1 = __builtin_amdgcn_permlane32_swap(a1, b1, false, false); \
    u32x4 w = {r0[0], r1[0], r0[1], r1[1]}; OUT = *reinterpret_cast<bf16x8*>(&w); } while (0)
  PK4(p0, 0, pa0); PK4(p0, 8, pa1); PK4(p1, 0, pa2); PK4(p1, 8, pa3);
#undef PK4
}
DI void qkt(f32x16& p0, f32x16& p1, const LAS char* Ks, const bf16x8* qr, int r32, int hi) {
  p0 = f32x16{}; p1 = f32x16{};
#pragma unroll
  for (int d0 = 0; d0 < 8; ++d0) { const int cb = (d0 * 16 + hi * 8) * 2;
    const bf16x8 b0 = *(const LAS bf16x8*)(Ks + KSWZ(r32, cb));
    const bf16x8 b1 = *(const LAS bf16x8*)(Ks + KSWZ(32 + r32, cb));
    p0 = MFMA32(b0, qr[d0], p0);
    p1 = MFMA32(b1, qr[d0], p1); }
}
DI int v_st(int k, int c) { const int kk = (k & ~0xC) | ((k & 4) << 1) | ((k & 8) >> 1); return ((kk >> 3) * 4 + (c >> 5)) * 512 + ((kk & 7) * 32 + (c & 31)) * 2; }
DI int v_rd_base(int lane) { return ((lane & 3) << 3) | (((lane >> 2) & 3) << 6) | (((lane >> 4) & 1) << 5) | (((lane >> 5) & 1) << 8); }
constexpr int v_rd_off(int d0, int ks, int half) { return d0 * 512 + ks * 4096 + half * 2048; }
template <int OFF> DI s16x4 tr_read(int vb) { s16x4 r; asm volatile("ds_read_b64_tr_b16 %0, %1 offset:%2" : "=&v"(r) : "v"(vb), "i"(OFF) : "memory"); return r; }
template <int D0> DI void pv_one(f32x16& od, int vb, bf16x8 pa0, bf16x8 pa1, bf16x8 pa2, bf16x8 pa3) {
  const s16x4 l0 = tr_read<v_rd_off(D0, 0, 0)>(vb), h0 = tr_read<v_rd_off(D0, 0, 1)>(vb), l1 = tr_read<v_rd_off(D0, 1, 0)>(vb), h1 = tr_read<v_rd_off(D0, 1, 1)>(vb);
  const s16x4 l2 = tr_read<v_rd_off(D0, 2, 0)>(vb), h2 = tr_read<v_rd_off(D0, 2, 1)>(vb), l3 = tr_read<v_rd_off(D0, 3, 0)>(vb), h3 = tr_read<v_rd_off(D0, 3, 1)>(vb);
  asm volatile("s_waitcnt lgkmcnt(0)" ::: "memory"); SBAR();
#define PKV(L, H) (bf16x8){L[0], L[1], L[2], L[3], H[0], H[1], H[2], H[3]}
  od = MFMA32(pa0, PKV(l0, h0), od);
  od = MFMA32(pa1, PKV(l1, h1), od);
  od = MFMA32(pa2, PKV(l2, h2), od);
  od = MFMA32(pa3, PKV(l3, h3), od);
#undef PKV
}
DI void pv_d0(f32x16* o, int vb, bf16x8 pa0, bf16x8 pa1, bf16x8 pa2, bf16x8 pa3) {
  pv_one<0>(o[0], vb, pa0, pa1, pa2, pa3); pv_one<1>(o[1], vb, pa0, pa1, pa2, pa3); pv_one<2>(o[2], vb, pa0, pa1, pa2, pa3); pv_one<3>(o[3], vb, pa0, pa1, pa2, pa3);
}
DI void mask_tail(f32x16& p0, f32x16& p1) {
#pragma unroll
  for (int r = 8; r < 16; ++r) p0[r] = -1e30f;
#pragma unroll
  for (int r = 0; r < 16; ++r) p1[r] = -1e30f;
}
DI void attn_unit(bf16* Qb, const bf16* Kh, const bf16* Vh, const bf16* Gb, int nvalid, LAS char* lds) {
  lnd(Qb); lnd(Kh); lnd(Vh); lnd(Gb);
  int NT = NT_C; asm volatile("" : "+s"(NT));
  int tid = threadIdx.x; asm volatile("" : "+v"(tid));
  const int wid = tid >> 6, lane = tid & 63, r32 = lane & 31, hi = lane >> 5;
  LAS char* V_lds = lds; LAS char* K_lds = lds + 2 * SHM_V;
  LAS float* wsf = (LAS float*)(lds + 2 * SHM_V + 2 * SHM_K) + wid * 64; LAS float* li_l = wsf; LAS float* al_l = wsf + 32;
  float m_reg = -1e30f, l_reg = 0; f32x16 o[4] = {}; bf16x8 qr[8];
  const bf16* Qw = Qb + (long)(wid * QBLK + r32) * LDQ + hi * 8;
#pragma unroll
  for (int d0 = 0; d0 < 8; ++d0) qr[d0] = *reinterpret_cast<const bf16x8*>(Qw + d0 * 16);
  const int sr = tid >> 4, sc = (tid & 15) * 8, vst0 = v_st(sr, sc), vst1 = v_st(32 + sr, sc);
  const int vb0 = (int)(unsigned)(uintptr_t)V_lds + v_rd_base(lane);
  struct { bf16x8 vs0, vs1, ks0, ks1; } sr_[2];
#define SLOAD(i, k0) do { sr_[i].vs0 = *(const bf16x8*)(&Vh[(long)((k0) + sr) * LDK + sc]); sr_[i].vs1 = *(const bf16x8*)(&Vh[(long)((k0) + 32 + sr) * LDK + sc]); \
    sr_[i].ks0 = *(const bf16x8*)(&Kh[(long)((k0) + sr) * LDK + sc]); sr_[i].ks1 = *(const bf16x8*)(&Kh[(long)((k0) + 32 + sr) * LDK + sc]); } while (0)
#define SWRITE(b, i) do { *(LAS bf16x8*)(V_lds + (b) * SHM_V + vst0) = sr_[i].vs0;          \
    *(LAS bf16x8*)(V_lds + (b) * SHM_V + vst1) = sr_[i].vs1; int kc = sc * 2;               \
    *(LAS bf16x8*)(K_lds + (b) * SHM_K + KSWZ(sr, kc)) = sr_[i].ks0;                       \
    *(LAS bf16x8*)(K_lds + (b) * SHM_K + KSWZ(32 + sr, kc)) = sr_[i].ks1; } while (0)
#define SWAIT() asm volatile("s_waitcnt vmcnt(4)" ::: "memory")
#define RESC(a) do { if (__any((a) < 1.f)) { if (hi == 0) al_l[r32] = (a); asm volatile("s_waitcnt lgkmcnt(0)" ::: "memory"); \
    _Pragma("unroll") for (int d = 0; d < 4; ++d) _Pragma("unroll") for (int r = 0; r < 16; ++r) o[d][r] *= al_l[crow(r, hi)]; } } while (0)
  f32x16 pA0, pA1, pB0, pB1; float mnA, mnB, alA, alB; bf16x8 pa0, pa1, pa2, pa3;
  constexpr int SE = 0, SO = 1;
  SLOAD(SE, 0); asm volatile("s_waitcnt vmcnt(0)" ::: "memory"); SWRITE(0, SE); __syncthreads();
  qkt(pA0, pA1, K_lds, qr, r32, hi); partialSM(pA0, pA1, m_reg, mnA, alA);
  SLOAD(SO, KVBLK); SLOAD(SE, 2 * KVBLK);
  SWAIT(); SWRITE(1, SO); __syncthreads();
  for (int j = 1; j + 1 < NT; j += 2) {
    SBAR(); qkt(pB0, pB1, K_lds + SHM_K, qr, r32, hi);
    finishSM(pA0, pA1, alA, l_reg, pa0, pa1, pa2, pa3); SBAR();
    if (j + 2 < NT) SLOAD(SO, (j + 2) * KVBLK);
    SBAR();
    pv_d0(o, vb0, pa0, pa1, pa2, pa3); partialSM(pB0, pB1, m_reg, mnB, alB);
    __syncthreads(); SWAIT(); SWRITE(0, SE);
    RESC(alB); __syncthreads();
    SBAR(); qkt(pA0, pA1, K_lds, qr, r32, hi);
    if (j + 1 == NT - 1) mask_tail(pA0, pA1);
    finishSM(pB0, pB1, alB, l_reg, pa0, pa1, pa2, pa3); SBAR();
    if (j + 3 < NT) SLOAD(SE, (j + 3) * KVBLK);
    SBAR();
    pv_d0(o, vb0 + (int)SHM_V, pa0, pa1, pa2, pa3); partialSM(pA0, pA1, m_reg, mnA, alA);
    __syncthreads(); SWAIT(); if (j + 2 < NT) SWRITE(1, SO);
    RESC(alA); __syncthreads();
  }
  finishSM(pA0, pA1, alA, l_reg, pa0, pa1, pa2, pa3); SBAR();
  pv_d0(o, vb0, pa0, pa1, pa2, pa3);
  if (hi == 0) li_l[r32] = l_reg; asm volatile("s_waitcnt lgkmcnt(0)" ::: "memory");
  float rli[16];
#pragma unroll
  for (int r = 0; r < 16; ++r) rli[r] = __builtin_amdgcn_rcpf(li_l[crow(r, hi)]);
#pragma unroll
  for (int r = 0; r < 16; ++r) { const int orow = wid * QBLK + crow(r, hi);
    if (orow < nvalid) {
      const bf16* gp = Gb + (long)orow * LDG + r32; bf16* qp = Qb + (long)orow * LDQ + r32;
      const float g0 = bf2f(gp[0]), g1 = bf2f(gp[32]), g2 = bf2f(gp[64]), g3 = bf2f(gp[96]);
      qp[0] = f2bf(o[0][r] * rli[r] * g0); qp[32] = f2bf(o[1][r] * rli[r] * g1); qp[64] = f2bf(o[2][r] * rli[r] * g2); qp[96] = f2bf(o[3][r] * rli[r] * g3); }
    asm volatile("" ::: "memory"); }
  __syncthreads();
#undef SLOAD
#undef SWRITE
#undef SWAIT
#undef RESC
}
}

DI void phase_attention(const Ctx& C, bf16* YAB, const bf16* Kb, const bf16* Vb, const bf16* GA) {
    constexpr int NQB = 65, NUNIT = NQB * 8;
    for (int u = C.bid; u < NUNIT; u += C.G) {
        const int h = u & 7, qb = u >> 3, row0 = qb * 256, g = h >> 2;
        int nvalid = LTOK - row0; if (nvalid > 256) nvalid = 256;
        att::attn_unit(YAB + (size_t)row0 * 2048 + h * 128, Kb + g * 128, Vb + g * 128, GA + (size_t)row0 * 1024 + h * 128, nvalid, (LAS char*)C.lds);
    }
}

constexpr int S5_NCH = 1025;
DI int s5_row0(int c) { return c == 0 ? SEQ : 16 * (c - 1); }
DI void cis_rev(float ang, float& c, float& s) { float rev = ang * 0.15915494309189535f; rev -= rintf(rev); c = __builtin_amdgcn_cosf(rev); s = __builtin_amdgcn_sinf(rev); }

DI void phase_s5_tables(const Ctx& C, int li) {
    f32x2* apow = (f32x2*)(C.dob + DO_APOW); f32x2* bb = (f32x2*)(C.dob + DO_BB);
    for (int i = C.gw * 64 + C.lane; i < 2 * 64 * 64; i += C.ngw * 64) {
        const int d = i >> 12, g = (i >> 6) & 63;
        const size_t pidx = (size_t)li * 2 * 64 * 64 + i;
        const float ar = C.in[I_ARE][pidx], ai = C.in[I_AIM][pidx];
        const float dt = fexp(C.in[I_LDT][(size_t)li * 128 + d * 64 + g]);
#pragma unroll 1
        for (int e = 0; e <= 16; ++e) { float c, s; cis_rev((float)e * ai * dt, c, s); const float mg = fexp((float)e * ar * dt); apow[(size_t)i * 17 + e] = (f32x2){mg * c, mg * s}; }
        float c1, s1; cis_rev(ai * dt, c1, s1); const float m1 = fexp(ar * dt);
        const float xr = m1 * c1 - 1.f, xi = m1 * s1, inv = 1.f / (ar * ar + ai * ai);
        const float kr = (xr * ar + xi * ai) * inv, ki = (xi * ar - xr * ai) * inv;
        const float* bre = C.in[I_BRE] + pidx * 16; const float* bim = C.in[I_BIM] + pidx * 16;
#pragma unroll 4
        for (int p = 0; p < 16; ++p) { const float br = bre[p], bi = bim[p]; bb[(size_t)i * 16 + p] = (f32x2){kr * br - ki * bi, kr * bi + ki * br}; }
    }
}
DI void phase_s5_ktab_hcat(const Ctx& C, int li) {
    const f32x2* apow = (const f32x2*)(C.dob + DO_APOW); const f32x2* bb = (const f32x2*)(C.dob + DO_BB);
    float* ktab = (float*)(C.dob + DO_KTAB); bf16* hcat = (bf16*)(C.dob + DO_HCAT);
    for (int i = C.gw * 64 + C.lane; i < 2 * 64 * 16 * 256; i += C.ngw * 64) {
        const int q = i & 15, p = (i >> 4) & 15, dl = (i >> 8) & 15, g = (i >> 12) & 63, d = i >> 18;
        const size_t dg = (size_t)d * 64 + g;
        const float* cre = C.in[I_CRE] + (((size_t)li * 2 * 64 + dg) * 16 + p) * 64; const float* cim = C.in[I_CIM] + (((size_t)li * 2 * 64 + dg) * 16 + p) * 64;
        float acc = 0.f;
        for (int n = 0; n < 64; ++n) { const f32x2 a = apow[(dg * 64 + n) * 17 + dl], b = bb[(dg * 64 + n) * 16 + q];
            const float wr = a.x * b.x - a.y * b.y, wi = a.x * b.y + a.y * b.x;
            acc += cre[n] * wr - cim[n] * wi; }
        ktab[i] = acc;
    }
    for (int i = C.gw * 64 + C.lane; i < 64 * 256 * 32; i += C.ngw * 64) {
        const int k8 = i & 31, rho = (i >> 5) & 255, g = i >> 13;
        const int d = rho >> 7, n = (rho >> 1) & 63, ri = rho & 1, s = k8 >> 1, q0 = (k8 & 1) * 8;
        const size_t dgn = ((size_t)d * 64 + g) * 64 + n;
        const f32x2 a = apow[dgn * 17 + (d == 0 ? 15 - s : s)];
        float o[8];
#pragma unroll
        for (int j = 0; j < 8; ++j) { const f32x2 b = bb[dgn * 16 + q0 + j]; o[j] = ri ? (a.x * b.y + a.y * b.x) : (a.x * b.x - a.y * b.y); }
        *(u32x4*)(hcat + ((size_t)g * 256 + rho) * 256 + k8 * 8) = pack8(o);
    }
}
DI void phase_s5_mg(const Ctx& C, int li) {
    const f32x2* apow = (const f32x2*)(C.dob + DO_APOW); const float* ktab = (const float*)(C.dob + DO_KTAB); bf16* mg = (bf16*)(C.dob + DO_MG);
    const float* dsk = C.in[I_SSMD] + (size_t)li * 1024;
    for (int i = C.gw * 64 + C.lane; i < 64 * 256 * 64; i += C.ngw * 64) {
        const int k8 = i & 63, tp = (i >> 6) & 255, g = i >> 14, t = tp >> 4, p = tp & 15;
        float o[8];
        if (k8 < 32) { const int s = k8 >> 1, q0 = (k8 & 1) * 8;
#pragma unroll
            for (int j = 0; j < 8; ++j) { const int q = q0 + j; float v = 0.f;
                if (s <= t) v += ktab[((((size_t)0 * 64 + g) * 16 + (t - s)) * 16 + p) * 16 + q];
                if (s >= t) v += ktab[((((size_t)1 * 64 + g) * 16 + (s - t)) * 16 + p) * 16 + q];
                if (s == t && p == q) v += dsk[g * 16 + p];
                o[j] = v; }
        } else { const int rho0 = (k8 - 32) * 8, d = rho0 >> 7; const size_t dg = (size_t)d * 64 + g;
            const float* cre = C.in[I_CRE] + (((size_t)li * 2 * 64 + dg) * 16 + p) * 64; const float* cim = C.in[I_CIM] + (((size_t)li * 2 * 64 + dg) * 16 + p) * 64;
            const int e = d == 0 ? t + 1 : 16 - t;
#pragma unroll
            for (int j = 0; j < 8; ++j) { const int rho = rho0 + j, n = (rho >> 1) & 63, ri = rho & 1; const f32x2 a = apow[(dg * 64 + n) * 17 + e];
                const float wr = cre[n] * a.x - cim[n] * a.y, wi = cre[n] * a.y + cim[n] * a.x; o[j] = ri ? -wi : wr; }
        }
        *(u32x4*)(mg + ((size_t)g * 256 + tp) * 512 + k8 * 8) = pack8(o);
    }
}
DI bf16x8 s5_ufrag(const bf16* U, int g, int c0, int kstep, int lane) {
    int c = c0 + (lane & 15); if (c >= S5_NCH) c = S5_NCH - 1;
    const int s = kstep * 2 + (lane >> 5), q0 = ((lane >> 4) & 1) * 8;
    return *(const bf16x8*)(U + (size_t)(s5_row0(c) + s) * 1024 + g * 16 + q0);
}
DI void phase_s5_local(const Ctx& C, const bf16* U) {
    const bf16* hcat = (const bf16*)(C.dob + DO_HCAT); bf16* ex = (bf16*)(C.dob + DO_EX);
    const int i16 = C.lane & 15, q4 = C.lane >> 4;
    for (int task = C.gw; task < 2048; task += C.ngw) {
        const int qu = task & 3, rr = (task >> 2) & 7, g = task >> 5;
        bf16x8 af[4][8];
#pragma unroll
        for (int m = 0; m < 4; ++m)
#pragma unroll
            for (int ks = 0; ks < 8; ++ks) af[m][ks] = *(const bf16x8*)(hcat + ((size_t)g * 256 + qu * 64 + m * 16 + i16) * 256 + ks * 32 + q4 * 8);
        for (int blk = rr; blk < 65; blk += 8) {
            const int c0 = blk * 16;
            f32x4 acc[4];
#pragma unroll
            for (int m = 0; m < 4; ++m) acc[m] = (f32x4){0.f, 0.f, 0.f, 0.f};
#pragma unroll
            for (int ks = 0; ks < 8; ++ks) { const bf16x8 b = s5_ufrag(U, g, c0, ks, C.lane);
#pragma unroll
                for (int m = 0; m < 4; ++m) acc[m] = MFMA16(af[m][ks], b, acc[m]); }
            const int c = c0 + i16;
            if (c < S5_NCH) {
#pragma unroll
                for (int m = 0; m < 4; ++m) { u32x2 w; w.x = cvt_pk_bf16(acc[m][0], acc[m][1]); w.y = cvt_pk_bf16(acc[m][2], acc[m][3]);
                    *(u32x2*)(ex + ((size_t)c * 64 + g) * 256 + qu * 64 + m * 16 + q4 * 4) = w; } }
        }
    }
}
DI void phase_s5_scan(const Ctx& C) {
    const f32x2* apow = (const f32x2*)(C.dob + DO_APOW); unsigned* ex = (unsigned*)(C.dob + DO_EX);
    if (C.gws >= 128) return;
    const int ch = C.gws * 64 + C.lane;
    const int g = ch >> 7, d = (ch >> 6) & 1, n = ch & 63;
    const f32x2 a16 = apow[(((size_t)d * 64 + g) * 64 + n) * 17 + 16];
    float xr = 0.f, xi = 0.f;
    const size_t base = (size_t)g * 128 + d * 64 + n;
    for (int i = 0; i < S5_NCH; i += 5) {
        unsigned w[5];
#pragma unroll
        for (int j = 0; j < 5; ++j) { const int c = d == 0 ? i + j : S5_NCH - 1 - (i + j); w[j] = ex[(size_t)c * 8192 + base]; }
#pragma unroll
        for (int j = 0; j < 5; ++j) { const int c = d == 0 ? i + j : S5_NCH - 1 - (i + j);
            const float er = bflo(w[j]), ei = bfhi(w[j]);
            ex[(size_t)c * 8192 + base] = cvt_pk_bf16(xr, xi);
            const float nr = a16.x * xr - a16.y * xi + er, ni = a16.x * xi + a16.y * xr + ei; xr = nr; xi = ni; }
    }
}
DI void phase_s5_out(const Ctx& C, const bf16* U, bf16* YG) {
    const bf16* mg = (const bf16*)(C.dob + DO_MG); const bf16* ex = (const bf16*)(C.dob + DO_EX);
    const int i16 = C.lane & 15, q4 = C.lane >> 4;
    for (int task = C.gw; task < 2048; task += C.ngw) {
        const int e8 = task & 7, rr = (task >> 3) & 3, g = task >> 5;
        bf16x8 af[2][16];
#pragma unroll
        for (int m = 0; m < 2; ++m)
#pragma unroll
            for (int ks = 0; ks < 16; ++ks) af[m][ks] = *(const bf16x8*)(mg + ((size_t)g * 256 + e8 * 32 + m * 16 + i16) * 512 + ks * 32 + q4 * 8);
        for (int blk = rr; blk < 65; blk += 4) {
            const int c0 = blk * 16;
            int cc = c0 + i16; if (cc >= S5_NCH) cc = S5_NCH - 1;
            f32x4 acc[2];
            acc[0] = (f32x4){0.f, 0.f, 0.f, 0.f}; acc[1] = acc[0];
#pragma unroll
            for (int ks = 0; ks < 16; ++ks) {
                bf16x8 b;
                if (ks < 8) b = s5_ufrag(U, g, c0, ks, C.lane);
                else b = *(const bf16x8*)(ex + ((size_t)cc * 64 + g) * 256 + (ks - 8) * 32 + q4 * 8);
                acc[0] = MFMA16(af[0][ks], b, acc[0]); acc[1] = MFMA16(af[1][ks], b, acc[1]); }
            const int c = c0 + i16;
            if (c < S5_NCH) {
#pragma unroll
                for (int m = 0; m < 2; ++m) { const int tp = e8 * 32 + m * 16 + q4 * 4, t = tp >> 4, p = tp & 15;
                    u32x2 w; w.x = cvt_pk_bf16(gelu_tanh_f(acc[m][0]), gelu_tanh_f(acc[m][1])); w.y = cvt_pk_bf16(gelu_tanh_f(acc[m][2]), gelu_tanh_f(acc[m][3]));
                    *(u32x2*)(YG + (size_t)(s5_row0(c) + t) * 1024 + g * 16 + p) = w; } }
        }
    }
}

DI int seq_of_row(int r) { return r < SEQ ? r + 16 : r - SEQ; }
DI int row_of_seq(int l) { return l < 16 ? SEQ + l : l - 16; }
DI void phase_conv(const Ctx& C, const bf16* XM, bf16* XC, const float* cw, const float* cb) {
    const int nitems = LTOK * 256;
    for (int it = C.gw * 64 + C.lane; it < nitems; it += C.ngw * 64) {
        const int row = it >> 8, c0 = (it & 255) * 8, l = seq_of_row(row);
        float acc[8];
        { const f32x4 b0 = *(const f32x4*)(cb + c0), b1 = *(const f32x4*)(cb + c0 + 4);
#pragma unroll
          for (int e = 0; e < 4; ++e) { acc[e] = b0[e]; acc[4 + e] = b1[e]; } }
#pragma unroll
        for (int j = 0; j < 5; ++j) { const int l2 = l + j - 2;
            if (l2 >= 0 && l2 < LTOK) { float x[8]; unpack8(*(const u32x4*)(XM + (size_t)row_of_seq(l2) * 2048 + c0), x);
                const f32x4 w0 = *(const f32x4*)(cw + (size_t)j * 2048 + c0), w1 = *(const f32x4*)(cw + (size_t)j * 2048 + c0 + 4);
#pragma unroll
                for (int e = 0; e < 4; ++e) { acc[e] += w0[e] * x[e]; acc[4 + e] += w1[e] * x[4 + e]; } } }
        float o[8];
#pragma unroll
        for (int e = 0; e < 8; ++e) o[e] = silu_f(acc[e]);
        *(u32x4*)(XC + (size_t)row * 2048 + c0) = pack8(o);
    }
}
DI int pos_of_row(int r) { return r < SEQ ? r + 64 : r - SEQ + 48; }
DI int row_of_pos(int pos) { return pos >= 64 ? pos - 64 : (pos >= 48 ? SEQ + pos - 48 : -1); }
DI float log_sigmoid_f(float x) { return fminf(x, 0.f) - __logf(1.f + __expf(-fabsf(x))); }
DI void phase_gates(const Ctx& C, const bf16* XC, const bf16* WG, const float* big, const float* bfg) {
    float* GI = (float*)(C.misc() + MS_GI); float* GF = (float*)(C.misc() + MS_GF);
    const int r32 = C.lane & 31, hi = C.lane >> 5;
    for (int i = C.gw * 64 + C.lane; i < 16 * 48; i += C.ngw * 64) { const int dh = i / 48, p = i % 48; GI[(size_t)dh * NPOS + p] = -1e9f; GF[(size_t)dh * NPOS + p] = 0.f; }
    for (int task = C.gws; task < (LTOK + 31) / 32; task += C.ngw) {
        const int r0 = task * 32; int ra = r0 + r32; if (ra >= LTOK) ra = LTOK - 1;
        const bf16* ap = XC + (size_t)ra * 2048 + hi * 8; const bf16* bp = WG + (size_t)r32 * 2048 + hi * 8;
        f32x16 acc = {};
#pragma unroll 8
        for (int k0 = 0; k0 < 2048; k0 += 16) acc = MFMA32(*(const bf16x8*)(ap + k0), *(const bf16x8*)(bp + k0), acc);
        const int ty = r32 >> 4, dh = r32 & 15; const float bias = (ty ? bfg : big)[dh];
#pragma unroll
        for (int r = 0; r < 16; ++r) { const int row = r0 + (r & 3) + 8 * (r >> 2) + 4 * hi;
            if (row < LTOK) { const float v = acc[r] + bias; const size_t idx = (size_t)dh * NPOS + pos_of_row(row);
                if (ty) GF[idx] = log_sigmoid_f(v); else GI[idx] = v; } }
    }
}
DI void phase_cell_rstd(const Ctx& C, const bf16* CELL, const bf16* CELLM) {
    float* rstd = (float*)(C.misc() + MS_RSTD);
    const int sub = C.lane & 31, half = C.lane >> 5;
    for (int it = C.gw * 2; it < LTOK * 8; it += C.ngw * 2) { const int i = it + half, row = i >> 3, h = i & 7;
        const bf16* p = ((row < SEQ) ? CELL + (size_t)row * 2048 : CELLM + (size_t)(row - SEQ) * 2048) + h * 256 + sub * 8;
        float v[8]; unpack8(*(const u32x4*)p, v); float s = 0.f;
#pragma unroll
        for (int e = 0; e < 8; ++e) s += v[e] * v[e];
        s += __shfl_xor(s, 1); s += __shfl_xor(s, 2); s += __shfl_xor(s, 4); s += __shfl_xor(s, 8); s += __shfl_xor(s, 16);
        if (sub == 0) rstd[i] = rsqrtf(s * (1.f / 256.f) + EPS); }
}

namespace ml {
constexpr int QS = 0, KS = 17408, KT = 34816, VT = 53248, SWO = 57856, CB = 67072, SC = 75776, DIRB = 78848;
constexpr int SC_A = 0, SC_M = 256, SC_ISC = 512, SC_FLO = 768, SC_W = 1024, SC_DEC = 1280, SC_STRIDE = 1536;
constexpr float QSCALE = 0.08838834764831845f;
DI int chunk_row(int cs, int t) { return cs == 0 ? (t < 48 ? -1 : SEQ + t - 48) : 64 * (cs - 1) + t; }
}
DI void phase_mlstm(const Ctx& C, const bf16* Q, const bf16* K, const bf16* V, const bf16* VM, bf16* CELL, bf16* CELLM) {
    using namespace ml;
    const float* GI = (const float*)(C.misc() + MS_GI); const float* GF = (const float*)(C.misc() + MS_GF);
    const int d = C.wave >> 2, w4 = C.wave & 3, tid4 = C.tid & 255, lane = C.lane, i16 = lane & 15, q4 = lane >> 4;
    LAS unsigned char* L = C.lds + d * DIRB;
    LAS bf16* Qs = (LAS bf16*)(L + QS); LAS bf16* Ks = (LAS bf16*)(L + KS); LAS bf16* Kt = (LAS bf16*)(L + KT); LAS bf16* Vt = (LAS bf16*)(L + VT);
    LAS bf16* SW = (LAS bf16*)(L + SWO); LAS bf16* Cb = (LAS bf16*)(L + CB); LAS float* Sc = (LAS float*)(L + SC);
    for (int unit = C.bid; unit < 128; unit += C.G) {
        const int h = unit & 7, sl = unit >> 3;
        const float* gi = GI + (size_t)(d * 8 + h) * NPOS; const float* gf = GF + (size_t)(d * 8 + h) * NPOS;
        for (int i = tid4; i < 16 * 64; i += 256) { const int v = 16 + (i >> 6), s = i & 63; Vt[v * 72 + s] = (v == 16) ? (bf16)0x3f80 : (bf16)0; }
        for (int i = tid4; i < 32 * 136; i += 256) Cb[i] = 0;
        f32x4 Cst00 = {0.f, 0.f, 0.f, 0.f}, Cst01 = Cst00, Cst10 = Cst00, Cst11 = Cst00;
        float m_prev = 0.f;
        u32x4 pq0, pq1, pq2, pq3, pk0, pk1, pk2, pk3, pv;
        float g1li = 0.f, g1lf = 0.f;
#define ML_LOADQK(j, PQ, PK, cs_) do { const int p_ = tid4 + 256 * (j), t_ = p_ >> 4, c8_ = (p_ & 15) * 8; const int row_ = chunk_row((cs_), t_); \
            if (row_ >= 0) { PQ = *(const u32x4*)(Q + (size_t)row_ * 1024 + h * 128 + c8_); PK = *(const u32x4*)(K + (size_t)row_ * 1024 + h * 128 + c8_); } \
            else { PQ = (u32x4){0u, 0u, 0u, 0u}; PK = PQ; } } while (0)
#define ML_LOAD(cs_) do { ML_LOADQK(0, pq0, pk0, cs_); ML_LOADQK(1, pq1, pk1, cs_); ML_LOADQK(2, pq2, pk2, cs_); ML_LOADQK(3, pq3, pk3, cs_); \
            { const int t_ = tid4 >> 1, c8_ = (tid4 & 1) * 8; const int row_ = chunk_row((cs_), t_); \
              if (tid4 < 128 && row_ >= 0) pv = (row_ < SEQ) ? *(const u32x4*)(V + (size_t)row_ * 2048 + h * 256 + sl * 16 + c8_) : *(const u32x4*)(VM + (size_t)(row_ - SEQ) * 2048 + h * 256 + sl * 16 + c8_); \
              else pv = (u32x4){0u, 0u, 0u, 0u}; } } while (0)
#define ML_SCALARS(li_, lf_, par_) do { \
            float b_ = (lf_); \
            _Pragma("unroll") for (int o_ = 1; o_ < 64; o_ <<= 1) { const float x_ = d == 0 ? __shfl_up(b_, o_) : __shfl_down(b_, o_); const bool ok_ = d == 0 ? (lane >= o_) : (lane + o_ < 64); b_ += ok_ ? x_ : 0.f; } \
            const float a_ = (li_) - b_; float cm_ = a_; \
            _Pragma("unroll") for (int o_ = 1; o_ < 64; o_ <<= 1) { const float x_ = d == 0 ? __shfl_up(cm_, o_) : __shfl_down(cm_, o_); const bool ok_ = d == 0 ? (lane >= o_) : (lane + o_ < 64); cm_ = ok_ ? fmaxf(cm_, x_) : cm_; } \
            const float cm_all_ = __shfl(cm_, d == 0 ? 63 : 0), b_last_ = __shfl(b_, d == 0 ? 63 : 0); \
            const float M_ = fmaxf(cm_, m_prev), Mst_ = fmaxf(cm_all_, m_prev); \
            LAS float* S_ = Sc + (par_) * (SC_STRIDE / 4); \
            S_[SC_A / 4 + lane] = a_; S_[SC_M / 4 + lane] = M_; S_[SC_ISC / 4 + lane] = __expf(m_prev - M_) * QSCALE; S_[SC_FLO / 4 + lane] = __expf(-b_ - M_); \
            S_[SC_W / 4 + lane] = __expf(a_ - Mst_); if (lane == 0) S_[SC_DEC / 4] = __expf(m_prev - Mst_); \
            m_prev = b_last_ + Mst_; } while (0)
#define ML_CS(i_) (d == 0 ? (i_) : 256 - (i_))
        ML_LOAD(ML_CS(0));
        if (w4 == 0) { const float li0 = gi[ML_CS(0) * 64 + lane], lf0 = gf[ML_CS(0) * 64 + lane]; g1li = gi[ML_CS(1) * 64 + lane]; g1lf = gf[ML_CS(1) * 64 + lane]; ML_SCALARS(li0, lf0, 0); }
        __syncthreads();
        for (int i = 0; i <= 256; ++i) {
            const int cs = ML_CS(i), par = i & 1;
            LAS float* S = Sc + par * (SC_STRIDE / 4);
#define ML_ST(j, PQ, PK) do { const int p_ = tid4 + 256 * (j), t_ = p_ >> 4, c8_ = (p_ & 15) * 8; *(LAS u32x4*)(Qs + t_ * 136 + c8_) = PQ; *(LAS u32x4*)(Ks + t_ * 136 + c8_) = PK; } while (0)
            ML_ST(0, pq0, pk0); ML_ST(1, pq1, pk1); ML_ST(2, pq2, pk2); ML_ST(3, pq3, pk3);
            if (tid4 < 128) { const int t = tid4 >> 1, c8 = (tid4 & 1) * 8;
                Vt[(c8 + 0) * 72 + t] = (bf16)(pv.x & 0xffffu); Vt[(c8 + 1) * 72 + t] = (bf16)(pv.x >> 16); Vt[(c8 + 2) * 72 + t] = (bf16)(pv.y & 0xffffu); Vt[(c8 + 3) * 72 + t] = (bf16)(pv.y >> 16);
                Vt[(c8 + 4) * 72 + t] = (bf16)(pv.z & 0xffffu); Vt[(c8 + 5) * 72 + t] = (bf16)(pv.z >> 16); Vt[(c8 + 6) * 72 + t] = (bf16)(pv.w & 0xffffu); Vt[(c8 + 7) * 72 + t] = (bf16)(pv.w >> 16); }
            __syncthreads();
            float g2li = 0.f, g2lf = 0.f;
            if (i < 256) ML_LOAD(ML_CS(i + 1));
            if (w4 == 0 && i < 255) { g2li = gi[ML_CS(i + 2) * 64 + lane]; g2lf = gf[ML_CS(i + 2) * 64 + lane]; }
            bf16x8 aq0 = *(const LAS bf16x8*)(Qs + (16 * w4 + i16) * 136 + 0 + 8 * q4), aq1 = *(const LAS bf16x8*)(Qs + (16 * w4 + i16) * 136 + 32 + 8 * q4),
                   aq2 = *(const LAS bf16x8*)(Qs + (16 * w4 + i16) * 136 + 64 + 8 * q4), aq3 = *(const LAS bf16x8*)(Qs + (16 * w4 + i16) * 136 + 96 + 8 * q4);
            const f32x4 Mt = *(const LAS f32x4*)(S + SC_M / 4 + 16 * w4 + 4 * q4);
#pragma unroll
            for (int sg = 0; sg < 4; ++sg) {
                const LAS bf16* kp = Ks + (16 * sg + i16) * 136 + 8 * q4;
                f32x4 acc = {0.f, 0.f, 0.f, 0.f};
                acc = MFMA16(aq0, *(const LAS bf16x8*)(kp), acc); acc = MFMA16(aq1, *(const LAS bf16x8*)(kp + 32), acc);
                acc = MFMA16(aq2, *(const LAS bf16x8*)(kp + 64), acc); acc = MFMA16(aq3, *(const LAS bf16x8*)(kp + 96), acc);
                const int s = 16 * sg + i16; const float as = S[SC_A / 4 + s];
#pragma unroll
                for (int r = 0; r < 4; ++r) { const int t = 16 * w4 + 4 * q4 + r; const bool ok = d == 0 ? (s <= t) : (s >= t);
                    const float v = ok ? __expf(as - Mt[r]) * acc[r] * QSCALE : 0.f; SW[t * 72 + s] = f2bf(v); }
            }
            f32x4 NX0 = {0.f, 0.f, 0.f, 0.f}, NX1 = NX0;
            { const LAS bf16* c0 = Cb + (i16) * 136 + 8 * q4; const LAS bf16* c1 = Cb + (16 + i16) * 136 + 8 * q4;
              NX0 = MFMA16(aq0, *(const LAS bf16x8*)(c0), NX0); NX0 = MFMA16(aq1, *(const LAS bf16x8*)(c0 + 32), NX0); NX0 = MFMA16(aq2, *(const LAS bf16x8*)(c0 + 64), NX0); NX0 = MFMA16(aq3, *(const LAS bf16x8*)(c0 + 96), NX0);
              NX1 = MFMA16(aq0, *(const LAS bf16x8*)(c1), NX1); NX1 = MFMA16(aq1, *(const LAS bf16x8*)(c1 + 32), NX1); NX1 = MFMA16(aq2, *(const LAS bf16x8*)(c1 + 64), NX1); NX1 = MFMA16(aq3, *(const LAS bf16x8*)(c1 + 96), NX1); }
            { const float ws = S[SC_W / 4 + lane];
#pragma unroll
              for (int j = 0; j < 4; ++j) { const int c8 = (w4 + 4 * j) * 8; float kv[8]; unpack8(*(const LAS u32x4*)(Ks + lane * 136 + c8), kv);
#pragma unroll
                  for (int e = 0; e < 8; ++e) Kt[(c8 + e) * 72 + lane] = f2bf(kv[e] * ws); } }
            __syncthreads();
            f32x4 NI0 = {0.f, 0.f, 0.f, 0.f}, NI1 = NI0;
            { const LAS bf16* sp = SW + (16 * w4 + i16) * 72 + 8 * q4; const LAS bf16* v0 = Vt + (i16) * 72 + 8 * q4; const LAS bf16* v1 = Vt + (16 + i16) * 72 + 8 * q4;
              const bf16x8 s0 = *(const LAS bf16x8*)(sp), s1 = *(const LAS bf16x8*)(sp + 32);
              NI0 = MFMA16(s0, *(const LAS bf16x8*)(v0), NI0); NI0 = MFMA16(s1, *(const LAS bf16x8*)(v0 + 32), NI0);
              NI1 = MFMA16(s0, *(const LAS bf16x8*)(v1), NI1); NI1 = MFMA16(s1, *(const LAS bf16x8*)(v1 + 32), NI1); }
            float hv[4], oth[4];
            { const f32x4 isc = *(const LAS f32x4*)(S + SC_ISC / 4 + 16 * w4 + 4 * q4), flo = *(const LAS f32x4*)(S + SC_FLO / 4 + 16 * w4 + 4 * q4);
#pragma unroll
              for (int r = 0; r < 4; ++r) { const float num = NI0[r] + isc[r] * NX0[r]; const float dn = NI1[r] + isc[r] * NX1[r];
                  const float den = __shfl(dn, lane & 48);
                  hv[r] = num / fmaxf(fabsf(den), flo[r]); }
#pragma unroll
              for (int r = 0; r < 4; ++r) oth[r] = __shfl_xor(hv[r], 1); }
#define ML_OUT(first_) do { const bool odd_ = i16 & 1; \
            _Pragma("unroll") for (int rr_ = 0; rr_ < 2; ++rr_) { const int r_ = odd_ ? 2 + rr_ : rr_; const int t_ = 16 * w4 + 4 * q4 + r_; const int row_ = chunk_row(cs, t_); \
                const float hm_ = odd_ ? (rr_ ? hv[3] : hv[2]) : (rr_ ? hv[1] : hv[0]), ho_ = odd_ ? (rr_ ? oth[3] : oth[2]) : (rr_ ? oth[1] : oth[0]); \
                float a0_ = odd_ ? ho_ : hm_, a1_ = odd_ ? hm_ : ho_; \
                if (row_ >= 0) { unsigned* p_ = (unsigned*)(((row_ < SEQ) ? CELL + (size_t)row_ * 2048 : CELLM + (size_t)(row_ - SEQ) * 2048) + h * 256 + sl * 16 + (i16 & ~1)); \
                    if (!(first_)) { const unsigned old_ = __hip_atomic_load(p_, __ATOMIC_RELAXED, __HIP_MEMORY_SCOPE_AGENT); a0_ += bflo(old_); a1_ += bfhi(old_); } \
                    *p_ = cvt_pk_bf16(a0_, a1_); } } } while (0)
            if (i == 128) {
                if (d == 0) { ML_OUT(true); VM_WAIT(); }
                __syncthreads();
                if (d == 1) { ML_OUT(false); }
            } else { const bool first = i < 128; ML_OUT(first); }
            {
                const float dec = S[SC_DEC / 4];
                const LAS bf16* v0 = Vt + (i16) * 72 + 8 * q4; const LAS bf16* v1 = Vt + (16 + i16) * 72 + 8 * q4;
                const LAS bf16* k0 = Kt + (16 * (2 * w4) + i16) * 72 + 8 * q4; const LAS bf16* k1 = Kt + (16 * (2 * w4 + 1) + i16) * 72 + 8 * q4;
                const bf16x8 va0 = *(const LAS bf16x8*)(v0), va1 = *(const LAS bf16x8*)(v0 + 32), vb0 = *(const LAS bf16x8*)(v1), vb1 = *(const LAS bf16x8*)(v1 + 32);
                const bf16x8 ka0 = *(const LAS bf16x8*)(k0), ka1 = *(const LAS bf16x8*)(k0 + 32), kb0 = *(const LAS bf16x8*)(k1), kb1 = *(const LAS bf16x8*)(k1 + 32);
                Cst00 = Cst00 * dec; Cst01 = Cst01 * dec; Cst10 = Cst10 * dec; Cst11 = Cst11 * dec;
                Cst00 = MFMA16(va0, ka0, Cst00); Cst00 = MFMA16(va1, ka1, Cst00);
                Cst01 = MFMA16(va0, kb0, Cst01); Cst01 = MFMA16(va1, kb1, Cst01);
                Cst10 = MFMA16(vb0, ka0, Cst10); Cst10 = MFMA16(vb1, ka1, Cst10);
                Cst11 = MFMA16(vb0, kb0, Cst11); Cst11 = MFMA16(vb1, kb1, Cst11);
            }
            if (w4 == 0 && i < 256) { ML_SCALARS(g1li, g1lf, par ^ 1); g1li = g2li; g1lf = g2lf; }
            __syncthreads();
#pragma unroll
            for (int r = 0; r < 4; ++r) {
                Cb[(4 * q4 + r) * 136 + 16 * (2 * w4) + i16] = f2bf(Cst00[r]); Cb[(4 * q4 + r) * 136 + 16 * (2 * w4 + 1) + i16] = f2bf(Cst01[r]);
                Cb[(16 + 4 * q4 + r) * 136 + 16 * (2 * w4) + i16] = f2bf(Cst10[r]); Cb[(16 + 4 * q4 + r) * 136 + 16 * (2 * w4 + 1) + i16] = f2bf(Cst11[r]); }
        }
        VM_WAIT(); __syncthreads();
#undef ML_LOADQK
#undef ML_LOAD
#undef ML_SCALARS
#undef ML_CS
#undef ML_ST
#undef ML_OUT
    }
}

#if DBG_CHECK
constexpr size_t MS_STASH = MS_END;
constexpr int ST_QATT = 0;
constexpr int ST_GB = 8 * 128;
constexpr int ST_XM = ST_GB + 16;
constexpr int NCHK = 16;
DI float* chk_words(const Ctx& C) { return (float*)((unsigned*)(C.misc() + MS_CTL) + CW_CHK); }
DI void chk_add(const Ctx& C, int id, float diff, float ref) {
    float d2 = diff * diff, r2 = ref * ref; if (!(d2 >= 0.f) || !(d2 < 1e30f)) d2 = 1e30f;
    atomicAdd(chk_words(C) + 2 * id, d2); atomicAdd(chk_words(C) + 2 * id + 1, r2);
}
DI unsigned hsh(unsigned x) { x ^= x >> 16; x *= 0x7feb352du; x ^= x >> 15; x *= 0x846ca68bu; x ^= x >> 16; return x; }
DI int smp_row(int s) { return s == 0 ? 0 : s == 1 ? 63 : s == 2 ? 16383 : s == 3 ? 16384 : s == 4 ? 16399 : s == 5 ? 8191 : (int)(hsh(1000 + s) % LTOK); }
DI float wdot_bf_f32col(const bf16* a, const float* w, int ldw, int K, int lane) { float s = 0.f; for (int k = lane; k < K; k += 64) s += bf2f(a[k]) * w[(size_t)k * ldw]; return wave_sum(s); }

DI void dbg_check_gemm_plain(const Ctx& C, int id, const bf16* A, int lda, const float* W, int ldw, int K, const bf16* O, int ldo) {
    for (int s = C.gw; s < 48; s += C.ngw) { const int row = smp_row(s % 12), col = (int)(hsh(77 + s) % (unsigned)ldo);
        const float ref = wdot_bf_f32col(A + (size_t)row * lda, W + col, ldw, K, C.lane);
        if (C.lane == 0) chk_add(C, id, bf2f(O[(size_t)row * ldo + col]) - ref, ref); }
}
DI void dbg_check_e1(const Ctx& C, int li, const bf16* h, const bf16* YAB, const bf16* Kb, const bf16* Vb, const bf16* GA, const bf16* U) {
    const float* W = C.in[I_WINE] + (size_t)li * 1024 * 4608;
    for (int s = C.gw; s < 96; s += C.ngw) { const int row = smp_row(s % 12); const int seg = (s / 12) % 6;
        const int lo_ = seg == 0 ? 0 : seg == 1 ? 1024 : seg == 2 ? 1280 : seg == 3 ? 1536 : seg == 4 ? 2560 : 3584, wd_ = (seg == 1 || seg == 2) ? 256 : 1024;
        const int col = lo_ + (int)(hsh(5 + s) % (unsigned)wd_), c = col - lo_;
        float ref = wdot_bf_f32col(h + (size_t)row * 1024, W + col, 4608, 1024, C.lane);
        float got;
        if (seg == 0) got = bf2f(YAB[(size_t)row * 2048 + c]); else if (seg == 1) got = bf2f(Kb[(size_t)row * 256 + c]); else if (seg == 2) got = bf2f(Vb[(size_t)row * 256 + c]);
        else if (seg == 3) { got = bf2f(GA[(size_t)row * 1024 + c]); ref = ref / (1.f + expf(-ref)); } else if (seg == 4) got = bf2f(U[(size_t)row * 1024 + c]);
        else { got = bf2f(YAB[(size_t)row * 2048 + 1024 + c]); ref = ref / (1.f + expf(-ref)); }
        if (C.lane == 0) chk_add(C, 2, got - ref, ref); }
}
DI void naive_qk_head(const Ctx& C, int li, const bf16* h, int row, int hs, float& o0, float& o1) {
    const float* W = C.in[I_WINE] + (size_t)li * 1024 * 4608; const int cb = hs < 8 ? hs * 128 : 1024 + (hs - 8) * 128;
    float r0 = 0.f, r1 = 0.f;
    for (int k = 0; k < 1024; ++k) { const float hv = bf2f(h[(size_t)row * 1024 + k]); r0 += hv * W[(size_t)k * 4608 + cb + C.lane]; r1 += hv * W[(size_t)k * 4608 + cb + 64 + C.lane]; }
    r0 = bf2f(f2bf(r0)); r1 = bf2f(f2bf(r1));
    const float ss = wave_sum(r0 * r0 + r1 * r1); const float rs = 1.f / sqrtf(ss / 128.f + EPS);
    const float* g = (hs < 8 ? C.in[I_QN] : C.in[I_KN]) + li * 128;
    const float n0 = r0 * rs * g[C.lane], n1 = r1 * rs * g[64 + C.lane];
    const int j = C.lane & 31; const float fr = exp2f(-(float)j * (13.287712379549449f / 32.f));
    float pr = 0.f, pc = 0.f; if (row < SEQ) { pr = (float)(row / 64); pc = (float)(row % 64); }
    const float p0 = __shfl_xor(n0, 32), p1 = __shfl_xor(n1, 32);
    float cr, sr, cc, sc; cis_rev(pr * fr, cr, sr); cis_rev(pc * fr, cc, sc);
    o0 = C.lane < 32 ? n0 * cr - p0 * sr : n0 * cr + p0 * sr;
    o1 = C.lane < 32 ? n1 * cc - p1 * sc : n1 * cc + p1 * sc;
}
DI void dbg_check_e2(const Ctx& C, int li, const bf16* h, const bf16* YAB, const bf16* Kb) {
    for (int s = C.gw; s < 40; s += C.ngw) { const int row = smp_row(s % 10), hs = (s * 7) % 10; float o0, o1; naive_qk_head(C, li, h, row, hs, o0, o1);
        const bf16* p = hs < 8 ? YAB + (size_t)row * 2048 + hs * 128 : Kb + (size_t)row * 256 + (hs - 8) * 128;
        const float d0 = bf2f(p[C.lane]) - o0, d1 = bf2f(p[64 + C.lane]) - o1;
        const float dd = wave_sum(d0 * d0 + d1 * d1), rr = wave_sum(o0 * o0 + o1 * o1);
        if (C.lane == 0) chk_add(C, 3, sqrtf(dd), sqrtf(rr)); }
}
DI void dbg_check_s5(const Ctx& C, int li, const bf16* U, const bf16* YG) {
    float* st = (float*)(C.misc() + MS_STASH);
    const bf16* YAB = C.slot(2);
    for (int s = C.gw; s < 8; s += C.ngw) { const int row = smp_row(s), hd = (s * 3) % 8; st[ST_QATT + s * 128 + C.lane] = bf2f(YAB[(size_t)row * 2048 + hd * 128 + C.lane]); st[ST_QATT + s * 128 + 64 + C.lane] = bf2f(YAB[(size_t)row * 2048 + hd * 128 + 64 + C.lane]); }
    if (C.gw == 8 && C.lane < 16) { const int row = smp_row(C.lane % 12), col = (int)(hsh(300 + C.lane) % 1024u); st[ST_GB + C.lane] = bf2f(YAB[(size_t)row * 2048 + 1024 + col]); }
    for (int s = C.gws; s < 6; s += C.ngw) {
        const int row = smp_row(s), g = (int)(hsh(40 + s) % 64u), l = seq_of_row(row), n = C.lane;
        float y[16];
#pragma unroll
        for (int p = 0; p < 16; ++p) y[p] = 0.f;
        for (int d = 0; d < 2; ++d) {
            const size_t pidx = (((size_t)li * 2 + d) * 64 + g) * 64 + n;
            const float ar = C.in[I_ARE][pidx], ai = C.in[I_AIM][pidx], dt = expf(C.in[I_LDT][((size_t)li * 2 + d) * 64 + g]);
            float c1_, s1_; cis_rev(ai * dt, c1_, s1_); const float mg = expf(ar * dt), abr = mg * c1_, abi = mg * s1_;
            const float xr0 = abr - 1.f, xi0 = abi, inv = 1.f / (ar * ar + ai * ai), kr = (xr0 * ar + xi0 * ai) * inv, ki = (xi0 * ar - xr0 * ai) * inv;
            float bbr[16], bbi[16];
#pragma unroll
            for (int p = 0; p < 16; ++p) { const float br = C.in[I_BRE][pidx * 16 + p], bi = C.in[I_BIM][pidx * 16 + p]; bbr[p] = kr * br - ki * bi; bbi[p] = kr * bi + ki * br; }
            float xr = 0.f, xi = 0.f;
            const int s0 = d == 0 ? 0 : LTOK - 1, s1 = l, step = d == 0 ? 1 : -1;
            for (int sq = s0;; sq += step) { const bf16* up = U + (size_t)row_of_seq(sq) * 1024 + g * 16; float ur = 0.f, ui = 0.f;
#pragma unroll
                for (int p = 0; p < 16; ++p) { const float u = bf2f(up[p]); ur += bbr[p] * u; ui += bbi[p] * u; }
                const float nr = abr * xr - abi * xi + ur, ni = abr * xi + abi * xr + ui; xr = nr; xi = ni;
                if (sq == s1) break; }
#pragma unroll
            for (int p = 0; p < 16; ++p) { const size_t ci = ((((size_t)li * 2 + d) * 64 + g) * 16 + p) * 64 + n; y[p] += wave_sum(C.in[I_CRE][ci] * xr - C.in[I_CIM][ci] * xi); }
        }
        float dd = 0.f, rr = 0.f;
#pragma unroll
        for (int p = 0; p < 16; ++p) { float v = y[p] + bf2f(U[(size_t)row * 1024 + g * 16 + p]) * C.in[I_SSMD][(size_t)li * 1024 + g * 16 + p];
            { const float z_ = 0.7978845608028654f * (v + 0.044715f * v * v * v); const float e2_ = expf(-2.f * fabsf(z_)); float th_ = (1.f - e2_) / (1.f + e2_); th_ = z_ < 0.f ? -th_ : th_; v = 0.5f * v * (1.f + th_); }
            const float df = bf2f(YG[(size_t)row * 1024 + g * 16 + p]) - v; dd += df * df; rr += v * v; }
        if (C.lane == 0) chk_add(C, 4, sqrtf(dd), sqrtf(rr));
    }
}
DI void dbg_check_e5(const Ctx& C, int li, const bf16* h, const bf16* YAB, const bf16* Kb, const bf16* Vb, const bf16* GA, const bf16* YG) {
    const float* st = (const float*)(C.misc() + MS_STASH);
    LAS float* sc = (LAS float*)C.lds; LAS float* red = sc + 16448;
    for (int s = C.bid; s < 8; s += C.G) { const int row = smp_row(s), hd = (s * 3) % 8, g = hd >> 2;
        const float* q = st + ST_QATT + s * 128;
        float mx = -1e30f;
        for (int key = C.tid; key < LTOK; key += NTHR) { float d = 0.f; for (int e = 0; e < 128; ++e) d += q[e] * bf2f(Kb[(size_t)key * 256 + g * 128 + e]); d *= 0.08838834764831845f; sc[key] = d; mx = fmaxf(mx, d); }
#pragma unroll
        for (int o = 1; o < 64; o <<= 1) mx = fmaxf(mx, __shfl_xor(mx, o));
        if (C.lane == 0) red[C.wave] = mx; __syncthreads();
        mx = red[0]; for (int w = 1; w < 8; ++w) mx = fmaxf(mx, red[w]); __syncthreads();
        float sm = 0.f; for (int key = C.tid; key < LTOK; key += NTHR) { const float p = expf(sc[key] - mx); sc[key] = p; sm += p; }
        sm = wave_sum(sm); if (C.lane == 0) red[C.wave] = sm; __syncthreads();
        sm = 0.f; for (int w = 0; w < 8; ++w) sm += red[w];
        if (C.tid < 128) { float o = 0.f; for (int key = 0; key < LTOK; ++key) o += sc[key] * bf2f(Vb[(size_t)key * 256 + g * 128 + C.tid]);
            o = o / sm * bf2f(GA[(size_t)row * 1024 + hd * 128 + C.tid]); const float got = bf2f(YAB[(size_t)row * 2048 + hd * 128 + C.tid]);
            const float dd = wave_sum((got - o) * (got - o)), rr = wave_sum(o * o); if (C.lane == 0) chk_add(C, 5, sqrtf(dd), sqrtf(rr)); }
        __syncthreads(); }
    const float* Wg = C.in[I_WGLU] + (size_t)li * 1024 * 1024;
    for (int s = C.gws; s < 16; s += C.ngw) { const int row = smp_row(s % 12), col = (int)(hsh(300 + s) % 1024u);
        const float pre = wdot_bf_f32col(YG + (size_t)row * 1024, Wg + col, 1024, 1024, C.lane) + C.in[I_BGLU][li * 1024 + col];
        const float ref = bf2f(YG[(size_t)row * 1024 + col]) / (1.f + expf(-pre)) * st[ST_GB + s];
        if (C.lane == 0) chk_add(C, 6, bf2f(YAB[(size_t)row * 2048 + 1024 + col]) - ref, ref); }
}
DI void dbg_check_conv(const Ctx& C, int li, const bf16* XM, const bf16* XC) {
    float* st = (float*)(C.misc() + MS_STASH);
    for (int s = C.gw; s < 8; s += C.ngw) { const int row = smp_row(s), hd = (s * 5) % 8;
        for (int e = C.lane; e < 256; e += 64) st[ST_XM + s * 256 + e] = bf2f(XM[(size_t)row * 2048 + hd * 256 + e]); }
    const float* cw = C.in[I_CONVW] + (size_t)li * 5 * 2048; const float* cb = C.in[I_CONVB] + (size_t)li * 2048;
    for (int s = C.gw * 64 + C.lane; s < 768; s += C.ngw * 64) { const int row = smp_row(s % 12), c = (int)(hsh(900 + s) % 2048u);
        const int l = row < SEQ ? row + 16 : row - SEQ; float a = cb[c];
        for (int j = 0; j < 5; ++j) { const int l2 = l + j - 2; if (l2 < 0 || l2 >= LTOK) continue; const int r2 = l2 < 16 ? SEQ + l2 : l2 - 16; a += cw[j * 2048 + c] * bf2f(XM[(size_t)r2 * 2048 + c]); }
        const float ref = a / (1.f + expf(-a)); chk_add(C, 10, bf2f(XC[(size_t)row * 2048 + c]) - ref, ref); }
}
DI void dbg_check_o3(const Ctx& C, int li, const bf16* XC, const bf16* Qm, const bf16* Km, const bf16* V, const bf16* VM) {
    const float* st = (const float*)(C.misc() + MS_STASH);
    for (int s = C.gw; s < 48; s += C.ngw) { const int row = smp_row(s % 12), hd = (int)(hsh(11 + s) % 8u), dm = (int)(hsh(12 + s) % 128u); const bool isk = s & 1;
        const float* W = (isk ? C.in[I_WK] : C.in[I_WQ]) + ((size_t)li * 8 + hd) * 256 * 128;
        const float ref = wdot_bf_f32col(XC + (size_t)row * 2048 + hd * 256, W + dm, 128, 256, C.lane);
        if (C.lane == 0) chk_add(C, 11, bf2f((isk ? Km : Qm)[(size_t)row * 1024 + hd * 128 + dm]) - ref, ref); }
    for (int s = C.gw; s < 8; s += C.ngw) { const int row = smp_row(s), hd = (s * 5) % 8;
        for (int t = 0; t < 4; ++t) { const int n = (int)(hsh(50 + s * 4 + t) % 256u); const float* W = C.in[I_WV] + ((size_t)li * 8 + hd) * 256 * 256 + n;
            float a = 0.f; for (int k = C.lane; k < 256; k += 64) a += st[ST_XM + s * 256 + k] * W[(size_t)k * 256]; a = wave_sum(a);
            const float got = bf2f(row < SEQ ? V[(size_t)row * 2048 + hd * 256 + n] : VM[(size_t)(row - SEQ) * 2048 + hd * 256 + n]);
            if (C.lane == 0) chk_add(C, 12, got - a, a); } }
    const float* GI = (const float*)(C.misc() + MS_GI); const float* GF = (const float*)(C.misc() + MS_GF);
    for (int s = C.gw; s < 48; s += C.ngw) { const int row = smp_row(s % 12), dh = (int)(hsh(70 + s) % 16u), d = dh >> 3, hd = dh & 7; const bool isf = s & 1;
        const float* W = (isf ? C.in[I_WFG] : C.in[I_WIG]) + ((size_t)li * 2 + d) * 2048 * 8 + hd;
        float a = wdot_bf_f32col(XC + (size_t)row * 2048, W, 8, 2048, C.lane) + (isf ? C.in[I_BFG] : C.in[I_BIG])[li * 16 + dh];
        if (isf) a = fminf(a, 0.f) - log1pf(expf(-fabsf(a)));
        const int pos = row < SEQ ? row + 64 : row - SEQ + 48;
        if (C.lane == 0) chk_add(C, 13, (isf ? GF : GI)[(size_t)dh * NPOS + pos] - a, a); }
    if (C.gw == 0 && C.lane < 16) { chk_add(C, 13, GI[(size_t)C.lane * NPOS + 5] + 1e9f, 1e9f); chk_add(C, 13, GF[(size_t)C.lane * NPOS + 47], 0.f); }
}
DI void dbg_check_mlstm(const Ctx& C, int li, const bf16* Qm, const bf16* Km, const bf16* V, const bf16* VM, const bf16* CELL, const bf16* CELLM) {
    const float* GI = (const float*)(C.misc() + MS_GI); const float* GF = (const float*)(C.misc() + MS_GF);
    for (int s = C.gws; s < 12; s += C.ngw) { const int row = smp_row(s), hd = (int)(hsh(21 + s) % 8u), vc = (int)(hsh(22 + s) % 256u); const int pos = row < SEQ ? row + 64 : row - SEQ + 48;
        float tot = 0.f;
        for (int d = 0; d < 2; ++d) { const float* gi = GI + (size_t)(d * 8 + hd) * NPOS; const float* gf = GF + (size_t)(d * 8 + hd) * NPOS;
            float num = 0.f, den = 0.f, carry = 0.f;
            for (int b0 = 0; b0 < NPOS; b0 += 64) { const int sp = d == 0 ? pos - b0 - C.lane : pos + b0 + C.lane; const bool ok = sp >= 48 && sp < NPOS;
                const float lf = ok ? gf[sp] : 0.f; const float lfe = (b0 == 0 && C.lane == 0) ? 0.f : lf;
                float pre = d == 0 ? lf : lf;
#pragma unroll
                for (int o = 1; o < 64; o <<= 1) { const float x = __shfl_up(pre, o); pre += C.lane >= o ? x : 0.f; }
                const float cum = carry + pre - lf; (void)lfe;
                if (ok && cum > -80.f) { const int r = sp >= 64 ? sp - 64 : SEQ + sp - 48; const int rt = row; float dot = 0.f;
                    for (int e = 0; e < 128; ++e) dot += bf2f(Qm[(size_t)rt * 1024 + hd * 128 + e]) * bf2f(Km[(size_t)r * 1024 + hd * 128 + e]);
                    const float w = expf(cum + gi[sp]) * dot * 0.08838834764831845f;
                    const float vv = bf2f(r < SEQ ? V[(size_t)r * 2048 + hd * 256 + vc] : VM[(size_t)(r - SEQ) * 2048 + hd * 256 + vc]);
                    num += w * vv; den += w; }
                carry += __shfl(pre, 63);
                if (carry < -80.f) break; }
            num = wave_sum(num); den = wave_sum(den); tot += num / fmaxf(fabsf(den), 1.f); }
        const float got = bf2f(row < SEQ ? CELL[(size_t)row * 2048 + hd * 256 + vc] : CELLM[(size_t)(row - SEQ) * 2048 + hd * 256 + vc]);
        if (C.lane == 0) chk_add(C, 14, got - tot, tot); }
}
DI void dbg_check_ogate(const Ctx& C, int li, const bf16* XC, const bf16* SZ, const bf16* CELL, const bf16* CELLM, const bf16* HZ) {
    for (int s = C.gw; s < 48; s += C.ngw) { const int row = smp_row(s % 12), col = (int)(hsh(90 + s) % 2048u), hd = col >> 8;
        const float pre = wdot_bf_f32col(XC + (size_t)row * 2048, C.in[I_WOG] + (size_t)li * 2048 * 2048 + col, 2048, 2048, C.lane) + C.in[I_BOG][(size_t)li * 2048 + col];
        const bf16* cp = row < SEQ ? CELL + (size_t)row * 2048 : CELLM + (size_t)(row - SEQ) * 2048;
        float ss = 0.f; for (int e = C.lane; e < 256; e += 64) { const float v = bf2f(cp[hd * 256 + e]); ss += v * v; } ss = wave_sum(ss);
        const float cn = bf2f(cp[col]) / sqrtf(ss / 256.f + EPS) * C.in[I_HN][(size_t)li * 2048 + col];
        const float hh = cn / (1.f + expf(-pre)) + C.in[I_SKIP][(size_t)li * 2048 + col] * bf2f(XC[(size_t)row * 2048 + col]);
        const float ref = hh * bf2f(SZ[(size_t)row * 2048 + col]);
        if (C.lane == 0) chk_add(C, 15, bf2f(HZ[(size_t)row * 2048 + col]) - ref, ref); }
}
DI void dbg_report(const Ctx& C, unsigned* ctl) {
    const float* w = (const float*)(ctl + CW_CHK); int code = 0;
    for (int id = 1; id < NCHK; ++id) { const float d2 = w[2 * id], r2 = w[2 * id + 1]; const bool used = (d2 != 0.f || r2 != 0.f);
        if (used && code == 0) { const float rel = sqrtf(d2 / fmaxf(r2, 1e-20f)); if (!(rel < 0.05f)) code = 3 + id + (rel > 0.5f || !(rel < 1e30f) ? 32 : 0); } }
    if (ctl[CW_BAR + XB_TMO] != 0u) code = 3 + 20;
    if (code) { const float v = exp2f((float)code); for (size_t i = (size_t)C.gw * 64 + C.lane; i < (size_t)SEQ * 1024; i += (size_t)C.ngw * 64) C.out[i] = v; }
}
#endif

#ifndef DBG_CHECK
#define DBG_CHECK 0
#endif
constexpr int N_PHASES = 33;
#ifndef ONLY_J
#define ONLY_J -1
#endif
#define INJ(j) (ONLY_J < 0 || ONLY_J == (j))

__global__ void __launch_bounds__(NTHR, 2) hybrid_fwd(Params prm) {
    extern __shared__ __attribute__((aligned(16))) unsigned char lds_raw[];
    Ctx C;
    C.lds = (LAS unsigned char*)lds_raw;
    C.tid = threadIdx.x; C.lane = C.tid & 63; C.wave = __builtin_amdgcn_readfirstlane(C.tid >> 6);
    C.G = gridDim.x; C.bid = blockIdx.x; C.gw = C.bid * NWAVES + C.wave; C.ngw = C.G * NWAVES; C.gws = C.wave * C.G + C.bid;
    C.in = prm.in; C.out = (float*)(GAS float*)prm.out; C.ws = (unsigned char*)(GAS unsigned char*)prm.ws; C.dob = (unsigned char*)(GAS unsigned char*)prm.out;
    volatile LAS unsigned* MISC = (volatile LAS unsigned*)(C.lds + LDS_MISC);
    if (C.tid < 16) MISC[C.tid] = 0u;
    __syncthreads();
    unsigned* ctl = (unsigned*)(C.misc() + MS_CTL);
    XcdBarrier bar; bar.bar = ctl + CW_BAR; bar.x = 0; bar.st = nullptr;
    if (prm.use_bar) bar = xcd_barrier_post(ctl + CW_BAR, MISC);
    const int lo = prm.ph_lo, hi = prm.ph_hi;
#define IN(k) (lo <= (k) && (k) < hi)
#define SEAM(k) do { if (IN(k) && IN((k) + 1)) xcd_barrier(bar); } while (0)
#if DBG_CHECK
#define CHECK(k, call) do { if (IN(k)) { call; xcd_barrier(bar); } } while (0)
#else
#define CHECK(k, call) do { } while (0)
#endif
#define resid (C.slot(0))
#define wr (C.wreg())

    if (INJ(16) && IN(0)) { const Ctx C0 = C; const Ctx C = C0.fresh();
        phase_init_rows(C, resid, C.slot(1));
        phase_rope_table(C);
        convert_even_weights(C, 0);
        phase_s5_tables(C, 0);
    }
    SEAM(0);
    for (int li = 0; li < 2; ++li) {
        const int pb = 1 + li * 16;
#define h_e (C.slot(1))
#define YAB (C.slot(2))
#define GA (C.slot(4))
#define U (C.slot(5))
#define Kb (C.slot(6))
#define Vb (C.slot(6) + (size_t)KVROWS * 256)
#define YG (C.slot(1))
#define y_e (C.slot(4))
        if (INJ(0) && IN(pb + 0)) { const Ctx C0 = C; const Ctx C = C0.fresh();
            for (int i = C.gw * 64 + C.lane; i < 2 * 48 * 256 / 8; i += C.ngw * 64) {
                const int which = i / (48 * 32), r = (i / 32) % 48, c8 = (i % 32) * 8;
                *(u32x4*)((which ? Vb : Kb) + (size_t)(LTOK + r) * 256 + c8) = (u32x4){0u, 0u, 0u, 0u}; }
            FEvenIn f{YAB, Kb, Vb, GA, U};
            run_gemm<1024, 1024, 1024, 4608, 0>(C, h_e, (const bf16*)(wr + WE_IN), f);
            phase_s5_ktab_hcat(C, li);
        }
        SEAM(pb + 0);
        CHECK(pb + 0, dbg_check_e1(C, li, h_e, YAB, Kb, Vb, GA, U));
        if (INJ(1) && IN(pb + 1)) { const Ctx C0 = C; const Ctx C = C0.fresh();
            phase_qk_norm_rope(C, YAB, Kb, C.in[I_QN] + li * 128, C.in[I_KN] + li * 128);
            phase_s5_local(C, U);
        }
        SEAM(pb + 1);
        CHECK(pb + 1, dbg_check_e2(C, li, h_e, YAB, Kb));
        if (INJ(2) && IN(pb + 2)) { const Ctx C0 = C; const Ctx C = C0.fresh();
            phase_s5_scan(C);
            phase_s5_mg(C, li);
        }
        SEAM(pb + 2);
        if (INJ(3) && IN(pb + 3)) { const Ctx C0 = C; const Ctx C = C0.fresh();
            phase_s5_out(C, U, YG);
        }
        SEAM(pb + 3);
        CHECK(pb + 3, dbg_check_s5(C, li, U, YG));
        if (INJ(4) && IN(pb + 4)) { const Ctx C0 = C; const Ctx C = C0.fresh();
#ifndef NO_ATT
            phase_attention(C, YAB, Kb, Vb, GA);
#endif
#ifndef NO_GLU
            { const Ctx C1 = C0.fresh(); const Ctx& C = C1;
              FGlu f{YG, YAB, C.in[I_BGLU] + li * 1024};
              run_gemm<1024, 1024, 1024, 1024, 0>(C, YG, (const bf16*)(wr + WE_GLU), f); }
#endif
        }
        SEAM(pb + 4);
        CHECK(pb + 4, dbg_check_e5(C, li, h_e, YAB, Kb, Vb, GA, YG));
        if (INJ(5) && IN(pb + 5)) { const Ctx C0 = C; const Ctx C = C0.fresh();
            FPlain f{y_e, 1024};
            run_gemm<2048, 2048, 2048, 1024, 0>(C, YAB, (const bf16*)(wr + WE_OUT), f);
        }
        SEAM(pb + 5);
        CHECK(pb + 5, dbg_check_gemm_plain(C, 7, YAB, 2048, C.in[I_WOUTE] + (size_t)li * 2048 * 1024, 1024, 2048, y_e, 1024));
        if (INJ(6) && IN(pb + 6)) { const Ctx C0 = C; const Ctx C = C0.fresh();
            phase_post_rows(C, y_e, resid, C.slot(5), 2 * li);
            convert_odd_weights(C, li);
        }
        SEAM(pb + 6);
#define h_o (C.slot(5))
#define XM (C.slot(3))
#define XC (C.slot(1))
#define Qm (C.slot(5))
#define Km (C.slot(6))
#define CELL ((bf16*)C.dob)
#define CELLM ((bf16*)(C.misc() + MS_CELLM))
#define VM ((bf16*)(C.misc() + MS_VM))
#define h_r (C.slot(3))
#define SZ (C.slot(5))
#define HZ (C.slot(3))
#define y_o (C.slot(5))
        if (INJ(7) && IN(pb + 7)) { const Ctx C0 = C; const Ctx C = C0.fresh();
            FPlain f{XM, 2048};
            run_gemm<1024, 1024, 1024, 2048, 0>(C, h_o, (const bf16*)(wr + WO_IN), f);
        }
        SEAM(pb + 7);
        CHECK(pb + 7, dbg_check_gemm_plain(C, 9, h_o, 1024, C.in[I_WINO] + (size_t)li * 1024 * 4096, 4096, 1024, XM, 2048));
        if (INJ(8) && IN(pb + 8)) { const Ctx C0 = C; const Ctx C = C0.fresh();
            phase_conv(C, XM, XC, C.in[I_CONVW] + (size_t)li * 5 * 2048, C.in[I_CONVB] + (size_t)li * 2048);
        }
        SEAM(pb + 8);
        CHECK(pb + 8, dbg_check_conv(C, li, XM, XC));
        if (INJ(9) && IN(pb + 9)) { const Ctx C0 = C; const Ctx C = C0.fresh();
#ifndef NO_QK
            { FQK f{Qm, Km}; run_gemm<2048, 256, 256, 2048, 256>(C, XC, (const bf16*)(wr + WO_QK), f); }
#endif
#ifndef NO_V
            { FVrow f{XM, VM}; run_gemm<2048, 256, 256, 2048, 256>(C, XM, (const bf16*)(wr + WO_V), f); }
#endif
#ifndef NO_GATES
            phase_gates(C, XC, (const bf16*)(wr + WO_G), C.in[I_BIG] + li * 16, C.in[I_BFG] + li * 16);
#endif
        }
        SEAM(pb + 9);
        CHECK(pb + 9, dbg_check_o3(C, li, XC, Qm, Km, XM, VM));
        if (INJ(10) && IN(pb + 10)) { const Ctx C0 = C; const Ctx C = C0.fresh();
            phase_mlstm(C, Qm, Km, XM, VM, CELL, CELLM);
        }
        SEAM(pb + 10);
        CHECK(pb + 10, dbg_check_mlstm(C, li, Qm, Km, XM, VM, CELL, CELLM));
        if (INJ(11) && IN(pb + 11)) { const Ctx C0 = C; const Ctx C = C0.fresh();
            phase_renorm_rows(C, resid, h_r, 2 * li + 1);
            phase_cell_rstd(C, CELL, CELLM);
        }
        SEAM(pb + 11);
        if (INJ(12) && IN(pb + 12)) { const Ctx C0 = C; const Ctx C = C0.fresh();
            FSilu f{SZ, 2048};
            run_gemm<1024, 1024, 1024, 2048, 0>(C, h_r, (const bf16*)(wr + WO_Z), f);
        }
        SEAM(pb + 12);
        if (INJ(13) && IN(pb + 13)) { const Ctx C0 = C; const Ctx C = C0.fresh();
            FOgate f{CELL, CELLM, XC, SZ, HZ, C.in[I_BOG] + (size_t)li * 2048, C.in[I_HN] + (size_t)li * 2048, C.in[I_SKIP] + (size_t)li * 2048, (const float*)(C.misc() + MS_RSTD)};
            run_gemm<2048, 2048, 2048, 2048, 0>(C, XC, (const bf16*)(wr + WO_OG), f);
        }
        SEAM(pb + 13);
        CHECK(pb + 13, dbg_check_ogate(C, li, XC, SZ, CELL, CELLM, HZ));
        if (INJ(14) && IN(pb + 14)) { const Ctx C0 = C; const Ctx C = C0.fresh();
            FPlain f{y_o, 1024};
            run_gemm<2048, 2048, 2048, 1024, 0>(C, HZ, (const bf16*)(wr + WO_OUT), f);
        }
        SEAM(pb + 14);
        CHECK(pb + 14, dbg_check_gemm_plain(C, 1, HZ, 2048, C.in[I_WOUTO] + (size_t)li * 2048 * 1024, 1024, 2048, y_o, 1024));
        if (INJ(15) && IN(pb + 15)) { const Ctx C0 = C; const Ctx C = C0.fresh();
            phase_post_rows(C, y_o, resid, C.slot(1), 2 * li + 1);
            if (li == 0) { convert_even_weights(C, 1); phase_s5_tables(C, 1); }
        }
        if (li == 0) SEAM(pb + 15);
    }
#if DBG_CHECK
    if (IN(N_PHASES - 1)) { xcd_barrier(bar); dbg_report(C, ctl); }
#endif
#undef IN
#undef SEAM
#undef CHECK
#undef h_e
#undef YAB
#undef GA
#undef U
#undef Kb
#undef Vb
#undef YG
#undef y_e
#undef h_o
#undef XM
#undef XC
#undef Qm
#undef Km
#undef CELL
#undef CELLM
#undef VM
#undef h_r
#undef SZ
#undef HZ
#undef y_o
#undef resid
#undef wr
}

#ifndef MULTI_LAUNCH
#define MULTI_LAUNCH 0
#endif
extern "C" void kernel_launch(void* const* d_in, const int* in_sizes, int n_in, void* d_out, int out_size, void* d_ws, size_t ws_size, hipStream_t stream) {
    static int grid = 0;
    if (grid == 0) {
        if (n_in != 33 || in_sizes[0] != SEQ * DM || out_size != SEQ * DM || ws_size < WS_NEED) {
            fprintf(stderr, "kernel_launch: shape mismatch: n_in %d in0 %d out %d ws %zu (need %zu)\n", n_in, n_in > 0 ? in_sizes[0] : -1, out_size, ws_size, (size_t)WS_NEED); grid = -1; return; }
        int dev = 0, cus = 0, per_cu = 0;
        if (hipGetDevice(&dev) != hipSuccess || hipDeviceGetAttribute(&cus, hipDeviceAttributeMultiprocessorCount, dev) != hipSuccess) { fprintf(stderr, "kernel_launch: device query failed\n"); grid = -1; return; }
        if (hipFuncSetAttribute((const void*)hybrid_fwd, hipFuncAttributeMaxDynamicSharedMemorySize, LDS_TOTAL) != hipSuccess) { fprintf(stderr, "kernel_launch: hipFuncSetAttribute failed\n"); grid = -1; return; }
        if (hipOccupancyMaxActiveBlocksPerMultiprocessor(&per_cu, (const void*)hybrid_fwd, NTHR, LDS_TOTAL) != hipSuccess || per_cu < 1) { fprintf(stderr, "kernel_launch: occupancy query says %d blocks per CU\n", per_cu); (void)hipGetLastError(); }
        grid = cus;
    }
    if (grid < 0) return;
    if (hipMemsetAsync((char*)d_ws + WS_MISC + MS_CTL, 0, 65536, stream) != hipSuccess) { fprintf(stderr, "kernel_launch: memset failed\n"); return; }
    Params p{};
    for (int i = 0; i < 33; ++i) p.in[i] = (const float*)d_in[i];
    p.out = (float*)d_out; p.ws = (unsigned char*)d_ws; p.pad = 0;
#if MULTI_LAUNCH
    for (int k = 0; k < N_PHASES; ++k) { p.ph_lo = k; p.ph_hi = k + 1; p.use_bar = 0;
        hipLaunchKernelGGL(hybrid_fwd, dim3(grid), dim3(NTHR), LDS_TOTAL, stream, p); }
#else
    p.ph_lo = 0; p.ph_hi = N_PHASES; p.use_bar = 1;
    hipLaunchKernelGGL(hybrid_fwd, dim3(grid), dim3(NTHR), LDS_TOTAL, stream, p);
#endif
    const hipError_t le = hipPeekAtLastError();
    if (le != hipSuccess) fprintf(stderr, "kernel_launch: launch failed: %s\n", hipGetErrorName(le));
}
```

```cpp
#include <hip/hip_runtime.h>
#include <cstdio>
#include <cstdint>

#define DI __device__ __forceinline__
#define GAS __attribute__((address_space(1)))
#define LAS __attribute__((address_space(3)))
typedef unsigned short bf16;
typedef short bf16x8 __attribute__((ext_vector_type(8)));
typedef float f32x4 __attribute__((ext_vector_type(4)));
typedef float f32x2 __attribute__((ext_vector_type(2)));
typedef float f32x16 __attribute__((ext_vector_type(16)));
typedef unsigned u32x4 __attribute__((ext_vector_type(4)));
typedef unsigned u32x2 __attribute__((ext_vector_type(2)));
typedef short s16x4 __attribute__((ext_vector_type(4)));

constexpr int DM = 1024, SEQ = 16384, NMETA = 16, LTOK = 16400;
constexpr int KVROWS = 16448;
constexpr int NPOS = 16448;
constexpr int NWAVES = 8, NTHR = 512;
constexpr float EPS = 1e-6f;

DI float bf2f(bf16 b) { return __uint_as_float(((unsigned)b) << 16); }
DI float bflo(unsigned w) { return __uint_as_float(w << 16); }
DI float bfhi(unsigned w) { return __uint_as_float(w & 0xffff0000u); }
typedef __bf16 bf16x2_t __attribute__((ext_vector_type(2)));
DI unsigned cvt_pk_bf16(float lo, float hi) { bf16x2_t v = {(__bf16)lo, (__bf16)hi}; return __builtin_bit_cast(unsigned, v); }
DI bf16 f2bf(float f) { return (bf16)(cvt_pk_bf16(f, 0.f) & 0xffffu); }
DI float fexp(float x) { return __builtin_amdgcn_exp2f(x * 1.4426950408889634f); }
DI float silu_f(float x) { return x * __builtin_amdgcn_rcpf(1.f + __expf(-x)); }
DI float sigmoid_f(float x) { return __builtin_amdgcn_rcpf(1.f + __expf(-x)); }
DI float gelu_tanh_f(float v) { const float z = 0.7978845608028654f * (v + 0.044715f * v * v * v); const float t = 1.f - 2.f * __builtin_amdgcn_rcpf(1.f + __expf(2.f * z)); return 0.5f * v * (1.f + t); }
DI float shf(float v, int src_lane) { return __int_as_float(__builtin_amdgcn_ds_bpermute(src_lane << 2, __float_as_int(v))); }
DI float shx(float v, int mask, int lane) { return shf(v, lane ^ mask); }
DI float wave_sum(float v, int lane) {
#pragma unroll
    for (int o = 1; o < 64; o <<= 1) v += shx(v, o, lane);
    return v;
}
DI void unpack8(u32x4 w, float (&v)[8]) { v[0] = bflo(w.x); v[1] = bfhi(w.x); v[2] = bflo(w.y); v[3] = bfhi(w.y); v[4] = bflo(w.z); v[5] = bfhi(w.z); v[6] = bflo(w.w); v[7] = bfhi(w.w); }
DI u32x4 pack8(const float (&v)[8]) { u32x4 w; w.x = cvt_pk_bf16(v[0], v[1]); w.y = cvt_pk_bf16(v[2], v[3]); w.z = cvt_pk_bf16(v[4], v[5]); w.w = cvt_pk_bf16(v[6], v[7]); return w; }
DI u32x4 pack8v(f32x4 a, f32x4 b) { u32x4 w; w.x = cvt_pk_bf16(a[0], a[1]); w.y = cvt_pk_bf16(a[2], a[3]); w.z = cvt_pk_bf16(b[0], b[1]); w.w = cvt_pk_bf16(b[2], b[3]); return w; }
template <class T> DI void lnd(T*& p) { GAS T* q = (GAS T*)p; asm volatile("" : "+s"(q)); p = (T*)q; }
#define LDS_WAIT() asm volatile("s_waitcnt lgkmcnt(0)" ::: "memory")
#define VM_WAIT() asm volatile("s_waitcnt vmcnt(0)" ::: "memory")
#define MFMA16(a, b, c) __builtin_amdgcn_mfma_f32_16x16x32_bf16((a), (b), (c), 0, 0, 0)
#define MFMA32(a, b, c) __builtin_amdgcn_mfma_f32_32x32x16_bf16((a), (b), (c), 0, 0, 0)

namespace pg8 {
constexpr int BM = 256, BK = 64, HALF = 128, HTB = HALF * BK * 2, STAGE_BYTES = 8 * HTB, NXCD = 8, WGM = 8;
__host__ __device__ __forceinline__ int lds_byte(int r, int c) { const int st = (r >> 4) * 2 + (c >> 5), rr = r & 15, cc = c & 31, ob = rr * 64 + cc * 2; return st * 1024 + (ob ^ (((ob >> 9) & 1) << 5)); }
__host__ __device__ __forceinline__ void stage_rc(int b, int& R, int& C) { const int st = b / 1024, sb = b % 1024, swz = sb ^ (((sb >> 9) & 1) << 5); R = (st >> 1) * 16 + swz / 64; C = (st & 1) * 32 + (swz % 64) / 2; }
__host__ __device__ __forceinline__ int perm32(int rho) { const int n = rho >> 4, i = rho & 15; return 8 * (i >> 2) + 4 * n + (i & 3); }

struct Unit { int pm, pn; };
struct Gemm { const bf16* A; const bf16* Bt; };

template <int NN> struct StaticOrder {
    static constexpr int nM = 64, nN = NN, nwg = nM * nN;
    int G, c;
    __device__ void init(int G_, int c_) { G = G_; c = c_; }
    __device__ bool next(int i, Unit& u) const {
        const long L = (long)i * G + c; if (L >= nwg) return false;
        int wgid = (int)L; { const int q = nwg / NXCD, r = nwg % NXCD, xcd = wgid % NXCD, off = wgid / NXCD; wgid = (xcd < r ? xcd * (q + 1) : r * (q + 1) + (xcd - r) * q) + off; }
        const int nig = WGM * nN, gid = wgid / nig, fm = gid * WGM, gsz = (nM - fm) < WGM ? (nM - fm) : WGM;
        u.pm = fm + ((wgid % nig) % gsz); u.pn = (wgid % nig) / gsz; return true;
    }
};

template <class F> struct EpiT {
    static constexpr bool PERM = true;
    F f;
    DI void operator()(const f32x4 (&acc)[2][2][4][2], const Unit& u, int wr, int wc, int fr, int fq) const {
        const int row0 = u.pm * BM + wr * 64 + fr, col0 = u.pn * BM + wc * 32 + 8 * fq;
#pragma unroll
        for (int ai = 0; ai < 2; ++ai)
#pragma unroll
            for (int m = 0; m < 4; ++m)
#pragma unroll
                for (int bj = 0; bj < 2; ++bj) f.op8(row0 + ai * HALF + m * 16, col0 + bj * HALF, acc[ai][bj][m][0], acc[ai][bj][m][1]);
    }
};

template <class F> struct EpiP {
    static constexpr bool PERM = true;
    F f;
    DI void operator()(const f32x4 (&acc)[2][2][4][2], const Unit& u, int wr, int wc, int fr, int fq) const {
        const int row0 = u.pm * BM + wr * 64 + fr, col0 = u.pn * BM + wc * 32 + 8 * fq;
#pragma unroll
        for (int bj = 0; bj < 2; ++bj) {
            const int col = col0 + bj * HALF;
            const typename F::Cols cp = f.cols(col);
            typename F::Pre p0 = f.pre(row0, col), p1 = p0;
#pragma unroll
            for (int k = 0; k < 8; ++k) {
                const int ai = k >> 2, m = k & 3, row = row0 + ai * HALF + m * 16;
                if (k + 1 < 8) { const int rn = row0 + ((k + 1) >> 2) * HALF + ((k + 1) & 3) * 16; if (k & 1) p0 = f.pre(rn, col); else p1 = f.pre(rn, col); }
                f.fin(row, col, acc[ai][bj][m][0], acc[ai][bj][m][1], (k & 1) ? p1 : p0, cp);
            }
        }
    }
};
template <class F, bool P = F::PIPE> struct EpiSel { typedef EpiT<F> type; };
template <class F> struct EpiSel<F, true> { typedef EpiP<F> type; };

template <class Epi, class Sched, int LDA, int LDB, int KK, int APN>
DI void gemm_phase(LAS unsigned char* lds, const Gemm g, const Sched& S, const Epi& E) {
    int tid = threadIdx.x; asm volatile("" : "+v"(tid));
    const int wid = __builtin_amdgcn_readfirstlane(tid >> 6), lane = tid & 63, wr = wid >> 2, wc = wid & 3, fr = lane & 15, fq = lane >> 4;
    constexpr int nt = KK / BK;
    unsigned voffA[2], voffB[2];
#pragma unroll
    for (int i = 0; i < 2; ++i) { int R, C; stage_rc(tid * 16 + i * 8192, R, C); const int Rb = Epi::PERM ? ((R & ~31) + perm32(R & 31)) : R;
        voffA[i] = (unsigned)(R * LDA + C) * 2u; voffB[i] = (unsigned)(Rb * LDB + C) * 2u; }
    constexpr size_t kstep = (size_t)(BK * 2);
    constexpr size_t hstepA = (size_t)HALF * LDA * 2, hstepB = (size_t)HALF * LDB * 2;
    constexpr size_t tstepA = 2 * hstepA, tstepB = 2 * hstepB;
    constexpr size_t pnstepA = (size_t)APN * 2;
    const unsigned ldsw = (unsigned)wid * 1024u;
    const int aoff = lds_byte(wr * 64 + fr, fq * 8), boff = lds_byte(wc * 32 + fr, fq * 8);
#define PG8_SA(b, h) (((b) * 2 + (h)) * HTB)
#define PG8_SB(b, h) ((4 + (b) * 2 + (h)) * HTB)
#define PG8_STAGE(bufoff, gbase, voff) do { _Pragma("unroll") for (int _i = 0; _i < 2; ++_i) \
        __builtin_amdgcn_global_load_lds((const unsigned*)((const char*)(gbase) + (voff)[_i]), (LAS unsigned*)(lds + (bufoff) + ldsw + _i * 8192), 16, 0, 0); } while (0)
#define PG8_LDA(dst, b, h) do { _Pragma("unroll") for (int m = 0; m < 4; ++m) _Pragma("unroll") for (int k = 0; k < 2; ++k) dst[m][k] = *(const LAS bf16x8*)(lds + PG8_SA(b, h) + aoff + m * 2048 + k * 1024); } while (0)
#define PG8_LDB(dst, b, h) do { _Pragma("unroll") for (int n = 0; n < 2; ++n) _Pragma("unroll") for (int k = 0; k < 2; ++k) dst[n][k] = *(const LAS bf16x8*)(lds + PG8_SB(b, h) + boff + n * 2048 + k * 1024); } while (0)
#define PG8_MMA(ai, bj, At, Bt) do { __builtin_amdgcn_s_setprio(1); _Pragma("unroll") for (int m = 0; m < 4; ++m) _Pragma("unroll") for (int n = 0; n < 2; ++n) _Pragma("unroll") for (int k = 0; k < 2; ++k) \
        acc[ai][bj][m][n] = __builtin_amdgcn_mfma_f32_16x16x32_bf16(Bt[n][k], At[m][k], acc[ai][bj][m][n], 0, 0, 0); __builtin_amdgcn_s_setprio(0); } while (0)
#define PG8_WAIT_V(n) asm volatile("s_waitcnt vmcnt(" #n ")" ::: "memory")
#define PG8_WAIT_L(n) asm volatile("s_waitcnt lgkmcnt(" #n ")" ::: "memory")
#define PG8_BAR __builtin_amdgcn_s_barrier()
#define PG8_SCHED __builtin_amdgcn_sched_barrier(0)
    Unit cur, nxt; int ui = 0;
    if (!S.next(0, cur)) return;
    const bf16* gA = g.A; const bf16* gB = g.Bt;
    asm volatile("" : "+s"(gA), "+s"(gB));
    f32x4 acc[2][2][4][2];
#pragma unroll
    for (int a = 0; a < 2; ++a)
#pragma unroll
        for (int b = 0; b < 2; ++b)
#pragma unroll
            for (int m = 0; m < 4; ++m)
#pragma unroll
                for (int n = 0; n < 2; ++n) acc[a][b][m][n] = (f32x4){0.f, 0.f, 0.f, 0.f};
    bf16x8 At[4][2], B0[2][2], B1[2][2];
    const char* cA = (const char*)gA + (size_t)cur.pm * tstepA + (size_t)cur.pn * pnstepA; const char* cB = (const char*)gB + (size_t)cur.pn * tstepB;
    PG8_STAGE(PG8_SB(0, 0), cB, voffB); PG8_STAGE(PG8_SB(0, 1), cB + hstepB, voffB); PG8_STAGE(PG8_SA(0, 0), cA, voffA); PG8_STAGE(PG8_SA(0, 1), cA + hstepA, voffA);
    if (wr == 1) PG8_BAR;
    PG8_WAIT_V(2); PG8_BAR;
    PG8_STAGE(PG8_SB(1, 0), cB + kstep, voffB); PG8_STAGE(PG8_SA(1, 0), cA + kstep, voffA); PG8_STAGE(PG8_SB(1, 1), cB + hstepB + kstep, voffB);
    PG8_WAIT_V(6); PG8_BAR;
    for (;;) {
        const bool has_next = S.next(ui + 1, nxt);
        const char* nA = has_next ? (const char*)gA + (size_t)nxt.pm * tstepA + (size_t)nxt.pn * pnstepA : cA; const char* nB = has_next ? (const char*)gB + (size_t)nxt.pn * tstepB : cB;
#pragma unroll 1
        for (int t = 0; t < nt; t += 2) {
            const bool last = (t == nt - 2);
            const char* a1 = cA + (size_t)(t + 1) * kstep;
            const char* a2 = last ? nA : cA + (size_t)(t + 2) * kstep; const char* b2 = last ? nB : cB + (size_t)(t + 2) * kstep;
            const char* a3 = a2 + kstep; const char* b3 = b2 + kstep;
            PG8_LDB(B0, 0, 0); PG8_LDB(B1, 0, 1); PG8_SCHED; PG8_LDA(At, 0, 0); PG8_STAGE(PG8_SA(1, 1), a1 + hstepA, voffA);
            PG8_WAIT_V(8); PG8_WAIT_L(0); PG8_BAR; PG8_MMA(0, 0, At, B0); PG8_MMA(0, 1, At, B1); PG8_BAR; PG8_SCHED;
            PG8_LDA(At, 0, 1); PG8_STAGE(PG8_SB(0, 0), b2, voffB); PG8_STAGE(PG8_SB(0, 1), b2 + hstepB, voffB); PG8_STAGE(PG8_SA(0, 0), a2, voffA);
            PG8_WAIT_V(8); PG8_WAIT_L(0); PG8_BAR; PG8_MMA(1, 0, At, B0); PG8_MMA(1, 1, At, B1); PG8_BAR; PG8_SCHED;
            PG8_LDB(B0, 1, 0); PG8_LDB(B1, 1, 1); PG8_SCHED; PG8_LDA(At, 1, 0); PG8_STAGE(PG8_SA(0, 1), a2 + hstepA, voffA);
            PG8_WAIT_V(8); PG8_WAIT_L(0); PG8_BAR; PG8_MMA(0, 0, At, B0); PG8_MMA(0, 1, At, B1); PG8_BAR; PG8_SCHED;
            PG8_LDA(At, 1, 1); PG8_STAGE(PG8_SB(1, 0), b3, voffB); PG8_STAGE(PG8_SB(1, 1), b3 + hstepB, voffB); PG8_STAGE(PG8_SA(1, 0), a3, voffA);
            PG8_WAIT_V(8); PG8_WAIT_L(0); PG8_BAR; PG8_MMA(1, 0, At, B0); PG8_MMA(1, 1, At, B1); PG8_BAR; PG8_SCHED;
        }
        if (wr == 0) PG8_BAR;
        E(acc, cur, wr, wc, fr, fq);
        if (!has_next) break;
#pragma unroll
        for (int a = 0; a < 2; ++a)
#pragma unroll
            for (int b = 0; b < 2; ++b)
#pragma unroll
                for (int m = 0; m < 4; ++m)
#pragma unroll
                    for (int n = 0; n < 2; ++n) acc[a][b][m][n] = (f32x4){0.f, 0.f, 0.f, 0.f};
        cur = nxt; cA = nA; cB = nB; ++ui;
        if (wr == 1) PG8_BAR;
    }
    PG8_WAIT_V(0);
    PG8_BAR;
#undef PG8_SA
#undef PG8_SB
#undef PG8_STAGE
#undef PG8_LDA
#undef PG8_LDB
#undef PG8_MMA
#undef PG8_WAIT_V
#undef PG8_WAIT_L
#undef PG8_BAR
#undef PG8_SCHED
}
}

template <class F>
DI void gemm_tail(LAS unsigned char* lds, const bf16* A, int lda, const bf16* Bt, int ldb, int K, int N, int a_pn_step, const F& f, int row_base, int bid, int G, int wave, int lane) {
    const int i16 = lane & 15, kq = lane >> 4;
    LAS float* P = (LAS float*)lds;
    for (int task = bid; task < N / 32; task += G) {
        const int n0 = task * 32, pn = n0 >> 8, kw = K >> 3, kb = wave * kw;
        const bf16* ap = A + (size_t)i16 * lda + (size_t)pn * a_pn_step + kb + 8 * kq;
        const bf16* b0p = Bt + (size_t)(n0 + 8 * (i16 >> 2) + (i16 & 3)) * ldb + kb + 8 * kq;
        const bf16* b1p = b0p + (size_t)4 * ldb;
        f32x4 acc0 = {0.f, 0.f, 0.f, 0.f}, acc1 = {0.f, 0.f, 0.f, 0.f};
#pragma unroll 8
        for (int k0 = 0; k0 < kw; k0 += 32) {
            const bf16x8 a = *(const bf16x8*)(ap + k0), b0 = *(const bf16x8*)(b0p + k0), b1 = *(const bf16x8*)(b1p + k0);
            acc0 = MFMA16(b0, a, acc0); acc1 = MFMA16(b1, a, acc1);
        }
#pragma unroll
        for (int r = 0; r < 4; ++r) { P[(wave * 8 + r) * 64 + lane] = acc0[r]; P[(wave * 8 + 4 + r) * 64 + lane] = acc1[r]; }
        __syncthreads();
        if (wave == 0) {
            f32x4 s0 = {0.f, 0.f, 0.f, 0.f}, s1 = s0;
#pragma unroll
            for (int ww = 0; ww < 8; ++ww)
#pragma unroll
                for (int r = 0; r < 4; ++r) { s0[r] += P[(ww * 8 + r) * 64 + lane]; s1[r] += P[(ww * 8 + 4 + r) * 64 + lane]; }
            f.op8(row_base + i16, n0 + 8 * kq, s0, s1);
        }
        __syncthreads();
    }
}

constexpr size_t SLOT = (size_t)LTOK * 1024 * 2;
constexpr size_t WS_SLOT0 = 0;
constexpr size_t WS_WREG = 7 * SLOT;
constexpr size_t WREG_BYTES = 24117248;
constexpr size_t WS_MISC = WS_WREG + WREG_BYTES;
constexpr size_t MS_CTL = 0;
constexpr size_t MS_GI = 65536;
constexpr size_t MS_GF = MS_GI + (size_t)2 * 8 * NPOS * 4;
constexpr size_t MS_RSTD = MS_GF + (size_t)2 * 8 * NPOS * 4;
constexpr size_t MS_CELLM = MS_RSTD + (size_t)LTOK * 8 * 4;
constexpr size_t MS_VM = MS_CELLM + 64 * 2048 * 2;
constexpr size_t MS_ROPE = MS_VM + 64 * 2048 * 2;
constexpr size_t MS_ZROW = MS_ROPE + 256 * 32 * 8;
constexpr size_t MS_GB = MS_ZROW + 4096;
constexpr size_t MS_K8 = MS_GB + (size_t)2 * 8 * NPOS * 4;
constexpr size_t MS_END = MS_K8 + (size_t)KVROWS * 256;
constexpr size_t WS_NEED = WS_MISC + MS_END;
constexpr size_t WE_IN = 0, WE_GLU = WE_IN + (size_t)4608 * 1024 * 2, WE_OUT = WE_GLU + (size_t)1024 * 1024 * 2;
constexpr size_t WO_IN = 0, WO_Z = WO_IN + (size_t)2048 * 1024 * 2, WO_QK = WO_Z + (size_t)2048 * 1024 * 2, WO_V = WO_QK + (size_t)2048 * 256 * 2,
                 WO_G = WO_V + (size_t)2048 * 256 * 2, WO_OUT = WO_G + (size_t)32 * 2048 * 2, WO_OG = WE_OUT + (size_t)2048 * 1024 * 2;
static_assert(WO_V == WE_GLU && WO_OUT + (size_t)1024 * 2048 * 2 <= WO_OG && WO_OG + (size_t)2048 * 2048 * 2 == WREG_BYTES, "odd weight region");
constexpr size_t DO_EX = 0;
constexpr size_t DO_HCAT = DO_EX + (size_t)1025 * 64 * 256 * 2;
constexpr size_t DO_MG = DO_HCAT + (size_t)64 * 256 * 256 * 2;
constexpr size_t DO_APOW = DO_MG + (size_t)64 * 256 * 512 * 2;
constexpr size_t DO_BB = DO_APOW + (size_t)2 * 64 * 64 * 17 * 8;
constexpr size_t DO_KTAB = DO_BB + (size_t)2 * 64 * 64 * 16 * 8;
static_assert(DO_KTAB + (size_t)2 * 64 * 16 * 256 * 4 <= (size_t)SEQ * 1024 * 4, "d_out scratch map");

constexpr int CW_BAR = 1024;
constexpr int CW_CHK = 8192;
constexpr int LDS_TOTAL = 160 * 1024;
constexpr int LDS_MISC = LDS_TOTAL - 64;

#define XB_TMO      128
#define XB_XCNT(j)  (256  + 64 * (j))
#define XB_XSUB(j)  (1280 + 64 * (j))
#define XB_XGEN(j)  (2304 + 64 * (j))
#define XB_TOP      3328
#define XB_TOPGEN   3392
#define XCD_BAR_WORDS 3456
#define XB_SPIN_CAP (1u << 21)
DI unsigned xb_ld(unsigned* p)              { return __hip_atomic_load(p, __ATOMIC_RELAXED, __HIP_MEMORY_SCOPE_AGENT); }
DI unsigned xb_add(unsigned* p, unsigned v) { return __hip_atomic_fetch_add(p, v, __ATOMIC_RELAXED, __HIP_MEMORY_SCOPE_AGENT); }
DI unsigned xb_xcc_id() { return (unsigned)__builtin_amdgcn_s_getreg((3 << 11) | 20) & 0xFu; }
#define XB_SPIN(cond, bar) do { unsigned _sp = 0; while (cond) { __builtin_amdgcn_s_sleep(1); \
    if ((++_sp & 255u) == 0u) { if (xb_ld(&(bar)[XB_TMO])) break; if (_sp > XB_SPIN_CAP) { atomicAdd(&(bar)[XB_TMO], 1u); break; } } } } while (0)
struct XcdBarrier { unsigned* bar; unsigned x; volatile LAS unsigned* st; };
DI XcdBarrier xcd_barrier_post(unsigned* bar, volatile LAS unsigned* st) {
    XcdBarrier b; b.bar = bar; b.x = xb_xcc_id(); b.st = st;
    if (threadIdx.x == 0) (void)xb_add(&bar[XB_XCNT(b.x)], 1u);
    return b;
}
DI void xcd_barrier_complete(unsigned* bar, unsigned x, unsigned& nloc, unsigned& nx) {
    const unsigned G = gridDim.x * gridDim.y * gridDim.z;
    unsigned sum, cnt, mine, sp = 0u;
    for (;;) {
        sum = 0u; cnt = 0u; mine = 0u;
#pragma unroll
        for (unsigned j = 0; j < 16; ++j) { const unsigned c = xb_ld(&bar[XB_XCNT(j)]); sum += c; cnt += (c > 0u) ? 1u : 0u; mine = (j == x) ? c : mine; }
        if (sum == G) break;
        __builtin_amdgcn_s_sleep(1);
        if ((++sp & 255u) == 0u) { if (xb_ld(&bar[XB_TMO])) break; if (sp > XB_SPIN_CAP) { atomicAdd(&bar[XB_TMO], 1u); break; } }
    }
    nloc = mine > 0u ? mine : 1u; nx = cnt > 0u ? cnt : 1u;
}
DI void xcd_barrier(const XcdBarrier& b) {
    asm volatile("s_waitcnt vmcnt(0)" ::: "memory");
    __syncthreads();
    if (threadIdx.x == 0) {
        unsigned* bar = b.bar; lnd(bar);
        __builtin_amdgcn_s_waitcnt(0);
        unsigned nloc = b.st[0], nx = b.st[1];
        if (nloc == 0u) { xcd_barrier_complete(bar, b.x, nloc, nx); b.st[0] = nloc; b.st[1] = nx; }
        const unsigned old = xb_add(&bar[XB_XSUB(b.x)], 1u);
        const unsigned gen = old / nloc;
        if (old + 1u == (gen + 1u) * nloc) {
            __builtin_amdgcn_fence(__ATOMIC_RELEASE, "agent");
            asm volatile("s_waitcnt vmcnt(0)" ::: "memory");
            const unsigned og = xb_add(&bar[XB_TOP], 1u);
            const unsigned tg = og / nx;
            if (og + 1u == (tg + 1u) * nx) xb_add(&bar[XB_TOPGEN], 1u);
            else XB_SPIN(xb_ld(&bar[XB_TOPGEN]) == tg, bar);
            __builtin_amdgcn_fence(__ATOMIC_ACQUIRE, "agent");
            xb_add(&bar[XB_XGEN(b.x)], 1u);
            asm volatile("s_waitcnt vmcnt(0)" ::: "memory");
        } else {
            XB_SPIN(xb_ld(&bar[XB_XGEN(b.x)]) == gen, bar);
            __builtin_amdgcn_fence(__ATOMIC_ACQUIRE, "agent");
            asm volatile("s_waitcnt vmcnt(0)" ::: "memory");
        }
    }
    __syncthreads();
}

struct Params { const float* in[33]; float* out; unsigned char* ws; int ph_lo, ph_hi, use_bar, pad; };
enum { I_X = 0, I_META, I_NPRE, I_NPOST, I_WINE, I_QN, I_KN, I_ARE, I_AIM, I_LDT, I_BRE, I_BIM, I_CRE, I_CIM, I_SSMD, I_WGLU, I_BGLU, I_WOUTE,
       I_WINO, I_CONVW, I_CONVB, I_WQ, I_WK, I_WV, I_WIG, I_BIG, I_WFG, I_BFG, I_WOG, I_BOG, I_HN, I_SKIP, I_WOUTO };

struct Ctx {
    LAS unsigned char* lds;
    int tid, lane, wave, G, bid;
    int gw, ngw;
    int gws;
    const float* const* in; float* out; unsigned char* ws; unsigned char* dob;
    DI bf16* slot(int i) const { return (bf16*)(ws + WS_SLOT0 + (size_t)i * SLOT); }
    DI Ctx fresh() const { Ctx P = *this; asm volatile("" : "+v"(P.tid)); P.lane = P.tid & 63; P.wave = __builtin_amdgcn_readfirstlane(P.tid >> 6);
        asm volatile("" : "+s"(P.G)); P.ngw = P.G * NWAVES; P.gw = P.bid * NWAVES + P.wave; P.gws = P.wave * P.G + P.bid; lnd(P.ws); lnd(P.dob); lnd(P.out); return P; }
    DI unsigned char* wreg() const { return ws + WS_WREG; }
    DI unsigned char* misc() const { return ws + WS_MISC; }
};

DI void transpose_item(const float* W, int ldw, int N, bf16* WT, int ldo, int row_off, LAS float* scr, int item, int lane, const float* ks = nullptr) {
    const int nblk = N / 32, kb = item / nblk, nb = item % nblk, k0 = 64 * kb, n0 = 32 * nb;
    f32x4 v[8];
#pragma unroll
    for (int i = 0; i < 8; ++i) v[i] = *(const f32x4*)(W + (size_t)(k0 + 8 * i + (lane >> 3)) * ldw + n0 + 4 * (lane & 7));
#pragma unroll
    for (int i = 0; i < 8; ++i) { const int kk = 8 * i + (lane >> 3); const float sc = ks ? ks[k0 + kk] : 1.f; LAS float* d = scr + kk * 33 + 4 * (lane & 7);
        d[0] = v[i][0] * sc; d[1] = v[i][1] * sc; d[2] = v[i][2] * sc; d[3] = v[i][3] * sc; }
    LDS_WAIT(); asm volatile("" ::: "memory");
    const int c = lane & 7;
#pragma unroll
    for (int j = 0; j < 4; ++j) { const int n = (lane >> 3) + 8 * j; const LAS float* s = scr + (8 * c) * 33 + n;
        u32x4 o; o.x = cvt_pk_bf16(s[0 * 33], s[1 * 33]); o.y = cvt_pk_bf16(s[2 * 33], s[3 * 33]); o.z = cvt_pk_bf16(s[4 * 33], s[5 * 33]); o.w = cvt_pk_bf16(s[6 * 33], s[7 * 33]);
        *(u32x4*)(WT + (size_t)(row_off + n0 + n) * ldo + k0 + 8 * c) = o; }
    LDS_WAIT(); asm volatile("" ::: "memory");
}

DI void convert_even_weights(const Ctx& C, int li) {
    LAS float* scr = (LAS float*)(C.lds + C.wave * 8704);
    unsigned char* wr = C.wreg();
    { const int n = (1024 / 64) * (4608 / 32); for (int it = C.gw; it < n; it += C.ngw) transpose_item(C.in[I_WINE] + (size_t)li * 1024 * 4608, 4608, 4608, (bf16*)(wr + WE_IN), 1024, 0, scr, it, C.lane); }
    { const int n = (1024 / 64) * (1024 / 32); for (int it = C.gw; it < n; it += C.ngw) transpose_item(C.in[I_WGLU] + (size_t)li * 1024 * 1024, 1024, 1024, (bf16*)(wr + WE_GLU), 1024, 0, scr, it, C.lane); }
    { const int n = (2048 / 64) * (1024 / 32); for (int it = C.gw; it < n; it += C.ngw) transpose_item(C.in[I_WOUTE] + (size_t)li * 2048 * 1024, 1024, 1024, (bf16*)(wr + WE_OUT), 2048, 0, scr, it, C.lane); }
}
DI void convert_odd_early(const Ctx& C, int li) {
    LAS float* scr = (LAS float*)(C.lds + C.wave * 8704);
    unsigned char* wr = C.wreg();
    const float* win = C.in[I_WINO] + (size_t)li * 1024 * 4096;
    { const int n = (1024 / 64) * (2048 / 32);
      for (int it = C.gw; it < n; it += C.ngw) transpose_item(win, 4096, 2048, (bf16*)(wr + WO_IN), 1024, 0, scr, it, C.lane);
      for (int it = C.gw; it < n; it += C.ngw) transpose_item(win + 2048, 4096, 2048, (bf16*)(wr + WO_Z), 1024, 0, scr, it, C.lane); }
    { const int nq = (256 / 64) * (128 / 32);
      for (int it = C.gw; it < 8 * nq; it += C.ngw) { const int h = it / nq, r = it % nq;
          transpose_item(C.in[I_WQ] + ((size_t)li * 8 + h) * 256 * 128, 128, 128, (bf16*)(wr + WO_QK), 256, h * 256, scr, r, C.lane);
          transpose_item(C.in[I_WK] + ((size_t)li * 8 + h) * 256 * 128, 128, 128, (bf16*)(wr + WO_QK), 256, h * 256 + 128, scr, r, C.lane); } }
    { const int n = (2048 / 64) * (2048 / 32);
      for (int it = C.gw; it < n; it += C.ngw) transpose_item(C.in[I_WOG] + (size_t)li * 2048 * 2048, 2048, 2048, (bf16*)(wr + WO_OG), 2048, 0, scr, it, C.lane); }
}
DI void convert_odd_late(const Ctx& C, int li) {
    LAS float* scr = (LAS float*)(C.lds + C.wave * 8704);
    unsigned char* wr = C.wreg();
    { const int nv = (256 / 64) * (256 / 32);
      for (int it = C.gw; it < 8 * nv; it += C.ngw) { const int h = it / nv, r = it % nv;
          transpose_item(C.in[I_WV] + ((size_t)li * 8 + h) * 256 * 256, 256, 256, (bf16*)(wr + WO_V), 256, h * 256, scr, r, C.lane); } }
    { const int n = (2048 / 64) * (1024 / 32);
      for (int it = C.gw; it < n; it += C.ngw) transpose_item(C.in[I_WOUTO] + (size_t)li * 2048 * 1024, 1024, 1024, (bf16*)(wr + WO_OUT), 2048, 0, scr, it, C.lane); }
    { bf16* wg = (bf16*)(wr + WO_G); const float* wi = C.in[I_WIG] + (size_t)li * 2 * 2048 * 8; const float* wf = C.in[I_WFG] + (size_t)li * 2 * 2048 * 8;
      for (int i = C.gw * 64 + C.lane; i < 32 * 2048; i += C.ngw * 64) { const int n = i >> 11, c = i & 2047, ty = n >> 4, d = (n >> 3) & 1, h = n & 7;
          wg[i] = f2bf((ty ? wf : wi)[((size_t)d * 2048 + c) * 8 + h]); } }
}

DI void load_row_bf16(const bf16* p, int lane, float (&v)[16]) {
    const u32x4 a = *(const u32x4*)(p + 8 * lane), b = *(const u32x4*)(p + 512 + 8 * lane);
    float t[8]; unpack8(a, t);
#pragma unroll
    for (int i = 0; i < 8; ++i) v[i] = t[i];
    unpack8(b, t);
#pragma unroll
    for (int i = 0; i < 8; ++i) v[8 + i] = t[i];
}
DI void load_row_bf16_nt(const bf16* p, int lane, float (&v)[16]) {
    const u32x4 a = __builtin_nontemporal_load((const u32x4*)(p + 8 * lane)), b = __builtin_nontemporal_load((const u32x4*)(p + 512 + 8 * lane));
    float t[8]; unpack8(a, t);
#pragma unroll
    for (int i = 0; i < 8; ++i) v[i] = t[i];
    unpack8(b, t);
#pragma unroll
    for (int i = 0; i < 8; ++i) v[8 + i] = t[i];
}
DI void load_row_f32(const float* p, int lane, float (&v)[16]) {
    const f32x4 a = *(const f32x4*)(p + 8 * lane), b = *(const f32x4*)(p + 8 * lane + 4), c = *(const f32x4*)(p + 512 + 8 * lane), d = *(const f32x4*)(p + 512 + 8 * lane + 4);
#pragma unroll
    for (int i = 0; i < 4; ++i) { v[i] = a[i]; v[4 + i] = b[i]; v[8 + i] = c[i]; v[12 + i] = d[i]; }
}
DI void store_row_bf16(bf16* p, int lane, const float (&v)[16]) {
    float t[8];
#pragma unroll
    for (int i = 0; i < 8; ++i) t[i] = v[i];
    *(u32x4*)(p + 8 * lane) = pack8(t);
#pragma unroll
    for (int i = 0; i < 8; ++i) t[i] = v[8 + i];
    *(u32x4*)(p + 512 + 8 * lane) = pack8(t);
}
DI void round_bf16_16(float (&v)[16]) {
#pragma unroll
    for (int i = 0; i < 16; i += 2) { const unsigned w = cvt_pk_bf16(v[i], v[i + 1]); v[i] = bflo(w); v[i + 1] = bfhi(w); }
}
DI void rms_row(const float (&v)[16], const float* g, int lane, float (&o)[16]) {
    float s = 0.f;
#pragma unroll
    for (int i = 0; i < 16; ++i) s += v[i] * v[i];
    s = wave_sum(s, lane);
    const float r = rsqrtf(s * (1.f / 1024.f) + EPS);
    float gg[16]; load_row_f32(g, lane, gg);
#pragma unroll
    for (int i = 0; i < 16; ++i) o[i] = v[i] * r * gg[i];
}

DI void phase_init_rows(const Ctx& C, bf16* resid, bf16* hdst) {
    for (int r = C.gw; r < LTOK; r += C.ngw) {
        float v[16], o[16];
        if (r < SEQ) load_row_f32(C.in[I_X] + (size_t)r * 1024, C.lane, v); else load_row_f32(C.in[I_META] + (size_t)(r - SEQ) * 1024, C.lane, v);
        round_bf16_16(v);
        store_row_bf16(resid + (size_t)r * 1024, C.lane, v);
        rms_row(v, C.in[I_NPRE], C.lane, o);
        store_row_bf16(hdst + (size_t)r * 1024, C.lane, o);
    }
}
DI void post_row_finish(const Ctx& C, int r, const float (&v)[16], float (&rs)[16], bf16* resid, bf16* hdst, int layer) {
    float o[16];
    rms_row(v, C.in[I_NPOST] + (size_t)layer * 1024, C.lane, o);
#pragma unroll
    for (int i = 0; i < 16; ++i) rs[i] += o[i];
    if (layer == 3) {
        if (r < SEQ) { float* op = C.out + (size_t)r * 1024;
            *(f32x4*)(op + 8 * C.lane) = (f32x4){rs[0], rs[1], rs[2], rs[3]}; *(f32x4*)(op + 8 * C.lane + 4) = (f32x4){rs[4], rs[5], rs[6], rs[7]};
            *(f32x4*)(op + 512 + 8 * C.lane) = (f32x4){rs[8], rs[9], rs[10], rs[11]}; *(f32x4*)(op + 512 + 8 * C.lane + 4) = (f32x4){rs[12], rs[13], rs[14], rs[15]}; }
    } else {
        round_bf16_16(rs);
        store_row_bf16(resid + (size_t)r * 1024, C.lane, rs);
        rms_row(rs, C.in[I_NPRE] + (size_t)(layer + 1) * 1024, C.lane, o);
        store_row_bf16(hdst + (size_t)r * 1024, C.lane, o);
    }
}
DI void phase_post_rows(const Ctx& C, const bf16* y, bf16* resid, bf16* hdst, int layer, bf16* resid_out = nullptr) {
    if (!resid_out) resid_out = resid;
    for (int r = C.gw; r < LTOK; r += 2 * C.ngw) {
        const int r2 = r + C.ngw; const bool has2 = r2 < LTOK; const int r2c = has2 ? r2 : r;
        float v[16], rs[16], v2[16], rs2[16];
        load_row_bf16_nt(y + (size_t)r * 1024, C.lane, v); load_row_bf16_nt(resid + (size_t)r * 1024, C.lane, rs);
        load_row_bf16_nt(y + (size_t)r2c * 1024, C.lane, v2); load_row_bf16_nt(resid + (size_t)r2c * 1024, C.lane, rs2);
        post_row_finish(C, r, v, rs, resid_out, hdst, layer);
        if (has2) post_row_finish(C, r2, v2, rs2, resid_out, hdst, layer);
    }
}
DI void phase_renorm_rows(const Ctx& C, const bf16* resid, bf16* hdst, int layer) {
    for (int r = C.gw; r < LTOK; r += C.ngw) {
        float v[16], o[16];
        load_row_bf16(resid + (size_t)r * 1024, C.lane, v);
        rms_row(v, C.in[I_NPRE] + (size_t)layer * 1024, C.lane, o);
        store_row_bf16(hdst + (size_t)r * 1024, C.lane, o);
    }
}
DI void phase_rope_table(const Ctx& C) {
    f32x2* tab = (f32x2*)(C.misc() + MS_ROPE);
    for (int i = C.gw * 64 + C.lane; i < 256 * 32; i += C.ngw * 64) { const int pos = i >> 5, j = i & 31;
        const float f = fexp(-(float)j * (9.210340371976184f / 32.f));
        float rev = (float)pos * f * 0.15915494309189535f; rev -= rintf(rev);
        tab[i] = (f32x2){__builtin_amdgcn_cosf(rev), __builtin_amdgcn_sinf(rev)}; }
}

DI void store8(bf16* dst, f32x4 a, f32x4 b) { *(u32x4*)dst = pack8v(a, b); }
DI f32x4 silu4(f32x4 v) { return (f32x4){silu_f(v[0]), silu_f(v[1]), silu_f(v[2]), silu_f(v[3])}; }
struct FEvenIn { static constexpr bool PIPE = false;
    bf16 *YAB, *Kb, *Vb, *GA, *U;
    DI void launder() { lnd(YAB); lnd(Kb); lnd(Vb); lnd(GA); lnd(U); }
    DI void op8(int row, int col, f32x4 a, f32x4 b) const {
        bf16* dst; bool act = false;
        if (col < 1024) dst = YAB + (size_t)row * 2048 + col;
        else if (col < 1280) dst = Kb + (size_t)row * 256 + (col - 1024);
        else if (col < 1536) dst = Vb + (size_t)row * 256 + (col - 1280);
        else if (col < 2560) { dst = GA + (size_t)row * 1024 + (col - 1536); act = true; }
        else if (col < 3584) { const int cu = col - 2560, rp = row < SEQ ? row + 16 : row - SEQ;
            dst = U + ((size_t)(cu >> 4) * LTOK + rp) * 16 + (cu & 15); }
        else { dst = YAB + (size_t)row * 2048 + 1024 + (col - 3584); act = true; }
        if (act) { a = silu4(a); b = silu4(b); }
        store8(dst, a, b);
    }
};
struct FPlain { static constexpr bool PIPE = false; bf16* O; int ldo; DI void launder() { lnd(O); } DI void op8(int row, int col, f32x4 a, f32x4 b) const { store8(O + (size_t)row * ldo + col, a, b); } };
struct FSilu { static constexpr bool PIPE = false; bf16* O; int ldo; DI void launder() { lnd(O); } DI void op8(int row, int col, f32x4 a, f32x4 b) const { store8(O + (size_t)row * ldo + col, silu4(a), silu4(b)); } };
struct FGlu {
    static constexpr bool PIPE = true;
    const bf16* YG; bf16* YAB; const float* bias;
    struct Pre { u32x4 yg, gb; };
    struct Cols { f32x4 b0, b1; };
    DI void launder() { lnd(YG); lnd(YAB); lnd(bias); }
    DI Cols cols(int col) const { Cols c; c.b0 = *(const f32x4*)(bias + col); c.b1 = *(const f32x4*)(bias + col + 4); return c; }
    DI Pre pre(int row, int col) const { Pre p; p.yg = *(const u32x4*)(YG + (size_t)row * 1024 + col); p.gb = *(const u32x4*)(YAB + (size_t)row * 2048 + 1024 + col); return p; }
    DI void fin(int row, int col, f32x4 a, f32x4 b, const Pre& p, const Cols& c) const {
        float yg[8], gb[8], o[8]; unpack8(p.yg, yg); unpack8(p.gb, gb);
#pragma unroll
        for (int j = 0; j < 4; ++j) { o[j] = yg[j] * sigmoid_f(a[j] + c.b0[j]) * gb[j]; o[4 + j] = yg[4 + j] * sigmoid_f(b[j] + c.b1[j]) * gb[4 + j]; }
        *(u32x4*)(YAB + (size_t)row * 2048 + 1024 + col) = pack8(o);
    }
    DI void op8(int row, int col, f32x4 a, f32x4 b) const { fin(row, col, a, b, pre(row, col), cols(col)); }
};
struct FQK { static constexpr bool PIPE = false;
    bf16 *Q, *Kd;
    DI void launder() { lnd(Q); lnd(Kd); }
    DI void op8(int row, int col, f32x4 a, f32x4 b) const { const int h = col >> 8, w = col & 255;
        bf16* dst = (w < 128) ? Q + (size_t)row * 1024 + h * 128 + w : Kd + (size_t)row * 1024 + h * 128 + (w - 128);
        store8(dst, a, b); }
};
struct FVrow { static constexpr bool PIPE = false;
    bf16 *V, *VM;
    DI void launder() { lnd(V); lnd(VM); }
    DI void op8(int row, int col, f32x4 a, f32x4 b) const { bf16* dst = (row < SEQ) ? V + (size_t)row * 2048 + col : VM + (size_t)(row - SEQ) * 2048 + col; store8(dst, a, b); }
};
struct FOgate {
    static constexpr bool PIPE = true;
    const bf16 *CELL, *CELLM, *XC, *SZ; bf16* HZ; const float *bo, *hn, *skip, *rstd;
    struct Pre { u32x4 ce, xc, sz; float rs; };
    struct Cols { f32x4 b0, b1, h0, h1, s0, s1; };
    DI void launder() { lnd(CELL); lnd(CELLM); lnd(XC); lnd(SZ); lnd(HZ); lnd(bo); lnd(hn); lnd(skip); lnd(rstd); }
    DI Cols cols(int col) const { Cols c; c.b0 = *(const f32x4*)(bo + col); c.b1 = *(const f32x4*)(bo + col + 4); c.h0 = *(const f32x4*)(hn + col); c.h1 = *(const f32x4*)(hn + col + 4);
        c.s0 = *(const f32x4*)(skip + col); c.s1 = *(const f32x4*)(skip + col + 4); return c; }
    DI Pre pre(int row, int col) const { Pre p;
        const bf16* cp = (row < SEQ) ? CELL + (size_t)row * 2048 + col : CELLM + (size_t)(row - SEQ) * 2048 + col;
        p.ce = *(const u32x4*)cp; p.xc = *(const u32x4*)(XC + (size_t)row * 2048 + col); p.sz = *(const u32x4*)(SZ + (size_t)row * 2048 + col); p.rs = rstd[(size_t)row * 8 + (col >> 8)]; return p; }
    DI void fin(int row, int col, f32x4 a, f32x4 b, const Pre& p, const Cols& c) const {
        float ce[8], xc[8], sz[8], o[8]; unpack8(p.ce, ce); unpack8(p.xc, xc); unpack8(p.sz, sz);
        const float rs = p.rs;
#pragma unroll
        for (int j = 0; j < 4; ++j) {
            o[j] = (sigmoid_f(a[j] + c.b0[j]) * (ce[j] * rs * c.h0[j]) + c.s0[j] * xc[j]) * sz[j];
            o[4 + j] = (sigmoid_f(b[j] + c.b1[j]) * (ce[4 + j] * rs * c.h1[j]) + c.s1[j] * xc[4 + j]) * sz[4 + j]; }
        *(u32x4*)(HZ + (size_t)row * 2048 + col) = pack8(o);
    }
    DI void op8(int row, int col, f32x4 a, f32x4 b) const { fin(row, col, a, b, pre(row, col), cols(col)); }
};

template <int LDA, int LDB, int KK, int NN, int APN, class F>
DI void run_gemm(const Ctx& C, const bf16* A, const bf16* Bt, const F& f0) {
    F f = f0; f.launder(); lnd(A); lnd(Bt);
    gemm_tail<F>(C.lds, A + (size_t)SEQ * LDA, LDA, Bt, LDB, KK, NN, APN, f, SEQ, C.bid, C.G, C.wave, C.lane);
    pg8::Gemm g{A, Bt};
    pg8::StaticOrder<NN / 256> S; S.init(C.G, C.bid);
    typedef typename pg8::EpiSel<F>::type Epi;
    Epi E{f};
    pg8::gemm_phase<Epi, pg8::StaticOrder<NN / 256>, LDA, LDB, KK, APN>(C.lds, g, S, E);
}

DI void phase_qk_norm_rope(const Ctx& C, bf16* YAB, bf16* Kb, const float* qn, const float* kn, unsigned char* K8, bf16* dummy = nullptr) {
    const f32x2* tab = (const f32x2*)(C.misc() + MS_ROPE);
    const int sub = C.lane & 15, grp = C.lane >> 4;
    const int nitems = LTOK * 10;
    constexpr int NB = 7;
    const f32x4 gq0 = *(const f32x4*)(qn + sub * 8), gq1 = *(const f32x4*)(qn + sub * 8 + 4), gk0 = *(const f32x4*)(kn + sub * 8), gk1 = *(const f32x4*)(kn + sub * 8 + 4);
    for (int it0 = C.gw * 4; it0 < nitems; it0 += C.ngw * 4 * NB) {
        bf16* p[NB]; u32x4 raw[NB]; bool ok[NB]; int rowv[NB], hsv[NB]; f32x4 tb[NB][4];
#pragma unroll
        for (int b = 0; b < NB; ++b) { const int it = it0 + b * C.ngw * 4 + grp; ok[b] = it < nitems; const int itc = ok[b] ? it : nitems - 1;
            const int row = itc / 10, hs = itc - row * 10; rowv[b] = row; hsv[b] = hs;
            p[b] = (hs < 8) ? YAB + (size_t)row * 2048 + hs * 128 + sub * 8 : Kb + (size_t)row * 256 + (hs - 8) * 128 + sub * 8;
            raw[b] = *(const u32x4*)p[b]; }
#pragma unroll
        for (int b = 0; b < NB; ++b) {
            int pos = 0; if (rowv[b] < SEQ) pos = (sub < 8) ? (rowv[b] >> 6) : (rowv[b] & 63);
            const f32x4* tp = (const f32x4*)(tab + pos * 32 + (sub & 3) * 8);
#pragma unroll
            for (int e = 0; e < 4; ++e) tb[b][e] = tp[e]; }
#pragma unroll
        for (int b = 0; b < NB; ++b) { const int row = rowv[b], hs = hsv[b];
            float v[8]; unpack8(raw[b], v);
            float s = 0.f;
#pragma unroll
            for (int e = 0; e < 8; ++e) s += v[e] * v[e];
            s += shx(s, 1, C.lane); s += shx(s, 2, C.lane); s += shx(s, 4, C.lane); s += shx(s, 8, C.lane);
            const float r = rsqrtf(s * (1.f / 128.f) + EPS);
            const bool isq = hs < 8;
            f32x4 g0, g1;
#pragma unroll
            for (int e = 0; e < 4; ++e) { g0[e] = isq ? gq0[e] : gk0[e]; g1[e] = isq ? gq1[e] : gk1[e]; }
#pragma unroll
            for (int e = 0; e < 4; ++e) { v[e] = v[e] * r * g0[e]; v[4 + e] = v[4 + e] * r * g1[e]; }
            const bool first = (sub & 4) == 0;
            float o[8];
#pragma unroll
            for (int e = 0; e < 8; ++e) {
                const float other = shx(v[e], 4, C.lane);
                const float cx = tb[b][e >> 1][(e & 1) * 2], cy = tb[b][e >> 1][(e & 1) * 2 + 1];
                o[e] = first ? (v[e] * cx - other * cy) : (v[e] * cx + other * cy);
            }
            bf16* dp = dummy ? dummy + (size_t)((rowv[b] * 10 + hsv[b]) & 65535) * 128 + sub * 8 : p[b];
            if (ok[b]) { *(u32x4*)dp = pack8(o);
                if (hs >= 8) { int w0 = 0, w1 = 0;
                    w0 = __builtin_amdgcn_cvt_pk_fp8_f32(o[0], o[1], w0, false); w0 = __builtin_amdgcn_cvt_pk_fp8_f32(o[2], o[3], w0, true);
                    w1 = __builtin_amdgcn_cvt_pk_fp8_f32(o[4], o[5], w1, false); w1 = __builtin_amdgcn_cvt_pk_fp8_f32(o[6], o[7], w1, true);
                    *(u32x2*)(K8 + (size_t)row * 256 + (hs - 8) * 128 + sub * 8) = (u32x2){(unsigned)w0, (unsigned)w1}; } } }
    }
}

namespace att {
constexpr int D = 128, NW = 8, QBLK = 32, KVBLK = 64;
constexpr float SCALE = 0.088388347648318440f;
constexpr float THR = 8.f;
constexpr int LDQ = 2048, LDK = 256, LDG = 1024;
constexpr size_t SHM_V = KVBLK * D * 2, SHM_K = KVBLK * D * 2, SHM_ATTN = 2 * SHM_V + 2 * SHM_K + NW * 64 * 4;
constexpr int NT_C = KVROWS / KVBLK;
#define KSWZ(row, colB) ((row) * 256 + ((colB) ^ (((row) & 7) << 4)))
#define SBAR() __builtin_amdgcn_sched_barrier(0)
DI int crow(int r, int hi) { return (r & 3) + 8 * (r >> 2) + 4 * hi; }
DI unsigned cvtpk_asm(float lo, float hi) { unsigned r; asm volatile("v_cvt_pk_bf16_f32 %0, %1, %2" : "=v"(r) : "v"(lo), "v"(hi)); return r; }
template <bool F8 = false> DI void partialSM(f32x16& p0, f32x16& p1, float& m_reg, float& mn, float& alpha) {
  constexpr float Cc = SCALE * 1.4426950408889634f;
  float pmax = p0[0];
#pragma unroll
  for (int r = 1; r < 16; ++r) pmax = fmaxf(pmax, p0[r]);
#pragma unroll
  for (int r = 0; r < 16; ++r) pmax = fmaxf(pmax, p1[r]);
  { auto rr = __builtin_amdgcn_permlane32_swap(__float_as_uint(pmax), __float_as_uint(pmax), false, false);
    pmax = fmaxf(__uint_as_float(rr[0]), __uint_as_float(rr[1])); }
  if (__builtin_expect(__all(pmax - m_reg <= (F8 ? 2.5f : THR) / SCALE), 1)) { mn = m_reg; alpha = 1.f; }
  else { mn = fmaxf(m_reg, pmax); alpha = __builtin_amdgcn_exp2f((m_reg - mn) * Cc); m_reg = mn; }
  const float mnC = -mn * Cc + (F8 ? 5.f : 0.f);
#pragma unroll
  for (int r = 0; r < 16; ++r) p0[r] = fmaf(p0[r], Cc, mnC);
#pragma unroll
  for (int r = 0; r < 16; ++r) p1[r] = fmaf(p1[r], Cc, mnC);
#pragma unroll
  for (int r = 0; r < 16; ++r) p0[r] = __builtin_amdgcn_exp2f(p0[r]);
}
DI void finishSM(f32x16& p0, f32x16& p1, float alpha, float& l_reg, bf16x8& pa0, bf16x8& pa1, bf16x8& pa2, bf16x8& pa3) {
#pragma unroll
  for (int r = 0; r < 16; ++r) p1[r] = __builtin_amdgcn_exp2f(p1[r]);
  float ps = 0;
#pragma unroll
  for (int r = 0; r < 16; ++r) ps += p0[r];
#pragma unroll
  for (int r = 0; r < 16; ++r) ps += p1[r];
  { auto rr = __builtin_amdgcn_permlane32_swap(__float_as_uint(ps), __float_as_uint(ps), false, false);
    ps = __uint_as_float(rr[0]) + __uint_as_float(rr[1]); }
  l_reg = l_reg * alpha + ps;
#define PK4(P, BASE, OUT) do { unsigned a0 = cvtpk_asm(P[BASE + 0], P[BASE + 1]), a1 = cvtpk_asm(P[BASE + 2], P[BASE + 3]);   \
    unsigned b0 = cvtpk_asm(P[BASE + 4], P[BASE + 5]), b1 = cvtpk_asm(P[BASE + 6], P[BASE + 7]);                              \
    auto r0 = __builtin_amdgcn_permlane32_swap(a0, b0, false, false); auto r1 = __builtin_amdgcn_permlane32_swap(a1, b1, false, false); \
    u32x4 w = {r0[0], r1[0], r0[1], r1[1]}; OUT = *reinterpret_cast<bf16x8*>(&w); } while (0)
  PK4(p0, 0, pa0); PK4(p0, 8, pa1); PK4(p1, 0, pa2); PK4(p1, 8, pa3);
#undef PK4
}
DI void qkt(f32x16& p0, f32x16& p1, const LAS char* Ks, const bf16x8* qr, int r32, int hi) {
  p0 = f32x16{}; p1 = f32x16{};
#pragma unroll
  for (int d0 = 0; d0 < 8; ++d0) { const int cb = (d0 * 16 + hi * 8) * 2;
    const bf16x8 b0 = *(const LAS bf16x8*)(Ks + KSWZ(r32, cb));
    const bf16x8 b1 = *(const LAS bf16x8*)(Ks + KSWZ(32 + r32, cb));
    p0 = MFMA32(b0, qr[d0], p0);
    p1 = MFMA32(b1, qr[d0], p1); }
}
typedef int i32x8 __attribute__((ext_vector_type(8)));
constexpr size_t SHM_K8 = KVBLK * D;
#define K8SW(row, c) ((row) * 128 + ((((c) ^ (((row) >> 1) & 7))) << 4))
DI void qkt8(f32x16& p0, f32x16& p1, const LAS char* Ks, const i32x8* q8, int r32, int hi) {
  p0 = f32x16{}; p1 = f32x16{};
#pragma unroll
  for (int s2 = 0; s2 < 2; ++s2) { const int c0 = 4 * s2 + 2 * hi;
    const u32x4 a0 = *(const LAS u32x4*)(Ks + K8SW(r32, c0)), a1 = *(const LAS u32x4*)(Ks + K8SW(r32, c0 + 1));
    const u32x4 b0 = *(const LAS u32x4*)(Ks + K8SW(32 + r32, c0)), b1 = *(const LAS u32x4*)(Ks + K8SW(32 + r32, c0 + 1));
    const i32x8 A = {(int)a0.x, (int)a0.y, (int)a0.z, (int)a0.w, (int)a1.x, (int)a1.y, (int)a1.z, (int)a1.w};
    const i32x8 B = {(int)b0.x, (int)b0.y, (int)b0.z, (int)b0.w, (int)b1.x, (int)b1.y, (int)b1.z, (int)b1.w};
    p0 = __builtin_amdgcn_mfma_scale_f32_32x32x64_f8f6f4(A, q8[s2], p0, 0, 0, 0, 0x7f7f7f7f, 0, 0x7f7f7f7f);
    p1 = __builtin_amdgcn_mfma_scale_f32_32x32x64_f8f6f4(B, q8[s2], p1, 0, 0, 0, 0x7f7f7f7f, 0, 0x7f7f7f7f); }
}
constexpr float CQ8 = SCALE * 1.4426950408889634f * 8.f;
constexpr float THRL = 2.5f * 1.4426950408889634f;
DI void qkt8c(f32x16& p0, f32x16& p1, const LAS char* Ks, const i32x8* q8, const f32x16& cinit, int r32, int hi) {
  { const int c0 = 2 * hi;
    const u32x4 a0 = *(const LAS u32x4*)(Ks + K8SW(r32, c0)), a1 = *(const LAS u32x4*)(Ks + K8SW(r32, c0 + 1));
    const u32x4 b0 = *(const LAS u32x4*)(Ks + K8SW(32 + r32, c0)), b1 = *(const LAS u32x4*)(Ks + K8SW(32 + r32, c0 + 1));
    const i32x8 A = {(int)a0.x, (int)a0.y, (int)a0.z, (int)a0.w, (int)a1.x, (int)a1.y, (int)a1.z, (int)a1.w};
    const i32x8 B = {(int)b0.x, (int)b0.y, (int)b0.z, (int)b0.w, (int)b1.x, (int)b1.y, (int)b1.z, (int)b1.w};
    p0 = __builtin_amdgcn_mfma_scale_f32_32x32x64_f8f6f4(A, q8[0], cinit, 0, 0, 0, 0x7f7f7f7f, 0, 0x7c7c7c7c);
    p1 = __builtin_amdgcn_mfma_scale_f32_32x32x64_f8f6f4(B, q8[0], cinit, 0, 0, 0, 0x7f7f7f7f, 0, 0x7c7c7c7c); }
  { const int c0 = 4 + 2 * hi;
    const u32x4 a0 = *(const LAS u32x4*)(Ks + K8SW(r32, c0)), a1 = *(const LAS u32x4*)(Ks + K8SW(r32, c0 + 1));
    const u32x4 b0 = *(const LAS u32x4*)(Ks + K8SW(32 + r32, c0)), b1 = *(const LAS u32x4*)(Ks + K8SW(32 + r32, c0 + 1));
    const i32x8 A = {(int)a0.x, (int)a0.y, (int)a0.z, (int)a0.w, (int)a1.x, (int)a1.y, (int)a1.z, (int)a1.w};
    const i32x8 B = {(int)b0.x, (int)b0.y, (int)b0.z, (int)b0.w, (int)b1.x, (int)b1.y, (int)b1.z, (int)b1.w};
    p0 = __builtin_amdgcn_mfma_scale_f32_32x32x64_f8f6f4(A, q8[1], p0, 0, 0, 0, 0x7f7f7f7f, 0, 0x7c7c7c7c);
    p1 = __builtin_amdgcn_mfma_scale_f32_32x32x64_f8f6f4(B, q8[1], p1, 0, 0, 0, 0x7f7f7f7f, 0, 0x7c7c7c7c); }
}
DI float rowmax32(const f32x16& p0, const f32x16& p1) {
  float pmax = p0[0];
#pragma unroll
  for (int r = 1; r < 16; ++r) pmax = fmaxf(pmax, p0[r]);
#pragma unroll
  for (int r = 0; r < 16; ++r) pmax = fmaxf(pmax, p1[r]);
  auto rr = __builtin_amdgcn_permlane32_swap(__float_as_uint(pmax), __float_as_uint(pmax), false, false);
  return fmaxf(__uint_as_float(rr[0]), __uint_as_float(rr[1]));
}
DI void partialSM8(f32x16& p0, f32x16& p1, float& m_reg, float& alpha, f32x16& cinit) {
  const float pmax = rowmax32(p0, p1);
  if (__builtin_expect(__all(pmax <= 5.f + THRL), 1)) alpha = 1.f;
  else { const float dl = fmaxf(pmax - 5.f, 0.f); alpha = __builtin_amdgcn_exp2f(-dl); m_reg += dl; const float ci = 5.f - m_reg;
#pragma unroll
    for (int r = 0; r < 16; ++r) { p0[r] -= dl; p1[r] -= dl; cinit[r] = ci; } }
#pragma unroll
  for (int r = 0; r < 16; ++r) p0[r] = __builtin_amdgcn_exp2f(p0[r]);
}
DI void firstSM8(f32x16& p0, f32x16& p1, float& m_reg, float& alpha, f32x16& cinit) {
  m_reg = rowmax32(p0, p1); alpha = 1.f; const float ci = 5.f - m_reg;
#pragma unroll
  for (int r = 0; r < 16; ++r) { p0[r] += ci; p1[r] += ci; cinit[r] = ci; }
#pragma unroll
  for (int r = 0; r < 16; ++r) p0[r] = __builtin_amdgcn_exp2f(p0[r]);
}
typedef short s16x2 __attribute__((__vector_size__(2 * sizeof(short))));
constexpr float CQS = SCALE * 1.4426950408889634f * 8.f;
constexpr float THRS = 2.5f * 1.4426950408889634f;
DI void qkt8s(f32x16& p0, f32x16& p1, const LAS char* Ks, const i32x8* q8, int r32, int hi) {
  p0 = f32x16{}; p1 = f32x16{};
#pragma unroll
  for (int s2 = 0; s2 < 2; ++s2) { const int c0 = 4 * s2 + 2 * hi;
    const u32x4 a0 = *(const LAS u32x4*)(Ks + K8SW(r32, c0)), a1 = *(const LAS u32x4*)(Ks + K8SW(r32, c0 + 1));
    const u32x4 b0 = *(const LAS u32x4*)(Ks + K8SW(32 + r32, c0)), b1 = *(const LAS u32x4*)(Ks + K8SW(32 + r32, c0 + 1));
    const i32x8 A = {(int)a0.x, (int)a0.y, (int)a0.z, (int)a0.w, (int)a1.x, (int)a1.y, (int)a1.z, (int)a1.w};
    const i32x8 B = {(int)b0.x, (int)b0.y, (int)b0.z, (int)b0.w, (int)b1.x, (int)b1.y, (int)b1.z, (int)b1.w};
    p0 = __builtin_amdgcn_mfma_scale_f32_32x32x64_f8f6f4(A, q8[s2], p0, 0, 0, 0, 0x7f7f7f7f, 0, 0x7c7c7c7c);
    p1 = __builtin_amdgcn_mfma_scale_f32_32x32x64_f8f6f4(B, q8[s2], p1, 0, 0, 0, 0x7f7f7f7f, 0, 0x7c7c7c7c); }
}
DI void partialSMs(f32x16& p0, f32x16& p1, float& M, float& alpha, float& scl) {
  float pmax = p0[0];
#pragma unroll
  for (int r = 1; r < 16; ++r) pmax = fmaxf(pmax, p0[r]);
#pragma unroll
  for (int r = 0; r < 16; ++r) pmax = fmaxf(pmax, p1[r]);
  { auto rr = __builtin_amdgcn_permlane32_swap(__float_as_uint(pmax), __float_as_uint(pmax), false, false);
    pmax = fmaxf(__uint_as_float(rr[0]), __uint_as_float(rr[1])); }
  if (__builtin_expect(__all(pmax - M <= THRS), 1)) alpha = 1.f;
  else { const float Mn = fmaxf(M, ceilf(pmax)); alpha = __builtin_amdgcn_exp2f(M - Mn); M = Mn; }
  scl = __builtin_amdgcn_exp2f(M - 5.f);
#pragma unroll
  for (int r = 0; r < 16; ++r) p0[r] = __builtin_amdgcn_exp2f(p0[r]);
}
DI int pk4s_fp8(float a, float b, float c, float d, float scl) {
  s16x2 w = __builtin_bit_cast(s16x2, a);
  w = __builtin_amdgcn_cvt_scalef32_pk_fp8_f32(w, a, b, scl, false); w = __builtin_amdgcn_cvt_scalef32_pk_fp8_f32(w, c, d, scl, true);
  return __builtin_bit_cast(int, w);
}
DI void finishSMs(f32x16& p0, f32x16& p1, i32x8& pa, float scl) {
#pragma unroll
  for (int r = 0; r < 16; ++r) p1[r] = __builtin_amdgcn_exp2f(p1[r]);
#pragma unroll
  for (int i = 0; i < 4; ++i) { pa[i] = pk4s_fp8(p0[4 * i], p0[4 * i + 1], p0[4 * i + 2], p0[4 * i + 3], scl); pa[4 + i] = pk4s_fp8(p1[4 * i], p1[4 * i + 1], p1[4 * i + 2], p1[4 * i + 3], scl); }
}
#define V8SW(d, c) ((d) * 64 + ((((c) ^ (((d) >> 2) & 3))) << 4))
DI int pk4_fp8(float a, float b, float c, float d) { int w = 0; w = __builtin_amdgcn_cvt_pk_fp8_f32(a, b, w, false); return __builtin_amdgcn_cvt_pk_fp8_f32(c, d, w, true); }
DI void finishSM8(f32x16& p0, f32x16& p1, i32x8& pa) {
#pragma unroll
  for (int r = 0; r < 16; ++r) p1[r] = __builtin_amdgcn_exp2f(p1[r]);
#pragma unroll
  for (int i = 0; i < 4; ++i) { pa[i] = pk4_fp8(p0[4 * i], p0[4 * i + 1], p0[4 * i + 2], p0[4 * i + 3]); pa[4 + i] = pk4_fp8(p1[4 * i], p1[4 * i + 1], p1[4 * i + 2], p1[4 * i + 3]); }
}
DI void pv8(f32x16* o, f32x16& lacc, const LAS char* Vs, const i32x8 pa, int r32, int hi) {
  { const int one4 = 0x38383838; const i32x8 ones = {one4, one4, one4, one4, one4, one4, one4, one4};
    lacc = __builtin_amdgcn_mfma_scale_f32_32x32x64_f8f6f4(pa, ones, lacc, 0, 0, 0, 0x7f7f7f7f, 0, 0x7f7f7f7f); }
#pragma unroll
  for (int db = 0; db < 4; ++db) { const int d = 32 * db + r32;
    const u32x4 a0 = *(const LAS u32x4*)(Vs + V8SW(d, 2 * hi)), a1 = *(const LAS u32x4*)(Vs + V8SW(d, 2 * hi + 1));
    const i32x8 B = {(int)a0.x, (int)a0.y, (int)a0.z, (int)a0.w, (int)a1.x, (int)a1.y, (int)a1.z, (int)a1.w};
    o[db] = __builtin_amdgcn_mfma_scale_f32_32x32x64_f8f6f4(pa, B, o[db], 0, 0, 0, 0x7f7f7f7f, 0, 0x7f7f7f7f); }
}
DI int v_st(int k, int c) { const int kk = (k & ~0xC) | ((k & 4) << 1) | ((k & 8) >> 1); return ((kk >> 3) * 4 + (c >> 5)) * 512 + ((kk & 7) * 32 + (c & 31)) * 2; }
DI int v_rd_base(int lane) { return ((lane & 3) << 3) | (((lane >> 2) & 3) << 6) | (((lane >> 4) & 1) << 5) | (((lane >> 5) & 1) << 8); }
constexpr int v_rd_off(int d0, int ks, int half) { return d0 * 512 + ks * 4096 + half * 2048; }
template <int OFF> DI s16x4 tr_read(int vb) { s16x4 r; asm volatile("ds_read_b64_tr_b16 %0, %1 offset:%2" : "=&v"(r) : "v"(vb), "i"(OFF) : "memory"); return r; }
template <int D0> DI void pv_one(f32x16& od, int vb, bf16x8 pa0, bf16x8 pa1, bf16x8 pa2, bf16x8 pa3) {
  const s16x4 l0 = tr_read<v_rd_off(D0, 0, 0)>(vb), h0 = tr_read<v_rd_off(D0, 0, 1)>(vb), l1 = tr_read<v_rd_off(D0, 1, 0)>(vb), h1 = tr_read<v_rd_off(D0, 1, 1)>(vb);
  const s16x4 l2 = tr_read<v_rd_off(D0, 2, 0)>(vb), h2 = tr_read<v_rd_off(D0, 2, 1)>(vb), l3 = tr_read<v_rd_off(D0, 3, 0)>(vb), h3 = tr_read<v_rd_off(D0, 3, 1)>(vb);
  asm volatile("s_waitcnt lgkmcnt(0)" ::: "memory"); SBAR();
#define PKV(L, H) (bf16x8){L[0], L[1], L[2], L[3], H[0], H[1], H[2], H[3]}
  od = MFMA32(pa0, PKV(l0, h0), od);
  od = MFMA32(pa1, PKV(l1, h1), od);
  od = MFMA32(pa2, PKV(l2, h2), od);
  od = MFMA32(pa3, PKV(l3, h3), od);
#undef PKV
}
DI void pv_d0(f32x16* o, int vb, bf16x8 pa0, bf16x8 pa1, bf16x8 pa2, bf16x8 pa3) {
  pv_one<0>(o[0], vb, pa0, pa1, pa2, pa3); pv_one<1>(o[1], vb, pa0, pa1, pa2, pa3); pv_one<2>(o[2], vb, pa0, pa1, pa2, pa3); pv_one<3>(o[3], vb, pa0, pa1, pa2, pa3);
}
DI void mask_tail(f32x16& p0, f32x16& p1) {
#pragma unroll
  for (int r = 8; r < 16; ++r) p0[r] = -1e30f;
#pragma unroll
  for (int r = 0; r < 16; ++r) p1[r] = -1e30f;
}
template <int LDO> DI void attn_unit(const bf16* Qb, bf16* Ob, const unsigned char* K8h, const unsigned char* V8h, const bf16* Gb, int nvalid, LAS char* lds) {
  lnd(Qb); lnd(Ob); lnd(K8h); lnd(V8h); lnd(Gb);
  int NT = NT_C; asm volatile("" : "+s"(NT));
  int tid = threadIdx.x; asm volatile("" : "+v"(tid));
  const int wid = tid >> 6, lane = tid & 63, r32 = lane & 31, hi = lane >> 5;
  LAS char* K_lds = lds; LAS char* V_lds = lds + 4 * SHM_K8;
  LAS float* wsf = (LAS float*)(lds + 8 * SHM_K8) + wid * 64; LAS float* li_l = wsf; LAS float* al_l = wsf + 32;
  float m_reg = -1e30f; f32x16 o[4] = {}, lacc = {}; i32x8 qr[2];
  { const bf16* Qw = Qb + (long)(wid * QBLK + r32) * LDQ + hi * 32;
    u32x4 qraw[2][4];
#pragma unroll
    for (int s2 = 0; s2 < 2; ++s2)
#pragma unroll
      for (int c = 0; c < 4; ++c) qraw[s2][c] = *reinterpret_cast<const u32x4*>(Qw + s2 * 64 + c * 8);
#pragma unroll
    for (int s2 = 0; s2 < 2; ++s2)
#pragma unroll
      for (int c = 0; c < 4; ++c) { float f[8]; unpack8(qraw[s2][c], f); int w0 = 0, w1 = 0;
#pragma unroll
        for (int e = 0; e < 8; ++e) f[e] *= CQS;
        w0 = __builtin_amdgcn_cvt_pk_fp8_f32(f[0], f[1], w0, false); w0 = __builtin_amdgcn_cvt_pk_fp8_f32(f[2], f[3], w0, true);
        w1 = __builtin_amdgcn_cvt_pk_fp8_f32(f[4], f[5], w1, false); w1 = __builtin_amdgcn_cvt_pk_fp8_f32(f[6], f[7], w1, true);
        qr[s2][2 * c] = w0; qr[s2][2 * c + 1] = w1; } }
  const unsigned kdo = (unsigned)((tid >> 3) * 256 + (((tid & 7) ^ ((tid >> 4) & 7)) << 4));
  const unsigned vdo = (unsigned)((tid >> 2) * 64 + (((tid & 3) ^ ((tid >> 4) & 3)) << 4));
  const unsigned ldw = (unsigned)(tid >> 6) * 1024u;
#define SDMA(b, k0) do { \
    __builtin_amdgcn_global_load_lds((const unsigned*)(K8h + (long)(k0) * 256 + kdo), (LAS unsigned*)(K_lds + (b) * (int)SHM_K8 + ldw), 16, 0, 0); \
    __builtin_amdgcn_global_load_lds((const unsigned*)(V8h + (long)(k0) * 128 + vdo), (LAS unsigned*)(V_lds + (b) * (int)SHM_K8 + ldw), 16, 0, 0); } while (0)
#define VWAIT(n) asm volatile("s_waitcnt vmcnt(" #n ")" ::: "memory")
#define RESC(a) do { if (__any((a) < 1.f)) { if (hi == 0) al_l[r32] = (a); asm volatile("s_waitcnt lgkmcnt(0)" ::: "memory"); \
    _Pragma("unroll") for (int r = 0; r < 16; ++r) { const float a_ = al_l[crow(r, hi)]; lacc[r] *= a_; _Pragma("unroll") for (int d = 0; d < 4; ++d) o[d][r] *= a_; } } } while (0)
  f32x16 pA0, pA1, pB0, pB1; float alA, alB, sclA = 1.f, sclB = 1.f; i32x8 pa;
  SDMA(0, 0); SDMA(1, KVBLK); VWAIT(0); __syncthreads();
  qkt8s(pA0, pA1, K_lds, qr, r32, hi); partialSMs(pA0, pA1, m_reg, alA, sclA);
  SDMA(2, 2 * KVBLK);
  static_assert((NT_C - 1) % 4 == 0, "tile count vs the 4-tile unroll");
#define ATT_STEP(CUR, PRV, KB, VB, DB, MODE_, T_) do { \
    SBAR(); qkt8s(p##CUR##0, p##CUR##1, K_lds + (KB) * (int)SHM_K8, qr, r32, hi); \
    if ((MODE_) == 2) mask_tail(p##CUR##0, p##CUR##1); \
    finishSMs(p##PRV##0, p##PRV##1, pa, scl##PRV); SBAR(); \
    if ((MODE_) == 0) SDMA((DB), ((T_) + 2) * KVBLK); \
    SBAR(); \
    pv8(o, lacc, V_lds + (VB) * (int)SHM_K8, pa, r32, hi); partialSMs(p##CUR##0, p##CUR##1, m_reg, al##CUR, scl##CUR); \
    RESC(al##CUR); \
    if ((MODE_) == 0) VWAIT(2); else VWAIT(0); \
    __syncthreads(); } while (0)
  int t = 1;
  for (; t + 5 < NT; t += 4) {
    ATT_STEP(B, A, 1, 0, 3, 0, t);
    ATT_STEP(A, B, 2, 1, 0, 0, t + 1);
    ATT_STEP(B, A, 3, 2, 1, 0, t + 2);
    ATT_STEP(A, B, 0, 3, 2, 0, t + 3);
  }
  ATT_STEP(B, A, 1, 0, 3, 0, t);
  ATT_STEP(A, B, 2, 1, 0, 0, t + 1);
  ATT_STEP(B, A, 3, 2, 1, 1, t + 2);
  ATT_STEP(A, B, 0, 3, 2, 2, t + 3);
#undef ATT_STEP
  finishSMs(pA0, pA1, pa, sclA); SBAR();
  pv8(o, lacc, V_lds, pa, r32, hi);
  float rli[16];
#pragma unroll
  for (int r = 0; r < 16; ++r) rli[r] = __builtin_amdgcn_rcpf(lacc[r]);
#pragma unroll
  for (int rb = 0; rb < 16; rb += 8) {
    float gt[8][4];
#pragma unroll
    for (int r = 0; r < 8; ++r) { const int orow = wid * QBLK + crow(rb + r, hi); const bf16* gp = Gb + (long)(orow < nvalid ? orow : 0) * LDG + r32;
      gt[r][0] = bf2f(gp[0]); gt[r][1] = bf2f(gp[32]); gt[r][2] = bf2f(gp[64]); gt[r][3] = bf2f(gp[96]); }
#pragma unroll
    for (int r = 0; r < 8; ++r) { const int orow = wid * QBLK + crow(rb + r, hi);
      if (orow < nvalid) { bf16* qp = Ob + (long)orow * LDO + r32; const float sc_ = rli[rb + r];
        qp[0] = f2bf(o[0][rb + r] * sc_ * gt[r][0]); qp[32] = f2bf(o[1][rb + r] * sc_ * gt[r][1]); qp[64] = f2bf(o[2][rb + r] * sc_ * gt[r][2]); qp[96] = f2bf(o[3][rb + r] * sc_ * gt[r][3]); } }
    asm volatile("" ::: "memory");
  }
  __syncthreads();
#undef SDMA
#undef VWAIT
#undef RESC
}

constexpr int NSEG = 128;
DI void attn_meta_unit(const bf16* YABm, const bf16* Kh, const bf16* Vh, int g, int t0, int t1, float* Pout, float* MLout, LAS char* lds) {
  lnd(YABm); lnd(Kh); lnd(Vh); lnd(Pout); lnd(MLout);
  int tid = threadIdx.x; asm volatile("" : "+v"(tid));
  const int wid = tid >> 6, lane = tid & 63, r32 = lane & 31, hi = lane >> 5;
  LAS char* V_lds = lds; LAS char* K_lds = lds + 2 * SHM_V;
  LAS float* wsf = (LAS float*)(lds + 2 * SHM_V + 2 * SHM_K) + wid * 64; LAS float* al_l = wsf + 32;
  float m_reg = -1e30f, l_reg = 0; f32x16 o[4] = {}; bf16x8 qr[8];
  const int rr = (wid & 1) * 32 + r32, hq = rr >> 4, mt = rr & 15;
  const bf16* Qw = YABm + (long)mt * LDQ + (4 * g + hq) * 128 + hi * 8;
#pragma unroll
  for (int d0 = 0; d0 < 8; ++d0) qr[d0] = *reinterpret_cast<const bf16x8*>(Qw + d0 * 16);
  const int sr = tid >> 4, sc = (tid & 15) * 8, vst0 = v_st(sr, sc), vst1 = v_st(32 + sr, sc);
  const int vb0 = (int)(unsigned)(uintptr_t)V_lds + v_rd_base(lane);
  for (int t = t0; t < t1; ++t) {
    const long k0 = (long)t * KVBLK;
    const bf16x8 vs0 = *(const bf16x8*)(&Vh[(k0 + sr) * LDK + sc]), vs1 = *(const bf16x8*)(&Vh[(k0 + 32 + sr) * LDK + sc]);
    const bf16x8 ks0 = *(const bf16x8*)(&Kh[(k0 + sr) * LDK + sc]), ks1 = *(const bf16x8*)(&Kh[(k0 + 32 + sr) * LDK + sc]);
    *(LAS bf16x8*)(V_lds + vst0) = vs0; *(LAS bf16x8*)(V_lds + vst1) = vs1;
    *(LAS bf16x8*)(K_lds + KSWZ(sr, sc * 2)) = ks0; *(LAS bf16x8*)(K_lds + KSWZ(32 + sr, sc * 2)) = ks1;
    __syncthreads();
    if (wid < 2) {
      f32x16 p0, p1; float mn, al; bf16x8 pa0, pa1, pa2, pa3;
      qkt(p0, p1, K_lds, qr, r32, hi);
      if (t == NT_C - 1) mask_tail(p0, p1);
      partialSM(p0, p1, m_reg, mn, al);
      if (__any(al < 1.f)) { if (hi == 0) al_l[r32] = al; asm volatile("s_waitcnt lgkmcnt(0)" ::: "memory");
#pragma unroll
        for (int d = 0; d < 4; ++d)
#pragma unroll
          for (int r = 0; r < 16; ++r) o[d][r] *= al_l[crow(r, hi)]; }
      finishSM(p0, p1, al, l_reg, pa0, pa1, pa2, pa3); SBAR();
      pv_d0(o, vb0, pa0, pa1, pa2, pa3);
    }
    __syncthreads();
  }
  if (wid < 2) {
    if (hi == 0) { MLout[rr * 2] = m_reg; MLout[rr * 2 + 1] = l_reg; }
#pragma unroll
    for (int r = 0; r < 16; ++r) { const int orow = (wid & 1) * 32 + crow(r, hi);
#pragma unroll
      for (int d0 = 0; d0 < 4; ++d0) Pout[(long)orow * 128 + d0 * 32 + r32] = o[d0][r]; }
  }
  __syncthreads();
}
}

constexpr size_t ATT_PART_OFF = (size_t)20 << 20;
DI void phase_v8_image(const Ctx& C, const bf16* Vb, unsigned char* V8t) {
    const int k = C.lane, blk = k >> 5, wi = k & 31, pos = ((wi >> 2) & 1) * 32 + blk * 16 + (wi >> 3) * 4 + (wi & 3);
    for (int it = C.gw; it < 2 * att::NT_C * 16; it += C.ngw) {
        const int dg = it & 15, tile = (it >> 4) % att::NT_C, g = it / (16 * att::NT_C);
        float f[8]; unpack8(*(const u32x4*)(Vb + (size_t)(tile * 64 + k) * 256 + g * 128 + dg * 8), f);
        unsigned char* dst = V8t + ((size_t)(g * att::NT_C + tile) * 128 + dg * 8) * 64 + pos;
#pragma unroll
        for (int e = 0; e < 8; e += 2) { const int w = __builtin_amdgcn_cvt_pk_fp8_f32(f[e], f[e + 1], 0, false); dst[(e) * 64] = (unsigned char)(w & 255); dst[(e + 1) * 64] = (unsigned char)((w >> 8) & 255); }
    }
}
DI void phase_attention(const Ctx& C, bf16* YAB, const bf16* Kb, const bf16* Vb, const bf16* GA, const unsigned char* K8, const unsigned char* V8t) {
    constexpr int NUNIT = 64 * 8;
    for (int u = C.bid; u < NUNIT; u += C.G) {
        const int h = u & 7, qb = u >> 3, row0 = qb * 256, g = h >> 2;
        #ifdef EXP_ATT2
        att::attn_unit<1024>(YAB + (size_t)row0 * 2048 + h * 128, C.slot(5) + (size_t)row0 * 1024 + h * 128, K8 + g * 128, V8t + (size_t)g * att::NT_C * 8192, GA + (size_t)row0 * 1024 + h * 128, 256, (LAS char*)C.lds);
#endif
        att::attn_unit<2048>(YAB + (size_t)row0 * 2048 + h * 128, YAB + (size_t)row0 * 2048 + h * 128, K8 + g * 128, V8t + (size_t)g * att::NT_C * 8192, GA + (size_t)row0 * 1024 + h * 128, 256, (LAS char*)C.lds);
    }
    float* P = (float*)((unsigned char*)C.slot(6) + ATT_PART_OFF); float* ML = P + (size_t)2 * att::NSEG * 64 * 128;
#ifdef DBL_META
    for (int u = C.bid; u < 2 * att::NSEG; u += C.G) {
        const int g = u & 1, seg = u >> 1, t0 = 2 * seg, t1 = (seg == att::NSEG - 1) ? att::NT_C : 2 * seg + 2;
        att::attn_meta_unit(YAB + (size_t)SEQ * 2048, Kb + g * 128, Vb + g * 128, g, t0, t1, P + (size_t)u * 64 * 128, ML + (size_t)u * 128, (LAS char*)C.lds);
    }
#endif
    for (int u = C.bid; u < 2 * att::NSEG; u += C.G) {
        const int g = u & 1, seg = u >> 1, t0 = 2 * seg, t1 = (seg == att::NSEG - 1) ? att::NT_C : 2 * seg + 2;
        att::attn_meta_unit(YAB + (size_t)SEQ * 2048, Kb + g * 128, Vb + g * 128, g, t0, t1, P + (size_t)u * 64 * 128, ML + (size_t)u * 128, (LAS char*)C.lds);
    }
}
DI void phase_attention_combine(const Ctx& C, bf16* YAB, const bf16* GA) {
    const float* P = (const float*)((unsigned char*)C.slot(6) + ATT_PART_OFF); const float* ML = P + (size_t)2 * att::NSEG * 64 * 128;
    constexpr float Cc = att::SCALE * 1.4426950408889634f;
    LAS float* X = (LAS float*)C.lds;
    for (int it = C.bid; it < 128; it += C.G) {
        const int mt = it & 15, h = it >> 4, g = h >> 2, hq = h & 3, rr = hq * 16 + mt, w = C.wave, lane = C.lane;
        float M = -1e30f;
#pragma unroll
        for (int s = 0; s < 16; ++s) M = fmaxf(M, ML[(size_t)((16 * w + s) * 2 + g) * 128 + rr * 2]);
        float a0 = 0.f, a1 = 0.f, l = 0.f;
#pragma unroll 4
        for (int s = 0; s < 16; ++s) { const size_t u = (size_t)((16 * w + s) * 2 + g); const float wt = __builtin_amdgcn_exp2f((ML[u * 128 + rr * 2] - M) * Cc);
            l += ML[u * 128 + rr * 2 + 1] * wt; a0 += P[(u * 64 + rr) * 128 + lane] * wt; a1 += P[(u * 64 + rr) * 128 + 64 + lane] * wt; }
        X[w * 130 + lane] = a0; X[w * 130 + 64 + lane] = a1; if (lane == 0) { X[w * 130 + 128] = l; X[w * 130 + 129] = M; }
        __syncthreads();
        if (w == 0) {
            float Mg = -1e30f;
#pragma unroll
            for (int ww = 0; ww < 8; ++ww) Mg = fmaxf(Mg, X[ww * 130 + 129]);
            float b0 = 0.f, b1 = 0.f, lg = 0.f;
#pragma unroll
            for (int ww = 0; ww < 8; ++ww) { const float wt = __builtin_amdgcn_exp2f((X[ww * 130 + 129] - Mg) * Cc); lg += X[ww * 130 + 128] * wt; b0 += X[ww * 130 + lane] * wt; b1 += X[ww * 130 + 64 + lane] * wt; }
            const float inv = 1.f / lg; const size_t row = SEQ + mt;
            YAB[row * 2048 + h * 128 + lane] = f2bf(b0 * inv * bf2f(GA[row * 1024 + h * 128 + lane]));
            YAB[row * 2048 + h * 128 + 64 + lane] = f2bf(b1 * inv * bf2f(GA[row * 1024 + h * 128 + 64 + lane]));
        }
        __syncthreads();
    }
}

constexpr int S5_NCH = 1025;
DI int s5_row0(int c) { return c == 0 ? SEQ : 16 * (c - 1); }
DI void cis_rev(float ang, float& c, float& s) { float rev = ang * 0.15915494309189535f; rev -= rintf(rev); c = __builtin_amdgcn_cosf(rev); s = __builtin_amdgcn_sinf(rev); }

DI void phase_s5_tables(const Ctx& C, int li) {
    f32x2* apow = (f32x2*)(C.dob + DO_APOW); f32x2* bb = (f32x2*)(C.dob + DO_BB);
    for (int i = C.gw * 64 + C.lane; i < 2 * 64 * 64; i += C.ngw * 64) {
        const int d = i >> 12, g = (i >> 6) & 63;
        const size_t pidx = (size_t)li * 2 * 64 * 64 + i;
        const float ar = C.in[I_ARE][pidx], ai = C.in[I_AIM][pidx];
        const float dt = fexp(C.in[I_LDT][(size_t)li * 128 + d * 64 + g]);
#pragma unroll 1
        for (int e = 0; e <= 16; ++e) { float c, s; cis_rev((float)e * ai * dt, c, s); const float mg = fexp((float)e * ar * dt); apow[(size_t)i * 17 + e] = (f32x2){mg * c, mg * s}; }
        float c1, s1; cis_rev(ai * dt, c1, s1); const float m1 = fexp(ar * dt);
        const float xr = m1 * c1 - 1.f, xi = m1 * s1, inv = 1.f / (ar * ar + ai * ai);
        const float kr = (xr * ar + xi * ai) * inv, ki = (xi * ar - xr * ai) * inv;
        const float* bre = C.in[I_BRE] + pidx * 16; const float* bim = C.in[I_BIM] + pidx * 16;
#pragma unroll 4
        for (int p = 0; p < 16; ++p) { const float br = bre[p], bi = bim[p]; bb[(size_t)i * 16 + p] = (f32x2){kr * br - ki * bi, kr * bi + ki * br}; }
    }
}
DI void phase_s5_ktab_hcat(const Ctx& C, int li) {
    const f32x2* apow = (const f32x2*)(C.dob + DO_APOW); const f32x2* bb = (const f32x2*)(C.dob + DO_BB);
    float* ktab = (float*)(C.dob + DO_KTAB); bf16* hcat = (bf16*)(C.dob + DO_HCAT);
    const bool half_grid = C.G == 256;
    for (int task = half_grid ? ((C.bid >= 128 && C.wave < 4) ? (C.bid - 128) * 4 + C.wave : 512) : C.gws; task < 512; task += half_grid ? 512 : C.ngw) {
        const int dg = task >> 2, dl = (task & 3) * 4 + (C.lane >> 4), q = C.lane & 15;
        const float* cre = C.in[I_CRE] + ((size_t)li * 128 + dg) * 1024; const float* cim = C.in[I_CIM] + ((size_t)li * 128 + dg) * 1024;
        float acc[16];
#pragma unroll
        for (int p = 0; p < 16; ++p) acc[p] = 0.f;
#pragma unroll 4
        for (int n = 0; n < 64; ++n) { const f32x2 a = apow[((size_t)dg * 64 + n) * 17 + dl], b = bb[((size_t)dg * 64 + n) * 16 + q];
            const float wr = a.x * b.x - a.y * b.y, wi = a.x * b.y + a.y * b.x;
#pragma unroll
            for (int p = 0; p < 16; ++p) acc[p] += cre[p * 64 + n] * wr - cim[p * 64 + n] * wi; }
#pragma unroll
        for (int p = 0; p < 16; ++p) ktab[(((size_t)dg * 16 + dl) * 16 + p) * 16 + q] = acc[p];
    }
    for (int i = C.gw * 64 + C.lane; i < 64 * 256 * 32; i += C.ngw * 64) {
        const int k8 = i & 31, rho = (i >> 5) & 255, g = i >> 13;
        const int d = rho >> 7, n = (rho >> 1) & 63, ri = rho & 1, s = k8 >> 1, q0 = (k8 & 1) * 8;
        const size_t dgn = ((size_t)d * 64 + g) * 64 + n;
        const f32x2 a = apow[dgn * 17 + (d == 0 ? 15 - s : s)];
        float o[8];
#pragma unroll
        for (int j = 0; j < 8; ++j) { const f32x2 b = bb[dgn * 16 + q0 + j]; o[j] = ri ? (a.x * b.y + a.y * b.x) : (a.x * b.x - a.y * b.y); }
        *(u32x4*)(hcat + ((size_t)g * 256 + rho) * 256 + k8 * 8) = pack8(o);
    }
}
DI void phase_s5_mg(const Ctx& C, int li) {
    const f32x2* apow = (const f32x2*)(C.dob + DO_APOW); const float* ktab = (const float*)(C.dob + DO_KTAB); bf16* mg = (bf16*)(C.dob + DO_MG);
    const float* dsk = C.in[I_SSMD] + (size_t)li * 1024;
    for (int i = C.gw * 64 + C.lane; i < 64 * 256 * 32; i += C.ngw * 64) {
        const int k8 = i & 31, tp = (i >> 5) & 255, g = i >> 13, t = tp >> 4, p = tp & 15, s = k8 >> 1, q0 = (k8 & 1) * 8;
        f32x4 v0 = {0.f, 0.f, 0.f, 0.f}, v1 = v0;
        if (s <= t) { const float* kp = ktab + ((((size_t)0 * 64 + g) * 16 + (t - s)) * 16 + p) * 16 + q0; v0 += *(const f32x4*)kp; v1 += *(const f32x4*)(kp + 4); }
        if (s >= t) { const float* kp = ktab + ((((size_t)1 * 64 + g) * 16 + (s - t)) * 16 + p) * 16 + q0; v0 += *(const f32x4*)kp; v1 += *(const f32x4*)(kp + 4); }
        float o[8];
#pragma unroll
        for (int j = 0; j < 4; ++j) { o[j] = v0[j]; o[4 + j] = v1[j]; }
        if (s == t) { const float dd = dsk[g * 16 + p];
#pragma unroll
            for (int j = 0; j < 8; ++j) o[j] += (p == q0 + j) ? dd : 0.f; }
        *(u32x4*)(mg + ((size_t)g * 256 + tp) * 512 + k8 * 8) = pack8(o);
    }
    for (int i = C.gw * 64 + C.lane; i < 64 * 256 * 32; i += C.ngw * 64) {
        const int k8 = i & 31, tp = (i >> 5) & 255, g = i >> 13, t = tp >> 4, p = tp & 15;
        const int rho0 = k8 * 8, d = rho0 >> 7, n0 = (rho0 >> 1) & 63; const size_t dg = (size_t)d * 64 + g;
        const float* cre = C.in[I_CRE] + (((size_t)li * 2 * 64 + dg) * 16 + p) * 64; const float* cim = C.in[I_CIM] + (((size_t)li * 2 * 64 + dg) * 16 + p) * 64;
        const int e = d == 0 ? t + 1 : 16 - t;
        const f32x4 cr = *(const f32x4*)(cre + n0), ci = *(const f32x4*)(cim + n0);
        float o[8];
#pragma unroll
        for (int m = 0; m < 4; ++m) { const f32x2 a = apow[(dg * 64 + n0 + m) * 17 + e];
            o[2 * m] = cr[m] * a.x - ci[m] * a.y; o[2 * m + 1] = -(cr[m] * a.y + ci[m] * a.x); }
        *(u32x4*)(mg + ((size_t)g * 256 + tp) * 512 + 256 + k8 * 8) = pack8(o);
    }
}
DI bf16x8 s5_ufrag(const bf16* U, int g, int c0, int kstep, int lane) {
    int c = c0 + (lane & 15); if (c >= S5_NCH) c = S5_NCH - 1;
    const int s = kstep * 2 + (lane >> 5), q0 = ((lane >> 4) & 1) * 8;
    return *(const bf16x8*)(U + ((size_t)g * LTOK + 16 * c + s) * 16 + q0);
}
DI void phase_s5_local(const Ctx& C, const bf16* U) {
    const bf16* hcat = (const bf16*)(C.dob + DO_HCAT); bf16* ex = (bf16*)(C.dob + DO_EX);
    const int i16 = C.lane & 15, q4 = C.lane >> 4;
    for (int task = C.gw; task < 2048; task += C.ngw) {
        const int qu = task & 3, rr = (task >> 2) & 7, g = task >> 5;
        bf16x8 af[4][8];
#pragma unroll
        for (int m = 0; m < 4; ++m)
#pragma unroll
            for (int ks = 0; ks < 8; ++ks) af[m][ks] = *(const bf16x8*)(hcat + ((size_t)g * 256 + qu * 64 + m * 16 + i16) * 256 + ks * 32 + q4 * 8);
        for (int blk = rr; blk < 65; blk += 8) {
            const int c0 = blk * 16;
            f32x4 acc[4];
#pragma unroll
            for (int m = 0; m < 4; ++m) acc[m] = (f32x4){0.f, 0.f, 0.f, 0.f};
#pragma unroll
            for (int ks = 0; ks < 8; ++ks) { const bf16x8 b = s5_ufrag(U, g, c0, ks, C.lane);
#pragma unroll
                for (int m = 0; m < 4; ++m) acc[m] = MFMA16(af[m][ks], b, acc[m]); }
            const int c = c0 + i16;
            if (c < S5_NCH) {
#pragma unroll
                for (int m = 0; m < 4; ++m) { u32x2 w; w.x = cvt_pk_bf16(acc[m][0], acc[m][1]); w.y = cvt_pk_bf16(acc[m][2], acc[m][3]);
                    *(u32x2*)(ex + ((size_t)c * 64 + g) * 256 + qu * 64 + m * 16 + q4 * 4) = w; } }
        }
    }
}
template <bool DUMMY = false> DI void phase_s5_scan(const Ctx& C) {
    const f32x2* apow = (const f32x2*)(C.dob + DO_APOW); unsigned* ex = DUMMY ? (unsigned*)C.slot(1) : (unsigned*)(C.dob + DO_EX);
    if (C.gws >= 128) return;
    const int ch = C.gws * 64 + C.lane;
    const int g = ch >> 7, d = (ch >> 6) & 1, n = ch & 63;
    const f32x2 a16 = apow[(((size_t)d * 64 + g) * 64 + n) * 17 + 16];
    float xr = 0.f, xi = 0.f;
    unsigned* p = ex + ((size_t)g * 128 + d * 64 + n) + (d == 0 ? (size_t)0 : (size_t)(S5_NCH - 1) * 8192);
    const long step = d == 0 ? 8192 : -8192;
    unsigned w[41], wn[41];
#pragma unroll
    for (int j = 0; j < 41; ++j) w[j] = p[(long)j * step];
    for (int i = 0; i < S5_NCH; i += 41) {
        if (i + 41 < S5_NCH) {
#pragma unroll
            for (int j = 0; j < 41; ++j) wn[j] = p[(long)(41 + j) * step];
        }
#pragma unroll
        for (int j = 0; j < 41; ++j) { const float er = bflo(w[j]), ei = bfhi(w[j]);
            p[(long)j * step] = cvt_pk_bf16(xr, xi);
            const float nr = a16.x * xr - a16.y * xi + er, ni = a16.x * xi + a16.y * xr + ei; xr = nr; xi = ni; }
#pragma unroll
        for (int j = 0; j < 41; ++j) w[j] = wn[j];
        p += 41 * step;
    }
}
DI void phase_s5_out(const Ctx& C, const bf16* U, bf16* YG) {
    const bf16* mg = (const bf16*)(C.dob + DO_MG); const bf16* ex = (const bf16*)(C.dob + DO_EX);
    const int i16 = C.lane & 15, q4 = C.lane >> 4, w = C.wave;
    LAS bf16x8* Bst = (LAS bf16x8*)C.lds;
    for (int wt = C.bid; wt < 256; wt += C.G) {
        const int yy = wt >> 3, rr = yy & 3, g = ((wt & 7) * 2 + (yy >> 4)) * 4 + ((yy >> 2) & 3), e8 = w;
        bf16x8 af[2][16];
#pragma unroll
        for (int m = 0; m < 2; ++m)
#pragma unroll
            for (int ks = 0; ks < 16; ++ks) af[m][ks] = *(const bf16x8*)(mg + ((size_t)g * 256 + e8 * 32 + m * 16 + i16) * 512 + ks * 32 + q4 * 8);
#define S5O_LD(dst0, dst1, c0_) do { if (w < 4) { dst0 = s5_ufrag(U, g, (c0_), 2 * w, C.lane); dst1 = s5_ufrag(U, g, (c0_), 2 * w + 1, C.lane); } \
            else { int cc_ = (c0_) + i16; if (cc_ >= S5_NCH) cc_ = S5_NCH - 1; const bf16* xp_ = ex + ((size_t)cc_ * 64 + g) * 256 + (2 * w - 8) * 32 + q4 * 8; \
                dst0 = *(const bf16x8*)xp_; dst1 = *(const bf16x8*)(xp_ + 32); } } while (0)
#define S5O_BLOCK(BUF_, RS0_, RS1_, RL0_, RL1_) do { const int c0 = blk * 16; \
            if (blk + 8 < 65) S5O_LD(RL0_, RL1_, c0 + 128); \
            f32x4 acc[2]; acc[0] = (f32x4){0.f, 0.f, 0.f, 0.f}; acc[1] = acc[0]; \
            _Pragma("unroll") for (int ks = 0; ks < 16; ++ks) { const bf16x8 b = Bst[((BUF_) * 16 + ks) * 64 + C.lane]; \
                acc[0] = MFMA16(af[0][ks], b, acc[0]); acc[1] = MFMA16(af[1][ks], b, acc[1]); } \
            const int c = c0 + i16; \
            if (c < S5_NCH) { \
                _Pragma("unroll") for (int m = 0; m < 2; ++m) { const int tp = e8 * 32 + m * 16 + q4 * 4, t = tp >> 4, p = tp & 15; \
                    u32x2 wv; wv.x = cvt_pk_bf16(gelu_tanh_f(acc[m][0]), gelu_tanh_f(acc[m][1])); wv.y = cvt_pk_bf16(gelu_tanh_f(acc[m][2]), gelu_tanh_f(acc[m][3])); \
                    *(u32x2*)(YG + (size_t)(s5_row0(c) + t) * 1024 + g * 16 + p) = wv; } } \
            if (blk + 4 < 65) { Bst[(((BUF_) ^ 1) * 16 + 2 * w) * 64 + C.lane] = RS0_; Bst[(((BUF_) ^ 1) * 16 + 2 * w + 1) * 64 + C.lane] = RS1_; } \
            __syncthreads(); } while (0)
        bf16x8 a0, a1, b0, b1;
        S5O_LD(a0, a1, rr * 16);
        Bst[(2 * w) * 64 + C.lane] = a0; Bst[(2 * w + 1) * 64 + C.lane] = a1;
        S5O_LD(a0, a1, rr * 16 + 64);
        __syncthreads();
        for (int blk = rr; blk < 65; blk += 8) {
            S5O_BLOCK(0, a0, a1, b0, b1);
            blk += 4;
            if (blk < 65) S5O_BLOCK(1, b0, b1, a0, a1);
            blk -= 4;
        }
#undef S5O_BLOCK
#undef S5O_LD
    }
}

DI int seq_of_row(int r) { return r < SEQ ? r + 16 : r - SEQ; }
DI int row_of_seq(int l) { return l < 16 ? SEQ + l : l - 16; }
DI void phase_conv(const Ctx& C, const bf16* XM, bf16* XC, const float* cw, const float* cb) {
    const int nitems = (LTOK / 8) * 256;
    for (int it = C.gw * 64 + C.lane; it < nitems; it += C.ngw * 64) {
        const int l0 = (it >> 8) * 8, c0 = (it & 255) * 8;
        float w[5][8], bias[8];
        { const f32x4 b0 = *(const f32x4*)(cb + c0), b1 = *(const f32x4*)(cb + c0 + 4);
#pragma unroll
          for (int e = 0; e < 4; ++e) { bias[e] = b0[e]; bias[4 + e] = b1[e]; } }
#pragma unroll
        for (int j = 0; j < 5; ++j) { const f32x4 w0 = *(const f32x4*)(cw + (size_t)j * 2048 + c0), w1 = *(const f32x4*)(cw + (size_t)j * 2048 + c0 + 4);
#pragma unroll
            for (int e = 0; e < 4; ++e) { w[j][e] = w0[e]; w[j][4 + e] = w1[e]; } }
        u32x4 xr[12];
#pragma unroll
        for (int r = 0; r < 12; ++r) { const int l2 = l0 + r - 2; xr[r] = (l2 >= 0 && l2 < LTOK) ? *(const u32x4*)(XM + (size_t)row_of_seq(l2) * 2048 + c0) : (u32x4){0u, 0u, 0u, 0u}; }
#pragma unroll
        for (int o = 0; o < 8; ++o) { float acc[8];
#pragma unroll
            for (int e = 0; e < 8; ++e) acc[e] = bias[e];
#pragma unroll
            for (int j = 0; j < 5; ++j) { float x[8]; unpack8(xr[o + j], x);
#pragma unroll
                for (int e = 0; e < 8; ++e) acc[e] += w[j][e] * x[e]; }
            float ov[8];
#pragma unroll
            for (int e = 0; e < 8; ++e) ov[e] = silu_f(acc[e]);
            *(u32x4*)(XC + (size_t)row_of_seq(l0 + o) * 2048 + c0) = pack8(ov); }
    }
}
DI int pos_of_row(int r) { return r < SEQ ? r + 64 : r - SEQ + 48; }
DI int row_of_pos(int pos) { return pos >= 64 ? pos - 64 : (pos >= 48 ? SEQ + pos - 48 : -1); }
DI float log_sigmoid_f(float x) { return fminf(x, 0.f) - __logf(1.f + __expf(-fabsf(x))); }
DI void phase_gates(const Ctx& C, const bf16* XC, const bf16* WG, const float* big, const float* bfg) {
    float* GA = (float*)(C.misc() + MS_GI); float* GCM = (float*)(C.misc() + MS_GF); float* GB = (float*)(C.misc() + MS_GB);
    const int lane = C.lane, r32 = lane & 31, hi = lane >> 5, w = C.wave, tid = C.tid;
    LAS float* P = (LAS float*)C.lds;
    LAS float* G = (LAS float*)(C.lds + 65536);
    for (int c = C.bid; c < 257; c += C.G) {
        const int rbase = c == 0 ? SEQ - 48 : 64 * (c - 1);
        const bf16* bp = WG + (size_t)r32 * 2048 + w * 256 + hi * 8;
#pragma unroll
        for (int j = 0; j < 2; ++j) {
            if (c == 0 && j == 0) continue;
            const bf16* ap = XC + (size_t)(rbase + 32 * j + r32) * 2048 + w * 256 + hi * 8;
            f32x16 acc = {};
#pragma unroll
            for (int k0 = 0; k0 < 256; k0 += 16) acc = MFMA32(*(const bf16x8*)(ap + k0), *(const bf16x8*)(bp + k0), acc);
#pragma unroll
            for (int r = 0; r < 16; ++r) { const int p = 32 * j + (r & 3) + 8 * (r >> 2) + 4 * hi; P[(w * 64 + p) * 32 + r32] = acc[r]; }
        }
        __syncthreads();
#pragma unroll
        for (int e = 0; e < 4; ++e) { const int idx = tid + 512 * e, p = idx >> 5, n = idx & 31; float v = 0.f;
#pragma unroll
            for (int ww = 0; ww < 8; ++ww) v += P[(ww * 64 + p) * 32 + n];
            const int ty = n >> 4; v += (ty ? bfg : big)[n & 15];
            v = ty ? log_sigmoid_f(v) : v; if (c == 0 && p < 48) v = ty ? 0.f : -1e9f;
            G[p * 33 + n] = v; }
        __syncthreads();
#pragma unroll 1
        for (int q = 0; q < 2; ++q) { const int dh = 2 * w + q, d = dh >> 3;
            const float li = G[lane * 33 + dh], lf = G[lane * 33 + 16 + dh];
            float b = lf;
#pragma unroll
            for (int o = 1; o < 64; o <<= 1) { const float x = shf(b, d == 0 ? lane - o : lane + o); const bool ok = d == 0 ? (lane >= o) : (lane + o < 64); b += ok ? x : 0.f; }
            const float a = li - b; float cm = a;
#pragma unroll
            for (int o = 1; o < 64; o <<= 1) { const float x = shf(cm, d == 0 ? lane - o : lane + o); const bool ok = d == 0 ? (lane >= o) : (lane + o < 64); cm = ok ? fmaxf(cm, x) : cm; }
            const size_t idx = (size_t)dh * NPOS + 64 * c + lane;
            GA[idx] = a; GCM[idx] = cm; GB[idx] = b; }
        __syncthreads();
    }
}
DI void phase_cell_merge(const Ctx& C, bf16* CELL, bf16* CELLM, const bf16* V2, const bf16* VM2, bf16* dummy = nullptr) {
    float* rstd = (float*)(C.misc() + MS_RSTD);
    const int sub = C.lane & 31, half = C.lane >> 5;
    constexpr int NIT = LTOK * 8;
    for (int it = C.gw * 2; it < NIT; it += C.ngw * 4) {
        int idx[2]; bf16* p[2]; u32x4 wa[2], wb[2];
#pragma unroll
        for (int k = 0; k < 2; ++k) { int i = it + half + k * C.ngw * 2; if (i >= NIT) i = NIT - 1; idx[k] = i; const int row = i >> 3, h = i & 7;
            const size_t off = (size_t)(row < SEQ ? row : row - SEQ) * 2048 + h * 256 + sub * 8;
            p[k] = (row < SEQ ? CELL : CELLM) + off; wa[k] = __builtin_nontemporal_load((const u32x4*)p[k]); wb[k] = __builtin_nontemporal_load((const u32x4*)((row < SEQ ? V2 : VM2) + off)); }
#pragma unroll
        for (int k = 0; k < 2; ++k) { float a[8], b[8]; unpack8(wa[k], a); unpack8(wb[k], b); float s = 0.f;
#pragma unroll
            for (int e = 0; e < 8; ++e) a[e] += b[e];
            const u32x4 w = pack8(a); unpack8(w, a);
#pragma unroll
            for (int e = 0; e < 8; ++e) s += a[e] * a[e];
            const bool live = (k == 0) || (it + half + C.ngw * 2 < NIT);
            if (live) *(u32x4*)(dummy ? dummy + ((size_t)idx[k] * 256 + sub * 8) % ((size_t)16 << 20) : p[k]) = w;
            s += shx(s, 1, C.lane); s += shx(s, 2, C.lane); s += shx(s, 4, C.lane); s += shx(s, 8, C.lane); s += shx(s, 16, C.lane);
            if (sub == 0 && live) rstd[idx[k]] = rsqrtf(s * (1.f / 256.f) + EPS); }
    }
}

namespace ml {
constexpr int TILE = 44032;
constexpr int QS = 0, KS = 17408, VT = 34816, VTW = 39424, NXB = 2 * TILE, NXSZ = 17408, NIB = NXB + 2 * NXSZ, NISZ = 8704, SC = NIB + 2 * NISZ, LDS_END = SC + 4 * 1536;
constexpr int SC_A = 0, SC_M = 256, SC_ISC = 512, SC_FLO = 768, SC_W = 1024, SC_DEC = 1280, SC_STRIDE = 1536;
constexpr float QSCALE = 0.08838834764831845f;
DI s16x4 trr(unsigned addr) { s16x4 r; asm volatile("ds_read_b64_tr_b16 %0, %1" : "=&v"(r) : "v"(addr) : "memory"); return r; }
template <int OFF> DI s16x4 trro(unsigned base) { s16x4 r; asm volatile("ds_read_b64_tr_b16 %0, %1 offset:%2" : "=&v"(r) : "v"(base), "i"(OFF) : "memory"); return r; }
static_assert(LDS_END <= LDS_MISC, "mLSTM LDS map");
}
constexpr int CW_PROG = 12288;
DI void phase_mlstm(const Ctx& C, int epoch, const bf16* Q, const bf16* K, bf16* V, bf16* VM, bf16* CELL, bf16* CELLM, bf16* V2d, bf16* VM2d) {
    using namespace ml;
    const float* GA = (const float*)(C.misc() + MS_GI); const float* GCM = (const float*)(C.misc() + MS_GF); const float* GB = (const float*)(C.misc() + MS_GB); const bf16* ZR = (const bf16*)(C.misc() + MS_ZROW);
    unsigned* prog = (unsigned*)(C.misc() + MS_CTL) + CW_PROG;
    const int w = C.wave, tid = C.tid, lane = C.lane, i16 = lane & 15, q4 = lane >> 4;
    const bool intra = w < 4; const int be = w & 1, eta = (w >> 1) & 1;
    LAS unsigned char* L = C.lds;
    for (int unit = C.bid; unit < 256; unit += C.G) {
        const int h = unit & 7, sl = (unit >> 3) & 15, d = unit >> 7;
        const int lo_ = d == 0 ? w : 3 - w;
        unsigned* prog_me = prog + unit * 16; unsigned* prog_pa = prog + (unit ^ 128) * 16;
        const float* ga = GA + (size_t)(d * 8 + h) * NPOS; const float* gcm = GCM + (size_t)(d * 8 + h) * NPOS; const float* gb = GB + (size_t)(d * 8 + h) * NPOS;
        for (int i = tid; i < 2 * 16 * 72; i += NTHR) { const int b = i / (16 * 72), r = i % (16 * 72), v = 16 + r / 72, s = r % 72;
            ((LAS bf16*)(L + b * TILE + VT))[v * 72 + s] = (v == 16) ? (bf16)0x3f80 : (bf16)0; ((LAS bf16*)(L + b * TILE + VTW))[v * 72 + s] = 0; }
        f32x4 Cs0 = {0.f, 0.f, 0.f, 0.f}, Cs1 = Cs0, Cs2 = Cs0, Cs3 = Cs0;
        float m_prev = 0.f;
        u32x4 pq0, pq1, pk0, pk1, pv;
        float g1a = 0.f, g1cm = 0.f, g1b = 0.f;
        const unsigned oq0_ = (unsigned)((tid >> 4) * 1024 + h * 128 + (tid & 15) * 8), oq1_ = oq0_ + 32u * 1024u;
        const unsigned ov_ = (unsigned)(((tid & 127) >> 1) * 2048 + h * 256 + sl * 16 + (tid & 1) * 8);
#define ML_LOADQK(j, PQ, PK, cs_) do { const int p_ = tid + 512 * (j), t_ = p_ >> 4, c8_ = (p_ & 15) * 8; const bool z_ = t_ < 48; \
            const unsigned of_ = z_ ? (unsigned)c8_ : (unsigned)((SEQ + t_ - 48) * 1024 + h * 128 + c8_); \
            PQ = *(const u32x4*)((z_ ? ZR : Q) + of_); PK = *(const u32x4*)((z_ ? ZR : K) + of_); } while (0)
#define ML_LOAD(cs_) do { if ((cs_) == 0) { ML_LOADQK(0, pq0, pk0, 0); ML_LOADQK(1, pq1, pk1, 0); \
              { const int t_ = (tid & 127) >> 1, c8_ = (tid & 1) * 8; const bool z_ = t_ < 48; const unsigned of_ = z_ ? (unsigned)c8_ : (unsigned)((t_ - 48) * 2048 + h * 256 + sl * 16 + c8_); \
                pv = *(const u32x4*)((z_ ? ZR : (const bf16*)VM) + of_); } } \
            else { const bf16* Qc_ = Q + (size_t)((cs_) - 1) * 65536; const bf16* Kc_ = K + (size_t)((cs_) - 1) * 65536; const bf16* Vc_ = (const bf16*)V + (size_t)((cs_) - 1) * 131072; \
              pq0 = *(const u32x4*)(Qc_ + oq0_); pk0 = *(const u32x4*)(Kc_ + oq0_); pq1 = *(const u32x4*)(Qc_ + oq1_); pk1 = *(const u32x4*)(Kc_ + oq1_); pv = *(const u32x4*)(Vc_ + ov_); } } while (0)
#define ML_SCALARS(a_, cm_, b_, slot_) do { \
            const float cm_all_ = __int_as_float(__builtin_amdgcn_readlane(__float_as_int(cm_), d == 0 ? 63 : 0)), b_last_ = __int_as_float(__builtin_amdgcn_readlane(__float_as_int(b_), d == 0 ? 63 : 0)); \
            const float M_ = fmaxf((cm_), m_prev), Mst_ = fmaxf(cm_all_, m_prev); \
            LAS float* S_ = (LAS float*)(L + SC) + (slot_) * (SC_STRIDE / 4); \
            S_[SC_A / 4 + lane] = (a_) * 1.4426950408889634f; S_[SC_M / 4 + lane] = M_ * 1.4426950408889634f + 3.5f;     S_[SC_ISC / 4 + lane] = __expf(m_prev - M_) * QSCALE; S_[SC_FLO / 4 + lane] = __expf(-(b_) - M_); \
            S_[SC_W / 4 + lane] = __expf((a_) - Mst_); if (lane == 0) S_[SC_DEC / 4] = __expf(m_prev - Mst_); \
            m_prev = b_last_ + Mst_; } while (0)
#define ML_CS(i_) (d == 0 ? (i_) : 256 - (i_))
#define ML_BAR() do { asm volatile("s_waitcnt lgkmcnt(0)" ::: "memory"); __builtin_amdgcn_s_barrier(); asm volatile("" ::: "memory"); } while (0)
#define ML_STAGE(st_) do { LAS unsigned char* T_ = L + ((st_) & 1) * TILE; const LAS float* Sw_ = (const LAS float*)(L + SC) + ((st_) & 3) * (SC_STRIDE / 4) + SC_W / 4; \
            { const int p_ = tid, t_ = p_ >> 4, c8_ = (p_ & 15) * 8; *(LAS u32x4*)((LAS bf16*)(T_ + QS) + t_ * 136 + c8_) = pq0; *(LAS u32x4*)((LAS bf16*)(T_ + KS) + t_ * 136 + c8_) = pk0; } \
            { const int p_ = tid + 512, t_ = p_ >> 4, c8_ = (p_ & 15) * 8; *(LAS u32x4*)((LAS bf16*)(T_ + QS) + t_ * 136 + c8_) = pq1; *(LAS u32x4*)((LAS bf16*)(T_ + KS) + t_ * 136 + c8_) = pk1; } \
            if (intra && lo_ < 2) { const int t_ = (tid & 127) >> 1, c8_ = (tid & 1) * 8; const float ws_ = Sw_[t_]; float vv_[8]; unpack8(pv, vv_); \
                _Pragma("unroll") for (int e_ = 0; e_ < 8; ++e_) { ((LAS bf16*)(T_ + VT))[(c8_ + e_) * 72 + t_] = f2bf(vv_[e_]); ((LAS bf16*)(T_ + VTW))[(c8_ + e_) * 72 + t_] = f2bf(vv_[e_] * ws_); } } \
            else if (intra && lo_ == 2) { const int t_ = lane; ((LAS bf16*)(T_ + VTW))[16 * 72 + t_] = f2bf(Sw_[t_]); } } while (0)
#define ML_FINISH(j_) do { const int cj_ = ML_CS(j_); const LAS float* Sj_ = (const LAS float*)(L + SC) + ((j_) & 3) * (SC_STRIDE / 4); const LAS float* NXj_ = (const LAS float*)(L + NXB + ((j_) & 1) * NXSZ); \
            const int tb_ = 16 * (w & 3) + 4 * q4; \
            const bool first_ = ((j_) < 128) || ((j_) == 128 && d == 0); \
            bf16* ob_ = cj_ == 0 ? (first_ ? CELLM : VM2d) : (first_ ? CELL : V2d); \
            const int rb_ = cj_ == 0 ? (tb_ < 48 ? 16 + tb_ : tb_ - 48) : 64 * (cj_ - 1) + tb_;     \
            const unsigned cb_ = (unsigned)(h * 256 + sl * 16 + i16); \
            if (!intra) { const LAS float* NIj_ = (const LAS float*)(L + NIB + ((j_) & 1) * NISZ); const f32x4 isc_ = *(const LAS f32x4*)(Sj_ + SC_ISC / 4 + tb_), flo_ = *(const LAS f32x4*)(Sj_ + SC_FLO / 4 + tb_); float hv_[4]; \
                const f32x4 ni_ = *(const LAS f32x4*)(NIj_ + i16 * 68 + tb_), nxa_ = *(const LAS f32x4*)(NXj_ + i16 * 68 + tb_), nxb_ = *(const LAS f32x4*)(NXj_ + 2 * 1088 + i16 * 68 + tb_); \
                const f32x4 de_ = *(const LAS f32x4*)(NIj_ + 1088 + tb_), dxa_ = *(const LAS f32x4*)(NXj_ + 1088 + tb_), dxb_ = *(const LAS f32x4*)(NXj_ + 3 * 1088 + tb_);     \
                _Pragma("unroll") for (int r_ = 0; r_ < 4; ++r_) { const float num_ = ni_[r_] + isc_[r_] * (nxa_[r_] + nxb_[r_]); const float den_ = de_[r_] + isc_[r_] * (dxa_[r_] + dxb_[r_]); \
                    hv_[r_] = num_ * __builtin_amdgcn_rcpf(fmaxf(fabsf(den_), flo_[r_])); } \
                if (!first_) { const unsigned need_ = (unsigned)(epoch * 1024 + 256 - (j_) + 1); unsigned sp_ = 0u; ppa = (unsigned)__builtin_amdgcn_readfirstlane((int)ppa); \
                    while (ppa < need_ && sp_ < (1u << 20)) { __builtin_amdgcn_s_sleep(1); ppa = (unsigned)__builtin_amdgcn_readfirstlane((int)__hip_atomic_load(prog_pa, __ATOMIC_RELAXED, __HIP_MEMORY_SCOPE_AGENT)); ++sp_; } } \
                { bf16* op_ = ob_ + (unsigned)(rb_ * 2048) + cb_; op_[0] = f2bf(hv_[0]); op_[2048] = f2bf(hv_[1]); op_[4096] = f2bf(hv_[2]); op_[6144] = f2bf(hv_[3]); } } } while (0)
        ML_LOAD(ML_CS(0));
        { const float a0 = ga[ML_CS(0) * 64 + lane], c0 = gcm[ML_CS(0) * 64 + lane], b0 = gb[ML_CS(0) * 64 + lane], a1 = ga[ML_CS(1) * 64 + lane], c1 = gcm[ML_CS(1) * 64 + lane], b1 = gb[ML_CS(1) * 64 + lane];
          if (intra && lo_ == 2) { ML_SCALARS(a0, c0, b0, 0); ML_SCALARS(a1, c1, b1, 1); } }
        __syncthreads();
        ML_STAGE(0);
        ML_LOAD(ML_CS(1));
        ML_BAR();
        unsigned ppa = 0u;
#ifdef DIAG
        unsigned long long tA_ = 0, tF_ = 0, tB_ = 0, tC_ = 0, t0_ = __builtin_amdgcn_s_memtime(), tx_;
#define DG_MARK(acc) do { const unsigned long long ty_ = __builtin_amdgcn_s_memtime(); acc += ty_ - tx_; tx_ = ty_; } while (0)
#else
#define DG_MARK(acc) do { } while (0)
#endif
        for (int i = 0; i <= 256; ++i) {
#ifdef DIAG
            tx_ = __builtin_amdgcn_s_memtime();
#endif
            const int par = i & 1;
            LAS unsigned char* T = L + par * TILE; const LAS float* S = (const LAS float*)(L + SC) + (i & 3) * (SC_STRIDE / 4);
            LAS bf16* Qs = (LAS bf16*)(T + QS); LAS bf16* Ks = (LAS bf16*)(T + KS); LAS bf16* Vt = (LAS bf16*)(T + VT); LAS bf16* Vtw = (LAS bf16*)(T + VTW);
            LAS float* NXb = (LAS float*)(L + NXB + par * NXSZ);
            ppa = __hip_atomic_load(prog_pa, __ATOMIC_RELAXED, __HIP_MEMORY_SCOPE_AGENT);
            if (tid == 0) __hip_atomic_store(prog_me, (unsigned)(epoch * 1024 + i + 1), __ATOMIC_RELAXED, __HIP_MEMORY_SCOPE_AGENT);
            if (i < 256) ML_STAGE(i + 1);
            { const int in_ = i < 255 ? i + 2 : 256; ML_LOAD(ML_CS(in_));
              if (intra && lo_ == 2) { const int ig_ = ML_CS(in_) * 64 + lane; g1a = ga[ig_]; g1cm = gcm[ig_]; g1b = gb[ig_]; } }
            DG_MARK(tA_);
            if (i > 0) ML_FINISH(i - 1);
            DG_MARK(tF_);
            if (intra) {
                const int tau_ = w; const LAS bf16* qp_ = Qs + (16 * tau_ + i16) * 136 + 8 * q4;
                const bf16x8 bq0_ = *(const LAS bf16x8*)(qp_), bq1_ = *(const LAS bf16x8*)(qp_ + 32), bq2_ = *(const LAS bf16x8*)(qp_ + 64), bq3_ = *(const LAS bf16x8*)(qp_ + 96);
                const float Mt_ = S[SC_M / 4 + 16 * tau_ + i16]; unsigned jw_[8];
#define ML_INTRA(NV_) do { bf16x8 kf_[NV_][4]; f32x4 ac_[NV_], as4_[NV_]; \
                    _Pragma("unroll") for (int j_ = 0; j_ < NV_; ++j_) { const int sg_ = d == 0 ? j_ : 3 - j_; const LAS bf16* kp_ = Ks + (16 * sg_ + i16) * 136 + 8 * q4; \
                        _Pragma("unroll") for (int kk_ = 0; kk_ < 4; ++kk_) kf_[j_][kk_] = *(const LAS bf16x8*)(kp_ + 32 * kk_); \
                        as4_[j_] = *(const LAS f32x4*)(S + SC_A / 4 + 16 * sg_ + 4 * q4); ac_[j_] = (f32x4){0.f, 0.f, 0.f, 0.f}; } \
                    _Pragma("unroll") for (int j_ = 0; j_ < NV_; ++j_) ac_[j_] = MFMA16(kf_[j_][0], bq0_, ac_[j_]); \
                    _Pragma("unroll") for (int j_ = 0; j_ < NV_; ++j_) ac_[j_] = MFMA16(kf_[j_][1], bq1_, ac_[j_]); \
                    _Pragma("unroll") for (int j_ = 0; j_ < NV_; ++j_) ac_[j_] = MFMA16(kf_[j_][2], bq2_, ac_[j_]); \
                    _Pragma("unroll") for (int j_ = 0; j_ < NV_; ++j_) ac_[j_] = MFMA16(kf_[j_][3], bq3_, ac_[j_]); \
                    _Pragma("unroll") for (int j_ = 0; j_ < NV_; ++j_) { float e_[4]; \
                        _Pragma("unroll") for (int r_ = 0; r_ < 4; ++r_) { float x_ = __builtin_amdgcn_exp2f(as4_[j_][r_] - Mt_) * ac_[j_][r_]; \
                            if (j_ == NV_ - 1) { const int sl_ = 4 * q4 + r_; const bool ok_ = d == 0 ? (sl_ <= i16) : (sl_ >= i16); x_ = ok_ ? x_ : 0.f; } e_[r_] = x_; } \
                        jw_[2 * j_] = cvt_pk_bf16(e_[0], e_[1]); jw_[2 * j_ + 1] = cvt_pk_bf16(e_[2], e_[3]); } \
                    _Pragma("unroll") for (int j_ = NV_; j_ < 4; ++j_) { jw_[2 * j_] = 0u; jw_[2 * j_ + 1] = 0u; } } while (0)
                if (lo_ == 0) ML_INTRA(1); else if (lo_ == 1) ML_INTRA(2); else if (lo_ == 2) ML_INTRA(3); else ML_INTRA(4);
#undef ML_INTRA
                const bool fw_ = d == 0;
                const u32x4 fa0_ = {fw_ ? jw_[0] : jw_[6], fw_ ? jw_[1] : jw_[7], fw_ ? jw_[2] : jw_[4], fw_ ? jw_[3] : jw_[5]}, fa1_ = {fw_ ? jw_[4] : jw_[2], fw_ ? jw_[5] : jw_[3], fw_ ? jw_[6] : jw_[0], fw_ ? jw_[7] : jw_[1]};
                const LAS bf16* v0_ = Vt + (i16) * 72 + 4 * q4; const LAS bf16* v1_ = Vt + (16 + i16) * 72 + 4 * q4;
                const u32x2 b00_ = *(const LAS u32x2*)(v0_), b01_ = *(const LAS u32x2*)(v0_ + 16), b02_ = *(const LAS u32x2*)(v0_ + 32), b03_ = *(const LAS u32x2*)(v0_ + 48);
                const u32x2 b10_ = *(const LAS u32x2*)(v1_), b11_ = *(const LAS u32x2*)(v1_ + 16), b12_ = *(const LAS u32x2*)(v1_ + 32), b13_ = *(const LAS u32x2*)(v1_ + 48);
                const u32x4 fb00_ = {b00_.x, b00_.y, b01_.x, b01_.y}, fb01_ = {b02_.x, b02_.y, b03_.x, b03_.y}, fb10_ = {b10_.x, b10_.y, b11_.x, b11_.y}, fb11_ = {b12_.x, b12_.y, b13_.x, b13_.y};
                f32x4 na_ = {0.f, 0.f, 0.f, 0.f}, nb_ = na_;
                na_ = MFMA16(__builtin_bit_cast(bf16x8, fa0_), __builtin_bit_cast(bf16x8, fb00_), na_); na_ = MFMA16(__builtin_bit_cast(bf16x8, fa1_), __builtin_bit_cast(bf16x8, fb01_), na_);
                nb_ = MFMA16(__builtin_bit_cast(bf16x8, fa0_), __builtin_bit_cast(bf16x8, fb10_), nb_); nb_ = MFMA16(__builtin_bit_cast(bf16x8, fa1_), __builtin_bit_cast(bf16x8, fb11_), nb_);
                { LAS float* NIw_ = (LAS float*)(L + NIB + par * NISZ);
                  *(LAS f32x4*)(NIw_ + i16 * 68 + 16 * tau_ + 4 * q4) = na_; *(LAS f32x4*)(NIw_ + 1088 + i16 * 68 + 16 * tau_ + 4 * q4) = nb_; }
            } else {
                bf16x8 Cf0, Cf1;
                { u32x4 f_; f_ = (u32x4){cvt_pk_bf16(Cs0[0], Cs0[1]), cvt_pk_bf16(Cs0[2], Cs0[3]), cvt_pk_bf16(Cs1[0], Cs1[1]), cvt_pk_bf16(Cs1[2], Cs1[3])}; Cf0 = __builtin_bit_cast(bf16x8, f_);
                  f_ = (u32x4){cvt_pk_bf16(Cs2[0], Cs2[1]), cvt_pk_bf16(Cs2[2], Cs2[3]), cvt_pk_bf16(Cs3[0], Cs3[1]), cvt_pk_bf16(Cs3[2], Cs3[3])}; Cf1 = __builtin_bit_cast(bf16x8, f_); }
                { u32x2 qa_[4][4];
#pragma unroll
                  for (int tt_ = 0; tt_ < 4; ++tt_) { const LAS bf16* qp_ = Qs + (16 * tt_ + i16) * 136 + 64 * eta + 4 * q4;
#pragma unroll
                      for (int jj_ = 0; jj_ < 4; ++jj_) qa_[tt_][jj_] = *(const LAS u32x2*)(qp_ + 16 * jj_); }
                  f32x4 nx_[4];
#pragma unroll
                  for (int tt_ = 0; tt_ < 4; ++tt_) { const u32x4 f_ = {qa_[tt_][0].x, qa_[tt_][0].y, qa_[tt_][1].x, qa_[tt_][1].y}; nx_[tt_] = MFMA16(__builtin_bit_cast(bf16x8, f_), Cf0, ((f32x4){0.f, 0.f, 0.f, 0.f})); }
#pragma unroll
                  for (int tt_ = 0; tt_ < 4; ++tt_) { const u32x4 f_ = {qa_[tt_][2].x, qa_[tt_][2].y, qa_[tt_][3].x, qa_[tt_][3].y}; nx_[tt_] = MFMA16(__builtin_bit_cast(bf16x8, f_), Cf1, nx_[tt_]); }
#pragma unroll
                  for (int tt_ = 0; tt_ < 4; ++tt_) *(LAS f32x4*)(NXb + (eta * 2 + be) * 1088 + i16 * 68 + 16 * tt_ + 4 * q4) = nx_[tt_]; }
                const float dec = S[SC_DEC / 4];
                const LAS bf16* vw_ = Vtw + (16 * be + i16) * 72 + 8 * q4; const bf16x8 vb0 = *(const LAS bf16x8*)(vw_), vb1 = *(const LAS bf16x8*)(vw_ + 32);
                const unsigned kb_ = (unsigned)(uintptr_t)Ks + (unsigned)((8 * q4 + (i16 >> 2)) * 272 + 8 * (i16 & 3) + 128 * eta);
#define ML_TR4(kt_, L0, H0, L1, H1) s16x4 L0 = trro<(kt_) * 32>(kb_), H0 = trro<(kt_) * 32 + 4 * 272>(kb_), L1 = trro<(kt_) * 32 + 32 * 272>(kb_), H1 = trro<(kt_) * 32 + 36 * 272>(kb_)
#define ML_MM(CS_, L0, H0, L1, H1) do { const bf16x8 a0_ = {L0[0], L0[1], L0[2], L0[3], H0[0], H0[1], H0[2], H0[3]}, a1_ = {L1[0], L1[1], L1[2], L1[3], H1[0], H1[1], H1[2], H1[3]}; \
                CS_ = CS_ * dec; CS_ = MFMA16(a0_, vb0, CS_); CS_ = MFMA16(a1_, vb1, CS_); } while (0)
                { ML_TR4(0, a0, a1, a2, a3); ML_TR4(1, b0, b1, b2, b3); ML_TR4(2, c0, c1, c2, c3); ML_TR4(3, e0, e1, e2, e3);
                  asm volatile("s_waitcnt lgkmcnt(0)" ::: "memory"); __builtin_amdgcn_sched_barrier(0);
                  ML_MM(Cs0, a0, a1, a2, a3); ML_MM(Cs1, b0, b1, b2, b3); ML_MM(Cs2, c0, c1, c2, c3); ML_MM(Cs3, e0, e1, e2, e3); }
            }
            if (intra && lo_ == 2 && i < 255) { ML_SCALARS(g1a, g1cm, g1b, (i + 2) & 3); }
            DG_MARK(tB_);
            ML_BAR();
            DG_MARK(tC_);
        }
#ifdef DIAG
        if (C.bid == 0 && lane == 0) { float* dg_ = (float*)((unsigned*)(C.misc() + MS_CTL) + CW_CHK) + C.wave * 8; dg_[0] = (float)(__builtin_amdgcn_s_memtime() - t0_) / 257.f; dg_[1] = (float)tA_ / 257.f; dg_[2] = (float)tF_ / 257.f; dg_[3] = (float)tB_ / 257.f; dg_[4] = (float)tC_ / 257.f; }
#endif
        { const int i = 257; (void)i; ppa = __hip_atomic_load(prog_pa, __ATOMIC_RELAXED, __HIP_MEMORY_SCOPE_AGENT); ML_FINISH(256); }
        VM_WAIT(); __syncthreads();
#undef ML_LOADQK
#undef ML_LOAD
#undef ML_SCALARS
#undef ML_CS
#undef ML_BAR
#undef ML_STAGE
#undef ML_FINISH
#undef ML_TR4
#undef ML_MM
    }
}

#if DBG_CHECK
constexpr size_t MS_STASH = MS_END;
constexpr int ST_QATT = 0;
constexpr int ST_GB = 8 * 128;
constexpr int ST_XM = ST_GB + 16;
constexpr int NCHK = 16;
DI float* chk_words(const Ctx& C) { return (float*)((unsigned*)(C.misc() + MS_CTL) + CW_CHK); }
DI void chk_add(const Ctx& C, int id, float diff, float ref) {
    float d2 = diff * diff, r2 = ref * ref; if (!(d2 >= 0.f) || !(d2 < 1e30f)) d2 = 1e30f;
    atomicAdd(chk_words(C) + 2 * id, d2); atomicAdd(chk_words(C) + 2 * id + 1, r2);
}
DI unsigned hsh(unsigned x) { x ^= x >> 16; x *= 0x7feb352du; x ^= x >> 15; x *= 0x846ca68bu; x ^= x >> 16; return x; }
DI int smp_row(int s) { return s == 0 ? 0 : s == 1 ? 63 : s == 2 ? 16383 : s == 3 ? 16384 : s == 4 ? 16399 : s == 5 ? 8191 : (int)(hsh(1000 + s) % LTOK); }
DI float wdot_bf_f32col(const bf16* a, const float* w, int ldw, int K, int lane) { float s = 0.f; for (int k = lane; k < K; k += 64) s += bf2f(a[k]) * w[(size_t)k * ldw]; return wave_sum(s, lane); }

DI void dbg_check_gemm_plain(const Ctx& C, int id, const bf16* A, int lda, const float* W, int ldw, int K, const bf16* O, int ldo) {
    for (int s = C.gw; s < 48; s += C.ngw) { const int row = smp_row(s % 12), col = (int)(hsh(77 + s) % (unsigned)ldo);
        const float ref = wdot_bf_f32col(A + (size_t)row * lda, W + col, ldw, K, C.lane);
        if (C.lane == 0) chk_add(C, id, bf2f(O[(size_t)row * ldo + col]) - ref, ref); }
}
DI void dbg_check_e1(const Ctx& C, int li, const bf16* h, const bf16* YAB, const bf16* Kb, const bf16* Vb, const bf16* GA, const bf16* U) {
    const float* W = C.in[I_WINE] + (size_t)li * 1024 * 4608;
    for (int s = C.gw; s < 96; s += C.ngw) { const int row = smp_row(s % 12); const int seg = (s / 12) % 6;
        const int lo_ = seg == 0 ? 0 : seg == 1 ? 1024 : seg == 2 ? 1280 : seg == 3 ? 1536 : seg == 4 ? 2560 : 3584, wd_ = (seg == 1 || seg == 2) ? 256 : 1024;
        const int col = lo_ + (int)(hsh(5 + s) % (unsigned)wd_), c = col - lo_;
        float ref = wdot_bf_f32col(h + (size_t)row * 1024, W + col, 4608, 1024, C.lane);
        float got;
        if (seg == 0) got = bf2f(YAB[(size_t)row * 2048 + c]); else if (seg == 1) got = bf2f(Kb[(size_t)row * 256 + c]); else if (seg == 2) got = bf2f(Vb[(size_t)row * 256 + c]);
        else if (seg == 3) { got = bf2f(GA[(size_t)row * 1024 + c]); ref = ref / (1.f + expf(-ref)); } else if (seg == 4) got = bf2f(U[(size_t)row * 1024 + c]);
        else { got = bf2f(YAB[(size_t)row * 2048 + 1024 + c]); ref = ref / (1.f + expf(-ref)); }
        if (C.lane == 0) chk_add(C, 2, got - ref, ref); }
}
DI void naive_qk_head(const Ctx& C, int li, const bf16* h, int row, int hs, float& o0, float& o1) {
    const float* W = C.in[I_WINE] + (size_t)li * 1024 * 4608; const int cb = hs < 8 ? hs * 128 : 1024 + (hs - 8) * 128;
    float r0 = 0.f, r1 = 0.f;
    for (int k = 0; k < 1024; ++k) { const float hv = bf2f(h[(size_t)row * 1024 + k]); r0 += hv * W[(size_t)k * 4608 + cb + C.lane]; r1 += hv * W[(size_t)k * 4608 + cb + 64 + C.lane]; }
    r0 = bf2f(f2bf(r0)); r1 = bf2f(f2bf(r1));
    const float ss = wave_sum(r0 * r0 + r1 * r1, C.lane); const float rs = 1.f / sqrtf(ss / 128.f + EPS);
    const float* g = (hs < 8 ? C.in[I_QN] : C.in[I_KN]) + li * 128;
    const float n0 = r0 * rs * g[C.lane], n1 = r1 * rs * g[64 + C.lane];
    const int j = C.lane & 31; const float fr = exp2f(-(float)j * (13.287712379549449f / 32.f));
    float pr = 0.f, pc = 0.f; if (row < SEQ) { pr = (float)(row / 64); pc = (float)(row % 64); }
    const float p0 = shx(n0, 32, C.lane), p1 = shx(n1, 32, C.lane);
    float cr, sr, cc, sc; cis_rev(pr * fr, cr, sr); cis_rev(pc * fr, cc, sc);
    o0 = C.lane < 32 ? n0 * cr - p0 * sr : n0 * cr + p0 * sr;
    o1 = C.lane < 32 ? n1 * cc - p1 * sc : n1 * cc + p1 * sc;
}
DI void dbg_check_e2(const Ctx& C, int li, const bf16* h, const bf16* YAB, const bf16* Kb) {
    for (int s = C.gw; s < 40; s += C.ngw) { const int row = smp_row(s % 10), hs = (s * 7) % 10; float o0, o1; naive_qk_head(C, li, h, row, hs, o0, o1);
        const bf16* p = hs < 8 ? YAB + (size_t)row * 2048 + hs * 128 : Kb + (size_t)row * 256 + (hs - 8) * 128;
        const float d0 = bf2f(p[C.lane]) - o0, d1 = bf2f(p[64 + C.lane]) - o1;
        const float dd = wave_sum(d0 * d0 + d1 * d1, C.lane), rr = wave_sum(o0 * o0 + o1 * o1, C.lane);
        if (C.lane == 0) chk_add(C, 3, sqrtf(dd), sqrtf(rr)); }
}
DI void dbg_check_s5(const Ctx& C, int li, const bf16* U, const bf16* YG) {
    float* st = (float*)(C.misc() + MS_STASH);
    const bf16* YAB = C.slot(2);
    for (int s = C.gw; s < 8; s += C.ngw) { const int row = smp_row(s), hd = (s * 3) % 8; st[ST_QATT + s * 128 + C.lane] = bf2f(YAB[(size_t)row * 2048 + hd * 128 + C.lane]); st[ST_QATT + s * 128 + 64 + C.lane] = bf2f(YAB[(size_t)row * 2048 + hd * 128 + 64 + C.lane]); }
    if (C.gw == 8 && C.lane < 16) { const int row = smp_row(C.lane % 12), col = (int)(hsh(300 + C.lane) % 1024u); st[ST_GB + C.lane] = bf2f(YAB[(size_t)row * 2048 + 1024 + col]); }
    for (int s = C.gws; s < 6; s += C.ngw) {
        const int row = smp_row(s), g = (int)(hsh(40 + s) % 64u), l = seq_of_row(row), n = C.lane;
        float y[16];
#pragma unroll
        for (int p = 0; p < 16; ++p) y[p] = 0.f;
        for (int d = 0; d < 2; ++d) {
            const size_t pidx = (((size_t)li * 2 + d) * 64 + g) * 64 + n;
            const float ar = C.in[I_ARE][pidx], ai = C.in[I_AIM][pidx], dt = expf(C.in[I_LDT][((size_t)li * 2 + d) * 64 + g]);
            float c1_, s1_; cis_rev(ai * dt, c1_, s1_); const float mg = expf(ar * dt), abr = mg * c1_, abi = mg * s1_;
            const float xr0 = abr - 1.f, xi0 = abi, inv = 1.f / (ar * ar + ai * ai), kr = (xr0 * ar + xi0 * ai) * inv, ki = (xi0 * ar - xr0 * ai) * inv;
            float bbr[16], bbi[16];
#pragma unroll
            for (int p = 0; p < 16; ++p) { const float br = C.in[I_BRE][pidx * 16 + p], bi = C.in[I_BIM][pidx * 16 + p]; bbr[p] = kr * br - ki * bi; bbi[p] = kr * bi + ki * br; }
            float xr = 0.f, xi = 0.f;
            const int s0 = d == 0 ? 0 : LTOK - 1, s1 = l, step = d == 0 ? 1 : -1;
            for (int sq = s0;; sq += step) { const bf16* up = U + (size_t)row_of_seq(sq) * 1024 + g * 16; float ur = 0.f, ui = 0.f;
#pragma unroll
                for (int p = 0; p < 16; ++p) { const float u = bf2f(up[p]); ur += bbr[p] * u; ui += bbi[p] * u; }
                const float nr = abr * xr - abi * xi + ur, ni = abr * xi + abi * xr + ui; xr = nr; xi = ni;
                if (sq == s1) break; }
#pragma unroll
            for (int p = 0; p < 16; ++p) { const size_t ci = ((((size_t)li * 2 + d) * 64 + g) * 16 + p) * 64 + n; y[p] += wave_sum(C.in[I_CRE][ci] * xr - C.in[I_CIM][ci] * xi, C.lane); }
        }
        float dd = 0.f, rr = 0.f;
#pragma unroll
        for (int p = 0; p < 16; ++p) { float v = y[p] + bf2f(U[(size_t)row * 1024 + g * 16 + p]) * C.in[I_SSMD][(size_t)li * 1024 + g * 16 + p];
            { const float z_ = 0.7978845608028654f * (v + 0.044715f * v * v * v); const float e2_ = expf(-2.f * fabsf(z_)); float th_ = (1.f - e2_) / (1.f + e2_); th_ = z_ < 0.f ? -th_ : th_; v = 0.5f * v * (1.f + th_); }
            const float df = bf2f(YG[(size_t)row * 1024 + g * 16 + p]) - v; dd += df * df; rr += v * v; }
        if (C.lane == 0) chk_add(C, 4, sqrtf(dd), sqrtf(rr));
    }
}
DI void dbg_check_e5(const Ctx& C, int li, const bf16* h, const bf16* YAB, const bf16* Kb, const bf16* Vb, const bf16* GA, const bf16* YG) {
    const float* st = (const float*)(C.misc() + MS_STASH);
    LAS float* sc = (LAS float*)C.lds; LAS float* red = sc + 16448;
    for (int s = C.bid; s < 8; s += C.G) { const int row = smp_row(s), hd = (s * 3) % 8, g = hd >> 2;
        const float* q = st + ST_QATT + s * 128;
        float mx = -1e30f;
        for (int key = C.tid; key < LTOK; key += NTHR) { float d = 0.f; for (int e = 0; e < 128; ++e) d += q[e] * bf2f(Kb[(size_t)key * 256 + g * 128 + e]); d *= 0.08838834764831845f; sc[key] = d; mx = fmaxf(mx, d); }
#pragma unroll
        for (int o = 1; o < 64; o <<= 1) mx = fmaxf(mx, shx(mx, o, C.lane));
        if (C.lane == 0) red[C.wave] = mx; __syncthreads();
        mx = red[0]; for (int w = 1; w < 8; ++w) mx = fmaxf(mx, red[w]); __syncthreads();
        float sm = 0.f; for (int key = C.tid; key < LTOK; key += NTHR) { const float p = expf(sc[key] - mx); sc[key] = p; sm += p; }
        sm = wave_sum(sm, C.lane); if (C.lane == 0) red[C.wave] = sm; __syncthreads();
        sm = 0.f; for (int w = 0; w < 8; ++w) sm += red[w];
        if (C.tid < 128) { float o = 0.f; for (int key = 0; key < LTOK; ++key) o += sc[key] * bf2f(Vb[(size_t)key * 256 + g * 128 + C.tid]);
            o = o / sm * bf2f(GA[(size_t)row * 1024 + hd * 128 + C.tid]); const float got = bf2f(YAB[(size_t)row * 2048 + hd * 128 + C.tid]);
            const float dd = wave_sum((got - o) * (got - o), C.lane), rr = wave_sum(o * o, C.lane); if (C.lane == 0) chk_add(C, 5, sqrtf(dd), sqrtf(rr)); }
        __syncthreads(); }
    const float* Wg = C.in[I_WGLU] + (size_t)li * 1024 * 1024;
    for (int s = C.gws; s < 16; s += C.ngw) { const int row = smp_row(s % 12), col = (int)(hsh(300 + s) % 1024u);
        const float pre = wdot_bf_f32col(YG + (size_t)row * 1024, Wg + col, 1024, 1024, C.lane) + C.in[I_BGLU][li * 1024 + col];
        const float ref = bf2f(YG[(size_t)row * 1024 + col]) / (1.f + expf(-pre)) * st[ST_GB + s];
        if (C.lane == 0) chk_add(C, 6, bf2f(YAB[(size_t)row * 2048 + 1024 + col]) - ref, ref); }
}
DI void dbg_check_conv(const Ctx& C, int li, const bf16* XM, const bf16* XC) {
    float* st = (float*)(C.misc() + MS_STASH);
    for (int s = C.gw; s < 8; s += C.ngw) { const int row = smp_row(s), hd = (s * 5) % 8;
        for (int e = C.lane; e < 256; e += 64) st[ST_XM + s * 256 + e] = bf2f(XM[(size_t)row * 2048 + hd * 256 + e]); }
    const float* cw = C.in[I_CONVW] + (size_t)li * 5 * 2048; const float* cb = C.in[I_CONVB] + (size_t)li * 2048;
    for (int s = C.gw * 64 + C.lane; s < 768; s += C.ngw * 64) { const int row = smp_row(s % 12), c = (int)(hsh(900 + s) % 2048u);
        const int l = row < SEQ ? row + 16 : row - SEQ; float a = cb[c];
        for (int j = 0; j < 5; ++j) { const int l2 = l + j - 2; if (l2 < 0 || l2 >= LTOK) continue; const int r2 = l2 < 16 ? SEQ + l2 : l2 - 16; a += cw[j * 2048 + c] * bf2f(XM[(size_t)r2 * 2048 + c]); }
        const float ref = a / (1.f + expf(-a)); chk_add(C, 10, bf2f(XC[(size_t)row * 2048 + c]) - ref, ref); }
}
DI void dbg_check_o3(const Ctx& C, int li, const bf16* XC, const bf16* Qm, const bf16* Km, const bf16* V, const bf16* VM) {
    const float* st = (const float*)(C.misc() + MS_STASH);
    for (int s = C.gw; s < 48; s += C.ngw) { const int row = smp_row(s % 12), hd = (int)(hsh(11 + s) % 8u), dm = (int)(hsh(12 + s) % 128u); const bool isk = s & 1;
        const float* W = (isk ? C.in[I_WK] : C.in[I_WQ]) + ((size_t)li * 8 + hd) * 256 * 128;
        const float ref = wdot_bf_f32col(XC + (size_t)row * 2048 + hd * 256, W + dm, 128, 256, C.lane);
        if (C.lane == 0) chk_add(C, 11, bf2f((isk ? Km : Qm)[(size_t)row * 1024 + hd * 128 + dm]) - ref, ref); }
    for (int s = C.gw; s < 8; s += C.ngw) { const int row = smp_row(s), hd = (s * 5) % 8;
        for (int t = 0; t < 4; ++t) { const int n = (int)(hsh(50 + s * 4 + t) % 256u); const float* W = C.in[I_WV] + ((size_t)li * 8 + hd) * 256 * 256 + n;
            float a = 0.f; for (int k = C.lane; k < 256; k += 64) a += st[ST_XM + s * 256 + k] * W[(size_t)k * 256]; a = wave_sum(a, C.lane);
            const float got = bf2f(row < SEQ ? V[(size_t)row * 2048 + hd * 256 + n] : VM[(size_t)(row - SEQ) * 2048 + hd * 256 + n]);
            if (C.lane == 0) chk_add(C, 12, got - a, a); } }
    const float* GI = (const float*)(C.misc() + MS_GI); const float* GF = (const float*)(C.misc() + MS_GF);
    for (int s = C.gw; s < 48; s += C.ngw) { const int row = smp_row(s % 12), dh = (int)(hsh(70 + s) % 16u), d = dh >> 3, hd = dh & 7; const bool isf = s & 1;
        const float* W = (isf ? C.in[I_WFG] : C.in[I_WIG]) + ((size_t)li * 2 + d) * 2048 * 8 + hd;
        float a = wdot_bf_f32col(XC + (size_t)row * 2048, W, 8, 2048, C.lane) + (isf ? C.in[I_BFG] : C.in[I_BIG])[li * 16 + dh];
        if (isf) a = fminf(a, 0.f) - log1pf(expf(-fabsf(a)));
        const int pos = row < SEQ ? row + 64 : row - SEQ + 48;
        if (C.lane == 0) chk_add(C, 13, (isf ? GF : GI)[(size_t)dh * NPOS + pos] - a, a); }
    if (C.gw == 0 && C.lane < 16) { chk_add(C, 13, GI[(size_t)C.lane * NPOS + 5] + 1e9f, 1e9f); chk_add(C, 13, GF[(size_t)C.lane * NPOS + 47], 0.f); }
}
DI void dbg_check_mlstm(const Ctx& C, int li, const bf16* Qm, const bf16* Km, const bf16* V, const bf16* VM, const bf16* CELL, const bf16* CELLM) {
    const float* GI = (const float*)(C.misc() + MS_GI); const float* GF = (const float*)(C.misc() + MS_GF);
    for (int s = C.gws; s < 12; s += C.ngw) { const int row = smp_row(s), hd = (int)(hsh(21 + s) % 8u), vc = (int)(hsh(22 + s) % 256u); const int pos = row < SEQ ? row + 64 : row - SEQ + 48;
        float tot = 0.f;
        for (int d = 0; d < 2; ++d) { const float* gi = GI + (size_t)(d * 8 + hd) * NPOS; const float* gf = GF + (size_t)(d * 8 + hd) * NPOS;
            float num = 0.f, den = 0.f, carry = 0.f;
            for (int b0 = 0; b0 < NPOS; b0 += 64) { const int sp = d == 0 ? pos - b0 - C.lane : pos + b0 + C.lane; const bool ok = sp >= 48 && sp < NPOS;
                const float lf = ok ? gf[sp] : 0.f; const float lfe = (b0 == 0 && C.lane == 0) ? 0.f : lf;
                float pre = d == 0 ? lf : lf;
#pragma unroll
                for (int o = 1; o < 64; o <<= 1) { const float x = shf(pre, C.lane - o); pre += C.lane >= o ? x : 0.f; }
                const float cum = carry + pre - lf; (void)lfe;
                if (ok && cum > -80.f) { const int r = sp >= 64 ? sp - 64 : SEQ + sp - 48; const int rt = row; float dot = 0.f;
                    for (int e = 0; e < 128; ++e) dot += bf2f(Qm[(size_t)rt * 1024 + hd * 128 + e]) * bf2f(Km[(size_t)r * 1024 + hd * 128 + e]);
                    const float w = expf(cum + gi[sp]) * dot * 0.08838834764831845f;
                    const float vv = bf2f(r < SEQ ? V[(size_t)r * 2048 + hd * 256 + vc] : VM[(size_t)(r - SEQ) * 2048 + hd * 256 + vc]);
                    num += w * vv; den += w; }
                carry += shf(pre, 63);
                if (carry < -80.f) break; }
            num = wave_sum(num, C.lane); den = wave_sum(den, C.lane); tot += num / fmaxf(fabsf(den), 1.f); }
        const float got = bf2f(row < SEQ ? CELL[(size_t)row * 2048 + hd * 256 + vc] : CELLM[(size_t)(row - SEQ) * 2048 + hd * 256 + vc]);
        if (C.lane == 0) chk_add(C, 14, got - tot, tot); }
}
DI void dbg_check_ogate(const Ctx& C, int li, const bf16* XC, const bf16* SZ, const bf16* CELL, const bf16* CELLM, const bf16* HZ) {
    for (int s = C.gw; s < 48; s += C.ngw) { const int row = smp_row(s % 12), col = (int)(hsh(90 + s) % 2048u), hd = col >> 8;
        const float pre = wdot_bf_f32col(XC + (size_t)row * 2048, C.in[I_WOG] + (size_t)li * 2048 * 2048 + col, 2048, 2048, C.lane) + C.in[I_BOG][(size_t)li * 2048 + col];
        const bf16* cp = row < SEQ ? CELL + (size_t)row * 2048 : CELLM + (size_t)(row - SEQ) * 2048;
        float ss = 0.f; for (int e = C.lane; e < 256; e += 64) { const float v = bf2f(cp[hd * 256 + e]); ss += v * v; } ss = wave_sum(ss, C.lane);
        const float cn = bf2f(cp[col]) / sqrtf(ss / 256.f + EPS) * C.in[I_HN][(size_t)li * 2048 + col];
        const float hh = cn / (1.f + expf(-pre)) + C.in[I_SKIP][(size_t)li * 2048 + col] * bf2f(XC[(size_t)row * 2048 + col]);
        const float ref = hh * bf2f(SZ[(size_t)row * 2048 + col]);
        if (C.lane == 0) chk_add(C, 15, bf2f(HZ[(size_t)row * 2048 + col]) - ref, ref); }
}
DI void dbg_report(const Ctx& C, unsigned* ctl) {
    const float* w = (const float*)(ctl + CW_CHK); int code = 0;
    for (int id = 1; id < NCHK; ++id) { const float d2 = w[2 * id], r2 = w[2 * id + 1]; const bool used = (d2 != 0.f || r2 != 0.f);
        if (used && code == 0) { const float rel = sqrtf(d2 / fmaxf(r2, 1e-20f)); if (!(rel < 0.05f)) code = 3 + id + (rel > 0.5f || !(rel < 1e30f) ? 32 : 0); } }
    if (ctl[CW_BAR + XB_TMO] != 0u) code = 3 + 20;
    if (code) { const float v = exp2f((float)code); for (size_t i = (size_t)C.gw * 64 + C.lane; i < (size_t)SEQ * 1024; i += (size_t)C.ngw * 64) C.out[i] = v; }
}
#endif

#ifndef DBG_CHECK
#define DBG_CHECK 0
#endif
constexpr int N_PHASES = 33;
#ifndef ONLY_J
#define ONLY_J -1
#endif
#define INJ(j) (ONLY_J < 0 || ONLY_J == (j))

__global__ void __launch_bounds__(NTHR, 2) hybrid_fwd(Params prm) {
    extern __shared__ __attribute__((aligned(16))) unsigned char lds_raw[];
    Ctx C;
    C.lds = (LAS unsigned char*)lds_raw;
    C.tid = threadIdx.x; C.lane = C.tid & 63; C.wave = __builtin_amdgcn_readfirstlane(C.tid >> 6);
    C.G = gridDim.x; C.bid = blockIdx.x; C.gw = C.bid * NWAVES + C.wave; C.ngw = C.G * NWAVES; C.gws = C.wave * C.G + C.bid;
    C.in = prm.in; C.out = (float*)(GAS float*)prm.out; C.ws = (unsigned char*)(GAS unsigned char*)prm.ws; C.dob = (unsigned char*)(GAS unsigned char*)prm.out;
    volatile LAS unsigned* MISC = (volatile LAS unsigned*)(C.lds + LDS_MISC);
    if (C.tid < 16) MISC[C.tid] = 0u;
    __syncthreads();
    unsigned* ctl = (unsigned*)(C.misc() + MS_CTL);
    XcdBarrier bar; bar.bar = ctl + CW_BAR; bar.x = 0; bar.st = nullptr;
    if (prm.use_bar) bar = xcd_barrier_post(ctl + CW_BAR, MISC);
    const int lo = prm.ph_lo, hi = prm.ph_hi;
#ifdef DIAG2
    unsigned long long* dts = (unsigned long long*)(C.misc() + MS_END + 65536);
    if (C.bid == 0 && C.tid == 0) dts[98] = wall_clock64();
#endif
#define IN(k) (lo <= (k) && (k) < hi)
#define xcd_barrier_if(ub, b) do { if (ub) xcd_barrier(b); } while (0)
#ifdef DIAG2
#define SEAM(k) do { if (IN(k) && IN((k) + 1)) { if (C.bid == 0 && C.tid == 0) dts[2 * (k)] = wall_clock64(); xcd_barrier(bar); if (C.bid == 0 && C.tid == 0) dts[2 * (k) + 1] = wall_clock64(); } } while (0)
#elif defined(PH_T)
    unsigned long long ph_prev = wall_clock64(), ph_dt = 0;
#define SEAM(k) do { if (IN(k) && IN((k) + 1)) { xcd_barrier(bar); { const unsigned long long tn_ = wall_clock64(); if ((k) == (PH_T)) ph_dt = tn_ - ph_prev; ph_prev = tn_; } } } while (0)
#else
#define SEAM(k) do { if (IN(k) && IN((k) + 1)) xcd_barrier(bar); } while (0)
#endif
#if DBG_CHECK
#define CHECK(k, call) do { if (IN(k)) { call; xcd_barrier(bar); } } while (0)
#else
#define CHECK(k, call) do { } while (0)
#endif
#define resid (C.slot(0))
#define wr (C.wreg())

    if (INJ(16) && IN(0)) { const Ctx C0 = C; const Ctx C = C0.fresh();
        phase_init_rows(C, resid, C.slot(1));
        phase_rope_table(C);
        convert_even_weights(C, 0);
        phase_s5_tables(C, 0);
#ifdef DBL_P0
        phase_init_rows(C, resid, C.slot(1)); phase_rope_table(C); convert_even_weights(C, 0); phase_s5_tables(C, 0);
#endif
    }
    SEAM(0);
    for (int li = 0; li < 2; ++li) {
        const int pb = 1 + li * 16;
#define h_e (C.slot(1))
#define YAB (C.slot(2))
#define GA (C.slot(4))
#define U (C.slot(5))
#define Kb (C.slot(6))
#define Vb (C.slot(6) + (size_t)KVROWS * 256)
#define YG (C.slot(1))
#define y_e (C.slot(4))
        if (INJ(0) && IN(pb + 0)) { const Ctx C0 = C; const Ctx C = C0.fresh();
            for (int i = C.gw * 64 + C.lane; i < 2 * 48 * 256 / 8; i += C.ngw * 64) {
                const int which = i / (48 * 32), r = (i / 32) % 48, c8 = (i % 32) * 8;
                unsigned z_ = 0u; asm volatile("" : "+v"(z_));
                *(u32x4*)((which ? Vb : Kb) + (size_t)(LTOK + r) * 256 + c8) = (u32x4){z_, z_, z_, z_};
                if (i < 48 * 16) *(u32x4*)(C.misc() + MS_K8 + (size_t)LTOK * 256 + (size_t)i * 16) = (u32x4){z_, z_, z_, z_}; }
            FEvenIn f{YAB, Kb, Vb, GA, U};
            run_gemm<1024, 1024, 1024, 4608, 0>(C, h_e, (const bf16*)(wr + WE_IN), f);
            phase_s5_ktab_hcat(C, li);
#ifdef DBL_KTAB
            phase_s5_ktab_hcat(C, li);
#endif
        }
        SEAM(pb + 0);
        CHECK(pb + 0, dbg_check_e1(C, li, h_e, YAB, Kb, Vb, GA, U));
        if (INJ(1) && IN(pb + 1)) { const Ctx C0 = C; const Ctx C = C0.fresh();
            phase_s5_local(C, U);
#ifdef DBL_LOCAL
            phase_s5_local(C, U);
#endif
        }
        SEAM(pb + 1);
        CHECK(pb + 1, dbg_check_e2(C, li, h_e, YAB, Kb));
        if (INJ(2) && IN(pb + 2)) { const Ctx C0 = C; const Ctx C = C0.fresh();
#ifdef SCAN_T
            if (C.gws < 128) { const unsigned long long t0_ = wall_clock64(); phase_s5_scan(C); asm volatile("s_waitcnt vmcnt(0)" ::: "memory"); const unsigned long long t1_ = wall_clock64();
                if (C.lane == 0 && (t1_ - t0_) > (unsigned long long)(SCAN_T) * 100ull) ctl[CW_CHK] = 1u; }
#elif defined(NS_T)
            if (C.gws < 128) phase_s5_scan(C);
            else { const unsigned long long t0_ = wall_clock64(); Ctx C2 = C; C2.gw = C.gws - 128; C2.ngw = C.ngw - 128; phase_s5_mg(C2, li); phase_qk_norm_rope(C2, YAB, Kb, C.in[I_QN] + li * 128, C.in[I_KN] + li * 128, (unsigned char*)(C.misc() + MS_K8)); phase_v8_image(C2, Vb, (unsigned char*)(wr + WO_OG));
                asm volatile("s_waitcnt vmcnt(0)" ::: "memory"); const unsigned long long t1_ = wall_clock64();
                if (C.lane == 0 && (t1_ - t0_) > (unsigned long long)(NS_T) * 100ull) ctl[CW_CHK] = 1u; }
            if (false) { }
#else
            if (C.gws < 128) phase_s5_scan(C);
#endif
            else { Ctx C2 = C; C2.gw = C.gws - 128; C2.ngw = C.ngw - 128;
#ifdef DBL_E3NS
                phase_s5_mg(C2, li); phase_qk_norm_rope(C2, YAB, Kb, C.in[I_QN] + li * 128, C.in[I_KN] + li * 128, (unsigned char*)(C.misc() + MS_K8), C.slot(1)); phase_v8_image(C2, Vb, (unsigned char*)(wr + WO_OG));
#endif
                phase_s5_mg(C2, li); phase_qk_norm_rope(C2, YAB, Kb, C.in[I_QN] + li * 128, C.in[I_KN] + li * 128, (unsigned char*)(C.misc() + MS_K8)); phase_v8_image(C2, Vb, (unsigned char*)(wr + WO_OG)); }
        }
        SEAM(pb + 2);
        if (INJ(3) && IN(pb + 3)) { const Ctx C0 = C; const Ctx C = C0.fresh();
            phase_s5_out(C, U, YG);
#ifdef DBL_S5OUT
            phase_s5_out(C, U, YG);
#endif
        }
        SEAM(pb + 3);
        CHECK(pb + 3, dbg_check_s5(C, li, U, YG));
        if (INJ(4) && IN(pb + 4)) { const Ctx C0 = C; const Ctx C = C0.fresh();
#ifndef NO_ATT
            phase_attention(C, YAB, Kb, Vb, GA, (const unsigned char*)(C.misc() + MS_K8), (const unsigned char*)(wr + WO_OG));
#endif
#ifndef NO_GLU
            { const Ctx C1 = C0.fresh(); const Ctx& C = C1;
              FGlu f{YG, YAB, C.in[I_BGLU] + li * 1024};
              run_gemm<1024, 1024, 1024, 1024, 0>(C, YG, (const bf16*)(wr + WE_GLU), f); }
#endif
        }
        if (IN(pb + 4)) { xcd_barrier_if(prm.use_bar, bar); { const Ctx C0 = C; const Ctx C = C0.fresh(); phase_attention_combine(C, YAB, GA);
#ifdef DBL_META
            phase_attention_combine(C, YAB, GA);
#endif
        } }
        SEAM(pb + 4);
        CHECK(pb + 4, dbg_check_e5(C, li, h_e, YAB, Kb, Vb, GA, YG));
        if (INJ(5) && IN(pb + 5)) { const Ctx C0 = C; const Ctx C = C0.fresh();
            FPlain f{y_e, 1024};
            run_gemm<2048, 2048, 2048, 1024, 0>(C, YAB, (const bf16*)(wr + WE_OUT), f);
        }
        SEAM(pb + 5);
        CHECK(pb + 5, dbg_check_gemm_plain(C, 7, YAB, 2048, C.in[I_WOUTE] + (size_t)li * 2048 * 1024, 1024, 2048, y_e, 1024));
        if (INJ(6) && IN(pb + 6)) { const Ctx C0 = C; const Ctx C = C0.fresh();
#ifdef DBL_POST
            phase_post_rows(C, y_e, resid, C.slot(2), 2 * li, C.slot(1));
#endif
            phase_post_rows(C, y_e, resid, C.slot(5), 2 * li);
            convert_odd_early(C, li); convert_odd_late(C, li);
        }
        SEAM(pb + 6);
#define h_o (C.slot(5))
#define XM (C.slot(3))
#define XC (C.slot(1))
#define Qm (C.slot(5))
#define Km (C.slot(6))
#define CELL ((bf16*)C.dob)
#define CELLM ((bf16*)(C.misc() + MS_CELLM))
#define VM ((bf16*)(C.misc() + MS_VM))
#define h_r (C.slot(5))
#define SZ (C.slot(3))
#define HZ (C.slot(3))
#define y_o (C.slot(5))
        if (INJ(7) && IN(pb + 7)) { const Ctx C0 = C; const Ctx C = C0.fresh();
            FPlain f{XM, 2048};
            run_gemm<1024, 1024, 1024, 2048, 0>(C, h_o, (const bf16*)(wr + WO_IN), f);
        }
        SEAM(pb + 7);
        CHECK(pb + 7, dbg_check_gemm_plain(C, 9, h_o, 1024, C.in[I_WINO] + (size_t)li * 1024 * 4096, 4096, 1024, XM, 2048));
        if (INJ(8) && IN(pb + 8)) { const Ctx C0 = C; const Ctx C = C0.fresh();
            phase_conv(C, XM, XC, C.in[I_CONVW] + (size_t)li * 5 * 2048, C.in[I_CONVB] + (size_t)li * 2048);
#ifdef DBL_CONV
            phase_conv(C, XM, XC, C.in[I_CONVW] + (size_t)li * 5 * 2048, C.in[I_CONVB] + (size_t)li * 2048);
#endif
            if (C.gw == 0) { for (int i = C.lane; i < 1024; i += 64) ((unsigned*)(C.misc() + MS_ZROW))[i] = 0u; }
        }
        SEAM(pb + 8);
        CHECK(pb + 8, dbg_check_conv(C, li, XM, XC));
        if (INJ(9) && IN(pb + 9)) { const Ctx C0 = C; const Ctx C = C0.fresh();
#ifndef NO_QK
            { FQK f{Qm, Km}; run_gemm<2048, 256, 256, 2048, 256>(C, XC, (const bf16*)(wr + WO_QK), f); }
#endif
#ifndef NO_V
            { FVrow f{XM, VM}; run_gemm<2048, 256, 256, 2048, 256>(C, XM, (const bf16*)(wr + WO_V), f); }
#endif
#ifndef NO_GATES
            phase_gates(C, XC, (const bf16*)(wr + WO_G), C.in[I_BIG] + li * 16, C.in[I_BFG] + li * 16);
#ifdef DBL_GATES
            phase_gates(C, XC, (const bf16*)(wr + WO_G), C.in[I_BIG] + li * 16, C.in[I_BFG] + li * 16);
#endif
#endif
        }
        SEAM(pb + 9);
        CHECK(pb + 9, dbg_check_o3(C, li, XC, Qm, Km, XM, VM));
        if (INJ(10) && IN(pb + 10)) { const Ctx C0 = C; const Ctx C = C0.fresh();
#ifdef DBL_MLSTM
            phase_mlstm(C, 2 * li, Qm, Km, XM, VM, CELL, CELLM, CELL, CELLM); xcd_barrier_if(prm.use_bar, bar);
            phase_mlstm(C, 2 * li + 1, Qm, Km, XM, VM, CELL, CELLM, XM, VM);
#else
            phase_mlstm(C, li, Qm, Km, XM, VM, CELL, CELLM, XM, VM);
#endif
        }
        SEAM(pb + 10);
        CHECK(pb + 10, dbg_check_mlstm(C, li, Qm, Km, XM, VM, CELL, CELLM));
        if (INJ(11) && IN(pb + 11)) { const Ctx C0 = C; const Ctx C = C0.fresh();
            phase_renorm_rows(C, resid, h_r, 2 * li + 1);
#ifdef DBL_RENORM
            phase_renorm_rows(C, resid, h_r, 2 * li + 1);
#endif
#ifdef DBL_MERGE
            phase_cell_merge(C, CELL, CELLM, XM, VM, C.slot(6));
#endif
            phase_cell_merge(C, CELL, CELLM, XM, VM);
        }
        SEAM(pb + 11);
        if (INJ(12) && IN(pb + 12)) { const Ctx C0 = C; const Ctx C = C0.fresh();
            FSilu f{SZ, 2048};
            run_gemm<1024, 1024, 1024, 2048, 0>(C, h_r, (const bf16*)(wr + WO_Z), f);
        }
        if (INJ(13) && IN(pb + 13)) { const Ctx C0 = C; const Ctx C = C0.fresh();
            FOgate f{CELL, CELLM, XC, SZ, HZ, C.in[I_BOG] + (size_t)li * 2048, C.in[I_HN] + (size_t)li * 2048, C.in[I_SKIP] + (size_t)li * 2048, (const float*)(C.misc() + MS_RSTD)};
            run_gemm<2048, 2048, 2048, 2048, 0>(C, XC, (const bf16*)(wr + WO_OG), f);
        }
        SEAM(pb + 13);
        CHECK(pb + 13, dbg_check_ogate(C, li, XC, SZ, CELL, CELLM, HZ));
        if (INJ(14) && IN(pb + 14)) { const Ctx C0 = C; const Ctx C = C0.fresh();
            FPlain f{y_o, 1024};
            run_gemm<2048, 2048, 2048, 1024, 0>(C, HZ, (const bf16*)(wr + WO_OUT), f);
        }
        SEAM(pb + 14);
        CHECK(pb + 14, dbg_check_gemm_plain(C, 1, HZ, 2048, C.in[I_WOUTO] + (size_t)li * 2048 * 1024, 1024, 2048, y_o, 1024));
        if (INJ(15) && IN(pb + 15)) { const Ctx C0 = C; const Ctx C = C0.fresh();
#ifdef DBL_POST
            if (li == 0) phase_post_rows(C, y_o, resid, C.slot(2), 2 * li + 1, C.slot(6));
#endif
            phase_post_rows(C, y_o, resid, C.slot(1), 2 * li + 1);
#if defined(SCAN_T) || defined(NS_T)
            if (li == 1 && C.bid == 0 && C.tid == 0 && ctl[CW_CHK] != 0u) C.out[0] = __builtin_nanf("");
#endif
#ifdef PH_T
            if (li == 1 && C.bid == 0 && C.tid == 0) { if ((PH_T) == 32) ph_dt = wall_clock64() - ph_prev;
                int n_ = (int)((float)ph_dt * 0.01f / (float)(PH_STEP)); n_ = n_ < 0 ? 0 : (n_ > 15 ? 15 : n_);
#ifdef PH_CAL
                n_ = PH_CAL;
#endif
                C.out[0] = C.out[0] + sqrtf((float)n_) * 700.f; }
#endif
            if (li == 0) { convert_even_weights(C, 1); phase_s5_tables(C, 1); }
        }
        if (li == 0) SEAM(pb + 15);
    }
#if DBG_CHECK
    if (IN(N_PHASES - 1)) { xcd_barrier(bar); dbg_report(C, ctl); }
#endif
#ifdef DIAG2
    if (IN(N_PHASES - 1)) {
        if (C.bid == 0 && C.tid == 0) { const unsigned long long tend = wall_clock64(); float grp[4] = {0.f, 0.f, 0.f, 0.f};
            for (int k = 0; k < N_PHASES; ++k) { const unsigned long long t0 = k == 0 ? dts[98] : dts[2 * (k - 1) + 1]; const unsigned long long t1 = k == N_PHASES - 1 ? tend : dts[2 * k];
                const float us = (float)(t1 - t0) * 0.01f; const int j = k == 0 ? 16 : (k - 1) % 16;
                const int gsel = DIAG2_GROUP(j); if (gsel >= 0) grp[gsel] += us;
                if (k < N_PHASES - 1) grp[3] += (float)(dts[2 * k + 1] - dts[2 * k]) * 0.01f; }
            float* dg = (float*)(ctl + CW_CHK); dg[0] = grp[DIAG_A]; dg[1] = grp[DIAG_B]; }
        xcd_barrier(bar); const float* dg = (const float*)(ctl + CW_CHK); const float va = rintf(4.f * log2f(fmaxf(dg[0], 1.f))), vb = rintf(4.f * log2f(fmaxf(dg[1], 1.f)));
        for (size_t i = (size_t)C.gw * 64 + C.lane; i < (size_t)SEQ * 1024; i += (size_t)C.ngw * 64) C.out[i] = (i < (size_t)SEQ * 768) ? va : vb; }
#endif
#ifdef DIAG
    if (IN(N_PHASES - 1)) { xcd_barrier(bar); const float* dg = (const float*)(ctl + CW_CHK); const float va = rintf(4.f * log2f(fmaxf(dg[DIAG_A], 1.f))), vb = rintf(4.f * log2f(fmaxf(dg[DIAG_B], 1.f)));
        for (size_t i = (size_t)C.gw * 64 + C.lane; i < (size_t)SEQ * 1024; i += (size_t)C.ngw * 64) C.out[i] = (i < (size_t)SEQ * 768) ? va : vb; }
#endif
#undef IN
#undef SEAM
#undef CHECK
#undef h_e
#undef YAB
#undef GA
#undef U
#undef Kb
#undef Vb
#undef YG
#undef y_e
#undef h_o
#undef XM
#undef XC
#undef Qm
#undef Km
#undef CELL
#undef CELLM
#undef VM
#undef h_r
#undef SZ
#undef HZ
#undef y_o
#undef resid
#undef wr
}

#ifndef MULTI_LAUNCH
#define MULTI_LAUNCH 0
#endif
extern "C" void kernel_launch(void* const* d_in, const int* in_sizes, int n_in, void* d_out, int out_size, void* d_ws, size_t ws_size, hipStream_t stream) {
    static int grid = 0;
    if (grid == 0) {
        if (n_in != 33 || in_sizes[0] != SEQ * DM || out_size != SEQ * DM || ws_size < WS_NEED) {
            fprintf(stderr, "kernel_launch: shape mismatch: n_in %d in0 %d out %d ws %zu (need %zu)\n", n_in, n_in > 0 ? in_sizes[0] : -1, out_size, ws_size, (size_t)WS_NEED); grid = -1; return; }
        int dev = 0, cus = 0, per_cu = 0;
        if (hipGetDevice(&dev) != hipSuccess || hipDeviceGetAttribute(&cus, hipDeviceAttributeMultiprocessorCount, dev) != hipSuccess) { fprintf(stderr, "kernel_launch: device query failed\n"); grid = -1; return; }
        if (hipFuncSetAttribute((const void*)hybrid_fwd, hipFuncAttributeMaxDynamicSharedMemorySize, LDS_TOTAL) != hipSuccess) { fprintf(stderr, "kernel_launch: hipFuncSetAttribute failed\n"); grid = -1; return; }
        if (hipOccupancyMaxActiveBlocksPerMultiprocessor(&per_cu, (const void*)hybrid_fwd, NTHR, LDS_TOTAL) != hipSuccess || per_cu < 1) { fprintf(stderr, "kernel_launch: occupancy query says %d blocks per CU\n", per_cu); (void)hipGetLastError(); }
        grid = cus;
    }
    if (grid < 0) return;
    if (hipMemsetAsync((char*)d_ws + WS_MISC + MS_CTL, 0, 65536, stream) != hipSuccess) { fprintf(stderr, "kernel_launch: memset failed\n"); return; }
    Params p{};
    for (int i = 0; i < 33; ++i) p.in[i] = (const float*)d_in[i];
    p.out = (float*)d_out; p.ws = (unsigned char*)d_ws; p.pad = 0;
#if MULTI_LAUNCH
    for (int k = 0; k < N_PHASES; ++k) { p.ph_lo = k; p.ph_hi = k + 1; p.use_bar = 0;
        hipLaunchKernelGGL(hybrid_fwd, dim3(grid), dim3(NTHR), LDS_TOTAL, stream, p); }
#else
    p.ph_lo = 0; p.ph_hi = N_PHASES; p.use_bar = 1;
    hipLaunchKernelGGL(hybrid_fwd, dim3(grid), dim3(NTHR), LDS_TOTAL, stream, p);
#endif
    const hipError_t le = hipPeekAtLastError();
    if (le != hipSuccess) fprintf(stderr, "kernel_launch: launch failed: %s\n", hipGetErrorName(le));
}
```

```cpp
#include <hip/hip_runtime.h>
#include <cstdio>
#include <cstdint>

#define DI __device__ __forceinline__
#define GAS __attribute__((address_space(1)))
#define LAS __attribute__((address_space(3)))
typedef unsigned short bf16;
typedef short bf16x8 __attribute__((ext_vector_type(8)));
typedef float f32x4 __attribute__((ext_vector_type(4)));
typedef float f32x2 __attribute__((ext_vector_type(2)));
typedef float f32x16 __attribute__((ext_vector_type(16)));
typedef unsigned u32x4 __attribute__((ext_vector_type(4)));
typedef unsigned u32x2 __attribute__((ext_vector_type(2)));
typedef short s16x4 __attribute__((ext_vector_type(4)));

constexpr int DM = 1024, SEQ = 16384, NMETA = 16, LTOK = 16400;
constexpr int KVROWS = 16448;
constexpr int NPOS = 16448;
constexpr int NWAVES = 8, NTHR = 512;
constexpr float EPS = 1e-6f;

DI float bf2f(bf16 b) { return __uint_as_float(((unsigned)b) << 16); }
DI float bflo(unsigned w) { return __uint_as_float(w << 16); }
DI float bfhi(unsigned w) { return __uint_as_float(w & 0xffff0000u); }
typedef __bf16 bf16x2_t __attribute__((ext_vector_type(2)));
DI unsigned cvt_pk_bf16(float lo, float hi) { bf16x2_t v = {(__bf16)lo, (__bf16)hi}; return __builtin_bit_cast(unsigned, v); }
DI bf16 f2bf(float f) { return (bf16)(cvt_pk_bf16(f, 0.f) & 0xffffu); }
DI float fexp(float x) { return __builtin_amdgcn_exp2f(x * 1.4426950408889634f); }
DI float silu_f(float x) { return x * __builtin_amdgcn_rcpf(1.f + __expf(-x)); }
DI float sigmoid_f(float x) { return __builtin_amdgcn_rcpf(1.f + __expf(-x)); }
DI float gelu_tanh_f(float v) { const float z = 0.7978845608028654f * (v + 0.044715f * v * v * v); const float t = 1.f - 2.f * __builtin_amdgcn_rcpf(1.f + __expf(2.f * z)); return 0.5f * v * (1.f + t); }
DI float shf(float v, int src_lane) { return __int_as_float(__builtin_amdgcn_ds_bpermute(src_lane << 2, __float_as_int(v))); }
DI float shx(float v, int mask, int lane) { return shf(v, lane ^ mask); }
DI float wave_sum(float v, int lane) {
#pragma unroll
    for (int o = 1; o < 64; o <<= 1) v += shx(v, o, lane);
    return v;
}
DI void unpack8(u32x4 w, float (&v)[8]) { v[0] = bflo(w.x); v[1] = bfhi(w.x); v[2] = bflo(w.y); v[3] = bfhi(w.y); v[4] = bflo(w.z); v[5] = bfhi(w.z); v[6] = bflo(w.w); v[7] = bfhi(w.w); }
DI u32x4 pack8(const float (&v)[8]) { u32x4 w; w.x = cvt_pk_bf16(v[0], v[1]); w.y = cvt_pk_bf16(v[2], v[3]); w.z = cvt_pk_bf16(v[4], v[5]); w.w = cvt_pk_bf16(v[6], v[7]); return w; }
DI u32x4 pack8v(f32x4 a, f32x4 b) { u32x4 w; w.x = cvt_pk_bf16(a[0], a[1]); w.y = cvt_pk_bf16(a[2], a[3]); w.z = cvt_pk_bf16(b[0], b[1]); w.w = cvt_pk_bf16(b[2], b[3]); return w; }
template <class T> DI void lnd(T*& p) { GAS T* q = (GAS T*)p; asm volatile("" : "+s"(q)); p = (T*)q; }
#define LDS_WAIT() asm volatile("s_waitcnt lgkmcnt(0)" ::: "memory")
#define VM_WAIT() asm volatile("s_waitcnt vmcnt(0)" ::: "memory")
#define MFMA16(a, b, c) __builtin_amdgcn_mfma_f32_16x16x32_bf16((a), (b), (c), 0, 0, 0)
#define MFMA32(a, b, c) __builtin_amdgcn_mfma_f32_32x32x16_bf16((a), (b), (c), 0, 0, 0)

namespace pg8 {
constexpr int BM = 256, BK = 64, HALF = 128, HTB = HALF * BK * 2, STAGE_BYTES = 8 * HTB, NXCD = 8, WGM = 8;
__host__ __device__ __forceinline__ int lds_byte(int r, int c) { const int st = (r >> 4) * 2 + (c >> 5), rr = r & 15, cc = c & 31, ob = rr * 64 + cc * 2; return st * 1024 + (ob ^ (((ob >> 9) & 1) << 5)); }
__host__ __device__ __forceinline__ void stage_rc(int b, int& R, int& C) { const int st = b / 1024, sb = b % 1024, swz = sb ^ (((sb >> 9) & 1) << 5); R = (st >> 1) * 16 + swz / 64; C = (st & 1) * 32 + (swz % 64) / 2; }
__host__ __device__ __forceinline__ int perm32(int rho) { const int n = rho >> 4, i = rho & 15; return 8 * (i >> 2) + 4 * n + (i & 3); }

struct Unit { int pm, pn; };
struct Gemm { const bf16* A; const bf16* Bt; };

template <int NN> struct StaticOrder {
    static constexpr int nM = 64, nN = NN, nwg = nM * nN;
    int G, c;
    __device__ void init(int G_, int c_) { G = G_; c = c_; }
    __device__ bool next(int i, Unit& u) const {
        const long L = (long)i * G + c; if (L >= nwg) return false;
        int wgid = (int)L; { const int q = nwg / NXCD, r = nwg % NXCD, xcd = wgid % NXCD, off = wgid / NXCD; wgid = (xcd < r ? xcd * (q + 1) : r * (q + 1) + (xcd - r) * q) + off; }
        const int nig = WGM * nN, gid = wgid / nig, fm = gid * WGM, gsz = (nM - fm) < WGM ? (nM - fm) : WGM;
        u.pm = fm + ((wgid % nig) % gsz); u.pn = (wgid % nig) / gsz; return true;
    }
};

template <class F> struct EpiT {
    static constexpr bool PERM = true;
    F f;
    DI void operator()(const f32x4 (&acc)[2][2][4][2], const Unit& u, int wr, int wc, int fr, int fq) const {
        const int row0 = u.pm * BM + wr * 64 + fr, col0 = u.pn * BM + wc * 32 + 8 * fq;
#pragma unroll
        for (int ai = 0; ai < 2; ++ai)
#pragma unroll
            for (int m = 0; m < 4; ++m)
#pragma unroll
                for (int bj = 0; bj < 2; ++bj) f.op8(row0 + ai * HALF + m * 16, col0 + bj * HALF, acc[ai][bj][m][0], acc[ai][bj][m][1]);
    }
};

template <class F> struct EpiP {
    static constexpr bool PERM = true;
    F f;
    DI void operator()(const f32x4 (&acc)[2][2][4][2], const Unit& u, int wr, int wc, int fr, int fq) const {
        const int row0 = u.pm * BM + wr * 64 + fr, col0 = u.pn * BM + wc * 32 + 8 * fq;
#pragma unroll
        for (int bj = 0; bj < 2; ++bj) {
            const int col = col0 + bj * HALF;
            const typename F::Cols cp = f.cols(col);
            typename F::Pre p0 = f.pre(row0, col), p1 = p0;
#pragma unroll
            for (int k = 0; k < 8; ++k) {
                const int ai = k >> 2, m = k & 3, row = row0 + ai * HALF + m * 16;
                if (k + 1 < 8) { const int rn = row0 + ((k + 1) >> 2) * HALF + ((k + 1) & 3) * 16; if (k & 1) p0 = f.pre(rn, col); else p1 = f.pre(rn, col); }
                f.fin(row, col, acc[ai][bj][m][0], acc[ai][bj][m][1], (k & 1) ? p1 : p0, cp);
            }
        }
    }
};
template <class F, bool P = F::PIPE> struct EpiSel { typedef EpiT<F> type; };
template <class F> struct EpiSel<F, true> { typedef EpiP<F> type; };

template <class Epi, class Sched, int LDA, int LDB, int KK, int APN, class Pre>
DI void gemm_phase(LAS unsigned char* lds, const Gemm g, const Sched& S, const Epi& E, const Pre& pre) {
    int tid = threadIdx.x; asm volatile("" : "+v"(tid));
    const int wid = __builtin_amdgcn_readfirstlane(tid >> 6), lane = tid & 63, wr = wid >> 2, wc = wid & 3, fr = lane & 15, fq = lane >> 4;
    constexpr int nt = KK / BK;
    unsigned voffA[2], voffB[2];
#pragma unroll
    for (int i = 0; i < 2; ++i) { int R, C; stage_rc(tid * 16 + i * 8192, R, C); const int Rb = Epi::PERM ? ((R & ~31) + perm32(R & 31)) : R;
        voffA[i] = (unsigned)(R * LDA + C) * 2u; voffB[i] = (unsigned)(Rb * LDB + C) * 2u; }
    constexpr size_t kstep = (size_t)(BK * 2);
    constexpr size_t hstepA = (size_t)HALF * LDA * 2, hstepB = (size_t)HALF * LDB * 2;
    constexpr size_t tstepA = 2 * hstepA, tstepB = 2 * hstepB;
    constexpr size_t pnstepA = (size_t)APN * 2;
    const unsigned ldsw = (unsigned)wid * 1024u;
    const int aoff = lds_byte(wr * 64 + fr, fq * 8), boff = lds_byte(wc * 32 + fr, fq * 8);
#define PG8_SA(b, h) (((b) * 2 + (h)) * HTB)
#define PG8_SB(b, h) ((4 + (b) * 2 + (h)) * HTB)
#define PG8_STAGE(bufoff, gbase, voff) do { _Pragma("unroll") for (int _i = 0; _i < 2; ++_i) \
        __builtin_amdgcn_global_load_lds((const unsigned*)((const char*)(gbase) + (voff)[_i]), (LAS unsigned*)(lds + (bufoff) + ldsw + _i * 8192), 16, 0, 0); } while (0)
#define PG8_LDA(dst, b, h) do { _Pragma("unroll") for (int m = 0; m < 4; ++m) _Pragma("unroll") for (int k = 0; k < 2; ++k) dst[m][k] = *(const LAS bf16x8*)(lds + PG8_SA(b, h) + aoff + m * 2048 + k * 1024); } while (0)
#define PG8_LDB(dst, b, h) do { _Pragma("unroll") for (int n = 0; n < 2; ++n) _Pragma("unroll") for (int k = 0; k < 2; ++k) dst[n][k] = *(const LAS bf16x8*)(lds + PG8_SB(b, h) + boff + n * 2048 + k * 1024); } while (0)
#define PG8_MMA(ai, bj, At, Bt) do { __builtin_amdgcn_s_setprio(1); _Pragma("unroll") for (int m = 0; m < 4; ++m) _Pragma("unroll") for (int n = 0; n < 2; ++n) _Pragma("unroll") for (int k = 0; k < 2; ++k) \
        acc[ai][bj][m][n] = __builtin_amdgcn_mfma_f32_16x16x32_bf16(Bt[n][k], At[m][k], acc[ai][bj][m][n], 0, 0, 0); __builtin_amdgcn_s_setprio(0); } while (0)
#define PG8_WAIT_V(n) asm volatile("s_waitcnt vmcnt(" #n ")" ::: "memory")
#define PG8_WAIT_L(n) asm volatile("s_waitcnt lgkmcnt(" #n ")" ::: "memory")
#define PG8_BAR __builtin_amdgcn_s_barrier()
#define PG8_SCHED __builtin_amdgcn_sched_barrier(0)
    Unit cur, nxt; int ui = 0;
    if (!S.next(0, cur)) { pre(); return; }
    const bf16* gA = g.A; const bf16* gB = g.Bt;
    asm volatile("" : "+s"(gA), "+s"(gB));
    f32x4 acc[2][2][4][2];
#pragma unroll
    for (int a = 0; a < 2; ++a)
#pragma unroll
        for (int b = 0; b < 2; ++b)
#pragma unroll
            for (int m = 0; m < 4; ++m)
#pragma unroll
                for (int n = 0; n < 2; ++n) acc[a][b][m][n] = (f32x4){0.f, 0.f, 0.f, 0.f};
    bf16x8 At[4][2], B0[2][2], B1[2][2];
    const char* cA = (const char*)gA + (size_t)cur.pm * tstepA + (size_t)cur.pn * pnstepA; const char* cB = (const char*)gB + (size_t)cur.pn * tstepB;
    PG8_STAGE(PG8_SB(0, 0), cB, voffB); PG8_STAGE(PG8_SB(0, 1), cB + hstepB, voffB); PG8_STAGE(PG8_SA(0, 0), cA, voffA); PG8_STAGE(PG8_SA(0, 1), cA + hstepA, voffA);
    PG8_STAGE(PG8_SB(1, 0), cB + kstep, voffB); PG8_STAGE(PG8_SA(1, 0), cA + kstep, voffA); PG8_STAGE(PG8_SB(1, 1), cB + hstepB + kstep, voffB);
    pre();
    if (wr == 1) PG8_BAR;
    PG8_WAIT_V(8); PG8_BAR;
    PG8_WAIT_V(6); PG8_BAR;
    for (;;) {
        const bool has_next = S.next(ui + 1, nxt);
        const char* nA = has_next ? (const char*)gA + (size_t)nxt.pm * tstepA + (size_t)nxt.pn * pnstepA : cA; const char* nB = has_next ? (const char*)gB + (size_t)nxt.pn * tstepB : cB;
#pragma unroll 1
        for (int t = 0; t < nt; t += 2) {
            const bool last = (t == nt - 2);
            const char* a1 = cA + (size_t)(t + 1) * kstep;
            const char* a2 = last ? nA : cA + (size_t)(t + 2) * kstep; const char* b2 = last ? nB : cB + (size_t)(t + 2) * kstep;
            const char* a3 = a2 + kstep; const char* b3 = b2 + kstep;
            PG8_LDB(B0, 0, 0); PG8_LDB(B1, 0, 1); PG8_SCHED; PG8_LDA(At, 0, 0); PG8_STAGE(PG8_SA(1, 1), a1 + hstepA, voffA);
            PG8_WAIT_V(8); PG8_WAIT_L(0); PG8_BAR; PG8_MMA(0, 0, At, B0); PG8_MMA(0, 1, At, B1); PG8_BAR; PG8_SCHED;
            PG8_LDA(At, 0, 1); PG8_STAGE(PG8_SB(0, 0), b2, voffB); PG8_STAGE(PG8_SB(0, 1), b2 + hstepB, voffB); PG8_STAGE(PG8_SA(0, 0), a2, voffA);
            PG8_WAIT_V(8); PG8_WAIT_L(0); PG8_BAR; PG8_MMA(1, 0, At, B0); PG8_MMA(1, 1, At, B1); PG8_BAR; PG8_SCHED;
            PG8_LDB(B0, 1, 0); PG8_LDB(B1, 1, 1); PG8_SCHED; PG8_LDA(At, 1, 0); PG8_STAGE(PG8_SA(0, 1), a2 + hstepA, voffA);
            PG8_WAIT_V(8); PG8_WAIT_L(0); PG8_BAR; PG8_MMA(0, 0, At, B0); PG8_MMA(0, 1, At, B1); PG8_BAR; PG8_SCHED;
            PG8_LDA(At, 1, 1); PG8_STAGE(PG8_SB(1, 0), b3, voffB); PG8_STAGE(PG8_SB(1, 1), b3 + hstepB, voffB); PG8_STAGE(PG8_SA(1, 0), a3, voffA);
            PG8_WAIT_V(8); PG8_WAIT_L(0); PG8_BAR; PG8_MMA(1, 0, At, B0); PG8_MMA(1, 1, At, B1); PG8_BAR; PG8_SCHED;
        }
        if (wr == 0) PG8_BAR;
        E(acc, cur, wr, wc, fr, fq);
        if (!has_next) break;
#pragma unroll
        for (int a = 0; a < 2; ++a)
#pragma unroll
            for (int b = 0; b < 2; ++b)
#pragma unroll
                for (int m = 0; m < 4; ++m)
#pragma unroll
                    for (int n = 0; n < 2; ++n) acc[a][b][m][n] = (f32x4){0.f, 0.f, 0.f, 0.f};
        cur = nxt; cA = nA; cB = nB; ++ui;
        if (wr == 1) PG8_BAR;
    }
    PG8_WAIT_V(0);
    PG8_BAR;
#undef PG8_SA
#undef PG8_SB
#undef PG8_STAGE
#undef PG8_LDA
#undef PG8_LDB
#undef PG8_MMA
#undef PG8_WAIT_V
#undef PG8_WAIT_L
#undef PG8_BAR
#undef PG8_SCHED
}
}

template <class F>
DI void gemm_tail(LAS unsigned char* lds, const bf16* A, int lda, const bf16* Bt, int ldb, int K, int N, int a_pn_step, const F& f, int row_base, int bid, int G, int wave, int lane) {
    const int i16 = lane & 15, kq = lane >> 4;
    LAS float* P = (LAS float*)lds;
    for (int task = bid; task < N / 32; task += G) {
        const int n0 = task * 32, pn = n0 >> 8, kw = K >> 3, kb = wave * kw;
        const bf16* ap = A + (size_t)i16 * lda + (size_t)pn * a_pn_step + kb + 8 * kq;
        const bf16* b0p = Bt + (size_t)(n0 + 8 * (i16 >> 2) + (i16 & 3)) * ldb + kb + 8 * kq;
        const bf16* b1p = b0p + (size_t)4 * ldb;
        f32x4 acc0 = {0.f, 0.f, 0.f, 0.f}, acc1 = {0.f, 0.f, 0.f, 0.f};
#pragma unroll 8
        for (int k0 = 0; k0 < kw; k0 += 32) {
            const bf16x8 a = *(const bf16x8*)(ap + k0), b0 = *(const bf16x8*)(b0p + k0), b1 = *(const bf16x8*)(b1p + k0);
            acc0 = MFMA16(b0, a, acc0); acc1 = MFMA16(b1, a, acc1);
        }
#pragma unroll
        for (int r = 0; r < 4; ++r) { P[(wave * 8 + r) * 64 + lane] = acc0[r]; P[(wave * 8 + 4 + r) * 64 + lane] = acc1[r]; }
        __syncthreads();
        if (wave == 0) {
            f32x4 s0 = {0.f, 0.f, 0.f, 0.f}, s1 = s0;
#pragma unroll
            for (int ww = 0; ww < 8; ++ww)
#pragma unroll
                for (int r = 0; r < 4; ++r) { s0[r] += P[(ww * 8 + r) * 64 + lane]; s1[r] += P[(ww * 8 + 4 + r) * 64 + lane]; }
            f.op8(row_base + i16, n0 + 8 * kq, s0, s1);
        }
        __syncthreads();
    }
}

constexpr size_t SLOT = (size_t)LTOK * 1024 * 2;
constexpr size_t WS_SLOT0 = 0;
constexpr size_t WS_WREG = 7 * SLOT;
constexpr size_t WREG_BYTES = 24117248;
constexpr size_t WS_MISC = WS_WREG + WREG_BYTES;
constexpr size_t MS_CTL = 0;
constexpr size_t MS_GI = 65536;
constexpr size_t MS_GF = MS_GI + (size_t)2 * 8 * NPOS * 4;
constexpr size_t MS_RSTD = MS_GF + (size_t)2 * 8 * NPOS * 4;
constexpr size_t MS_CELLM = MS_RSTD + (size_t)LTOK * 8 * 4;
constexpr size_t MS_VM = MS_CELLM + 64 * 2048 * 2;
constexpr size_t MS_ROPE = MS_VM + 64 * 2048 * 2;
constexpr size_t MS_ZROW = MS_ROPE + 256 * 32 * 8;
constexpr size_t MS_GB = MS_ZROW + 4096;
constexpr size_t MS_K8 = MS_GB + (size_t)2 * 8 * NPOS * 4;
constexpr size_t MS_END = MS_K8 + (size_t)KVROWS * 256;
constexpr size_t WS_NEED = WS_MISC + MS_END;
constexpr size_t WE_IN = 0, WE_GLU = WE_IN + (size_t)4608 * 1024 * 2, WE_OUT = WE_GLU + (size_t)1024 * 1024 * 2;
constexpr size_t WO_IN = 0, WO_Z = WO_IN + (size_t)2048 * 1024 * 2, WO_QK = WO_Z + (size_t)2048 * 1024 * 2, WO_V = WO_QK + (size_t)2048 * 256 * 2,
                 WO_G = WO_V + (size_t)2048 * 256 * 2, WO_OUT = WO_G + (size_t)32 * 2048 * 2, WO_OG = WE_OUT + (size_t)2048 * 1024 * 2;
static_assert(WO_V == WE_GLU && WO_OUT + (size_t)1024 * 2048 * 2 <= WO_OG && WO_OG + (size_t)2048 * 2048 * 2 == WREG_BYTES, "odd weight region");
constexpr size_t DO_EX = 0;
constexpr size_t DO_HCAT = DO_EX + (size_t)1025 * 64 * 256 * 2;
constexpr size_t DO_MG = DO_HCAT + (size_t)64 * 256 * 256 * 2;
constexpr size_t DO_APOW = DO_MG + (size_t)64 * 256 * 512 * 2;
constexpr size_t DO_BB = DO_APOW + (size_t)2 * 64 * 64 * 17 * 8;
constexpr size_t DO_KTAB = DO_BB + (size_t)2 * 64 * 64 * 16 * 8;
static_assert(DO_KTAB + (size_t)2 * 64 * 16 * 256 * 4 <= (size_t)SEQ * 1024 * 4, "d_out scratch map");

constexpr int CW_BAR = 1024;
constexpr int CW_CHK = 8192;
constexpr int LDS_TOTAL = 160 * 1024;
constexpr int LDS_MISC = LDS_TOTAL - 64;

#define XB_TMO      128
#define XB_XCNT(j)  (256  + 64 * (j))
#define XB_XSUB(j)  (1280 + 64 * (j))
#define XB_XGEN(j)  (2304 + 64 * (j))
#define XB_TOP      3328
#define XB_TOPGEN   3392
#define XCD_BAR_WORDS 3456
#define XB_SPIN_CAP (1u << 21)
DI unsigned xb_ld(unsigned* p)              { return __hip_atomic_load(p, __ATOMIC_RELAXED, __HIP_MEMORY_SCOPE_AGENT); }
DI unsigned xb_add(unsigned* p, unsigned v) { return __hip_atomic_fetch_add(p, v, __ATOMIC_RELAXED, __HIP_MEMORY_SCOPE_AGENT); }
DI unsigned xb_xcc_id() { return (unsigned)__builtin_amdgcn_s_getreg((3 << 11) | 20) & 0xFu; }
#define XB_SPIN(cond, bar) do { unsigned _sp = 0; while (cond) { __builtin_amdgcn_s_sleep(1); \
    if ((++_sp & 255u) == 0u) { if (xb_ld(&(bar)[XB_TMO])) break; if (_sp > XB_SPIN_CAP) { atomicAdd(&(bar)[XB_TMO], 1u); break; } } } } while (0)
struct XcdBarrier { unsigned* bar; unsigned x; volatile LAS unsigned* st; };
DI XcdBarrier xcd_barrier_post(unsigned* bar, volatile LAS unsigned* st) {
    XcdBarrier b; b.bar = bar; b.x = xb_xcc_id(); b.st = st;
    if (threadIdx.x == 0) (void)xb_add(&bar[XB_XCNT(b.x)], 1u);
    return b;
}
DI void xcd_barrier_complete(unsigned* bar, unsigned x, unsigned& nloc, unsigned& nx) {
    const unsigned G = gridDim.x * gridDim.y * gridDim.z;
    unsigned sum, cnt, mine, sp = 0u;
    for (;;) {
        sum = 0u; cnt = 0u; mine = 0u;
#pragma unroll
        for (unsigned j = 0; j < 16; ++j) { const unsigned c = xb_ld(&bar[XB_XCNT(j)]); sum += c; cnt += (c > 0u) ? 1u : 0u; mine = (j == x) ? c : mine; }
        if (sum == G) break;
        __builtin_amdgcn_s_sleep(1);
        if ((++sp & 255u) == 0u) { if (xb_ld(&bar[XB_TMO])) break; if (sp > XB_SPIN_CAP) { atomicAdd(&bar[XB_TMO], 1u); break; } }
    }
    nloc = mine > 0u ? mine : 1u; nx = cnt > 0u ? cnt : 1u;
}
DI void xcd_barrier(const XcdBarrier& b) {
    asm volatile("s_waitcnt vmcnt(0)" ::: "memory");
    __syncthreads();
    if (threadIdx.x == 0) {
        unsigned* bar = b.bar; lnd(bar);
        __builtin_amdgcn_s_waitcnt(0);
        unsigned nloc = b.st[0], nx = b.st[1];
        if (nloc == 0u) { xcd_barrier_complete(bar, b.x, nloc, nx); b.st[0] = nloc; b.st[1] = nx; }
        const unsigned old = xb_add(&bar[XB_XSUB(b.x)], 1u);
        const unsigned gen = old / nloc;
        if (old + 1u == (gen + 1u) * nloc) {
            __builtin_amdgcn_fence(__ATOMIC_RELEASE, "agent");
            asm volatile("s_waitcnt vmcnt(0)" ::: "memory");
            const unsigned og = xb_add(&bar[XB_TOP], 1u);
            const unsigned tg = og / nx;
            if (og + 1u == (tg + 1u) * nx) xb_add(&bar[XB_TOPGEN], 1u);
            else XB_SPIN(xb_ld(&bar[XB_TOPGEN]) == tg, bar);
            __builtin_amdgcn_fence(__ATOMIC_ACQUIRE, "agent");
            xb_add(&bar[XB_XGEN(b.x)], 1u);
            asm volatile("s_waitcnt vmcnt(0)" ::: "memory");
        } else {
            XB_SPIN(xb_ld(&bar[XB_XGEN(b.x)]) == gen, bar);
            __builtin_amdgcn_fence(__ATOMIC_ACQUIRE, "agent");
            asm volatile("s_waitcnt vmcnt(0)" ::: "memory");
        }
    }
    __syncthreads();
}

struct Params { const float* in[33]; float* out; unsigned char* ws; int ph_lo, ph_hi, use_bar, pad; };
enum { I_X = 0, I_META, I_NPRE, I_NPOST, I_WINE, I_QN, I_KN, I_ARE, I_AIM, I_LDT, I_BRE, I_BIM, I_CRE, I_CIM, I_SSMD, I_WGLU, I_BGLU, I_WOUTE,
       I_WINO, I_CONVW, I_CONVB, I_WQ, I_WK, I_WV, I_WIG, I_BIG, I_WFG, I_BFG, I_WOG, I_BOG, I_HN, I_SKIP, I_WOUTO };

struct Ctx {
    LAS unsigned char* lds;
    int tid, lane, wave, G, bid;
    int gw, ngw;
    int gws;
    const float* const* in; float* out; unsigned char* ws; unsigned char* dob;
    DI bf16* slot(int i) const { return (bf16*)(ws + WS_SLOT0 + (size_t)i * SLOT); }
    DI Ctx fresh() const { Ctx P = *this; asm volatile("" : "+v"(P.tid)); P.lane = P.tid & 63; P.wave = __builtin_amdgcn_readfirstlane(P.tid >> 6);
        asm volatile("" : "+s"(P.G)); P.ngw = P.G * NWAVES; P.gw = P.bid * NWAVES + P.wave; P.gws = P.wave * P.G + P.bid; lnd(P.ws); lnd(P.dob); lnd(P.out); return P; }
    DI unsigned char* wreg() const { return ws + WS_WREG; }
    DI unsigned char* misc() const { return ws + WS_MISC; }
};

DI void transpose_item(const float* W, int ldw, int N, bf16* WT, int ldo, int row_off, LAS float* scr, int item, int lane, const float* ks = nullptr) {
    const int nblk = N / 32, kb = item / nblk, nb = item % nblk, k0 = 64 * kb, n0 = 32 * nb;
    f32x4 v[8];
#pragma unroll
    for (int i = 0; i < 8; ++i) v[i] = *(const f32x4*)(W + (size_t)(k0 + 8 * i + (lane >> 3)) * ldw + n0 + 4 * (lane & 7));
#pragma unroll
    for (int i = 0; i < 8; ++i) { const int kk = 8 * i + (lane >> 3); const float sc = ks ? ks[k0 + kk] : 1.f; LAS float* d = scr + kk * 33 + 4 * (lane & 7);
        d[0] = v[i][0] * sc; d[1] = v[i][1] * sc; d[2] = v[i][2] * sc; d[3] = v[i][3] * sc; }
    LDS_WAIT(); asm volatile("" ::: "memory");
    const int c = lane & 7;
#pragma unroll
    for (int j = 0; j < 4; ++j) { const int n = (lane >> 3) + 8 * j; const LAS float* s = scr + (8 * c) * 33 + n;
        u32x4 o; o.x = cvt_pk_bf16(s[0 * 33], s[1 * 33]); o.y = cvt_pk_bf16(s[2 * 33], s[3 * 33]); o.z = cvt_pk_bf16(s[4 * 33], s[5 * 33]); o.w = cvt_pk_bf16(s[6 * 33], s[7 * 33]);
        *(u32x4*)(WT + (size_t)(row_off + n0 + n) * ldo + k0 + 8 * c) = o; }
    LDS_WAIT(); asm volatile("" ::: "memory");
}

DI void convert_even_weights(const Ctx& C, int li) {
    LAS float* scr = (LAS float*)(C.lds + C.wave * 8704);
    unsigned char* wr = C.wreg();
    { const int n = (1024 / 64) * (4608 / 32); for (int it = C.gw; it < n; it += C.ngw) transpose_item(C.in[I_WINE] + (size_t)li * 1024 * 4608, 4608, 4608, (bf16*)(wr + WE_IN), 1024, 0, scr, it, C.lane); }
    { const int n = (1024 / 64) * (1024 / 32); for (int it = C.gw; it < n; it += C.ngw) transpose_item(C.in[I_WGLU] + (size_t)li * 1024 * 1024, 1024, 1024, (bf16*)(wr + WE_GLU), 1024, 0, scr, it, C.lane); }
    { const int n = (2048 / 64) * (1024 / 32); for (int it = C.gw; it < n; it += C.ngw) transpose_item(C.in[I_WOUTE] + (size_t)li * 2048 * 1024, 1024, 1024, (bf16*)(wr + WE_OUT), 2048, 0, scr, it, C.lane); }
}
DI void convert_odd_early(const Ctx& C, int li) {
    LAS float* scr = (LAS float*)(C.lds + C.wave * 8704);
    unsigned char* wr = C.wreg();
    const float* win = C.in[I_WINO] + (size_t)li * 1024 * 4096;
    { const int n = (1024 / 64) * (2048 / 32);
      for (int it = C.gw; it < n; it += C.ngw) transpose_item(win, 4096, 2048, (bf16*)(wr + WO_IN), 1024, 0, scr, it, C.lane);
      for (int it = C.gw; it < n; it += C.ngw) transpose_item(win + 2048, 4096, 2048, (bf16*)(wr + WO_Z), 1024, 0, scr, it, C.lane); }
    { const int nq = (256 / 64) * (128 / 32);
      for (int it = C.gw; it < 8 * nq; it += C.ngw) { const int h = it / nq, r = it % nq;
          transpose_item(C.in[I_WQ] + ((size_t)li * 8 + h) * 256 * 128, 128, 128, (bf16*)(wr + WO_QK), 256, h * 256, scr, r, C.lane);
          transpose_item(C.in[I_WK] + ((size_t)li * 8 + h) * 256 * 128, 128, 128, (bf16*)(wr + WO_QK), 256, h * 256 + 128, scr, r, C.lane); } }
    { const int n = (2048 / 64) * (2048 / 32);
      for (int it = C.gw; it < n; it += C.ngw) transpose_item(C.in[I_WOG] + (size_t)li * 2048 * 2048, 2048, 2048, (bf16*)(wr + WO_OG), 2048, 0, scr, it, C.lane); }
}
DI void convert_odd_late(const Ctx& C, int li) {
    LAS float* scr = (LAS float*)(C.lds + C.wave * 8704);
    unsigned char* wr = C.wreg();
    { const int nv = (256 / 64) * (256 / 32);
      for (int it = C.gw; it < 8 * nv; it += C.ngw) { const int h = it / nv, r = it % nv;
          transpose_item(C.in[I_WV] + ((size_t)li * 8 + h) * 256 * 256, 256, 256, (bf16*)(wr + WO_V), 256, h * 256, scr, r, C.lane); } }
    { const int n = (2048 / 64) * (1024 / 32);
      for (int it = C.gw; it < n; it += C.ngw) transpose_item(C.in[I_WOUTO] + (size_t)li * 2048 * 1024, 1024, 1024, (bf16*)(wr + WO_OUT), 2048, 0, scr, it, C.lane); }
    { bf16* wg = (bf16*)(wr + WO_G); const float* wi = C.in[I_WIG] + (size_t)li * 2 * 2048 * 8; const float* wf = C.in[I_WFG] + (size_t)li * 2 * 2048 * 8;
      for (int i = C.gw * 64 + C.lane; i < 32 * 2048; i += C.ngw * 64) { const int n = i >> 11, c = i & 2047, ty = n >> 4, d = (n >> 3) & 1, h = n & 7;
          wg[i] = f2bf((ty ? wf : wi)[((size_t)d * 2048 + c) * 8 + h]); } }
}

DI void load_row_bf16(const bf16* p, int lane, float (&v)[16]) {
    const u32x4 a = *(const u32x4*)(p + 8 * lane), b = *(const u32x4*)(p + 512 + 8 * lane);
    float t[8]; unpack8(a, t);
#pragma unroll
    for (int i = 0; i < 8; ++i) v[i] = t[i];
    unpack8(b, t);
#pragma unroll
    for (int i = 0; i < 8; ++i) v[8 + i] = t[i];
}
DI void load_row_f32(const float* p, int lane, float (&v)[16]) {
    const f32x4 a = *(const f32x4*)(p + 8 * lane), b = *(const f32x4*)(p + 8 * lane + 4), c = *(const f32x4*)(p + 512 + 8 * lane), d = *(const f32x4*)(p + 512 + 8 * lane + 4);
#pragma unroll
    for (int i = 0; i < 4; ++i) { v[i] = a[i]; v[4 + i] = b[i]; v[8 + i] = c[i]; v[12 + i] = d[i]; }
}
DI void store_row_bf16(bf16* p, int lane, const float (&v)[16]) {
    float t[8];
#pragma unroll
    for (int i = 0; i < 8; ++i) t[i] = v[i];
    *(u32x4*)(p + 8 * lane) = pack8(t);
#pragma unroll
    for (int i = 0; i < 8; ++i) t[i] = v[8 + i];
    *(u32x4*)(p + 512 + 8 * lane) = pack8(t);
}
DI void round_bf16_16(float (&v)[16]) {
#pragma unroll
    for (int i = 0; i < 16; i += 2) { const unsigned w = cvt_pk_bf16(v[i], v[i + 1]); v[i] = bflo(w); v[i + 1] = bfhi(w); }
}
DI void rms_row(const float (&v)[16], const float* g, int lane, float (&o)[16]) {
    float s = 0.f;
#pragma unroll
    for (int i = 0; i < 16; ++i) s += v[i] * v[i];
    s = wave_sum(s, lane);
    const float r = rsqrtf(s * (1.f / 1024.f) + EPS);
    float gg[16]; load_row_f32(g, lane, gg);
#pragma unroll
    for (int i = 0; i < 16; ++i) o[i] = v[i] * r * gg[i];
}

DI void phase_init_rows(const Ctx& C, bf16* resid, bf16* hdst) {
    for (int r = C.gw; r < LTOK; r += C.ngw) {
        float v[16], o[16];
        if (r < SEQ) load_row_f32(C.in[I_X] + (size_t)r * 1024, C.lane, v); else load_row_f32(C.in[I_META] + (size_t)(r - SEQ) * 1024, C.lane, v);
        round_bf16_16(v);
        store_row_bf16(resid + (size_t)r * 1024, C.lane, v);
        rms_row(v, C.in[I_NPRE], C.lane, o);
        store_row_bf16(hdst + (size_t)r * 1024, C.lane, o);
    }
}
DI void post_row_finish(const Ctx& C, int r, const float (&v)[16], float (&rs)[16], bf16* resid, bf16* hdst, int layer) {
    float o[16];
    rms_row(v, C.in[I_NPOST] + (size_t)layer * 1024, C.lane, o);
#pragma unroll
    for (int i = 0; i < 16; ++i) rs[i] += o[i];
    if (layer == 3) {
        if (r < SEQ) { float* op = C.out + (size_t)r * 1024;
            *(f32x4*)(op + 8 * C.lane) = (f32x4){rs[0], rs[1], rs[2], rs[3]}; *(f32x4*)(op + 8 * C.lane + 4) = (f32x4){rs[4], rs[5], rs[6], rs[7]};
            *(f32x4*)(op + 512 + 8 * C.lane) = (f32x4){rs[8], rs[9], rs[10], rs[11]}; *(f32x4*)(op + 512 + 8 * C.lane + 4) = (f32x4){rs[12], rs[13], rs[14], rs[15]}; }
    } else {
        round_bf16_16(rs);
        store_row_bf16(resid + (size_t)r * 1024, C.lane, rs);
        rms_row(rs, C.in[I_NPRE] + (size_t)(layer + 1) * 1024, C.lane, o);
        store_row_bf16(hdst + (size_t)r * 1024, C.lane, o);
    }
}
DI void phase_post_rows(const Ctx& C, const bf16* y, bf16* resid, bf16* hdst, int layer, bf16* resid_out = nullptr) {
    if (!resid_out) resid_out = resid;
    for (int r = C.gw; r < LTOK; r += 2 * C.ngw) {
        const int r2 = r + C.ngw; const bool has2 = r2 < LTOK; const int r2c = has2 ? r2 : r;
        float v[16], rs[16], v2[16], rs2[16];
        load_row_bf16(y + (size_t)r * 1024, C.lane, v); load_row_bf16(resid + (size_t)r * 1024, C.lane, rs);
        load_row_bf16(y + (size_t)r2c * 1024, C.lane, v2); load_row_bf16(resid + (size_t)r2c * 1024, C.lane, rs2);
        post_row_finish(C, r, v, rs, resid_out, hdst, layer);
        if (has2) post_row_finish(C, r2, v2, rs2, resid_out, hdst, layer);
    }
}
DI void phase_renorm_rows(const Ctx& C, const bf16* resid, bf16* hdst, int layer) {
    for (int r = C.gw; r < LTOK; r += C.ngw) {
        float v[16], o[16];
        load_row_bf16(resid + (size_t)r * 1024, C.lane, v);
        rms_row(v, C.in[I_NPRE] + (size_t)layer * 1024, C.lane, o);
        store_row_bf16(hdst + (size_t)r * 1024, C.lane, o);
    }
}
DI void phase_rope_table(const Ctx& C) {
    f32x2* tab = (f32x2*)(C.misc() + MS_ROPE);
    for (int i = C.gw * 64 + C.lane; i < 256 * 32; i += C.ngw * 64) { const int pos = i >> 5, j = i & 31;
        const float f = fexp(-(float)j * (9.210340371976184f / 32.f));
        float rev = (float)pos * f * 0.15915494309189535f; rev -= rintf(rev);
        tab[i] = (f32x2){__builtin_amdgcn_cosf(rev), __builtin_amdgcn_sinf(rev)}; }
}

DI void store8(bf16* dst, f32x4 a, f32x4 b) { *(u32x4*)dst = pack8v(a, b); }
DI f32x4 silu4(f32x4 v) { return (f32x4){silu_f(v[0]), silu_f(v[1]), silu_f(v[2]), silu_f(v[3])}; }
struct FEvenIn { static constexpr bool PIPE = false;
    bf16 *YAB, *Kb, *Vb, *GA, *U;
    DI void launder() { lnd(YAB); lnd(Kb); lnd(Vb); lnd(GA); lnd(U); }
    DI void op8(int row, int col, f32x4 a, f32x4 b) const {
        bf16* dst; bool act = false;
        if (col < 1024) dst = YAB + (size_t)row * 2048 + col;
        else if (col < 1280) dst = Kb + (size_t)row * 256 + (col - 1024);
        else if (col < 1536) dst = Vb + (size_t)row * 256 + (col - 1280);
        else if (col < 2560) { dst = GA + (size_t)row * 1024 + (col - 1536); act = true; }
        else if (col < 3584) { const int cu = col - 2560, rp = row < SEQ ? row + 16 : row - SEQ;
            dst = U + ((size_t)(cu >> 4) * LTOK + rp) * 16 + (cu & 15); }
        else { dst = YAB + (size_t)row * 2048 + 1024 + (col - 3584); act = true; }
        if (act) { a = silu4(a); b = silu4(b); }
        store8(dst, a, b);
    }
};
struct FPlain { static constexpr bool PIPE = false; bf16* O; int ldo; DI void launder() { lnd(O); } DI void op8(int row, int col, f32x4 a, f32x4 b) const { store8(O + (size_t)row * ldo + col, a, b); } };
struct FSilu { static constexpr bool PIPE = false; bf16* O; int ldo; DI void launder() { lnd(O); } DI void op8(int row, int col, f32x4 a, f32x4 b) const { store8(O + (size_t)row * ldo + col, silu4(a), silu4(b)); } };
struct FGlu {
    static constexpr bool PIPE = true;
    const bf16* YG; bf16* YAB; const float* bias;
    struct Pre { u32x4 yg, gb; };
    struct Cols { f32x4 b0, b1; };
    DI void launder() { lnd(YG); lnd(YAB); lnd(bias); }
    DI Cols cols(int col) const { Cols c; c.b0 = *(const f32x4*)(bias + col); c.b1 = *(const f32x4*)(bias + col + 4); return c; }
    DI Pre pre(int row, int col) const { Pre p; p.yg = *(const u32x4*)(YG + (size_t)row * 1024 + col); p.gb = *(const u32x4*)(YAB + (size_t)row * 2048 + 1024 + col); return p; }
    DI void fin(int row, int col, f32x4 a, f32x4 b, const Pre& p, const Cols& c) const {
        float yg[8], gb[8], o[8]; unpack8(p.yg, yg); unpack8(p.gb, gb);
#pragma unroll
        for (int j = 0; j < 4; ++j) { o[j] = yg[j] * sigmoid_f(a[j] + c.b0[j]) * gb[j]; o[4 + j] = yg[4 + j] * sigmoid_f(b[j] + c.b1[j]) * gb[4 + j]; }
        *(u32x4*)(YAB + (size_t)row * 2048 + 1024 + col) = pack8(o);
    }
    DI void op8(int row, int col, f32x4 a, f32x4 b) const { fin(row, col, a, b, pre(row, col), cols(col)); }
};
struct FQK { static constexpr bool PIPE = false;
    bf16 *Q, *Kd;
    DI void launder() { lnd(Q); lnd(Kd); }
    DI void op8(int row, int col, f32x4 a, f32x4 b) const { const int h = col >> 8, w = col & 255;
        bf16* dst = (w < 128) ? Q + (size_t)row * 1024 + h * 128 + w : Kd + (size_t)row * 1024 + h * 128 + (w - 128);
        store8(dst, a, b); }
};
struct FVrow { static constexpr bool PIPE = false;
    bf16 *V, *VM;
    DI void launder() { lnd(V); lnd(VM); }
    DI void op8(int row, int col, f32x4 a, f32x4 b) const { bf16* dst = (row < SEQ) ? V + (size_t)row * 2048 + col : VM + (size_t)(row - SEQ) * 2048 + col; store8(dst, a, b); }
};
struct FOgate {
    static constexpr bool PIPE = true;
    const bf16 *CELL, *CELLM, *XC, *SZ; bf16* HZ; const float *bo, *hn, *skip, *rstd;
    struct Pre { u32x4 ce, xc, sz; float rs; };
    struct Cols { f32x4 b0, b1, h0, h1, s0, s1; };
    DI void launder() { lnd(CELL); lnd(CELLM); lnd(XC); lnd(SZ); lnd(HZ); lnd(bo); lnd(hn); lnd(skip); lnd(rstd); }
    DI Cols cols(int col) const { Cols c; c.b0 = *(const f32x4*)(bo + col); c.b1 = *(const f32x4*)(bo + col + 4); c.h0 = *(const f32x4*)(hn + col); c.h1 = *(const f32x4*)(hn + col + 4);
        c.s0 = *(const f32x4*)(skip + col); c.s1 = *(const f32x4*)(skip + col + 4); return c; }
    DI Pre pre(int row, int col) const { Pre p;
        const bf16* cp = (row < SEQ) ? CELL + (size_t)row * 2048 + col : CELLM + (size_t)(row - SEQ) * 2048 + col;
        p.ce = *(const u32x4*)cp; p.xc = *(const u32x4*)(XC + (size_t)row * 2048 + col); p.sz = *(const u32x4*)(SZ + (size_t)row * 2048 + col); p.rs = rstd[(size_t)row * 8 + (col >> 8)]; return p; }
    DI void fin(int row, int col, f32x4 a, f32x4 b, const Pre& p, const Cols& c) const {
        float ce[8], xc[8], sz[8], o[8]; unpack8(p.ce, ce); unpack8(p.xc, xc); unpack8(p.sz, sz);
        const float rs = p.rs;
#pragma unroll
        for (int j = 0; j < 4; ++j) {
            o[j] = (sigmoid_f(a[j] + c.b0[j]) * (ce[j] * rs * c.h0[j]) + c.s0[j] * xc[j]) * sz[j];
            o[4 + j] = (sigmoid_f(b[j] + c.b1[j]) * (ce[4 + j] * rs * c.h1[j]) + c.s1[j] * xc[4 + j]) * sz[4 + j]; }
        *(u32x4*)(HZ + (size_t)row * 2048 + col) = pack8(o);
    }
    DI void op8(int row, int col, f32x4 a, f32x4 b) const { fin(row, col, a, b, pre(row, col), cols(col)); }
};

template <int LDA, int LDB, int KK, int NN, int APN, class F>
DI void run_gemm(const Ctx& C, const bf16* A, const bf16* Bt, const F& f0) {
    F f = f0; f.launder(); lnd(A); lnd(Bt);
    pg8::Gemm g{A, Bt};
    pg8::StaticOrder<NN / 256> S; S.init(C.G, C.bid);
    typedef typename pg8::EpiSel<F>::type Epi;
    Epi E{f};
    auto pre = [&]() { gemm_tail<F>(C.lds + pg8::STAGE_BYTES, A + (size_t)SEQ * LDA, LDA, Bt, LDB, KK, NN, APN, f, SEQ, C.bid, C.G, C.wave, C.lane); };
    pg8::gemm_phase<Epi, pg8::StaticOrder<NN / 256>, LDA, LDB, KK, APN>(C.lds, g, S, E, pre);
}

DI void phase_qk_norm_rope(const Ctx& C, bf16* YAB, bf16* Kb, const float* qn, const float* kn, unsigned char* K8, bf16* dummy = nullptr) {
    const f32x2* tab = (const f32x2*)(C.misc() + MS_ROPE);
    const int sub = C.lane & 15, grp = C.lane >> 4;
    const int nitems = LTOK * 10;
    constexpr int NB = 7;
    const f32x4 gq0 = *(const f32x4*)(qn + sub * 8), gq1 = *(const f32x4*)(qn + sub * 8 + 4), gk0 = *(const f32x4*)(kn + sub * 8), gk1 = *(const f32x4*)(kn + sub * 8 + 4);
    for (int it0 = C.gw * 4; it0 < nitems; it0 += C.ngw * 4 * NB) {
        bf16* p[NB]; u32x4 raw[NB]; bool ok[NB]; int rowv[NB], hsv[NB]; f32x4 tb[NB][4];
#pragma unroll
        for (int b = 0; b < NB; ++b) { const int it = it0 + b * C.ngw * 4 + grp; ok[b] = it < nitems; const int itc = ok[b] ? it : nitems - 1;
            const int row = itc / 10, hs = itc - row * 10; rowv[b] = row; hsv[b] = hs;
            p[b] = (hs < 8) ? YAB + (size_t)row * 2048 + hs * 128 + sub * 8 : Kb + (size_t)row * 256 + (hs - 8) * 128 + sub * 8;
            raw[b] = *(const u32x4*)p[b]; }
#pragma unroll
        for (int b = 0; b < NB; ++b) {
            int pos = 0; if (rowv[b] < SEQ) pos = (sub < 8) ? (rowv[b] >> 6) : (rowv[b] & 63);
            const f32x4* tp = (const f32x4*)(tab + pos * 32 + (sub & 3) * 8);
#pragma unroll
            for (int e = 0; e < 4; ++e) tb[b][e] = tp[e]; }
#pragma unroll
        for (int b = 0; b < NB; ++b) { const int row = rowv[b], hs = hsv[b];
            float v[8]; unpack8(raw[b], v);
            float s = 0.f;
#pragma unroll
            for (int e = 0; e < 8; ++e) s += v[e] * v[e];
            s += shx(s, 1, C.lane); s += shx(s, 2, C.lane); s += shx(s, 4, C.lane); s += shx(s, 8, C.lane);
            const float r = rsqrtf(s * (1.f / 128.f) + EPS);
            const bool isq = hs < 8;
            f32x4 g0, g1;
#pragma unroll
            for (int e = 0; e < 4; ++e) { g0[e] = isq ? gq0[e] : gk0[e]; g1[e] = isq ? gq1[e] : gk1[e]; }
#pragma unroll
            for (int e = 0; e < 4; ++e) { v[e] = v[e] * r * g0[e]; v[4 + e] = v[4 + e] * r * g1[e]; }
            const bool first = (sub & 4) == 0;
            float o[8];
#pragma unroll
            for (int e = 0; e < 8; ++e) {
                const float other = shx(v[e], 4, C.lane);
                const float cx = tb[b][e >> 1][(e & 1) * 2], cy = tb[b][e >> 1][(e & 1) * 2 + 1];
                o[e] = first ? (v[e] * cx - other * cy) : (v[e] * cx + other * cy);
            }
            bf16* dp = dummy ? dummy + (size_t)((rowv[b] * 10 + hsv[b]) & 65535) * 128 + sub * 8 : p[b];
            if (ok[b]) { *(u32x4*)dp = pack8(o);
                if (hs >= 8) { int w0 = 0, w1 = 0;
                    w0 = __builtin_amdgcn_cvt_pk_fp8_f32(o[0], o[1], w0, false); w0 = __builtin_amdgcn_cvt_pk_fp8_f32(o[2], o[3], w0, true);
                    w1 = __builtin_amdgcn_cvt_pk_fp8_f32(o[4], o[5], w1, false); w1 = __builtin_amdgcn_cvt_pk_fp8_f32(o[6], o[7], w1, true);
                    *(u32x2*)(K8 + (size_t)row * 256 + (hs - 8) * 128 + sub * 8) = (u32x2){(unsigned)w0, (unsigned)w1}; } } }
    }
}

namespace att {
constexpr int D = 128, NW = 8, QBLK = 32, KVBLK = 64;
constexpr float SCALE = 0.088388347648318440f;
constexpr float THR = 8.f;
constexpr int LDQ = 2048, LDK = 256, LDG = 1024;
constexpr size_t SHM_V = KVBLK * D * 2, SHM_K = KVBLK * D * 2, SHM_ATTN = 2 * SHM_V + 2 * SHM_K + NW * 64 * 4;
constexpr int NT_C = KVROWS / KVBLK;
#define KSWZ(row, colB) ((row) * 256 + ((colB) ^ (((row) & 7) << 4)))
#define SBAR() __builtin_amdgcn_sched_barrier(0)
DI int crow(int r, int hi) { return (r & 3) + 8 * (r >> 2) + 4 * hi; }
DI unsigned cvtpk_asm(float lo, float hi) { unsigned r; asm volatile("v_cvt_pk_bf16_f32 %0, %1, %2" : "=v"(r) : "v"(lo), "v"(hi)); return r; }
template <bool F8 = false> DI void partialSM(f32x16& p0, f32x16& p1, float& m_reg, float& mn, float& alpha) {
  constexpr float Cc = SCALE * 1.4426950408889634f;
  float pmax = p0[0];
#pragma unroll
  for (int r = 1; r < 16; ++r) pmax = fmaxf(pmax, p0[r]);
#pragma unroll
  for (int r = 0; r < 16; ++r) pmax = fmaxf(pmax, p1[r]);
  { auto rr = __builtin_amdgcn_permlane32_swap(__float_as_uint(pmax), __float_as_uint(pmax), false, false);
    pmax = fmaxf(__uint_as_float(rr[0]), __uint_as_float(rr[1])); }
  if (__builtin_expect(__all(pmax - m_reg <= (F8 ? 2.5f : THR) / SCALE), 1)) { mn = m_reg; alpha = 1.f; }
  else { mn = fmaxf(m_reg, pmax); alpha = __builtin_amdgcn_exp2f((m_reg - mn) * Cc); m_reg = mn; }
  const float mnC = -mn * Cc + (F8 ? 5.f : 0.f);
#pragma unroll
  for (int r = 0; r < 16; ++r) p0[r] = fmaf(p0[r], Cc, mnC);
#pragma unroll
  for (int r = 0; r < 16; ++r) p1[r] = fmaf(p1[r], Cc, mnC);
#pragma unroll
  for (int r = 0; r < 16; ++r) p0[r] = __builtin_amdgcn_exp2f(p0[r]);
}
DI void finishSM(f32x16& p0, f32x16& p1, float alpha, float& l_reg, bf16x8& pa0, bf16x8& pa1, bf16x8& pa2, bf16x8& pa3) {
#pragma unroll
  for (int r = 0; r < 16; ++r) p1[r] = __builtin_amdgcn_exp2f(p1[r]);
  float ps = 0;
#pragma unroll
  for (int r = 0; r < 16; ++r) ps += p0[r];
#pragma unroll
  for (int r = 0; r < 16; ++r) ps += p1[r];
  { auto rr = __builtin_amdgcn_permlane32_swap(__float_as_uint(ps), __float_as_uint(ps), false, false);
    ps = __uint_as_float(rr[0]) + __uint_as_float(rr[1]); }
  l_reg = l_reg * alpha + ps;
#define PK4(P, BASE, OUT) do { unsigned a0 = cvtpk_asm(P[BASE + 0], P[BASE + 1]), a1 = cvtpk_asm(P[BASE + 2], P[BASE + 3]);   \
    unsigned b0 = cvtpk_asm(P[BASE + 4], P[BASE + 5]), b1 = cvtpk_asm(P[BASE + 6], P[BASE + 7]);                              \
    auto r0 = __builtin_amdgcn_permlane32_swap(a0, b0, false, false); auto r1 = __builtin_amdgcn_permlane32_swap(a1, b1, false, false); \
    u32x4 w = {r0[0], r1[0], r0[1], r1[1]}; OUT = *reinterpret_cast<bf16x8*>(&w); } while (0)
  PK4(p0, 0, pa0); PK4(p0, 8, pa1); PK4(p1, 0, pa2); PK4(p1, 8, pa3);
#undef PK4
}
DI void qkt(f32x16& p0, f32x16& p1, const LAS char* Ks, const bf16x8* qr, int r32, int hi) {
  p0 = f32x16{}; p1 = f32x16{};
#pragma unroll
  for (int d0 = 0; d0 < 8; ++d0) { const int cb = (d0 * 16 + hi * 8) * 2;
    const bf16x8 b0 = *(const LAS bf16x8*)(Ks + KSWZ(r32, cb));
    const bf16x8 b1 = *(const LAS bf16x8*)(Ks + KSWZ(32 + r32, cb));
    p0 = MFMA32(b0, qr[d0], p0);
    p1 = MFMA32(b1, qr[d0], p1); }
}
typedef int i32x8 __attribute__((ext_vector_type(8)));
constexpr size_t SHM_K8 = KVBLK * D;
#define K8SW(row, c) ((row) * 128 + ((((c) ^ (((row) >> 1) & 7))) << 4))
DI void qkt8(f32x16& p0, f32x16& p1, const LAS char* Ks, const i32x8* q8, int r32, int hi) {
  p0 = f32x16{}; p1 = f32x16{};
#pragma unroll
  for (int s2 = 0; s2 < 2; ++s2) { const int c0 = 4 * s2 + 2 * hi;
    const u32x4 a0 = *(const LAS u32x4*)(Ks + K8SW(r32, c0)), a1 = *(const LAS u32x4*)(Ks + K8SW(r32, c0 + 1));
    const u32x4 b0 = *(const LAS u32x4*)(Ks + K8SW(32 + r32, c0)), b1 = *(const LAS u32x4*)(Ks + K8SW(32 + r32, c0 + 1));
    const i32x8 A = {(int)a0.x, (int)a0.y, (int)a0.z, (int)a0.w, (int)a1.x, (int)a1.y, (int)a1.z, (int)a1.w};
    const i32x8 B = {(int)b0.x, (int)b0.y, (int)b0.z, (int)b0.w, (int)b1.x, (int)b1.y, (int)b1.z, (int)b1.w};
    p0 = __builtin_amdgcn_mfma_scale_f32_32x32x64_f8f6f4(A, q8[s2], p0, 0, 0, 0, 0x7f7f7f7f, 0, 0x7f7f7f7f);
    p1 = __builtin_amdgcn_mfma_scale_f32_32x32x64_f8f6f4(B, q8[s2], p1, 0, 0, 0, 0x7f7f7f7f, 0, 0x7f7f7f7f); }
}
constexpr float CQ8 = SCALE * 1.4426950408889634f * 8.f;
constexpr float THRL = 2.5f * 1.4426950408889634f;
DI void qkt8c(f32x16& p0, f32x16& p1, const LAS char* Ks, const i32x8* q8, const f32x16& cinit, int r32, int hi) {
  { const int c0 = 2 * hi;
    const u32x4 a0 = *(const LAS u32x4*)(Ks + K8SW(r32, c0)), a1 = *(const LAS u32x4*)(Ks + K8SW(r32, c0 + 1));
    const u32x4 b0 = *(const LAS u32x4*)(Ks + K8SW(32 + r32, c0)), b1 = *(const LAS u32x4*)(Ks + K8SW(32 + r32, c0 + 1));
    const i32x8 A = {(int)a0.x, (int)a0.y, (int)a0.z, (int)a0.w, (int)a1.x, (int)a1.y, (int)a1.z, (int)a1.w};
    const i32x8 B = {(int)b0.x, (int)b0.y, (int)b0.z, (int)b0.w, (int)b1.x, (int)b1.y, (int)b1.z, (int)b1.w};
    p0 = __builtin_amdgcn_mfma_scale_f32_32x32x64_f8f6f4(A, q8[0], cinit, 0, 0, 0, 0x7f7f7f7f, 0, 0x7c7c7c7c);
    p1 = __builtin_amdgcn_mfma_scale_f32_32x32x64_f8f6f4(B, q8[0], cinit, 0, 0, 0, 0x7f7f7f7f, 0, 0x7c7c7c7c); }
  { const int c0 = 4 + 2 * hi;
    const u32x4 a0 = *(const LAS u32x4*)(Ks + K8SW(r32, c0)), a1 = *(const LAS u32x4*)(Ks + K8SW(r32, c0 + 1));
    const u32x4 b0 = *(const LAS u32x4*)(Ks + K8SW(32 + r32, c0)), b1 = *(const LAS u32x4*)(Ks + K8SW(32 + r32, c0 + 1));
    const i32x8 A = {(int)a0.x, (int)a0.y, (int)a0.z, (int)a0.w, (int)a1.x, (int)a1.y, (int)a1.z, (int)a1.w};
    const i32x8 B = {(int)b0.x, (int)b0.y, (int)b0.z, (int)b0.w, (int)b1.x, (int)b1.y, (int)b1.z, (int)b1.w};
    p0 = __builtin_amdgcn_mfma_scale_f32_32x32x64_f8f6f4(A, q8[1], p0, 0, 0, 0, 0x7f7f7f7f, 0, 0x7c7c7c7c);
    p1 = __builtin_amdgcn_mfma_scale_f32_32x32x64_f8f6f4(B, q8[1], p1, 0, 0, 0, 0x7f7f7f7f, 0, 0x7c7c7c7c); }
}
DI float rowmax32(const f32x16& p0, const f32x16& p1) {
  float pmax = p0[0];
#pragma unroll
  for (int r = 1; r < 16; ++r) pmax = fmaxf(pmax, p0[r]);
#pragma unroll
  for (int r = 0; r < 16; ++r) pmax = fmaxf(pmax, p1[r]);
  auto rr = __builtin_amdgcn_permlane32_swap(__float_as_uint(pmax), __float_as_uint(pmax), false, false);
  return fmaxf(__uint_as_float(rr[0]), __uint_as_float(rr[1]));
}
DI void partialSM8(f32x16& p0, f32x16& p1, float& m_reg, float& alpha, f32x16& cinit) {
  const float pmax = rowmax32(p0, p1);
  if (__builtin_expect(__all(pmax <= 5.f + THRL), 1)) alpha = 1.f;
  else { const float dl = fmaxf(pmax - 5.f, 0.f); alpha = __builtin_amdgcn_exp2f(-dl); m_reg += dl; const float ci = 5.f - m_reg;
#pragma unroll
    for (int r = 0; r < 16; ++r) { p0[r] -= dl; p1[r] -= dl; cinit[r] = ci; } }
#pragma unroll
  for (int r = 0; r < 16; ++r) p0[r] = __builtin_amdgcn_exp2f(p0[r]);
}
DI void firstSM8(f32x16& p0, f32x16& p1, float& m_reg, float& alpha, f32x16& cinit) {
  m_reg = rowmax32(p0, p1); alpha = 1.f; const float ci = 5.f - m_reg;
#pragma unroll
  for (int r = 0; r < 16; ++r) { p0[r] += ci; p1[r] += ci; cinit[r] = ci; }
#pragma unroll
  for (int r = 0; r < 16; ++r) p0[r] = __builtin_amdgcn_exp2f(p0[r]);
}
typedef short s16x2 __attribute__((__vector_size__(2 * sizeof(short))));
constexpr float CQS = SCALE * 1.4426950408889634f * 8.f;
constexpr float THRS = 2.5f * 1.4426950408889634f;
DI void qkt8s(f32x16& p0, f32x16& p1, const LAS char* Ks, const i32x8* q8, int r32, int hi) {
  p0 = f32x16{}; p1 = f32x16{};
#pragma unroll
  for (int s2 = 0; s2 < 2; ++s2) { const int c0 = 4 * s2 + 2 * hi;
    const u32x4 a0 = *(const LAS u32x4*)(Ks + K8SW(r32, c0)), a1 = *(const LAS u32x4*)(Ks + K8SW(r32, c0 + 1));
    const u32x4 b0 = *(const LAS u32x4*)(Ks + K8SW(32 + r32, c0)), b1 = *(const LAS u32x4*)(Ks + K8SW(32 + r32, c0 + 1));
    const i32x8 A = {(int)a0.x, (int)a0.y, (int)a0.z, (int)a0.w, (int)a1.x, (int)a1.y, (int)a1.z, (int)a1.w};
    const i32x8 B = {(int)b0.x, (int)b0.y, (int)b0.z, (int)b0.w, (int)b1.x, (int)b1.y, (int)b1.z, (int)b1.w};
    p0 = __builtin_amdgcn_mfma_scale_f32_32x32x64_f8f6f4(A, q8[s2], p0, 0, 0, 0, 0x7f7f7f7f, 0, 0x7c7c7c7c);
    p1 = __builtin_amdgcn_mfma_scale_f32_32x32x64_f8f6f4(B, q8[s2], p1, 0, 0, 0, 0x7f7f7f7f, 0, 0x7c7c7c7c); }
}
DI void partialSMs(f32x16& p0, f32x16& p1, float& M, float& alpha, float& scl) {
  float pmax = p0[0];
#pragma unroll
  for (int r = 1; r < 16; ++r) pmax = fmaxf(pmax, p0[r]);
#pragma unroll
  for (int r = 0; r < 16; ++r) pmax = fmaxf(pmax, p1[r]);
  { auto rr = __builtin_amdgcn_permlane32_swap(__float_as_uint(pmax), __float_as_uint(pmax), false, false);
    pmax = fmaxf(__uint_as_float(rr[0]), __uint_as_float(rr[1])); }
  if (__builtin_expect(__all(pmax - M <= THRS), 1)) alpha = 1.f;
  else { const float Mn = fmaxf(M, ceilf(pmax)); alpha = __builtin_amdgcn_exp2f(M - Mn); M = Mn; }
  scl = __builtin_amdgcn_exp2f(M - 5.f);
#pragma unroll
  for (int r = 0; r < 16; ++r) p0[r] = __builtin_amdgcn_exp2f(p0[r]);
}
DI int pk4s_fp8(float a, float b, float c, float d, float scl) {
  s16x2 w = __builtin_bit_cast(s16x2, a);
  w = __builtin_amdgcn_cvt_scalef32_pk_fp8_f32(w, a, b, scl, false); w = __builtin_amdgcn_cvt_scalef32_pk_fp8_f32(w, c, d, scl, true);
  return __builtin_bit_cast(int, w);
}
DI void finishSMs(f32x16& p0, f32x16& p1, i32x8& pa, float scl) {
#pragma unroll
  for (int r = 0; r < 16; ++r) p1[r] = __builtin_amdgcn_exp2f(p1[r]);
#pragma unroll
  for (int i = 0; i < 4; ++i) { pa[i] = pk4s_fp8(p0[4 * i], p0[4 * i + 1], p0[4 * i + 2], p0[4 * i + 3], scl); pa[4 + i] = pk4s_fp8(p1[4 * i], p1[4 * i + 1], p1[4 * i + 2], p1[4 * i + 3], scl); }
}
#define V8SW(d, c) ((d) * 64 + ((((c) ^ (((d) >> 2) & 3))) << 4))
DI int pk4_fp8(float a, float b, float c, float d) { int w = 0; w = __builtin_amdgcn_cvt_pk_fp8_f32(a, b, w, false); return __builtin_amdgcn_cvt_pk_fp8_f32(c, d, w, true); }
DI void finishSM8(f32x16& p0, f32x16& p1, i32x8& pa) {
#pragma unroll
  for (int r = 0; r < 16; ++r) p1[r] = __builtin_amdgcn_exp2f(p1[r]);
#pragma unroll
  for (int i = 0; i < 4; ++i) { pa[i] = pk4_fp8(p0[4 * i], p0[4 * i + 1], p0[4 * i + 2], p0[4 * i + 3]); pa[4 + i] = pk4_fp8(p1[4 * i], p1[4 * i + 1], p1[4 * i + 2], p1[4 * i + 3]); }
}
DI void pv8(f32x16* o, f32x16& lacc, const LAS char* Vs, const i32x8 pa, int r32, int hi) {
  { const int one4 = 0x38383838; const i32x8 ones = {one4, one4, one4, one4, one4, one4, one4, one4};
    lacc = __builtin_amdgcn_mfma_scale_f32_32x32x64_f8f6f4(pa, ones, lacc, 0, 0, 0, 0x7f7f7f7f, 0, 0x7f7f7f7f); }
#pragma unroll
  for (int db = 0; db < 4; ++db) { const int d = 32 * db + r32;
    const u32x4 a0 = *(const LAS u32x4*)(Vs + V8SW(d, 2 * hi)), a1 = *(const LAS u32x4*)(Vs + V8SW(d, 2 * hi + 1));
    const i32x8 B = {(int)a0.x, (int)a0.y, (int)a0.z, (int)a0.w, (int)a1.x, (int)a1.y, (int)a1.z, (int)a1.w};
    o[db] = __builtin_amdgcn_mfma_scale_f32_32x32x64_f8f6f4(pa, B, o[db], 0, 0, 0, 0x7f7f7f7f, 0, 0x7f7f7f7f); }
}
DI int v_st(int k, int c) { const int kk = (k & ~0xC) | ((k & 4) << 1) | ((k & 8) >> 1); return ((kk >> 3) * 4 + (c >> 5)) * 512 + ((kk & 7) * 32 + (c & 31)) * 2; }
DI int v_rd_base(int lane) { return ((lane & 3) << 3) | (((lane >> 2) & 3) << 6) | (((lane >> 4) & 1) << 5) | (((lane >> 5) & 1) << 8); }
constexpr int v_rd_off(int d0, int ks, int half) { return d0 * 512 + ks * 4096 + half * 2048; }
template <int OFF> DI s16x4 tr_read(int vb) { s16x4 r; asm volatile("ds_read_b64_tr_b16 %0, %1 offset:%2" : "=&v"(r) : "v"(vb), "i"(OFF) : "memory"); return r; }
template <int D0> DI void pv_one(f32x16& od, int vb, bf16x8 pa0, bf16x8 pa1, bf16x8 pa2, bf16x8 pa3) {
  const s16x4 l0 = tr_read<v_rd_off(D0, 0, 0)>(vb), h0 = tr_read<v_rd_off(D0, 0, 1)>(vb), l1 = tr_read<v_rd_off(D0, 1, 0)>(vb), h1 = tr_read<v_rd_off(D0, 1, 1)>(vb);
  const s16x4 l2 = tr_read<v_rd_off(D0, 2, 0)>(vb), h2 = tr_read<v_rd_off(D0, 2, 1)>(vb), l3 = tr_read<v_rd_off(D0, 3, 0)>(vb), h3 = tr_read<v_rd_off(D0, 3, 1)>(vb);
  asm volatile("s_waitcnt lgkmcnt(0)" ::: "memory"); SBAR();
#define PKV(L, H) (bf16x8){L[0], L[1], L[2], L[3], H[0], H[1], H[2], H[3]}
  od = MFMA32(pa0, PKV(l0, h0), od);
  od = MFMA32(pa1, PKV(l1, h1), od);
  od = MFMA32(pa2, PKV(l2, h2), od);
  od = MFMA32(pa3, PKV(l3, h3), od);
#undef PKV
}
DI void pv_d0(f32x16* o, int vb, bf16x8 pa0, bf16x8 pa1, bf16x8 pa2, bf16x8 pa3) {
  pv_one<0>(o[0], vb, pa0, pa1, pa2, pa3); pv_one<1>(o[1], vb, pa0, pa1, pa2, pa3); pv_one<2>(o[2], vb, pa0, pa1, pa2, pa3); pv_one<3>(o[3], vb, pa0, pa1, pa2, pa3);
}
DI void mask_tail(f32x16& p0, f32x16& p1) {
#pragma unroll
  for (int r = 8; r < 16; ++r) p0[r] = -1e30f;
#pragma unroll
  for (int r = 0; r < 16; ++r) p1[r] = -1e30f;
}
template <int LDO> DI void attn_unit(const bf16* Qb, bf16* Ob, const unsigned char* K8h, const unsigned char* V8h, const bf16* Gb, int nvalid, LAS char* lds) {
  lnd(Qb); lnd(Ob); lnd(K8h); lnd(V8h); lnd(Gb);
  int NT = NT_C; asm volatile("" : "+s"(NT));
  int tid = threadIdx.x; asm volatile("" : "+v"(tid));
  const int wid = tid >> 6, lane = tid & 63, r32 = lane & 31, hi = lane >> 5;
  LAS char* K_lds = lds; LAS char* V_lds = lds + 4 * SHM_K8;
  LAS float* wsf = (LAS float*)(lds + 8 * SHM_K8) + wid * 64; LAS float* li_l = wsf; LAS float* al_l = wsf + 32;
  float m_reg = -1e30f; f32x16 o[4] = {}, lacc = {}; i32x8 qr[2];
  { const bf16* Qw = Qb + (long)(wid * QBLK + r32) * LDQ + hi * 32;
    u32x4 qraw[2][4];
#pragma unroll
    for (int s2 = 0; s2 < 2; ++s2)
#pragma unroll
      for (int c = 0; c < 4; ++c) qraw[s2][c] = *reinterpret_cast<const u32x4*>(Qw + s2 * 64 + c * 8);
#pragma unroll
    for (int s2 = 0; s2 < 2; ++s2)
#pragma unroll
      for (int c = 0; c < 4; ++c) { float f[8]; unpack8(qraw[s2][c], f); int w0 = 0, w1 = 0;
#pragma unroll
        for (int e = 0; e < 8; ++e) f[e] *= CQS;
        w0 = __builtin_amdgcn_cvt_pk_fp8_f32(f[0], f[1], w0, false); w0 = __builtin_amdgcn_cvt_pk_fp8_f32(f[2], f[3], w0, true);
        w1 = __builtin_amdgcn_cvt_pk_fp8_f32(f[4], f[5], w1, false); w1 = __builtin_amdgcn_cvt_pk_fp8_f32(f[6], f[7], w1, true);
        qr[s2][2 * c] = w0; qr[s2][2 * c + 1] = w1; } }
  const unsigned kdo = (unsigned)((tid >> 3) * 256 + (((tid & 7) ^ ((tid >> 4) & 7)) << 4));
  const unsigned vdo = (unsigned)((tid >> 2) * 64 + (((tid & 3) ^ ((tid >> 4) & 3)) << 4));
  const unsigned ldw = (unsigned)(tid >> 6) * 1024u;
#define SDMA(b, k0) do { \
    __builtin_amdgcn_global_load_lds((const unsigned*)(K8h + (long)(k0) * 256 + kdo), (LAS unsigned*)(K_lds + (b) * (int)SHM_K8 + ldw), 16, 0, 0); \
    __builtin_amdgcn_global_load_lds((const unsigned*)(V8h + (long)(k0) * 128 + vdo), (LAS unsigned*)(V_lds + (b) * (int)SHM_K8 + ldw), 16, 0, 0); } while (0)
#define VWAIT(n) asm volatile("s_waitcnt vmcnt(" #n ")" ::: "memory")
#define RESC(a) do { if (__any((a) < 1.f)) { if (hi == 0) al_l[r32] = (a); asm volatile("s_waitcnt lgkmcnt(0)" ::: "memory"); \
    _Pragma("unroll") for (int r = 0; r < 16; ++r) { const float a_ = al_l[crow(r, hi)]; lacc[r] *= a_; _Pragma("unroll") for (int d = 0; d < 4; ++d) o[d][r] *= a_; } } } while (0)
  f32x16 pA0, pA1, pB0, pB1; float alA, alB, sclA = 1.f, sclB = 1.f; i32x8 pa;
  SDMA(0, 0); SDMA(1, KVBLK); VWAIT(0); __syncthreads();
  qkt8s(pA0, pA1, K_lds, qr, r32, hi); partialSMs(pA0, pA1, m_reg, alA, sclA);
  SDMA(2, 2 * KVBLK);
  static_assert((NT_C - 1) % 4 == 0, "tile count vs the 4-tile unroll");
#define ATT_STEP(CUR, PRV, KB, VB, DB, MODE_, T_) do { \
    SBAR(); qkt8s(p##CUR##0, p##CUR##1, K_lds + (KB) * (int)SHM_K8, qr, r32, hi); \
    if ((MODE_) == 2) mask_tail(p##CUR##0, p##CUR##1); \
    finishSMs(p##PRV##0, p##PRV##1, pa, scl##PRV); SBAR(); \
    if ((MODE_) == 0) SDMA((DB), ((T_) + 2) * KVBLK); \
    SBAR(); \
    pv8(o, lacc, V_lds + (VB) * (int)SHM_K8, pa, r32, hi); partialSMs(p##CUR##0, p##CUR##1, m_reg, al##CUR, scl##CUR); \
    RESC(al##CUR); \
    if ((MODE_) == 0) VWAIT(2); else VWAIT(0); \
    __syncthreads(); } while (0)
  int t = 1;
  for (; t + 5 < NT; t += 4) {
    ATT_STEP(B, A, 1, 0, 3, 0, t);
    ATT_STEP(A, B, 2, 1, 0, 0, t + 1);
    ATT_STEP(B, A, 3, 2, 1, 0, t + 2);
    ATT_STEP(A, B, 0, 3, 2, 0, t + 3);
  }
  ATT_STEP(B, A, 1, 0, 3, 0, t);
  ATT_STEP(A, B, 2, 1, 0, 0, t + 1);
  ATT_STEP(B, A, 3, 2, 1, 1, t + 2);
  ATT_STEP(A, B, 0, 3, 2, 2, t + 3);
#undef ATT_STEP
  finishSMs(pA0, pA1, pa, sclA); SBAR();
  pv8(o, lacc, V_lds, pa, r32, hi);
  float rli[16];
#pragma unroll
  for (int r = 0; r < 16; ++r) rli[r] = __builtin_amdgcn_rcpf(lacc[r]);
#pragma unroll
  for (int rb = 0; rb < 16; rb += 8) {
    float gt[8][4];
#pragma unroll
    for (int r = 0; r < 8; ++r) { const int orow = wid * QBLK + crow(rb + r, hi); const bf16* gp = Gb + (long)(orow < nvalid ? orow : 0) * LDG + r32;
      gt[r][0] = bf2f(gp[0]); gt[r][1] = bf2f(gp[32]); gt[r][2] = bf2f(gp[64]); gt[r][3] = bf2f(gp[96]); }
#pragma unroll
    for (int r = 0; r < 8; ++r) { const int orow = wid * QBLK + crow(rb + r, hi);
      if (orow < nvalid) { bf16* qp = Ob + (long)orow * LDO + r32; const float sc_ = rli[rb + r];
        qp[0] = f2bf(o[0][rb + r] * sc_ * gt[r][0]); qp[32] = f2bf(o[1][rb + r] * sc_ * gt[r][1]); qp[64] = f2bf(o[2][rb + r] * sc_ * gt[r][2]); qp[96] = f2bf(o[3][rb + r] * sc_ * gt[r][3]); } }
    asm volatile("" ::: "memory");
  }
  __syncthreads();
#undef SDMA
#undef VWAIT
#undef RESC
}

constexpr int NSEG = 128;
DI void attn_meta_unit(const bf16* YABm, const bf16* Kh, const bf16* Vh, int g, int t0, int t1, float* Pout, float* MLout, LAS char* lds) {
  lnd(YABm); lnd(Kh); lnd(Vh); lnd(Pout); lnd(MLout);
  int tid = threadIdx.x; asm volatile("" : "+v"(tid));
  const int wid = tid >> 6, lane = tid & 63, r32 = lane & 31, hi = lane >> 5;
  LAS char* V_lds = lds; LAS char* K_lds = lds + 2 * SHM_V;
  LAS float* wsf = (LAS float*)(lds + 2 * SHM_V + 2 * SHM_K) + wid * 64; LAS float* al_l = wsf + 32;
  float m_reg = -1e30f, l_reg = 0; f32x16 o[4] = {}; bf16x8 qr[8];
  const int rr = (wid & 1) * 32 + r32, hq = rr >> 4, mt = rr & 15;
  const bf16* Qw = YABm + (long)mt * LDQ + (4 * g + hq) * 128 + hi * 8;
#pragma unroll
  for (int d0 = 0; d0 < 8; ++d0) qr[d0] = *reinterpret_cast<const bf16x8*>(Qw + d0 * 16);
  const int sr = tid >> 4, sc = (tid & 15) * 8, vst0 = v_st(sr, sc), vst1 = v_st(32 + sr, sc);
  const int vb0 = (int)(unsigned)(uintptr_t)V_lds + v_rd_base(lane);
  for (int t = t0; t < t1; ++t) {
    const long k0 = (long)t * KVBLK;
    const bf16x8 vs0 = *(const bf16x8*)(&Vh[(k0 + sr) * LDK + sc]), vs1 = *(const bf16x8*)(&Vh[(k0 + 32 + sr) * LDK + sc]);
    const bf16x8 ks0 = *(const bf16x8*)(&Kh[(k0 + sr) * LDK + sc]), ks1 = *(const bf16x8*)(&Kh[(k0 + 32 + sr) * LDK + sc]);
    *(LAS bf16x8*)(V_lds + vst0) = vs0; *(LAS bf16x8*)(V_lds + vst1) = vs1;
    *(LAS bf16x8*)(K_lds + KSWZ(sr, sc * 2)) = ks0; *(LAS bf16x8*)(K_lds + KSWZ(32 + sr, sc * 2)) = ks1;
    __syncthreads();
    if (wid < 2) {
      f32x16 p0, p1; float mn, al; bf16x8 pa0, pa1, pa2, pa3;
      qkt(p0, p1, K_lds, qr, r32, hi);
      if (t == NT_C - 1) mask_tail(p0, p1);
      partialSM(p0, p1, m_reg, mn, al);
      if (__any(al < 1.f)) { if (hi == 0) al_l[r32] = al; asm volatile("s_waitcnt lgkmcnt(0)" ::: "memory");
#pragma unroll
        for (int d = 0; d < 4; ++d)
#pragma unroll
          for (int r = 0; r < 16; ++r) o[d][r] *= al_l[crow(r, hi)]; }
      finishSM(p0, p1, al, l_reg, pa0, pa1, pa2, pa3); SBAR();
      pv_d0(o, vb0, pa0, pa1, pa2, pa3);
    }
    __syncthreads();
  }
  if (wid < 2) {
    if (hi == 0) { MLout[rr * 2] = m_reg; MLout[rr * 2 + 1] = l_reg; }
#pragma unroll
    for (int r = 0; r < 16; ++r) { const int orow = (wid & 1) * 32 + crow(r, hi);
#pragma unroll
      for (int d0 = 0; d0 < 4; ++d0) Pout[(long)orow * 128 + d0 * 32 + r32] = o[d0][r]; }
  }
  __syncthreads();
}
}

constexpr size_t ATT_PART_OFF = (size_t)20 << 20;
DI void phase_v8_image(const Ctx& C, const bf16* Vb, unsigned char* V8t) {
    const int k = C.lane, blk = k >> 5, wi = k & 31, pos = ((wi >> 2) & 1) * 32 + blk * 16 + (wi >> 3) * 4 + (wi & 3);
    for (int it = C.gw; it < 2 * att::NT_C * 16; it += C.ngw) {
        const int dg = it & 15, tile = (it >> 4) % att::NT_C, g = it / (16 * att::NT_C);
        float f[8]; unpack8(*(const u32x4*)(Vb + (size_t)(tile * 64 + k) * 256 + g * 128 + dg * 8), f);
        unsigned char* dst = V8t + ((size_t)(g * att::NT_C + tile) * 128 + dg * 8) * 64 + pos;
#pragma unroll
        for (int e = 0; e < 8; e += 2) { const int w = __builtin_amdgcn_cvt_pk_fp8_f32(f[e], f[e + 1], 0, false); dst[(e) * 64] = (unsigned char)(w & 255); dst[(e + 1) * 64] = (unsigned char)((w >> 8) & 255); }
    }
}
DI void phase_attention(const Ctx& C, bf16* YAB, const bf16* Kb, const bf16* Vb, const bf16* GA, const unsigned char* K8, const unsigned char* V8t) {
    constexpr int NUNIT = 64 * 8;
    for (int u = C.bid; u < NUNIT; u += C.G) {
        const int h = u & 7, qb = u >> 3, row0 = qb * 256, g = h >> 2;
        #ifdef EXP_ATT2
        att::attn_unit<1024>(YAB + (size_t)row0 * 2048 + h * 128, C.slot(5) + (size_t)row0 * 1024 + h * 128, K8 + g * 128, V8t + (size_t)g * att::NT_C * 8192, GA + (size_t)row0 * 1024 + h * 128, 256, (LAS char*)C.lds);
#endif
        att::attn_unit<2048>(YAB + (size_t)row0 * 2048 + h * 128, YAB + (size_t)row0 * 2048 + h * 128, K8 + g * 128, V8t + (size_t)g * att::NT_C * 8192, GA + (size_t)row0 * 1024 + h * 128, 256, (LAS char*)C.lds);
    }
    float* P = (float*)((unsigned char*)C.slot(6) + ATT_PART_OFF); float* ML = P + (size_t)2 * att::NSEG * 64 * 128;
#ifdef DBL_META
    for (int u = C.bid; u < 2 * att::NSEG; u += C.G) {
        const int g = u & 1, seg = u >> 1, t0 = 2 * seg, t1 = (seg == att::NSEG - 1) ? att::NT_C : 2 * seg + 2;
        att::attn_meta_unit(YAB + (size_t)SEQ * 2048, Kb + g * 128, Vb + g * 128, g, t0, t1, P + (size_t)u * 64 * 128, ML + (size_t)u * 128, (LAS char*)C.lds);
    }
#endif
    for (int u = C.bid; u < 2 * att::NSEG; u += C.G) {
        const int g = u & 1, seg = u >> 1, t0 = 2 * seg, t1 = (seg == att::NSEG - 1) ? att::NT_C : 2 * seg + 2;
        att::attn_meta_unit(YAB + (size_t)SEQ * 2048, Kb + g * 128, Vb + g * 128, g, t0, t1, P + (size_t)u * 64 * 128, ML + (size_t)u * 128, (LAS char*)C.lds);
    }
}
DI void phase_attention_combine(const Ctx& C, bf16* YAB, const bf16* GA) {
    const float* P = (const float*)((unsigned char*)C.slot(6) + ATT_PART_OFF); const float* ML = P + (size_t)2 * att::NSEG * 64 * 128;
    constexpr float Cc = att::SCALE * 1.4426950408889634f;
    LAS float* X = (LAS float*)C.lds;
    for (int it = C.bid; it < 128; it += C.G) {
        const int mt = it & 15, h = it >> 4, g = h >> 2, hq = h & 3, rr = hq * 16 + mt, w = C.wave, lane = C.lane;
        float M = -1e30f;
#pragma unroll
        for (int s = 0; s < 16; ++s) M = fmaxf(M, ML[(size_t)((16 * w + s) * 2 + g) * 128 + rr * 2]);
        float a0 = 0.f, a1 = 0.f, l = 0.f;
#pragma unroll 4
        for (int s = 0; s < 16; ++s) { const size_t u = (size_t)((16 * w + s) * 2 + g); const float wt = __builtin_amdgcn_exp2f((ML[u * 128 + rr * 2] - M) * Cc);
            l += ML[u * 128 + rr * 2 + 1] * wt; a0 += P[(u * 64 + rr) * 128 + lane] * wt; a1 += P[(u * 64 + rr) * 128 + 64 + lane] * wt; }
        X[w * 130 + lane] = a0; X[w * 130 + 64 + lane] = a1; if (lane == 0) { X[w * 130 + 128] = l; X[w * 130 + 129] = M; }
        __syncthreads();
        if (w == 0) {
            float Mg = -1e30f;
#pragma unroll
            for (int ww = 0; ww < 8; ++ww) Mg = fmaxf(Mg, X[ww * 130 + 129]);
            float b0 = 0.f, b1 = 0.f, lg = 0.f;
#pragma unroll
            for (int ww = 0; ww < 8; ++ww) { const float wt = __builtin_amdgcn_exp2f((X[ww * 130 + 129] - Mg) * Cc); lg += X[ww * 130 + 128] * wt; b0 += X[ww * 130 + lane] * wt; b1 += X[ww * 130 + 64 + lane] * wt; }
            const float inv = 1.f / lg; const size_t row = SEQ + mt;
            YAB[row * 2048 + h * 128 + lane] = f2bf(b0 * inv * bf2f(GA[row * 1024 + h * 128 + lane]));
            YAB[row * 2048 + h * 128 + 64 + lane] = f2bf(b1 * inv * bf2f(GA[row * 1024 + h * 128 + 64 + lane]));
        }
        __syncthreads();
    }
}

constexpr int S5_NCH = 1025;
DI int s5_row0(int c) { return c == 0 ? SEQ : 16 * (c - 1); }
DI void cis_rev(float ang, float& c, float& s) { float rev = ang * 0.15915494309189535f; rev -= rintf(rev); c = __builtin_amdgcn_cosf(rev); s = __builtin_amdgcn_sinf(rev); }

DI void phase_s5_tables(const Ctx& C, int li) {
    f32x2* apow = (f32x2*)(C.dob + DO_APOW); f32x2* bb = (f32x2*)(C.dob + DO_BB);
    for (int i = C.gw * 64 + C.lane; i < 2 * 64 * 64; i += C.ngw * 64) {
        const int d = i >> 12, g = (i >> 6) & 63;
        const size_t pidx = (size_t)li * 2 * 64 * 64 + i;
        const float ar = C.in[I_ARE][pidx], ai = C.in[I_AIM][pidx];
        const float dt = fexp(C.in[I_LDT][(size_t)li * 128 + d * 64 + g]);
#pragma unroll 1
        for (int e = 0; e <= 16; ++e) { float c, s; cis_rev((float)e * ai * dt, c, s); const float mg = fexp((float)e * ar * dt); apow[(size_t)i * 17 + e] = (f32x2){mg * c, mg * s}; }
        float c1, s1; cis_rev(ai * dt, c1, s1); const float m1 = fexp(ar * dt);
        const float xr = m1 * c1 - 1.f, xi = m1 * s1, inv = 1.f / (ar * ar + ai * ai);
        const float kr = (xr * ar + xi * ai) * inv, ki = (xi * ar - xr * ai) * inv;
        const float* bre = C.in[I_BRE] + pidx * 16; const float* bim = C.in[I_BIM] + pidx * 16;
#pragma unroll 4
        for (int p = 0; p < 16; ++p) { const float br = bre[p], bi = bim[p]; bb[(size_t)i * 16 + p] = (f32x2){kr * br - ki * bi, kr * bi + ki * br}; }
    }
}
DI void phase_s5_ktab_hcat(const Ctx& C, int li) {
    const f32x2* apow = (const f32x2*)(C.dob + DO_APOW); const f32x2* bb = (const f32x2*)(C.dob + DO_BB);
    float* ktab = (float*)(C.dob + DO_KTAB); bf16* hcat = (bf16*)(C.dob + DO_HCAT);
    const bool half_grid = C.G == 256;
    for (int task = half_grid ? ((C.bid >= 128 && C.wave < 4) ? (C.bid - 128) * 4 + C.wave : 512) : C.gws; task < 512; task += half_grid ? 512 : C.ngw) {
        const int dg = task >> 2, dl = (task & 3) * 4 + (C.lane >> 4), q = C.lane & 15;
        const float* cre = C.in[I_CRE] + ((size_t)li * 128 + dg) * 1024; const float* cim = C.in[I_CIM] + ((size_t)li * 128 + dg) * 1024;
        float acc[16];
#pragma unroll
        for (int p = 0; p < 16; ++p) acc[p] = 0.f;
#pragma unroll 4
        for (int n = 0; n < 64; ++n) { const f32x2 a = apow[((size_t)dg * 64 + n) * 17 + dl], b = bb[((size_t)dg * 64 + n) * 16 + q];
            const float wr = a.x * b.x - a.y * b.y, wi = a.x * b.y + a.y * b.x;
#pragma unroll
            for (int p = 0; p < 16; ++p) acc[p] += cre[p * 64 + n] * wr - cim[p * 64 + n] * wi; }
#pragma unroll
        for (int p = 0; p < 16; ++p) ktab[(((size_t)dg * 16 + dl) * 16 + p) * 16 + q] = acc[p];
    }
    for (int i = C.gw * 64 + C.lane; i < 64 * 256 * 32; i += C.ngw * 64) {
        const int k8 = i & 31, rho = (i >> 5) & 255, g = i >> 13;
        const int d = rho >> 7, n = (rho >> 1) & 63, ri = rho & 1, s = k8 >> 1, q0 = (k8 & 1) * 8;
        const size_t dgn = ((size_t)d * 64 + g) * 64 + n;
        const f32x2 a = apow[dgn * 17 + (d == 0 ? 15 - s : s)];
        float o[8];
#pragma unroll
        for (int j = 0; j < 8; ++j) { const f32x2 b = bb[dgn * 16 + q0 + j]; o[j] = ri ? (a.x * b.y + a.y * b.x) : (a.x * b.x - a.y * b.y); }
        *(u32x4*)(hcat + ((size_t)g * 256 + rho) * 256 + k8 * 8) = pack8(o);
    }
}
DI void phase_s5_mg(const Ctx& C, int li) {
    const f32x2* apow = (const f32x2*)(C.dob + DO_APOW); const float* ktab = (const float*)(C.dob + DO_KTAB); bf16* mg = (bf16*)(C.dob + DO_MG);
    const float* dsk = C.in[I_SSMD] + (size_t)li * 1024;
    for (int i = C.gw * 64 + C.lane; i < 64 * 256 * 32; i += C.ngw * 64) {
        const int k8 = i & 31, tp = (i >> 5) & 255, g = i >> 13, t = tp >> 4, p = tp & 15, s = k8 >> 1, q0 = (k8 & 1) * 8;
        f32x4 v0 = {0.f, 0.f, 0.f, 0.f}, v1 = v0;
        if (s <= t) { const float* kp = ktab + ((((size_t)0 * 64 + g) * 16 + (t - s)) * 16 + p) * 16 + q0; v0 += *(const f32x4*)kp; v1 += *(const f32x4*)(kp + 4); }
        if (s >= t) { const float* kp = ktab + ((((size_t)1 * 64 + g) * 16 + (s - t)) * 16 + p) * 16 + q0; v0 += *(const f32x4*)kp; v1 += *(const f32x4*)(kp + 4); }
        float o[8];
#pragma unroll
        for (int j = 0; j < 4; ++j) { o[j] = v0[j]; o[4 + j] = v1[j]; }
        if (s == t) { const float dd = dsk[g * 16 + p];
#pragma unroll
            for (int j = 0; j < 8; ++j) o[j] += (p == q0 + j) ? dd : 0.f; }
        *(u32x4*)(mg + ((size_t)g * 256 + tp) * 512 + k8 * 8) = pack8(o);
    }
    for (int i = C.gw * 64 + C.lane; i < 64 * 256 * 32; i += C.ngw * 64) {
        const int k8 = i & 31, tp = (i >> 5) & 255, g = i >> 13, t = tp >> 4, p = tp & 15;
        const int rho0 = k8 * 8, d = rho0 >> 7, n0 = (rho0 >> 1) & 63; const size_t dg = (size_t)d * 64 + g;
        const float* cre = C.in[I_CRE] + (((size_t)li * 2 * 64 + dg) * 16 + p) * 64; const float* cim = C.in[I_CIM] + (((size_t)li * 2 * 64 + dg) * 16 + p) * 64;
        const int e = d == 0 ? t + 1 : 16 - t;
        const f32x4 cr = *(const f32x4*)(cre + n0), ci = *(const f32x4*)(cim + n0);
        float o[8];
#pragma unroll
        for (int m = 0; m < 4; ++m) { const f32x2 a = apow[(dg * 64 + n0 + m) * 17 + e];
            o[2 * m] = cr[m] * a.x - ci[m] * a.y; o[2 * m + 1] = -(cr[m] * a.y + ci[m] * a.x); }
        *(u32x4*)(mg + ((size_t)g * 256 + tp) * 512 + 256 + k8 * 8) = pack8(o);
    }
}
DI bf16x8 s5_ufrag(const bf16* U, int g, int c0, int kstep, int lane) {
    int c = c0 + (lane & 15); if (c >= S5_NCH) c = S5_NCH - 1;
    const int s = kstep * 2 + (lane >> 5), q0 = ((lane >> 4) & 1) * 8;
    return *(const bf16x8*)(U + ((size_t)g * LTOK + 16 * c + s) * 16 + q0);
}
DI void phase_s5_local(const Ctx& C, const bf16* U) {
    const bf16* hcat = (const bf16*)(C.dob + DO_HCAT); bf16* ex = (bf16*)(C.dob + DO_EX);
    const int i16 = C.lane & 15, q4 = C.lane >> 4;
    for (int task = C.gw; task < 2048; task += C.ngw) {
        const int qu = task & 3, rr = (task >> 2) & 7, g = task >> 5;
        bf16x8 af[4][8];
#pragma unroll
        for (int m = 0; m < 4; ++m)
#pragma unroll
            for (int ks = 0; ks < 8; ++ks) af[m][ks] = *(const bf16x8*)(hcat + ((size_t)g * 256 + qu * 64 + m * 16 + i16) * 256 + ks * 32 + q4 * 8);
        for (int blk = rr; blk < 65; blk += 8) {
            const int c0 = blk * 16;
            f32x4 acc[4];
#pragma unroll
            for (int m = 0; m < 4; ++m) acc[m] = (f32x4){0.f, 0.f, 0.f, 0.f};
#pragma unroll
            for (int ks = 0; ks < 8; ++ks) { const bf16x8 b = s5_ufrag(U, g, c0, ks, C.lane);
#pragma unroll
                for (int m = 0; m < 4; ++m) acc[m] = MFMA16(af[m][ks], b, acc[m]); }
            const int c = c0 + i16;
            if (c < S5_NCH) {
#pragma unroll
                for (int m = 0; m < 4; ++m) { u32x2 w; w.x = cvt_pk_bf16(acc[m][0], acc[m][1]); w.y = cvt_pk_bf16(acc[m][2], acc[m][3]);
                    *(u32x2*)(ex + ((size_t)c * 64 + g) * 256 + qu * 64 + m * 16 + q4 * 4) = w; } }
        }
    }
}
template <bool DUMMY = false> DI void phase_s5_scan(const Ctx& C) {
    const f32x2* apow = (const f32x2*)(C.dob + DO_APOW); unsigned* ex = DUMMY ? (unsigned*)C.slot(1) : (unsigned*)(C.dob + DO_EX);
    if (C.gws >= 128) return;
    const int ch = C.gws * 64 + C.lane;
    const int g = ch >> 7, d = (ch >> 6) & 1, n = ch & 63;
    const f32x2 a16 = apow[(((size_t)d * 64 + g) * 64 + n) * 17 + 16];
    float xr = 0.f, xi = 0.f;
    unsigned* p = ex + ((size_t)g * 128 + d * 64 + n) + (d == 0 ? (size_t)0 : (size_t)(S5_NCH - 1) * 8192);
    const long step = d == 0 ? 8192 : -8192;
    unsigned w[41], wn[41];
#pragma unroll
    for (int j = 0; j < 41; ++j) w[j] = p[(long)j * step];
    for (int i = 0; i < S5_NCH; i += 41) {
        if (i + 41 < S5_NCH) {
#pragma unroll
            for (int j = 0; j < 41; ++j) wn[j] = p[(long)(41 + j) * step];
        }
#pragma unroll
        for (int j = 0; j < 41; ++j) { const float er = bflo(w[j]), ei = bfhi(w[j]);
            p[(long)j * step] = cvt_pk_bf16(xr, xi);
            const float nr = a16.x * xr - a16.y * xi + er, ni = a16.x * xi + a16.y * xr + ei; xr = nr; xi = ni; }
#pragma unroll
        for (int j = 0; j < 41; ++j) w[j] = wn[j];
        p += 41 * step;
    }
}
DI void phase_s5_out(const Ctx& C, const bf16* U, bf16* YG) {
    const bf16* mg = (const bf16*)(C.dob + DO_MG); const bf16* ex = (const bf16*)(C.dob + DO_EX);
    const int i16 = C.lane & 15, q4 = C.lane >> 4, w = C.wave;
    LAS bf16x8* Bst = (LAS bf16x8*)C.lds;
    for (int wt = C.bid; wt < 256; wt += C.G) {
        const int yy = wt >> 3, rr = yy & 3, g = ((wt & 7) * 2 + (yy >> 4)) * 4 + ((yy >> 2) & 3), e8 = w;
        bf16x8 af[2][16];
#pragma unroll
        for (int m = 0; m < 2; ++m)
#pragma unroll
            for (int ks = 0; ks < 16; ++ks) af[m][ks] = *(const bf16x8*)(mg + ((size_t)g * 256 + e8 * 32 + m * 16 + i16) * 512 + ks * 32 + q4 * 8);
#define S5O_LD(dst0, dst1, c0_) do { if (w < 4) { dst0 = s5_ufrag(U, g, (c0_), 2 * w, C.lane); dst1 = s5_ufrag(U, g, (c0_), 2 * w + 1, C.lane); } \
            else { int cc_ = (c0_) + i16; if (cc_ >= S5_NCH) cc_ = S5_NCH - 1; const bf16* xp_ = ex + ((size_t)cc_ * 64 + g) * 256 + (2 * w - 8) * 32 + q4 * 8; \
                dst0 = *(const bf16x8*)xp_; dst1 = *(const bf16x8*)(xp_ + 32); } } while (0)
#define S5O_BLOCK(BUF_, RS0_, RS1_, RL0_, RL1_) do { const int c0 = blk * 16; \
            if (blk + 8 < 65) S5O_LD(RL0_, RL1_, c0 + 128); \
            f32x4 acc[2]; acc[0] = (f32x4){0.f, 0.f, 0.f, 0.f}; acc[1] = acc[0]; \
            _Pragma("unroll") for (int ks = 0; ks < 16; ++ks) { const bf16x8 b = Bst[((BUF_) * 16 + ks) * 64 + C.lane]; \
                acc[0] = MFMA16(af[0][ks], b, acc[0]); acc[1] = MFMA16(af[1][ks], b, acc[1]); } \
            const int c = c0 + i16; \
            if (c < S5_NCH) { \
                _Pragma("unroll") for (int m = 0; m < 2; ++m) { const int tp = e8 * 32 + m * 16 + q4 * 4, t = tp >> 4, p = tp & 15; \
                    u32x2 wv; wv.x = cvt_pk_bf16(gelu_tanh_f(acc[m][0]), gelu_tanh_f(acc[m][1])); wv.y = cvt_pk_bf16(gelu_tanh_f(acc[m][2]), gelu_tanh_f(acc[m][3])); \
                    *(u32x2*)(YG + (size_t)(s5_row0(c) + t) * 1024 + g * 16 + p) = wv; } } \
            if (blk + 4 < 65) { Bst[(((BUF_) ^ 1) * 16 + 2 * w) * 64 + C.lane] = RS0_; Bst[(((BUF_) ^ 1) * 16 + 2 * w + 1) * 64 + C.lane] = RS1_; } \
            __syncthreads(); } while (0)
        bf16x8 a0, a1, b0, b1;
        S5O_LD(a0, a1, rr * 16);
        Bst[(2 * w) * 64 + C.lane] = a0; Bst[(2 * w + 1) * 64 + C.lane] = a1;
        S5O_LD(a0, a1, rr * 16 + 64);
        __syncthreads();
        for (int blk = rr; blk < 65; blk += 8) {
            S5O_BLOCK(0, a0, a1, b0, b1);
            blk += 4;
            if (blk < 65) S5O_BLOCK(1, b0, b1, a0, a1);
            blk -= 4;
        }
#undef S5O_BLOCK
#undef S5O_LD
    }
}

DI int seq_of_row(int r) { return r < SEQ ? r + 16 : r - SEQ; }
DI int row_of_seq(int l) { return l < 16 ? SEQ + l : l - 16; }
DI void phase_conv(const Ctx& C, const bf16* XM, bf16* XC, const float* cw, const float* cb) {
    const int nitems = (LTOK / 8) * 256;
    for (int it = C.gw * 64 + C.lane; it < nitems; it += C.ngw * 64) {
        const int l0 = (it >> 8) * 8, c0 = (it & 255) * 8;
        float w[5][8], bias[8];
        { const f32x4 b0 = *(const f32x4*)(cb + c0), b1 = *(const f32x4*)(cb + c0 + 4);
#pragma unroll
          for (int e = 0; e < 4; ++e) { bias[e] = b0[e]; bias[4 + e] = b1[e]; } }
#pragma unroll
        for (int j = 0; j < 5; ++j) { const f32x4 w0 = *(const f32x4*)(cw + (size_t)j * 2048 + c0), w1 = *(const f32x4*)(cw + (size_t)j * 2048 + c0 + 4);
#pragma unroll
            for (int e = 0; e < 4; ++e) { w[j][e] = w0[e]; w[j][4 + e] = w1[e]; } }
        u32x4 xr[12];
#pragma unroll
        for (int r = 0; r < 12; ++r) { const int l2 = l0 + r - 2; xr[r] = (l2 >= 0 && l2 < LTOK) ? *(const u32x4*)(XM + (size_t)row_of_seq(l2) * 2048 + c0) : (u32x4){0u, 0u, 0u, 0u}; }
#pragma unroll
        for (int o = 0; o < 8; ++o) { float acc[8];
#pragma unroll
            for (int e = 0; e < 8; ++e) acc[e] = bias[e];
#pragma unroll
            for (int j = 0; j < 5; ++j) { float x[8]; unpack8(xr[o + j], x);
#pragma unroll
                for (int e = 0; e < 8; ++e) acc[e] += w[j][e] * x[e]; }
            float ov[8];
#pragma unroll
            for (int e = 0; e < 8; ++e) ov[e] = silu_f(acc[e]);
            *(u32x4*)(XC + (size_t)row_of_seq(l0 + o) * 2048 + c0) = pack8(ov); }
    }
}
DI int pos_of_row(int r) { return r < SEQ ? r + 64 : r - SEQ + 48; }
DI int row_of_pos(int pos) { return pos >= 64 ? pos - 64 : (pos >= 48 ? SEQ + pos - 48 : -1); }
DI float log_sigmoid_f(float x) { return fminf(x, 0.f) - __logf(1.f + __expf(-fabsf(x))); }
DI void phase_gates(const Ctx& C, const bf16* XC, const bf16* WG, const float* big, const float* bfg) {
    float* GA = (float*)(C.misc() + MS_GI); float* GCM = (float*)(C.misc() + MS_GF); float* GB = (float*)(C.misc() + MS_GB);
    const int lane = C.lane, r32 = lane & 31, hi = lane >> 5, w = C.wave, tid = C.tid;
    LAS float* P = (LAS float*)C.lds;
    LAS float* G = (LAS float*)(C.lds + 65536);
    for (int c = C.bid; c < 257; c += C.G) {
        const int rbase = c == 0 ? SEQ - 48 : 64 * (c - 1);
        const bf16* bp = WG + (size_t)r32 * 2048 + w * 256 + hi * 8;
#pragma unroll
        for (int j = 0; j < 2; ++j) {
            if (c == 0 && j == 0) continue;
            const bf16* ap = XC + (size_t)(rbase + 32 * j + r32) * 2048 + w * 256 + hi * 8;
            f32x16 acc = {};
#pragma unroll
            for (int k0 = 0; k0 < 256; k0 += 16) acc = MFMA32(*(const bf16x8*)(ap + k0), *(const bf16x8*)(bp + k0), acc);
#pragma unroll
            for (int r = 0; r < 16; ++r) { const int p = 32 * j + (r & 3) + 8 * (r >> 2) + 4 * hi; P[(w * 64 + p) * 32 + r32] = acc[r]; }
        }
        __syncthreads();
#pragma unroll
        for (int e = 0; e < 4; ++e) { const int idx = tid + 512 * e, p = idx >> 5, n = idx & 31; float v = 0.f;
#pragma unroll
            for (int ww = 0; ww < 8; ++ww) v += P[(ww * 64 + p) * 32 + n];
            const int ty = n >> 4; v += (ty ? bfg : big)[n & 15];
            v = ty ? log_sigmoid_f(v) : v; if (c == 0 && p < 48) v = ty ? 0.f : -1e9f;
            G[p * 33 + n] = v; }
        __syncthreads();
#pragma unroll 1
        for (int q = 0; q < 2; ++q) { const int dh = 2 * w + q, d = dh >> 3;
            const float li = G[lane * 33 + dh], lf = G[lane * 33 + 16 + dh];
            float b = lf;
#pragma unroll
            for (int o = 1; o < 64; o <<= 1) { const float x = shf(b, d == 0 ? lane - o : lane + o); const bool ok = d == 0 ? (lane >= o) : (lane + o < 64); b += ok ? x : 0.f; }
            const float a = li - b; float cm = a;
#pragma unroll
            for (int o = 1; o < 64; o <<= 1) { const float x = shf(cm, d == 0 ? lane - o : lane + o); const bool ok = d == 0 ? (lane >= o) : (lane + o < 64); cm = ok ? fmaxf(cm, x) : cm; }
            const size_t idx = (size_t)dh * NPOS + 64 * c + lane;
            GA[idx] = a; GCM[idx] = cm; GB[idx] = b; }
        __syncthreads();
    }
}
DI void phase_cell_merge(const Ctx& C, bf16* CELL, bf16* CELLM, const bf16* V2, const bf16* VM2, bf16* dummy = nullptr) {
    float* rstd = (float*)(C.misc() + MS_RSTD);
    const int sub = C.lane & 31, half = C.lane >> 5;
    constexpr int NIT = LTOK * 8;
    for (int it = C.gw * 2; it < NIT; it += C.ngw * 4) {
        int idx[2]; bf16* p[2]; u32x4 wa[2], wb[2];
#pragma unroll
        for (int k = 0; k < 2; ++k) { int i = it + half + k * C.ngw * 2; if (i >= NIT) i = NIT - 1; idx[k] = i; const int row = i >> 3, h = i & 7;
            const size_t off = (size_t)(row < SEQ ? row : row - SEQ) * 2048 + h * 256 + sub * 8;
            p[k] = (row < SEQ ? CELL : CELLM) + off; wa[k] = *(const u32x4*)p[k]; wb[k] = *(const u32x4*)((row < SEQ ? V2 : VM2) + off); }
#pragma unroll
        for (int k = 0; k < 2; ++k) { float a[8], b[8]; unpack8(wa[k], a); unpack8(wb[k], b); float s = 0.f;
#pragma unroll
            for (int e = 0; e < 8; ++e) a[e] += b[e];
            const u32x4 w = pack8(a); unpack8(w, a);
#pragma unroll
            for (int e = 0; e < 8; ++e) s += a[e] * a[e];
            const bool live = (k == 0) || (it + half + C.ngw * 2 < NIT);
            if (live) *(u32x4*)(dummy ? dummy + ((size_t)idx[k] * 256 + sub * 8) % ((size_t)16 << 20) : p[k]) = w;
            s += shx(s, 1, C.lane); s += shx(s, 2, C.lane); s += shx(s, 4, C.lane); s += shx(s, 8, C.lane); s += shx(s, 16, C.lane);
            if (sub == 0 && live) rstd[idx[k]] = rsqrtf(s * (1.f / 256.f) + EPS); }
    }
}

namespace ml {
constexpr int TILE = 44032;
constexpr int QS = 0, KS = 17408, VT = 34816, VTW = 39424, NXB = 2 * TILE, NXSZ = 17408, NIB = NXB + 2 * NXSZ, NISZ = 8704, SC = NIB + 2 * NISZ, LDS_END = SC + 4 * 1536;
constexpr int SC_A = 0, SC_M = 256, SC_ISC = 512, SC_FLO = 768, SC_W = 1024, SC_DEC = 1280, SC_STRIDE = 1536;
constexpr float QSCALE = 0.08838834764831845f;
DI s16x4 trr(unsigned addr) { s16x4 r; asm volatile("ds_read_b64_tr_b16 %0, %1" : "=&v"(r) : "v"(addr) : "memory"); return r; }
template <int OFF> DI s16x4 trro(unsigned base) { s16x4 r; asm volatile("ds_read_b64_tr_b16 %0, %1 offset:%2" : "=&v"(r) : "v"(base), "i"(OFF) : "memory"); return r; }
static_assert(LDS_END <= LDS_MISC, "mLSTM LDS map");
}
constexpr int CW_PROG = 12288;
DI void phase_mlstm(const Ctx& C, int epoch, const bf16* Q, const bf16* K, bf16* V, bf16* VM, bf16* CELL, bf16* CELLM, bf16* V2d, bf16* VM2d) {
    using namespace ml;
    const float* GA = (const float*)(C.misc() + MS_GI); const float* GCM = (const float*)(C.misc() + MS_GF); const float* GB = (const float*)(C.misc() + MS_GB); const bf16* ZR = (const bf16*)(C.misc() + MS_ZROW);
    unsigned* prog = (unsigned*)(C.misc() + MS_CTL) + CW_PROG;
    const int w = C.wave, tid = C.tid, lane = C.lane, i16 = lane & 15, q4 = lane >> 4;
    const bool intra = w < 4; const int be = w & 1, eta = (w >> 1) & 1;
    LAS unsigned char* L = C.lds;
    for (int unit = C.bid; unit < 256; unit += C.G) {
        const int h = unit & 7, sl = (unit >> 3) & 15, d = unit >> 7;
        const int lo_ = d == 0 ? w : 3 - w;
        unsigned* prog_me = prog + unit * 16; unsigned* prog_pa = prog + (unit ^ 128) * 16;
        const float* ga = GA + (size_t)(d * 8 + h) * NPOS; const float* gcm = GCM + (size_t)(d * 8 + h) * NPOS; const float* gb = GB + (size_t)(d * 8 + h) * NPOS;
        for (int i = tid; i < 2 * 16 * 72; i += NTHR) { const int b = i / (16 * 72), r = i % (16 * 72), v = 16 + r / 72, s = r % 72;
            ((LAS bf16*)(L + b * TILE + VT))[v * 72 + s] = (v == 16) ? (bf16)0x3f80 : (bf16)0; ((LAS bf16*)(L + b * TILE + VTW))[v * 72 + s] = 0; }
        f32x4 Cs0 = {0.f, 0.f, 0.f, 0.f}, Cs1 = Cs0, Cs2 = Cs0, Cs3 = Cs0;
        float m_prev = 0.f;
        u32x4 pq0, pq1, pk0, pk1, pv;
        float g1a = 0.f, g1cm = 0.f, g1b = 0.f;
        const unsigned oq0_ = (unsigned)((tid >> 4) * 1024 + h * 128 + (tid & 15) * 8), oq1_ = oq0_ + 32u * 1024u;
        const unsigned ov_ = (unsigned)(((tid & 127) >> 1) * 2048 + h * 256 + sl * 16 + (tid & 1) * 8);
#define ML_LOADQK(j, PQ, PK, cs_) do { const int p_ = tid + 512 * (j), t_ = p_ >> 4, c8_ = (p_ & 15) * 8; const bool z_ = t_ < 48; \
            const unsigned of_ = z_ ? (unsigned)c8_ : (unsigned)((SEQ + t_ - 48) * 1024 + h * 128 + c8_); \
            PQ = *(const u32x4*)((z_ ? ZR : Q) + of_); PK = *(const u32x4*)((z_ ? ZR : K) + of_); } while (0)
#define ML_LOAD(cs_) do { if ((cs_) == 0) { ML_LOADQK(0, pq0, pk0, 0); ML_LOADQK(1, pq1, pk1, 0); \
              { const int t_ = (tid & 127) >> 1, c8_ = (tid & 1) * 8; const bool z_ = t_ < 48; const unsigned of_ = z_ ? (unsigned)c8_ : (unsigned)((t_ - 48) * 2048 + h * 256 + sl * 16 + c8_); \
                pv = *(const u32x4*)((z_ ? ZR : (const bf16*)VM) + of_); } } \
            else { const bf16* Qc_ = Q + (size_t)((cs_) - 1) * 65536; const bf16* Kc_ = K + (size_t)((cs_) - 1) * 65536; const bf16* Vc_ = (const bf16*)V + (size_t)((cs_) - 1) * 131072; \
              pq0 = *(const u32x4*)(Qc_ + oq0_); pk0 = *(const u32x4*)(Kc_ + oq0_); pq1 = *(const u32x4*)(Qc_ + oq1_); pk1 = *(const u32x4*)(Kc_ + oq1_); pv = *(const u32x4*)(Vc_ + ov_); } } while (0)
#define ML_SCALARS(a_, cm_, b_, slot_) do { \
            const float cm_all_ = __int_as_float(__builtin_amdgcn_readlane(__float_as_int(cm_), d == 0 ? 63 : 0)), b_last_ = __int_as_float(__builtin_amdgcn_readlane(__float_as_int(b_), d == 0 ? 63 : 0)); \
            const float M_ = fmaxf((cm_), m_prev), Mst_ = fmaxf(cm_all_, m_prev); \
            LAS float* S_ = (LAS float*)(L + SC) + (slot_) * (SC_STRIDE / 4); \
            S_[SC_A / 4 + lane] = (a_) * 1.4426950408889634f; S_[SC_M / 4 + lane] = M_ * 1.4426950408889634f + 3.5f;     S_[SC_ISC / 4 + lane] = __expf(m_prev - M_) * QSCALE; S_[SC_FLO / 4 + lane] = __expf(-(b_) - M_); \
            S_[SC_W / 4 + lane] = __expf((a_) - Mst_); if (lane == 0) S_[SC_DEC / 4] = __expf(m_prev - Mst_); \
            m_prev = b_last_ + Mst_; } while (0)
#define ML_CS(i_) (d == 0 ? (i_) : 256 - (i_))
#define ML_BAR() do { asm volatile("s_waitcnt lgkmcnt(0)" ::: "memory"); __builtin_amdgcn_s_barrier(); asm volatile("" ::: "memory"); } while (0)
#define ML_STAGE(st_) do { LAS unsigned char* T_ = L + ((st_) & 1) * TILE; const LAS float* Sw_ = (const LAS float*)(L + SC) + ((st_) & 3) * (SC_STRIDE / 4) + SC_W / 4; \
            { const int p_ = tid, t_ = p_ >> 4, c8_ = (p_ & 15) * 8; *(LAS u32x4*)((LAS bf16*)(T_ + QS) + t_ * 136 + c8_) = pq0; *(LAS u32x4*)((LAS bf16*)(T_ + KS) + t_ * 136 + c8_) = pk0; } \
            { const int p_ = tid + 512, t_ = p_ >> 4, c8_ = (p_ & 15) * 8; *(LAS u32x4*)((LAS bf16*)(T_ + QS) + t_ * 136 + c8_) = pq1; *(LAS u32x4*)((LAS bf16*)(T_ + KS) + t_ * 136 + c8_) = pk1; } \
            if (intra && lo_ < 2) { const int t_ = (tid & 127) >> 1, c8_ = (tid & 1) * 8; const float ws_ = Sw_[t_]; float vv_[8]; unpack8(pv, vv_); \
                _Pragma("unroll") for (int e_ = 0; e_ < 8; ++e_) { ((LAS bf16*)(T_ + VT))[(c8_ + e_) * 72 + t_] = f2bf(vv_[e_]); ((LAS bf16*)(T_ + VTW))[(c8_ + e_) * 72 + t_] = f2bf(vv_[e_] * ws_); } } \
            else if (intra && lo_ == 2) { const int t_ = lane; ((LAS bf16*)(T_ + VTW))[16 * 72 + t_] = f2bf(Sw_[t_]); } } while (0)
#define ML_FINISH(j_) do { const int cj_ = ML_CS(j_); const LAS float* Sj_ = (const LAS float*)(L + SC) + ((j_) & 3) * (SC_STRIDE / 4); const LAS float* NXj_ = (const LAS float*)(L + NXB + ((j_) & 1) * NXSZ); \
            const int tb_ = 16 * (w & 3) + 4 * q4; \
            const bool first_ = ((j_) < 128) || ((j_) == 128 && d == 0); \
            bf16* ob_ = cj_ == 0 ? (first_ ? CELLM : VM2d) : (first_ ? CELL : V2d); \
            const int rb_ = cj_ == 0 ? (tb_ < 48 ? 16 + tb_ : tb_ - 48) : 64 * (cj_ - 1) + tb_;     \
            const unsigned cb_ = (unsigned)(h * 256 + sl * 16 + i16); \
            if (!intra) { const LAS float* NIj_ = (const LAS float*)(L + NIB + ((j_) & 1) * NISZ); const f32x4 isc_ = *(const LAS f32x4*)(Sj_ + SC_ISC / 4 + tb_), flo_ = *(const LAS f32x4*)(Sj_ + SC_FLO / 4 + tb_); float hv_[4]; \
                const f32x4 ni_ = *(const LAS f32x4*)(NIj_ + i16 * 68 + tb_), nxa_ = *(const LAS f32x4*)(NXj_ + i16 * 68 + tb_), nxb_ = *(const LAS f32x4*)(NXj_ + 2 * 1088 + i16 * 68 + tb_); \
                const f32x4 de_ = *(const LAS f32x4*)(NIj_ + 1088 + tb_), dxa_ = *(const LAS f32x4*)(NXj_ + 1088 + tb_), dxb_ = *(const LAS f32x4*)(NXj_ + 3 * 1088 + tb_);     \
                _Pragma("unroll") for (int r_ = 0; r_ < 4; ++r_) { const float num_ = ni_[r_] + isc_[r_] * (nxa_[r_] + nxb_[r_]); const float den_ = de_[r_] + isc_[r_] * (dxa_[r_] + dxb_[r_]); \
                    hv_[r_] = num_ * __builtin_amdgcn_rcpf(fmaxf(fabsf(den_), flo_[r_])); } \
                if (!first_) { const unsigned need_ = (unsigned)(epoch * 1024 + 256 - (j_) + 1); unsigned sp_ = 0u; ppa = (unsigned)__builtin_amdgcn_readfirstlane((int)ppa); \
                    while (ppa < need_ && sp_ < (1u << 20)) { __builtin_amdgcn_s_sleep(1); ppa = (unsigned)__builtin_amdgcn_readfirstlane((int)__hip_atomic_load(prog_pa, __ATOMIC_RELAXED, __HIP_MEMORY_SCOPE_AGENT)); ++sp_; } } \
                { bf16* op_ = ob_ + (unsigned)(rb_ * 2048) + cb_; op_[0] = f2bf(hv_[0]); op_[2048] = f2bf(hv_[1]); op_[4096] = f2bf(hv_[2]); op_[6144] = f2bf(hv_[3]); } } } while (0)
        ML_LOAD(ML_CS(0));
        { const float a0 = ga[ML_CS(0) * 64 + lane], c0 = gcm[ML_CS(0) * 64 + lane], b0 = gb[ML_CS(0) * 64 + lane], a1 = ga[ML_CS(1) * 64 + lane], c1 = gcm[ML_CS(1) * 64 + lane], b1 = gb[ML_CS(1) * 64 + lane];
          if (intra && lo_ == 2) { ML_SCALARS(a0, c0, b0, 0); ML_SCALARS(a1, c1, b1, 1); } }
        __syncthreads();
        ML_STAGE(0);
        ML_LOAD(ML_CS(1));
        ML_BAR();
        unsigned ppa = 0u;
#ifdef DIAG
        unsigned long long tA_ = 0, tF_ = 0, tB_ = 0, tC_ = 0, t0_ = __builtin_amdgcn_s_memtime(), tx_;
#define DG_MARK(acc) do { const unsigned long long ty_ = __builtin_amdgcn_s_memtime(); acc += ty_ - tx_; tx_ = ty_; } while (0)
#else
#define DG_MARK(acc) do { } while (0)
#endif
        for (int i = 0; i <= 256; ++i) {
#ifdef DIAG
            tx_ = __builtin_amdgcn_s_memtime();
#endif
            const int par = i & 1;
            LAS unsigned char* T = L + par * TILE; const LAS float* S = (const LAS float*)(L + SC) + (i & 3) * (SC_STRIDE / 4);
            LAS bf16* Qs = (LAS bf16*)(T + QS); LAS bf16* Ks = (LAS bf16*)(T + KS); LAS bf16* Vt = (LAS bf16*)(T + VT); LAS bf16* Vtw = (LAS bf16*)(T + VTW);
            LAS float* NXb = (LAS float*)(L + NXB + par * NXSZ);
            ppa = __hip_atomic_load(prog_pa, __ATOMIC_RELAXED, __HIP_MEMORY_SCOPE_AGENT);
            if (tid == 0) __hip_atomic_store(prog_me, (unsigned)(epoch * 1024 + i + 1), __ATOMIC_RELAXED, __HIP_MEMORY_SCOPE_AGENT);
            if (i < 256) ML_STAGE(i + 1);
            { const int in_ = i < 255 ? i + 2 : 256; ML_LOAD(ML_CS(in_));
              if (intra && lo_ == 2) { const int ig_ = ML_CS(in_) * 64 + lane; g1a = ga[ig_]; g1cm = gcm[ig_]; g1b = gb[ig_]; } }
            DG_MARK(tA_);
            if (i > 0) ML_FINISH(i - 1);
            DG_MARK(tF_);
            if (intra) {
                const int tau_ = w; const LAS bf16* qp_ = Qs + (16 * tau_ + i16) * 136 + 8 * q4;
                const bf16x8 bq0_ = *(const LAS bf16x8*)(qp_), bq1_ = *(const LAS bf16x8*)(qp_ + 32), bq2_ = *(const LAS bf16x8*)(qp_ + 64), bq3_ = *(const LAS bf16x8*)(qp_ + 96);
                const float Mt_ = S[SC_M / 4 + 16 * tau_ + i16]; unsigned jw_[8];
#define ML_INTRA(NV_) do { bf16x8 kf_[NV_][4]; f32x4 ac_[NV_], as4_[NV_]; \
                    _Pragma("unroll") for (int j_ = 0; j_ < NV_; ++j_) { const int sg_ = d == 0 ? j_ : 3 - j_; const LAS bf16* kp_ = Ks + (16 * sg_ + i16) * 136 + 8 * q4; \
                        _Pragma("unroll") for (int kk_ = 0; kk_ < 4; ++kk_) kf_[j_][kk_] = *(const LAS bf16x8*)(kp_ + 32 * kk_); \
                        as4_[j_] = *(const LAS f32x4*)(S + SC_A / 4 + 16 * sg_ + 4 * q4); ac_[j_] = (f32x4){0.f, 0.f, 0.f, 0.f}; } \
                    _Pragma("unroll") for (int j_ = 0; j_ < NV_; ++j_) ac_[j_] = MFMA16(kf_[j_][0], bq0_, ac_[j_]); \
                    _Pragma("unroll") for (int j_ = 0; j_ < NV_; ++j_) ac_[j_] = MFMA16(kf_[j_][1], bq1_, ac_[j_]); \
                    _Pragma("unroll") for (int j_ = 0; j_ < NV_; ++j_) ac_[j_] = MFMA16(kf_[j_][2], bq2_, ac_[j_]); \
                    _Pragma("unroll") for (int j_ = 0; j_ < NV_; ++j_) ac_[j_] = MFMA16(kf_[j_][3], bq3_, ac_[j_]); \
                    _Pragma("unroll") for (int j_ = 0; j_ < NV_; ++j_) { float e_[4]; \
                        _Pragma("unroll") for (int r_ = 0; r_ < 4; ++r_) { float x_ = __builtin_amdgcn_exp2f(as4_[j_][r_] - Mt_) * ac_[j_][r_]; \
                            if (j_ == NV_ - 1) { const int sl_ = 4 * q4 + r_; const bool ok_ = d == 0 ? (sl_ <= i16) : (sl_ >= i16); x_ = ok_ ? x_ : 0.f; } e_[r_] = x_; } \
                        jw_[2 * j_] = cvt_pk_bf16(e_[0], e_[1]); jw_[2 * j_ + 1] = cvt_pk_bf16(e_[2], e_[3]); } \
                    _Pragma("unroll") for (int j_ = NV_; j_ < 4; ++j_) { jw_[2 * j_] = 0u; jw_[2 * j_ + 1] = 0u; } } while (0)
                if (lo_ == 0) ML_INTRA(1); else if (lo_ == 1) ML_INTRA(2); else if (lo_ == 2) ML_INTRA(3); else ML_INTRA(4);
#undef ML_INTRA
                const bool fw_ = d == 0;
                const u32x4 fa0_ = {fw_ ? jw_[0] : jw_[6], fw_ ? jw_[1] : jw_[7], fw_ ? jw_[2] : jw_[4], fw_ ? jw_[3] : jw_[5]}, fa1_ = {fw_ ? jw_[4] : jw_[2], fw_ ? jw_[5] : jw_[3], fw_ ? jw_[6] : jw_[0], fw_ ? jw_[7] : jw_[1]};
                const LAS bf16* v0_ = Vt + (i16) * 72 + 4 * q4; const LAS bf16* v1_ = Vt + (16 + i16) * 72 + 4 * q4;
                const u32x2 b00_ = *(const LAS u32x2*)(v0_), b01_ = *(const LAS u32x2*)(v0_ + 16), b02_ = *(const LAS u32x2*)(v0_ + 32), b03_ = *(const LAS u32x2*)(v0_ + 48);
                const u32x2 b10_ = *(const LAS u32x2*)(v1_), b11_ = *(const LAS u32x2*)(v1_ + 16), b12_ = *(const LAS u32x2*)(v1_ + 32), b13_ = *(const LAS u32x2*)(v1_ + 48);
                const u32x4 fb00_ = {b00_.x, b00_.y, b01_.x, b01_.y}, fb01_ = {b02_.x, b02_.y, b03_.x, b03_.y}, fb10_ = {b10_.x, b10_.y, b11_.x, b11_.y}, fb11_ = {b12_.x, b12_.y, b13_.x, b13_.y};
                f32x4 na_ = {0.f, 0.f, 0.f, 0.f}, nb_ = na_;
                na_ = MFMA16(__builtin_bit_cast(bf16x8, fa0_), __builtin_bit_cast(bf16x8, fb00_), na_); na_ = MFMA16(__builtin_bit_cast(bf16x8, fa1_), __builtin_bit_cast(bf16x8, fb01_), na_);
                nb_ = MFMA16(__builtin_bit_cast(bf16x8, fa0_), __builtin_bit_cast(bf16x8, fb10_), nb_); nb_ = MFMA16(__builtin_bit_cast(bf16x8, fa1_), __builtin_bit_cast(bf16x8, fb11_), nb_);
                { LAS float* NIw_ = (LAS float*)(L + NIB + par * NISZ);
                  *(LAS f32x4*)(NIw_ + i16 * 68 + 16 * tau_ + 4 * q4) = na_; *(LAS f32x4*)(NIw_ + 1088 + i16 * 68 + 16 * tau_ + 4 * q4) = nb_; }
            } else {
                bf16x8 Cf0, Cf1;
                { u32x4 f_; f_ = (u32x4){cvt_pk_bf16(Cs0[0], Cs0[1]), cvt_pk_bf16(Cs0[2], Cs0[3]), cvt_pk_bf16(Cs1[0], Cs1[1]), cvt_pk_bf16(Cs1[2], Cs1[3])}; Cf0 = __builtin_bit_cast(bf16x8, f_);
                  f_ = (u32x4){cvt_pk_bf16(Cs2[0], Cs2[1]), cvt_pk_bf16(Cs2[2], Cs2[3]), cvt_pk_bf16(Cs3[0], Cs3[1]), cvt_pk_bf16(Cs3[2], Cs3[3])}; Cf1 = __builtin_bit_cast(bf16x8, f_); }
                { u32x2 qa_[4][4];
#pragma unroll
                  for (int tt_ = 0; tt_ < 4; ++tt_) { const LAS bf16* qp_ = Qs + (16 * tt_ + i16) * 136 + 64 * eta + 4 * q4;
#pragma unroll
                      for (int jj_ = 0; jj_ < 4; ++jj_) qa_[tt_][jj_] = *(const LAS u32x2*)(qp_ + 16 * jj_); }
                  f32x4 nx_[4];
#pragma unroll
                  for (int tt_ = 0; tt_ < 4; ++tt_) { const u32x4 f_ = {qa_[tt_][0].x, qa_[tt_][0].y, qa_[tt_][1].x, qa_[tt_][1].y}; nx_[tt_] = MFMA16(__builtin_bit_cast(bf16x8, f_), Cf0, ((f32x4){0.f, 0.f, 0.f, 0.f})); }
#pragma unroll
                  for (int tt_ = 0; tt_ < 4; ++tt_) { const u32x4 f_ = {qa_[tt_][2].x, qa_[tt_][2].y, qa_[tt_][3].x, qa_[tt_][3].y}; nx_[tt_] = MFMA16(__builtin_bit_cast(bf16x8, f_), Cf1, nx_[tt_]); }
#pragma unroll
                  for (int tt_ = 0; tt_ < 4; ++tt_) *(LAS f32x4*)(NXb + (eta * 2 + be) * 1088 + i16 * 68 + 16 * tt_ + 4 * q4) = nx_[tt_]; }
                const float dec = S[SC_DEC / 4];
                const LAS bf16* vw_ = Vtw + (16 * be + i16) * 72 + 8 * q4; const bf16x8 vb0 = *(const LAS bf16x8*)(vw_), vb1 = *(const LAS bf16x8*)(vw_ + 32);
                const unsigned kb_ = (unsigned)(uintptr_t)Ks + (unsigned)((8 * q4 + (i16 >> 2)) * 272 + 8 * (i16 & 3) + 128 * eta);
#define ML_TR4(kt_, L0, H0, L1, H1) s16x4 L0 = trro<(kt_) * 32>(kb_), H0 = trro<(kt_) * 32 + 4 * 272>(kb_), L1 = trro<(kt_) * 32 + 32 * 272>(kb_), H1 = trro<(kt_) * 32 + 36 * 272>(kb_)
#define ML_MM(CS_, L0, H0, L1, H1) do { const bf16x8 a0_ = {L0[0], L0[1], L0[2], L0[3], H0[0], H0[1], H0[2], H0[3]}, a1_ = {L1[0], L1[1], L1[2], L1[3], H1[0], H1[1], H1[2], H1[3]}; \
                CS_ = CS_ * dec; CS_ = MFMA16(a0_, vb0, CS_); CS_ = MFMA16(a1_, vb1, CS_); } while (0)
                { ML_TR4(0, a0, a1, a2, a3); ML_TR4(1, b0, b1, b2, b3); ML_TR4(2, c0, c1, c2, c3); ML_TR4(3, e0, e1, e2, e3);
                  asm volatile("s_waitcnt lgkmcnt(0)" ::: "memory"); __builtin_amdgcn_sched_barrier(0);
                  ML_MM(Cs0, a0, a1, a2, a3); ML_MM(Cs1, b0, b1, b2, b3); ML_MM(Cs2, c0, c1, c2, c3); ML_MM(Cs3, e0, e1, e2, e3); }
            }
            if (intra && lo_ == 2 && i < 255) { ML_SCALARS(g1a, g1cm, g1b, (i + 2) & 3); }
            DG_MARK(tB_);
            ML_BAR();
            DG_MARK(tC_);
        }
#ifdef DIAG
        if (C.bid == 0 && lane == 0) { float* dg_ = (float*)((unsigned*)(C.misc() + MS_CTL) + CW_CHK) + C.wave * 8; dg_[0] = (float)(__builtin_amdgcn_s_memtime() - t0_) / 257.f; dg_[1] = (float)tA_ / 257.f; dg_[2] = (float)tF_ / 257.f; dg_[3] = (float)tB_ / 257.f; dg_[4] = (float)tC_ / 257.f; }
#endif
        { const int i = 257; (void)i; ppa = __hip_atomic_load(prog_pa, __ATOMIC_RELAXED, __HIP_MEMORY_SCOPE_AGENT); ML_FINISH(256); }
        VM_WAIT(); __syncthreads();
#undef ML_LOADQK
#undef ML_LOAD
#undef ML_SCALARS
#undef ML_CS
#undef ML_BAR
#undef ML_STAGE
#undef ML_FINISH
#undef ML_TR4
#undef ML_MM
    }
}

#if DBG_CHECK
constexpr size_t MS_STASH = MS_END;
constexpr int ST_QATT = 0;
constexpr int ST_GB = 8 * 128;
constexpr int ST_XM = ST_GB + 16;
constexpr int NCHK = 16;
DI float* chk_words(const Ctx& C) { return (float*)((unsigned*)(C.misc() + MS_CTL) + CW_CHK); }
DI void chk_add(const Ctx& C, int id, float diff, float ref) {
    float d2 = diff * diff, r2 = ref * ref; if (!(d2 >= 0.f) || !(d2 < 1e30f)) d2 = 1e30f;
    atomicAdd(chk_words(C) + 2 * id, d2); atomicAdd(chk_words(C) + 2 * id + 1, r2);
}
DI unsigned hsh(unsigned x) { x ^= x >> 16; x *= 0x7feb352du; x ^= x >> 15; x *= 0x846ca68bu; x ^= x >> 16; return x; }
DI int smp_row(int s) { return s == 0 ? 0 : s == 1 ? 63 : s == 2 ? 16383 : s == 3 ? 16384 : s == 4 ? 16399 : s == 5 ? 8191 : (int)(hsh(1000 + s) % LTOK); }
DI float wdot_bf_f32col(const bf16* a, const float* w, int ldw, int K, int lane) { float s = 0.f; for (int k = lane; k < K; k += 64) s += bf2f(a[k]) * w[(size_t)k * ldw]; return wave_sum(s, lane); }

DI void dbg_check_gemm_plain(const Ctx& C, int id, const bf16* A, int lda, const float* W, int ldw, int K, const bf16* O, int ldo) {
    for (int s = C.gw; s < 48; s += C.ngw) { const int row = smp_row(s % 12), col = (int)(hsh(77 + s) % (unsigned)ldo);
        const float ref = wdot_bf_f32col(A + (size_t)row * lda, W + col, ldw, K, C.lane);
        if (C.lane == 0) chk_add(C, id, bf2f(O[(size_t)row * ldo + col]) - ref, ref); }
}
DI void dbg_check_e1(const Ctx& C, int li, const bf16* h, const bf16* YAB, const bf16* Kb, const bf16* Vb, const bf16* GA, const bf16* U) {
    const float* W = C.in[I_WINE] + (size_t)li * 1024 * 4608;
    for (int s = C.gw; s < 96; s += C.ngw) { const int row = smp_row(s % 12); const int seg = (s / 12) % 6;
        const int lo_ = seg == 0 ? 0 : seg == 1 ? 1024 : seg == 2 ? 1280 : seg == 3 ? 1536 : seg == 4 ? 2560 : 3584, wd_ = (seg == 1 || seg == 2) ? 256 : 1024;
        const int col = lo_ + (int)(hsh(5 + s) % (unsigned)wd_), c = col - lo_;
        float ref = wdot_bf_f32col(h + (size_t)row * 1024, W + col, 4608, 1024, C.lane);
        float got;
        if (seg == 0) got = bf2f(YAB[(size_t)row * 2048 + c]); else if (seg == 1) got = bf2f(Kb[(size_t)row * 256 + c]); else if (seg == 2) got = bf2f(Vb[(size_t)row * 256 + c]);
        else if (seg == 3) { got = bf2f(GA[(size_t)row * 1024 + c]); ref = ref / (1.f + expf(-ref)); } else if (seg == 4) got = bf2f(U[(size_t)row * 1024 + c]);
        else { got = bf2f(YAB[(size_t)row * 2048 + 1024 + c]); ref = ref / (1.f + expf(-ref)); }
        if (C.lane == 0) chk_add(C, 2, got - ref, ref); }
}
DI void naive_qk_head(const Ctx& C, int li, const bf16* h, int row, int hs, float& o0, float& o1) {
    const float* W = C.in[I_WINE] + (size_t)li * 1024 * 4608; const int cb = hs < 8 ? hs * 128 : 1024 + (hs - 8) * 128;
    float r0 = 0.f, r1 = 0.f;
    for (int k = 0; k < 1024; ++k) { const float hv = bf2f(h[(size_t)row * 1024 + k]); r0 += hv * W[(size_t)k * 4608 + cb + C.lane]; r1 += hv * W[(size_t)k * 4608 + cb + 64 + C.lane]; }
    r0 = bf2f(f2bf(r0)); r1 = bf2f(f2bf(r1));
    const float ss = wave_sum(r0 * r0 + r1 * r1, C.lane); const float rs = 1.f / sqrtf(ss / 128.f + EPS);
    const float* g = (hs < 8 ? C.in[I_QN] : C.in[I_KN]) + li * 128;
    const float n0 = r0 * rs * g[C.lane], n1 = r1 * rs * g[64 + C.lane];
    const int j = C.lane & 31; const float fr = exp2f(-(float)j * (13.287712379549449f / 32.f));
    float pr = 0.f, pc = 0.f; if (row < SEQ) { pr = (float)(row / 64); pc = (float)(row % 64); }
    const float p0 = shx(n0, 32, C.lane), p1 = shx(n1, 32, C.lane);
    float cr, sr, cc, sc; cis_rev(pr * fr, cr, sr); cis_rev(pc * fr, cc, sc);
    o0 = C.lane < 32 ? n0 * cr - p0 * sr : n0 * cr + p0 * sr;
    o1 = C.lane < 32 ? n1 * cc - p1 * sc : n1 * cc + p1 * sc;
}
DI void dbg_check_e2(const Ctx& C, int li, const bf16* h, const bf16* YAB, const bf16* Kb) {
    for (int s = C.gw; s < 40; s += C.ngw) { const int row = smp_row(s % 10), hs = (s * 7) % 10; float o0, o1; naive_qk_head(C, li, h, row, hs, o0, o1);
        const bf16* p = hs < 8 ? YAB + (size_t)row * 2048 + hs * 128 : Kb + (size_t)row * 256 + (hs - 8) * 128;
        const float d0 = bf2f(p[C.lane]) - o0, d1 = bf2f(p[64 + C.lane]) - o1;
        const float dd = wave_sum(d0 * d0 + d1 * d1, C.lane), rr = wave_sum(o0 * o0 + o1 * o1, C.lane);
        if (C.lane == 0) chk_add(C, 3, sqrtf(dd), sqrtf(rr)); }
}
DI void dbg_check_s5(const Ctx& C, int li, const bf16* U, const bf16* YG) {
    float* st = (float*)(C.misc() + MS_STASH);
    const bf16* YAB = C.slot(2);
    for (int s = C.gw; s < 8; s += C.ngw) { const int row = smp_row(s), hd = (s * 3) % 8; st[ST_QATT + s * 128 + C.lane] = bf2f(YAB[(size_t)row * 2048 + hd * 128 + C.lane]); st[ST_QATT + s * 128 + 64 + C.lane] = bf2f(YAB[(size_t)row * 2048 + hd * 128 + 64 + C.lane]); }
    if (C.gw == 8 && C.lane < 16) { const int row = smp_row(C.lane % 12), col = (int)(hsh(300 + C.lane) % 1024u); st[ST_GB + C.lane] = bf2f(YAB[(size_t)row * 2048 + 1024 + col]); }
    for (int s = C.gws; s < 6; s += C.ngw) {
        const int row = smp_row(s), g = (int)(hsh(40 + s) % 64u), l = seq_of_row(row), n = C.lane;
        float y[16];
#pragma unroll
        for (int p = 0; p < 16; ++p) y[p] = 0.f;
        for (int d = 0; d < 2; ++d) {
            const size_t pidx = (((size_t)li * 2 + d) * 64 + g) * 64 + n;
            const float ar = C.in[I_ARE][pidx], ai = C.in[I_AIM][pidx], dt = expf(C.in[I_LDT][((size_t)li * 2 + d) * 64 + g]);
            float c1_, s1_; cis_rev(ai * dt, c1_, s1_); const float mg = expf(ar * dt), abr = mg * c1_, abi = mg * s1_;
            const float xr0 = abr - 1.f, xi0 = abi, inv = 1.f / (ar * ar + ai * ai), kr = (xr0 * ar + xi0 * ai) * inv, ki = (xi0 * ar - xr0 * ai) * inv;
            float bbr[16], bbi[16];
#pragma unroll
            for (int p = 0; p < 16; ++p) { const float br = C.in[I_BRE][pidx * 16 + p], bi = C.in[I_BIM][pidx * 16 + p]; bbr[p] = kr * br - ki * bi; bbi[p] = kr * bi + ki * br; }
            float xr = 0.f, xi = 0.f;
            const int s0 = d == 0 ? 0 : LTOK - 1, s1 = l, step = d == 0 ? 1 : -1;
            for (int sq = s0;; sq += step) { const bf16* up = U + (size_t)row_of_seq(sq) * 1024 + g * 16; float ur = 0.f, ui = 0.f;
#pragma unroll
                for (int p = 0; p < 16; ++p) { const float u = bf2f(up[p]); ur += bbr[p] * u; ui += bbi[p] * u; }
                const float nr = abr * xr - abi * xi + ur, ni = abr * xi + abi * xr + ui; xr = nr; xi = ni;
                if (sq == s1) break; }
#pragma unroll
            for (int p = 0; p < 16; ++p) { const size_t ci = ((((size_t)li * 2 + d) * 64 + g) * 16 + p) * 64 + n; y[p] += wave_sum(C.in[I_CRE][ci] * xr - C.in[I_CIM][ci] * xi, C.lane); }
        }
        float dd = 0.f, rr = 0.f;
#pragma unroll
        for (int p = 0; p < 16; ++p) { float v = y[p] + bf2f(U[(size_t)row * 1024 + g * 16 + p]) * C.in[I_SSMD][(size_t)li * 1024 + g * 16 + p];
            { const float z_ = 0.7978845608028654f * (v + 0.044715f * v * v * v); const float e2_ = expf(-2.f * fabsf(z_)); float th_ = (1.f - e2_) / (1.f + e2_); th_ = z_ < 0.f ? -th_ : th_; v = 0.5f * v * (1.f + th_); }
            const float df = bf2f(YG[(size_t)row * 1024 + g * 16 + p]) - v; dd += df * df; rr += v * v; }
        if (C.lane == 0) chk_add(C, 4, sqrtf(dd), sqrtf(rr));
    }
}
DI void dbg_check_e5(const Ctx& C, int li, const bf16* h, const bf16* YAB, const bf16* Kb, const bf16* Vb, const bf16* GA, const bf16* YG) {
    const float* st = (const float*)(C.misc() + MS_STASH);
    LAS float* sc = (LAS float*)C.lds; LAS float* red = sc + 16448;
    for (int s = C.bid; s < 8; s += C.G) { const int row = smp_row(s), hd = (s * 3) % 8, g = hd >> 2;
        const float* q = st + ST_QATT + s * 128;
        float mx = -1e30f;
        for (int key = C.tid; key < LTOK; key += NTHR) { float d = 0.f; for (int e = 0; e < 128; ++e) d += q[e] * bf2f(Kb[(size_t)key * 256 + g * 128 + e]); d *= 0.08838834764831845f; sc[key] = d; mx = fmaxf(mx, d); }
#pragma unroll
        for (int o = 1; o < 64; o <<= 1) mx = fmaxf(mx, shx(mx, o, C.lane));
        if (C.lane == 0) red[C.wave] = mx; __syncthreads();
        mx = red[0]; for (int w = 1; w < 8; ++w) mx = fmaxf(mx, red[w]); __syncthreads();
        float sm = 0.f; for (int key = C.tid; key < LTOK; key += NTHR) { const float p = expf(sc[key] - mx); sc[key] = p; sm += p; }
        sm = wave_sum(sm, C.lane); if (C.lane == 0) red[C.wave] = sm; __syncthreads();
        sm = 0.f; for (int w = 0; w < 8; ++w) sm += red[w];
        if (C.tid < 128) { float o = 0.f; for (int key = 0; key < LTOK; ++key) o += sc[key] * bf2f(Vb[(size_t)key * 256 + g * 128 + C.tid]);
            o = o / sm * bf2f(GA[(size_t)row * 1024 + hd * 128 + C.tid]); const float got = bf2f(YAB[(size_t)row * 2048 + hd * 128 + C.tid]);
            const float dd = wave_sum((got - o) * (got - o), C.lane), rr = wave_sum(o * o, C.lane); if (C.lane == 0) chk_add(C, 5, sqrtf(dd), sqrtf(rr)); }
        __syncthreads(); }
    const float* Wg = C.in[I_WGLU] + (size_t)li * 1024 * 1024;
    for (int s = C.gws; s < 16; s += C.ngw) { const int row = smp_row(s % 12), col = (int)(hsh(300 + s) % 1024u);
        const float pre = wdot_bf_f32col(YG + (size_t)row * 1024, Wg + col, 1024, 1024, C.lane) + C.in[I_BGLU][li * 1024 + col];
        const float ref = bf2f(YG[(size_t)row * 1024 + col]) / (1.f + expf(-pre)) * st[ST_GB + s];
        if (C.lane == 0) chk_add(C, 6, bf2f(YAB[(size_t)row * 2048 + 1024 + col]) - ref, ref); }
}
DI void dbg_check_conv(const Ctx& C, int li, const bf16* XM, const bf16* XC) {
    float* st = (float*)(C.misc() + MS_STASH);
    for (int s = C.gw; s < 8; s += C.ngw) { const int row = smp_row(s), hd = (s * 5) % 8;
        for (int e = C.lane; e < 256; e += 64) st[ST_XM + s * 256 + e] = bf2f(XM[(size_t)row * 2048 + hd * 256 + e]); }
    const float* cw = C.in[I_CONVW] + (size_t)li * 5 * 2048; const float* cb = C.in[I_CONVB] + (size_t)li * 2048;
    for (int s = C.gw * 64 + C.lane; s < 768; s += C.ngw * 64) { const int row = smp_row(s % 12), c = (int)(hsh(900 + s) % 2048u);
        const int l = row < SEQ ? row + 16 : row - SEQ; float a = cb[c];
        for (int j = 0; j < 5; ++j) { const int l2 = l + j - 2; if (l2 < 0 || l2 >= LTOK) continue; const int r2 = l2 < 16 ? SEQ + l2 : l2 - 16; a += cw[j * 2048 + c] * bf2f(XM[(size_t)r2 * 2048 + c]); }
        const float ref = a / (1.f + expf(-a)); chk_add(C, 10, bf2f(XC[(size_t)row * 2048 + c]) - ref, ref); }
}
DI void dbg_check_o3(const Ctx& C, int li, const bf16* XC, const bf16* Qm, const bf16* Km, const bf16* V, const bf16* VM) {
    const float* st = (const float*)(C.misc() + MS_STASH);
    for (int s = C.gw; s < 48; s += C.ngw) { const int row = smp_row(s % 12), hd = (int)(hsh(11 + s) % 8u), dm = (int)(hsh(12 + s) % 128u); const bool isk = s & 1;
        const float* W = (isk ? C.in[I_WK] : C.in[I_WQ]) + ((size_t)li * 8 + hd) * 256 * 128;
        const float ref = wdot_bf_f32col(XC + (size_t)row * 2048 + hd * 256, W + dm, 128, 256, C.lane);
        if (C.lane == 0) chk_add(C, 11, bf2f((isk ? Km : Qm)[(size_t)row * 1024 + hd * 128 + dm]) - ref, ref); }
    for (int s = C.gw; s < 8; s += C.ngw) { const int row = smp_row(s), hd = (s * 5) % 8;
        for (int t = 0; t < 4; ++t) { const int n = (int)(hsh(50 + s * 4 + t) % 256u); const float* W = C.in[I_WV] + ((size_t)li * 8 + hd) * 256 * 256 + n;
            float a = 0.f; for (int k = C.lane; k < 256; k += 64) a += st[ST_XM + s * 256 + k] * W[(size_t)k * 256]; a = wave_sum(a, C.lane);
            const float got = bf2f(row < SEQ ? V[(size_t)row * 2048 + hd * 256 + n] : VM[(size_t)(row - SEQ) * 2048 + hd * 256 + n]);
            if (C.lane == 0) chk_add(C, 12, got - a, a); } }
    const float* GI = (const float*)(C.misc() + MS_GI); const float* GF = (const float*)(C.misc() + MS_GF);
    for (int s = C.gw; s < 48; s += C.ngw) { const int row = smp_row(s % 12), dh = (int)(hsh(70 + s) % 16u), d = dh >> 3, hd = dh & 7; const bool isf = s & 1;
        const float* W = (isf ? C.in[I_WFG] : C.in[I_WIG]) + ((size_t)li * 2 + d) * 2048 * 8 + hd;
        float a = wdot_bf_f32col(XC + (size_t)row * 2048, W, 8, 2048, C.lane) + (isf ? C.in[I_BFG] : C.in[I_BIG])[li * 16 + dh];
        if (isf) a = fminf(a, 0.f) - log1pf(expf(-fabsf(a)));
        const int pos = row < SEQ ? row + 64 : row - SEQ + 48;
        if (C.lane == 0) chk_add(C, 13, (isf ? GF : GI)[(size_t)dh * NPOS + pos] - a, a); }
    if (C.gw == 0 && C.lane < 16) { chk_add(C, 13, GI[(size_t)C.lane * NPOS + 5] + 1e9f, 1e9f); chk_add(C, 13, GF[(size_t)C.lane * NPOS + 47], 0.f); }
}
DI void dbg_check_mlstm(const Ctx& C, int li, const bf16* Qm, const bf16* Km, const bf16* V, const bf16* VM, const bf16* CELL, const bf16* CELLM) {
    const float* GI = (const float*)(C.misc() + MS_GI); const float* GF = (const float*)(C.misc() + MS_GF);
    for (int s = C.gws; s < 12; s += C.ngw) { const int row = smp_row(s), hd = (int)(hsh(21 + s) % 8u), vc = (int)(hsh(22 + s) % 256u); const int pos = row < SEQ ? row + 64 : row - SEQ + 48;
        float tot = 0.f;
        for (int d = 0; d < 2; ++d) { const float* gi = GI + (size_t)(d * 8 + hd) * NPOS; const float* gf = GF + (size_t)(d * 8 + hd) * NPOS;
            float num = 0.f, den = 0.f, carry = 0.f;
            for (int b0 = 0; b0 < NPOS; b0 += 64) { const int sp = d == 0 ? pos - b0 - C.lane : pos + b0 + C.lane; const bool ok = sp >= 48 && sp < NPOS;
                const float lf = ok ? gf[sp] : 0.f; const float lfe = (b0 == 0 && C.lane == 0) ? 0.f : lf;
                float pre = d == 0 ? lf : lf;
#pragma unroll
                for (int o = 1; o < 64; o <<= 1) { const float x = shf(pre, C.lane - o); pre += C.lane >= o ? x : 0.f; }
                const float cum = carry + pre - lf; (void)lfe;
                if (ok && cum > -80.f) { const int r = sp >= 64 ? sp - 64 : SEQ + sp - 48; const int rt = row; float dot = 0.f;
                    for (int e = 0; e < 128; ++e) dot += bf2f(Qm[(size_t)rt * 1024 + hd * 128 + e]) * bf2f(Km[(size_t)r * 1024 + hd * 128 + e]);
                    const float w = expf(cum + gi[sp]) * dot * 0.08838834764831845f;
                    const float vv = bf2f(r < SEQ ? V[(size_t)r * 2048 + hd * 256 + vc] : VM[(size_t)(r - SEQ) * 2048 + hd * 256 + vc]);
                    num += w * vv; den += w; }
                carry += shf(pre, 63);
                if (carry < -80.f) break; }
            num = wave_sum(num, C.lane); den = wave_sum(den, C.lane); tot += num / fmaxf(fabsf(den), 1.f); }
        const float got = bf2f(row < SEQ ? CELL[(size_t)row * 2048 + hd * 256 + vc] : CELLM[(size_t)(row - SEQ) * 2048 + hd * 256 + vc]);
        if (C.lane == 0) chk_add(C, 14, got - tot, tot); }
}
DI void dbg_check_ogate(const Ctx& C, int li, const bf16* XC, const bf16* SZ, const bf16* CELL, const bf16* CELLM, const bf16* HZ) {
    for (int s = C.gw; s < 48; s += C.ngw) { const int row = smp_row(s % 12), col = (int)(hsh(90 + s) % 2048u), hd = col >> 8;
        const float pre = wdot_bf_f32col(XC + (size_t)row * 2048, C.in[I_WOG] + (size_t)li * 2048 * 2048 + col, 2048, 2048, C.lane) + C.in[I_BOG][(size_t)li * 2048 + col];
        const bf16* cp = row < SEQ ? CELL + (size_t)row * 2048 : CELLM + (size_t)(row - SEQ) * 2048;
        float ss = 0.f; for (int e = C.lane; e < 256; e += 64) { const float v = bf2f(cp[hd * 256 + e]); ss += v * v; } ss = wave_sum(ss, C.lane);
        const float cn = bf2f(cp[col]) / sqrtf(ss / 256.f + EPS) * C.in[I_HN][(size_t)li * 2048 + col];
        const float hh = cn / (1.f + expf(-pre)) + C.in[I_SKIP][(size_t)li * 2048 + col] * bf2f(XC[(size_t)row * 2048 + col]);
        const float ref = hh * bf2f(SZ[(size_t)row * 2048 + col]);
        if (C.lane == 0) chk_add(C, 15, bf2f(HZ[(size_t)row * 2048 + col]) - ref, ref); }
}
DI void dbg_report(const Ctx& C, unsigned* ctl) {
    const float* w = (const float*)(ctl + CW_CHK); int code = 0;
    for (int id = 1; id < NCHK; ++id) { const float d2 = w[2 * id], r2 = w[2 * id + 1]; const bool used = (d2 != 0.f || r2 != 0.f);
        if (used && code == 0) { const float rel = sqrtf(d2 / fmaxf(r2, 1e-20f)); if (!(rel < 0.05f)) code = 3 + id + (rel > 0.5f || !(rel < 1e30f) ? 32 : 0); } }
    if (ctl[CW_BAR + XB_TMO] != 0u) code = 3 + 20;
    if (code) { const float v = exp2f((float)code); for (size_t i = (size_t)C.gw * 64 + C.lane; i < (size_t)SEQ * 1024; i += (size_t)C.ngw * 64) C.out[i] = v; }
}
#endif

#ifndef DBG_CHECK
#define DBG_CHECK 0
#endif
constexpr int N_PHASES = 33;
#ifndef ONLY_J
#define ONLY_J -1
#endif
#define INJ(j) (ONLY_J < 0 || ONLY_J == (j))

__global__ void __launch_bounds__(NTHR, 2) hybrid_fwd(Params prm) {
    extern __shared__ __attribute__((aligned(16))) unsigned char lds_raw[];
    Ctx C;
    C.lds = (LAS unsigned char*)lds_raw;
    C.tid = threadIdx.x; C.lane = C.tid & 63; C.wave = __builtin_amdgcn_readfirstlane(C.tid >> 6);
    C.G = gridDim.x; C.bid = blockIdx.x; C.gw = C.bid * NWAVES + C.wave; C.ngw = C.G * NWAVES; C.gws = C.wave * C.G + C.bid;
    C.in = prm.in; C.out = (float*)(GAS float*)prm.out; C.ws = (unsigned char*)(GAS unsigned char*)prm.ws; C.dob = (unsigned char*)(GAS unsigned char*)prm.out;
    volatile LAS unsigned* MISC = (volatile LAS unsigned*)(C.lds + LDS_MISC);
    if (C.tid < 16) MISC[C.tid] = 0u;
    __syncthreads();
    unsigned* ctl = (unsigned*)(C.misc() + MS_CTL);
    XcdBarrier bar; bar.bar = ctl + CW_BAR; bar.x = 0; bar.st = nullptr;
    if (prm.use_bar) bar = xcd_barrier_post(ctl + CW_BAR, MISC);
    const int lo = prm.ph_lo, hi = prm.ph_hi;
#ifdef DIAG2
    unsigned long long* dts = (unsigned long long*)(C.misc() + MS_END + 65536);
    if (C.bid == 0 && C.tid == 0) dts[98] = wall_clock64();
#endif
#define IN(k) (lo <= (k) && (k) < hi)
#define xcd_barrier_if(ub, b) do { if (ub) xcd_barrier(b); } while (0)
#ifdef DIAG2
#define SEAM(k) do { if (IN(k) && IN((k) + 1)) { if (C.bid == 0 && C.tid == 0) dts[2 * (k)] = wall_clock64(); xcd_barrier(bar); if (C.bid == 0 && C.tid == 0) dts[2 * (k) + 1] = wall_clock64(); } } while (0)
#elif defined(PH_T)
    unsigned long long ph_prev = wall_clock64(), ph_dt = 0;
#define SEAM(k) do { if (IN(k) && IN((k) + 1)) { xcd_barrier(bar); { const unsigned long long tn_ = wall_clock64(); if ((k) == (PH_T)) ph_dt = tn_ - ph_prev; ph_prev = tn_; } } } while (0)
#else
#define SEAM(k) do { if (IN(k) && IN((k) + 1)) xcd_barrier(bar); } while (0)
#endif
#if DBG_CHECK
#define CHECK(k, call) do { if (IN(k)) { call; xcd_barrier(bar); } } while (0)
#else
#define CHECK(k, call) do { } while (0)
#endif
#define resid (C.slot(0))
#define wr (C.wreg())

    if (INJ(16) && IN(0)) { const Ctx C0 = C; const Ctx C = C0.fresh();
        phase_init_rows(C, resid, C.slot(1));
        phase_rope_table(C);
        convert_even_weights(C, 0);
        phase_s5_tables(C, 0);
#ifdef DBL_P0
        phase_init_rows(C, resid, C.slot(1)); phase_rope_table(C); convert_even_weights(C, 0); phase_s5_tables(C, 0);
#endif
    }
    SEAM(0);
    for (int li = 0; li < 2; ++li) {
        const int pb = 1 + li * 16;
#define h_e (C.slot(1))
#define YAB (C.slot(2))
#define GA (C.slot(4))
#define U (C.slot(5))
#define Kb (C.slot(6))
#define Vb (C.slot(6) + (size_t)KVROWS * 256)
#define YG (C.slot(1))
#define y_e (C.slot(4))
        if (INJ(0) && IN(pb + 0)) { const Ctx C0 = C; const Ctx C = C0.fresh();
            for (int i = C.gw * 64 + C.lane; i < 2 * 48 * 256 / 8; i += C.ngw * 64) {
                const int which = i / (48 * 32), r = (i / 32) % 48, c8 = (i % 32) * 8;
                unsigned z_ = 0u; asm volatile("" : "+v"(z_));
                *(u32x4*)((which ? Vb : Kb) + (size_t)(LTOK + r) * 256 + c8) = (u32x4){z_, z_, z_, z_};
                if (i < 48 * 16) *(u32x4*)(C.misc() + MS_K8 + (size_t)LTOK * 256 + (size_t)i * 16) = (u32x4){z_, z_, z_, z_}; }
            FEvenIn f{YAB, Kb, Vb, GA, U};
            run_gemm<1024, 1024, 1024, 4608, 0>(C, h_e, (const bf16*)(wr + WE_IN), f);
            phase_s5_ktab_hcat(C, li);
#ifdef DBL_KTAB
            phase_s5_ktab_hcat(C, li);
#endif
        }
        SEAM(pb + 0);
        CHECK(pb + 0, dbg_check_e1(C, li, h_e, YAB, Kb, Vb, GA, U));
        if (INJ(1) && IN(pb + 1)) { const Ctx C0 = C; const Ctx C = C0.fresh();
            phase_s5_local(C, U);
#ifdef DBL_LOCAL
            phase_s5_local(C, U);
#endif
        }
        SEAM(pb + 1);
        CHECK(pb + 1, dbg_check_e2(C, li, h_e, YAB, Kb));
        if (INJ(2) && IN(pb + 2)) { const Ctx C0 = C; const Ctx C = C0.fresh();
#ifdef SCAN_T
            if (C.gws < 128) { const unsigned long long t0_ = wall_clock64(); phase_s5_scan(C); asm volatile("s_waitcnt vmcnt(0)" ::: "memory"); const unsigned long long t1_ = wall_clock64();
                if (C.lane == 0 && (t1_ - t0_) > (unsigned long long)(SCAN_T) * 100ull) ctl[CW_CHK] = 1u; }
#elif defined(NS_T)
            if (C.gws < 128) phase_s5_scan(C);
            else { const unsigned long long t0_ = wall_clock64(); Ctx C2 = C; C2.gw = C.gws - 128; C2.ngw = C.ngw - 128; phase_s5_mg(C2, li); phase_qk_norm_rope(C2, YAB, Kb, C.in[I_QN] + li * 128, C.in[I_KN] + li * 128, (unsigned char*)(C.misc() + MS_K8)); phase_v8_image(C2, Vb, (unsigned char*)(wr + WO_OG));
                asm volatile("s_waitcnt vmcnt(0)" ::: "memory"); const unsigned long long t1_ = wall_clock64();
                if (C.lane == 0 && (t1_ - t0_) > (unsigned long long)(NS_T) * 100ull) ctl[CW_CHK] = 1u; }
            if (false) { }
#else
            if (C.gws < 128) phase_s5_scan(C);
#endif
            else { Ctx C2 = C; C2.gw = C.gws - 128; C2.ngw = C.ngw - 128;
#ifdef DBL_E3NS
                phase_s5_mg(C2, li); phase_qk_norm_rope(C2, YAB, Kb, C.in[I_QN] + li * 128, C.in[I_KN] + li * 128, (unsigned char*)(C.misc() + MS_K8), C.slot(1)); phase_v8_image(C2, Vb, (unsigned char*)(wr + WO_OG));
#endif
                phase_s5_mg(C2, li); phase_qk_norm_rope(C2, YAB, Kb, C.in[I_QN] + li * 128, C.in[I_KN] + li * 128, (unsigned char*)(C.misc() + MS_K8)); phase_v8_image(C2, Vb, (unsigned char*)(wr + WO_OG)); }
        }
        SEAM(pb + 2);
        if (INJ(3) && IN(pb + 3)) { const Ctx C0 = C; const Ctx C = C0.fresh();
            phase_s5_out(C, U, YG);
#ifdef DBL_S5OUT
            phase_s5_out(C, U, YG);
#endif
        }
        SEAM(pb + 3);
        CHECK(pb + 3, dbg_check_s5(C, li, U, YG));
        if (INJ(4) && IN(pb + 4)) { const Ctx C0 = C; const Ctx C = C0.fresh();
#ifndef NO_ATT
            phase_attention(C, YAB, Kb, Vb, GA, (const unsigned char*)(C.misc() + MS_K8), (const unsigned char*)(wr + WO_OG));
#endif
#ifndef NO_GLU
            { const Ctx C1 = C0.fresh(); const Ctx& C = C1;
              FGlu f{YG, YAB, C.in[I_BGLU] + li * 1024};
              run_gemm<1024, 1024, 1024, 1024, 0>(C, YG, (const bf16*)(wr + WE_GLU), f); }
#endif
        }
        if (IN(pb + 4)) { xcd_barrier_if(prm.use_bar, bar); { const Ctx C0 = C; const Ctx C = C0.fresh(); phase_attention_combine(C, YAB, GA);
#ifdef DBL_META
            phase_attention_combine(C, YAB, GA);
#endif
        } }
        SEAM(pb + 4);
        CHECK(pb + 4, dbg_check_e5(C, li, h_e, YAB, Kb, Vb, GA, YG));
        if (INJ(5) && IN(pb + 5)) { const Ctx C0 = C; const Ctx C = C0.fresh();
            FPlain f{y_e, 1024};
            run_gemm<2048, 2048, 2048, 1024, 0>(C, YAB, (const bf16*)(wr + WE_OUT), f);
        }
        SEAM(pb + 5);
        CHECK(pb + 5, dbg_check_gemm_plain(C, 7, YAB, 2048, C.in[I_WOUTE] + (size_t)li * 2048 * 1024, 1024, 2048, y_e, 1024));
        if (INJ(6) && IN(pb + 6)) { const Ctx C0 = C; const Ctx C = C0.fresh();
#ifdef DBL_POST
            phase_post_rows(C, y_e, resid, C.slot(2), 2 * li, C.slot(1));
#endif
            phase_post_rows(C, y_e, resid, C.slot(5), 2 * li);
            convert_odd_early(C, li); convert_odd_late(C, li);
        }
        SEAM(pb + 6);
#define h_o (C.slot(5))
#define XM (C.slot(3))
#define XC (C.slot(1))
#define Qm (C.slot(5))
#define Km (C.slot(6))
#define CELL ((bf16*)C.dob)
#define CELLM ((bf16*)(C.misc() + MS_CELLM))
#define VM ((bf16*)(C.misc() + MS_VM))
#define h_r (C.slot(5))
#define SZ (C.slot(3))
#define HZ (C.slot(3))
#define y_o (C.slot(5))
        if (INJ(7) && IN(pb + 7)) { const Ctx C0 = C; const Ctx C = C0.fresh();
            FPlain f{XM, 2048};
            run_gemm<1024, 1024, 1024, 2048, 0>(C, h_o, (const bf16*)(wr + WO_IN), f);
        }
        SEAM(pb + 7);
        CHECK(pb + 7, dbg_check_gemm_plain(C, 9, h_o, 1024, C.in[I_WINO] + (size_t)li * 1024 * 4096, 4096, 1024, XM, 2048));
        if (INJ(8) && IN(pb + 8)) { const Ctx C0 = C; const Ctx C = C0.fresh();
            phase_conv(C, XM, XC, C.in[I_CONVW] + (size_t)li * 5 * 2048, C.in[I_CONVB] + (size_t)li * 2048);
#ifdef DBL_CONV
            phase_conv(C, XM, XC, C.in[I_CONVW] + (size_t)li * 5 * 2048, C.in[I_CONVB] + (size_t)li * 2048);
#endif
            if (C.gw == 0) { for (int i = C.lane; i < 1024; i += 64) ((unsigned*)(C.misc() + MS_ZROW))[i] = 0u; }
        }
        SEAM(pb + 8);
        CHECK(pb + 8, dbg_check_conv(C, li, XM, XC));
        if (INJ(9) && IN(pb + 9)) { const Ctx C0 = C; const Ctx C = C0.fresh();
#ifndef NO_QK
            { FQK f{Qm, Km}; run_gemm<2048, 256, 256, 2048, 256>(C, XC, (const bf16*)(wr + WO_QK), f); }
#endif
#ifndef NO_V
            { FVrow f{XM, VM}; run_gemm<2048, 256, 256, 2048, 256>(C, XM, (const bf16*)(wr + WO_V), f); }
#endif
#ifndef NO_GATES
            phase_gates(C, XC, (const bf16*)(wr + WO_G), C.in[I_BIG] + li * 16, C.in[I_BFG] + li * 16);
#ifdef DBL_GATES
            phase_gates(C, XC, (const bf16*)(wr + WO_G), C.in[I_BIG] + li * 16, C.in[I_BFG] + li * 16);
#endif
#endif
        }
        SEAM(pb + 9);
        CHECK(pb + 9, dbg_check_o3(C, li, XC, Qm, Km, XM, VM));
        if (INJ(10) && IN(pb + 10)) { const Ctx C0 = C; const Ctx C = C0.fresh();
#ifdef DBL_MLSTM
            phase_mlstm(C, 2 * li, Qm, Km, XM, VM, CELL, CELLM, CELL, CELLM); xcd_barrier_if(prm.use_bar, bar);
            phase_mlstm(C, 2 * li + 1, Qm, Km, XM, VM, CELL, CELLM, XM, VM);
#else
            phase_mlstm(C, li, Qm, Km, XM, VM, CELL, CELLM, XM, VM);
#endif
        }
        SEAM(pb + 10);
        CHECK(pb + 10, dbg_check_mlstm(C, li, Qm, Km, XM, VM, CELL, CELLM));
        if (INJ(11) && IN(pb + 11)) { const Ctx C0 = C; const Ctx C = C0.fresh();
            phase_renorm_rows(C, resid, h_r, 2 * li + 1);
#ifdef DBL_RENORM
            phase_renorm_rows(C, resid, h_r, 2 * li + 1);
#endif
#ifdef DBL_MERGE
            phase_cell_merge(C, CELL, CELLM, XM, VM, C.slot(6));
#endif
            phase_cell_merge(C, CELL, CELLM, XM, VM);
        }
        SEAM(pb + 11);
        if (INJ(12) && IN(pb + 12)) { const Ctx C0 = C; const Ctx C = C0.fresh();
            FSilu f{SZ, 2048};
            run_gemm<1024, 1024, 1024, 2048, 0>(C, h_r, (const bf16*)(wr + WO_Z), f);
        }
        if (INJ(13) && IN(pb + 13)) { const Ctx C0 = C; const Ctx C = C0.fresh();
            FOgate f{CELL, CELLM, XC, SZ, HZ, C.in[I_BOG] + (size_t)li * 2048, C.in[I_HN] + (size_t)li * 2048, C.in[I_SKIP] + (size_t)li * 2048, (const float*)(C.misc() + MS_RSTD)};
            run_gemm<2048, 2048, 2048, 2048, 0>(C, XC, (const bf16*)(wr + WO_OG), f);
        }
        SEAM(pb + 13);
        CHECK(pb + 13, dbg_check_ogate(C, li, XC, SZ, CELL, CELLM, HZ));
        if (INJ(14) && IN(pb + 14)) { const Ctx C0 = C; const Ctx C = C0.fresh();
            FPlain f{y_o, 1024};
            run_gemm<2048, 2048, 2048, 1024, 0>(C, HZ, (const bf16*)(wr + WO_OUT), f);
        }
        SEAM(pb + 14);
        CHECK(pb + 14, dbg_check_gemm_plain(C, 1, HZ, 2048, C.in[I_WOUTO] + (size_t)li * 2048 * 1024, 1024, 2048, y_o, 1024));
        if (INJ(15) && IN(pb + 15)) { const Ctx C0 = C; const Ctx C = C0.fresh();
#ifdef DBL_POST
            if (li == 0) phase_post_rows(C, y_o, resid, C.slot(2), 2 * li + 1, C.slot(6));
#endif
            phase_post_rows(C, y_o, resid, C.slot(1), 2 * li + 1);
#if defined(SCAN_T) || defined(NS_T)
            if (li == 1 && C.bid == 0 && C.tid == 0 && ctl[CW_CHK] != 0u) C.out[0] = __builtin_nanf("");
#endif
#ifdef PH_T
            if (li == 1 && C.bid == 0 && C.tid == 0) { if ((PH_T) == 32) ph_dt = wall_clock64() - ph_prev;
                int n_ = (int)((float)ph_dt * 0.01f / (float)(PH_STEP)); n_ = n_ < 0 ? 0 : (n_ > 15 ? 15 : n_);
#ifdef PH_CAL
                n_ = PH_CAL;
#endif
                C.out[0] = C.out[0] + sqrtf((float)n_) * 700.f; }
#endif
            if (li == 0) { convert_even_weights(C, 1); phase_s5_tables(C, 1); }
        }
        if (li == 0) SEAM(pb + 15);
    }
#if DBG_CHECK
    if (IN(N_PHASES - 1)) { xcd_barrier(bar); dbg_report(C, ctl); }
#endif
#ifdef DIAG2
    if (IN(N_PHASES - 1)) {
        if (C.bid == 0 && C.tid == 0) { const unsigned long long tend = wall_clock64(); float grp[4] = {0.f, 0.f, 0.f, 0.f};
            for (int k = 0; k < N_PHASES; ++k) { const unsigned long long t0 = k == 0 ? dts[98] : dts[2 * (k - 1) + 1]; const unsigned long long t1 = k == N_PHASES - 1 ? tend : dts[2 * k];
                const float us = (float)(t1 - t0) * 0.01f; const int j = k == 0 ? 16 : (k - 1) % 16;
                const int gsel = DIAG2_GROUP(j); if (gsel >= 0) grp[gsel] += us;
                if (k < N_PHASES - 1) grp[3] += (float)(dts[2 * k + 1] - dts[2 * k]) * 0.01f; }
            float* dg = (float*)(ctl + CW_CHK); dg[0] = grp[DIAG_A]; dg[1] = grp[DIAG_B]; }
        xcd_barrier(bar); const float* dg = (const float*)(ctl + CW_CHK); const float va = rintf(4.f * log2f(fmaxf(dg[0], 1.f))), vb = rintf(4.f * log2f(fmaxf(dg[1], 1.f)));
        for (size_t i = (size_t)C.gw * 64 + C.lane; i < (size_t)SEQ * 1024; i += (size_t)C.ngw * 64) C.out[i] = (i < (size_t)SEQ * 768) ? va : vb; }
#endif
#ifdef DIAG
    if (IN(N_PHASES - 1)) { xcd_barrier(bar); const float* dg = (const float*)(ctl + CW_CHK); const float va = rintf(4.f * log2f(fmaxf(dg[DIAG_A], 1.f))), vb = rintf(4.f * log2f(fmaxf(dg[DIAG_B], 1.f)));
        for (size_t i = (size_t)C.gw * 64 + C.lane; i < (size_t)SEQ * 1024; i += (size_t)C.ngw * 64) C.out[i] = (i < (size_t)SEQ * 768) ? va : vb; }
#endif
#undef IN
#undef SEAM
#undef CHECK
#undef h_e
#undef YAB
#undef GA
#undef U
#undef Kb
#undef Vb
#undef YG
#undef y_e
#undef h_o
#undef XM
#undef XC
#undef Qm
#undef Km
#undef CELL
#undef CELLM
#undef VM
#undef h_r
#undef SZ
#undef HZ
#undef y_o
#undef resid
#undef wr
}

#ifndef MULTI_LAUNCH
#define MULTI_LAUNCH 0
#endif
extern "C" void kernel_launch(void* const* d_in, const int* in_sizes, int n_in, void* d_out, int out_size, void* d_ws, size_t ws_size, hipStream_t stream) {
    static int grid = 0;
    if (grid == 0) {
        if (n_in != 33 || in_sizes[0] != SEQ * DM || out_size != SEQ * DM || ws_size < WS_NEED) {
            fprintf(stderr, "kernel_launch: shape mismatch: n_in %d in0 %d out %d ws %zu (need %zu)\n", n_in, n_in > 0 ? in_sizes[0] : -1, out_size, ws_size, (size_t)WS_NEED); grid = -1; return; }
        int dev = 0, cus = 0, per_cu = 0;
        if (hipGetDevice(&dev) != hipSuccess || hipDeviceGetAttribute(&cus, hipDeviceAttributeMultiprocessorCount, dev) != hipSuccess) { fprintf(stderr, "kernel_launch: device query failed\n"); grid = -1; return; }
        if (hipFuncSetAttribute((const void*)hybrid_fwd, hipFuncAttributeMaxDynamicSharedMemorySize, LDS_TOTAL) != hipSuccess) { fprintf(stderr, "kernel_launch: hipFuncSetAttribute failed\n"); grid = -1; return; }
        if (hipOccupancyMaxActiveBlocksPerMultiprocessor(&per_cu, (const void*)hybrid_fwd, NTHR, LDS_TOTAL) != hipSuccess || per_cu < 1) { fprintf(stderr, "kernel_launch: occupancy query says %d blocks per CU\n", per_cu); (void)hipGetLastError(); }
        grid = cus;
    }
    if (grid < 0) return;
    if (hipMemsetAsync((char*)d_ws + WS_MISC + MS_CTL, 0, 65536, stream) != hipSuccess) { fprintf(stderr, "kernel_launch: memset failed\n"); return; }
    Params p{};
    for (int i = 0; i < 33; ++i) p.in[i] = (const float*)d_in[i];
    p.out = (float*)d_out; p.ws = (unsigned char*)d_ws; p.pad = 0;
#if MULTI_LAUNCH
    for (int k = 0; k < N_PHASES; ++k) { p.ph_lo = k; p.ph_hi = k + 1; p.use_bar = 0;
        hipLaunchKernelGGL(hybrid_fwd, dim3(grid), dim3(NTHR), LDS_TOTAL, stream, p); }
#else
    p.ph_lo = 0; p.ph_hi = N_PHASES; p.use_bar = 1;
    hipLaunchKernelGGL(hybrid_fwd, dim3(grid), dim3(NTHR), LDS_TOTAL, stream, p);
#endif
    const hipError_t le = hipPeekAtLastError();
    if (le != hipSuccess) fprintf(stderr, "kernel_launch: launch failed: %s\n", hipGetErrorName(le));
}
```

```cpp
#include <hip/hip_runtime.h>
#include <cstdio>
#include <cstdint>

#define DI __device__ __forceinline__
#define GAS __attribute__((address_space(1)))
#define LAS __attribute__((address_space(3)))
typedef unsigned short bf16;
typedef short bf16x8 __attribute__((ext_vector_type(8)));
typedef float f32x4 __attribute__((ext_vector_type(4)));
typedef float f32x2 __attribute__((ext_vector_type(2)));
typedef float f32x16 __attribute__((ext_vector_type(16)));
typedef unsigned u32x4 __attribute__((ext_vector_type(4)));
typedef unsigned u32x2 __attribute__((ext_vector_type(2)));
typedef short s16x4 __attribute__((ext_vector_type(4)));

constexpr int DM = 1024, SEQ = 16384, NMETA = 16, LTOK = 16400;
constexpr int KVROWS = 16448;
constexpr int NPOS = 16448;
constexpr int NWAVES = 8, NTHR = 512;
constexpr float EPS = 1e-6f;

DI float bf2f(bf16 b) { return __uint_as_float(((unsigned)b) << 16); }
DI float bflo(unsigned w) { return __uint_as_float(w << 16); }
DI float bfhi(unsigned w) { return __uint_as_float(w & 0xffff0000u); }
typedef __bf16 bf16x2_t __attribute__((ext_vector_type(2)));
DI unsigned cvt_pk_bf16(float lo, float hi) { bf16x2_t v = {(__bf16)lo, (__bf16)hi}; return __builtin_bit_cast(unsigned, v); }
DI bf16 f2bf(float f) { return (bf16)(cvt_pk_bf16(f, 0.f) & 0xffffu); }
DI float fexp(float x) { return __builtin_amdgcn_exp2f(x * 1.4426950408889634f); }
DI float silu_f(float x) { return x * __builtin_amdgcn_rcpf(1.f + __expf(-x)); }
DI float sigmoid_f(float x) { return __builtin_amdgcn_rcpf(1.f + __expf(-x)); }
DI float gelu_tanh_f(float v) { const float z = 0.7978845608028654f * (v + 0.044715f * v * v * v); const float t = 1.f - 2.f * __builtin_amdgcn_rcpf(1.f + __expf(2.f * z)); return 0.5f * v * (1.f + t); }
DI float shf(float v, int src_lane) { return __int_as_float(__builtin_amdgcn_ds_bpermute(src_lane << 2, __float_as_int(v))); }
DI float shx(float v, int mask, int lane) { return shf(v, lane ^ mask); }
DI float wave_sum(float v, int lane) {
#pragma unroll
    for (int o = 1; o < 64; o <<= 1) v += shx(v, o, lane);
    return v;
}
DI void unpack8(u32x4 w, float (&v)[8]) { v[0] = bflo(w.x); v[1] = bfhi(w.x); v[2] = bflo(w.y); v[3] = bfhi(w.y); v[4] = bflo(w.z); v[5] = bfhi(w.z); v[6] = bflo(w.w); v[7] = bfhi(w.w); }
DI u32x4 pack8(const float (&v)[8]) { u32x4 w; w.x = cvt_pk_bf16(v[0], v[1]); w.y = cvt_pk_bf16(v[2], v[3]); w.z = cvt_pk_bf16(v[4], v[5]); w.w = cvt_pk_bf16(v[6], v[7]); return w; }
DI u32x4 pack8v(f32x4 a, f32x4 b) { u32x4 w; w.x = cvt_pk_bf16(a[0], a[1]); w.y = cvt_pk_bf16(a[2], a[3]); w.z = cvt_pk_bf16(b[0], b[1]); w.w = cvt_pk_bf16(b[2], b[3]); return w; }
template <class T> DI void lnd(T*& p) { GAS T* q = (GAS T*)p; asm volatile("" : "+s"(q)); p = (T*)q; }
#define LDS_WAIT() asm volatile("s_waitcnt lgkmcnt(0)" ::: "memory")
#define VM_WAIT() asm volatile("s_waitcnt vmcnt(0)" ::: "memory")
#define MFMA16(a, b, c) __builtin_amdgcn_mfma_f32_16x16x32_bf16((a), (b), (c), 0, 0, 0)
#define MFMA32(a, b, c) __builtin_amdgcn_mfma_f32_32x32x16_bf16((a), (b), (c), 0, 0, 0)

namespace pg8 {
constexpr int BM = 256, BK = 64, HALF = 128, HTB = HALF * BK * 2, STAGE_BYTES = 8 * HTB, NXCD = 8, WGM = 8;
__host__ __device__ __forceinline__ int lds_byte(int r, int c) { const int st = (r >> 4) * 2 + (c >> 5), rr = r & 15, cc = c & 31, ob = rr * 64 + cc * 2; return st * 1024 + (ob ^ (((ob >> 9) & 1) << 5)); }
__host__ __device__ __forceinline__ void stage_rc(int b, int& R, int& C) { const int st = b / 1024, sb = b % 1024, swz = sb ^ (((sb >> 9) & 1) << 5); R = (st >> 1) * 16 + swz / 64; C = (st & 1) * 32 + (swz % 64) / 2; }
__host__ __device__ __forceinline__ int perm32(int rho) { const int n = rho >> 4, i = rho & 15; return 8 * (i >> 2) + 4 * n + (i & 3); }

struct Unit { int pm, pn; };
struct Gemm { const bf16* A; const bf16* Bt; };

template <int NN> struct StaticOrder {
    static constexpr int nM = 64, nN = NN, nwg = nM * nN;
    int G, c;
    __device__ void init(int G_, int c_) { G = G_; c = c_; }
    __device__ bool next(int i, Unit& u) const {
        const long L = (long)i * G + c; if (L >= nwg) return false;
        int wgid = (int)L; { const int q = nwg / NXCD, r = nwg % NXCD, xcd = wgid % NXCD, off = wgid / NXCD; wgid = (xcd < r ? xcd * (q + 1) : r * (q + 1) + (xcd - r) * q) + off; }
        const int nig = WGM * nN, gid = wgid / nig, fm = gid * WGM, gsz = (nM - fm) < WGM ? (nM - fm) : WGM;
        u.pm = fm + ((wgid % nig) % gsz); u.pn = (wgid % nig) / gsz; return true;
    }
};

template <class F> struct EpiT {
    static constexpr bool PERM = true;
    F f;
    DI void operator()(const f32x4 (&acc)[2][2][4][2], const Unit& u, int wr, int wc, int fr, int fq) const {
        const int row0 = u.pm * BM + wr * 64 + fr, col0 = u.pn * BM + wc * 32 + 8 * fq;
#pragma unroll
        for (int ai = 0; ai < 2; ++ai)
#pragma unroll
            for (int m = 0; m < 4; ++m)
#pragma unroll
                for (int bj = 0; bj < 2; ++bj) f.op8(row0 + ai * HALF + m * 16, col0 + bj * HALF, acc[ai][bj][m][0], acc[ai][bj][m][1]);
    }
};

template <class F> struct EpiP {
    static constexpr bool PERM = true;
    F f;
    DI void operator()(const f32x4 (&acc)[2][2][4][2], const Unit& u, int wr, int wc, int fr, int fq) const {
        const int row0 = u.pm * BM + wr * 64 + fr, col0 = u.pn * BM + wc * 32 + 8 * fq;
#pragma unroll
        for (int bj = 0; bj < 2; ++bj) {
            const int col = col0 + bj * HALF;
            const typename F::Cols cp = f.cols(col);
            typename F::Pre p0 = f.pre(row0, col), p1 = p0;
#pragma unroll
            for (int k = 0; k < 8; ++k) {
                const int ai = k >> 2, m = k & 3, row = row0 + ai * HALF + m * 16;
                if (k + 1 < 8) { const int rn = row0 + ((k + 1) >> 2) * HALF + ((k + 1) & 3) * 16; if (k & 1) p0 = f.pre(rn, col); else p1 = f.pre(rn, col); }
                f.fin(row, col, acc[ai][bj][m][0], acc[ai][bj][m][1], (k & 1) ? p1 : p0, cp);
            }
        }
    }
};
template <class F, bool P = F::PIPE> struct EpiSel { typedef EpiT<F> type; };
template <class F> struct EpiSel<F, true> { typedef EpiP<F> type; };

template <class Epi, class Sched, int LDA, int LDB, int KK, int APN>
DI void gemm_phase(LAS unsigned char* lds, const Gemm g, const Sched& S, const Epi& E) {
    int tid = threadIdx.x; asm volatile("" : "+v"(tid));
    const int wid = __builtin_amdgcn_readfirstlane(tid >> 6), lane = tid & 63, wr = wid >> 2, wc = wid & 3, fr = lane & 15, fq = lane >> 4;
    constexpr int nt = KK / BK;
    unsigned voffA[2], voffB[2];
#pragma unroll
    for (int i = 0; i < 2; ++i) { int R, C; stage_rc(tid * 16 + i * 8192, R, C); const int Rb = Epi::PERM ? ((R & ~31) + perm32(R & 31)) : R;
        voffA[i] = (unsigned)(R * LDA + C) * 2u; voffB[i] = (unsigned)(Rb * LDB + C) * 2u; }
    constexpr size_t kstep = (size_t)(BK * 2);
    constexpr size_t hstepA = (size_t)HALF * LDA * 2, hstepB = (size_t)HALF * LDB * 2;
    constexpr size_t tstepA = 2 * hstepA, tstepB = 2 * hstepB;
    constexpr size_t pnstepA = (size_t)APN * 2;
    const unsigned ldsw = (unsigned)wid * 1024u;
    const int aoff = lds_byte(wr * 64 + fr, fq * 8), boff = lds_byte(wc * 32 + fr, fq * 8);
#define PG8_SA(b, h) (((b) * 2 + (h)) * HTB)
#define PG8_SB(b, h) ((4 + (b) * 2 + (h)) * HTB)
#define PG8_STAGE(bufoff, gbase, voff) do { _Pragma("unroll") for (int _i = 0; _i < 2; ++_i) \
        __builtin_amdgcn_global_load_lds((const unsigned*)((const char*)(gbase) + (voff)[_i]), (LAS unsigned*)(lds + (bufoff) + ldsw + _i * 8192), 16, 0, 0); } while (0)
#define PG8_LDA(dst, b, h) do { _Pragma("unroll") for (int m = 0; m < 4; ++m) _Pragma("unroll") for (int k = 0; k < 2; ++k) dst[m][k] = *(const LAS bf16x8*)(lds + PG8_SA(b, h) + aoff + m * 2048 + k * 1024); } while (0)
#define PG8_LDB(dst, b, h) do { _Pragma("unroll") for (int n = 0; n < 2; ++n) _Pragma("unroll") for (int k = 0; k < 2; ++k) dst[n][k] = *(const LAS bf16x8*)(lds + PG8_SB(b, h) + boff + n * 2048 + k * 1024); } while (0)
#define PG8_MMA(ai, bj, At, Bt) do { __builtin_amdgcn_s_setprio(1); _Pragma("unroll") for (int m = 0; m < 4; ++m) _Pragma("unroll") for (int n = 0; n < 2; ++n) _Pragma("unroll") for (int k = 0; k < 2; ++k) \
        acc[ai][bj][m][n] = __builtin_amdgcn_mfma_f32_16x16x32_bf16(Bt[n][k], At[m][k], acc[ai][bj][m][n], 0, 0, 0); __builtin_amdgcn_s_setprio(0); } while (0)
#define PG8_WAIT_V(n) asm volatile("s_waitcnt vmcnt(" #n ")" ::: "memory")
#define PG8_WAIT_L(n) asm volatile("s_waitcnt lgkmcnt(" #n ")" ::: "memory")
#define PG8_BAR __builtin_amdgcn_s_barrier()
#define PG8_SCHED __builtin_amdgcn_sched_barrier(0)
    Unit cur, nxt; int ui = 0;
    if (!S.next(0, cur)) return;
    const bf16* gA = g.A; const bf16* gB = g.Bt;
    asm volatile("" : "+s"(gA), "+s"(gB));
    f32x4 acc[2][2][4][2];
#pragma unroll
    for (int a = 0; a < 2; ++a)
#pragma unroll
        for (int b = 0; b < 2; ++b)
#pragma unroll
            for (int m = 0; m < 4; ++m)
#pragma unroll
                for (int n = 0; n < 2; ++n) acc[a][b][m][n] = (f32x4){0.f, 0.f, 0.f, 0.f};
    bf16x8 At[4][2], B0[2][2], B1[2][2];
    const char* cA = (const char*)gA + (size_t)cur.pm * tstepA + (size_t)cur.pn * pnstepA; const char* cB = (const char*)gB + (size_t)cur.pn * tstepB;
    PG8_STAGE(PG8_SB(0, 0), cB, voffB); PG8_STAGE(PG8_SB(0, 1), cB + hstepB, voffB); PG8_STAGE(PG8_SA(0, 0), cA, voffA); PG8_STAGE(PG8_SA(0, 1), cA + hstepA, voffA);
    if (wr == 1) PG8_BAR;
    PG8_WAIT_V(2); PG8_BAR;
    PG8_STAGE(PG8_SB(1, 0), cB + kstep, voffB); PG8_STAGE(PG8_SA(1, 0), cA + kstep, voffA); PG8_STAGE(PG8_SB(1, 1), cB + hstepB + kstep, voffB);
    PG8_WAIT_V(6); PG8_BAR;
    for (;;) {
        const bool has_next = S.next(ui + 1, nxt);
        const char* nA = has_next ? (const char*)gA + (size_t)nxt.pm * tstepA + (size_t)nxt.pn * pnstepA : cA; const char* nB = has_next ? (const char*)gB + (size_t)nxt.pn * tstepB : cB;
#pragma unroll 1
        for (int t = 0; t < nt; t += 2) {
            const bool last = (t == nt - 2);
            const char* a1 = cA + (size_t)(t + 1) * kstep;
            const char* a2 = last ? nA : cA + (size_t)(t + 2) * kstep; const char* b2 = last ? nB : cB + (size_t)(t + 2) * kstep;
            const char* a3 = a2 + kstep; const char* b3 = b2 + kstep;
            PG8_LDB(B0, 0, 0); PG8_LDB(B1, 0, 1); PG8_SCHED; PG8_LDA(At, 0, 0); PG8_STAGE(PG8_SA(1, 1), a1 + hstepA, voffA);
            PG8_WAIT_V(8); PG8_WAIT_L(0); PG8_BAR; PG8_MMA(0, 0, At, B0); PG8_MMA(0, 1, At, B1); PG8_BAR; PG8_SCHED;
            PG8_LDA(At, 0, 1); PG8_STAGE(PG8_SB(0, 0), b2, voffB); PG8_STAGE(PG8_SB(0, 1), b2 + hstepB, voffB); PG8_STAGE(PG8_SA(0, 0), a2, voffA);
            PG8_WAIT_V(8); PG8_WAIT_L(0); PG8_BAR; PG8_MMA(1, 0, At, B0); PG8_MMA(1, 1, At, B1); PG8_BAR; PG8_SCHED;
            PG8_LDB(B0, 1, 0); PG8_LDB(B1, 1, 1); PG8_SCHED; PG8_LDA(At, 1, 0); PG8_STAGE(PG8_SA(0, 1), a2 + hstepA, voffA);
            PG8_WAIT_V(8); PG8_WAIT_L(0); PG8_BAR; PG8_MMA(0, 0, At, B0); PG8_MMA(0, 1, At, B1); PG8_BAR; PG8_SCHED;
            PG8_LDA(At, 1, 1); PG8_STAGE(PG8_SB(1, 0), b3, voffB); PG8_STAGE(PG8_SB(1, 1), b3 + hstepB, voffB); PG8_STAGE(PG8_SA(1, 0), a3, voffA);
            PG8_WAIT_V(8); PG8_WAIT_L(0); PG8_BAR; PG8_MMA(1, 0, At, B0); PG8_MMA(1, 1, At, B1); PG8_BAR; PG8_SCHED;
        }
        if (wr == 0) PG8_BAR;
        E(acc, cur, wr, wc, fr, fq);
        if (!has_next) break;
#pragma unroll
        for (int a = 0; a < 2; ++a)
#pragma unroll
            for (int b = 0; b < 2; ++b)
#pragma unroll
                for (int m = 0; m < 4; ++m)
#pragma unroll
                    for (int n = 0; n < 2; ++n) acc[a][b][m][n] = (f32x4){0.f, 0.f, 0.f, 0.f};
        cur = nxt; cA = nA; cB = nB; ++ui;
        if (wr == 1) PG8_BAR;
    }
    PG8_WAIT_V(0);
    PG8_BAR;
#undef PG8_SA
#undef PG8_SB
#undef PG8_STAGE
#undef PG8_LDA
#undef PG8_LDB
#undef PG8_MMA
#undef PG8_WAIT_V
#undef PG8_WAIT_L
#undef PG8_BAR
#undef PG8_SCHED
}
}

template <class F>
DI void gemm_tail(LAS unsigned char* lds, const bf16* A, int lda, const bf16* Bt, int ldb, int K, int N, int a_pn_step, const F& f, int row_base, int bid, int G, int wave, int lane) {
    const int i16 = lane & 15, kq = lane >> 4;
    LAS float* P = (LAS float*)lds;
    for (int task = bid; task < N / 32; task += G) {
        const int n0 = task * 32, pn = n0 >> 8, kw = K >> 3, kb = wave * kw;
        const bf16* ap = A + (size_t)i16 * lda + (size_t)pn * a_pn_step + kb + 8 * kq;
        const bf16* b0p = Bt + (size_t)(n0 + 8 * (i16 >> 2) + (i16 & 3)) * ldb + kb + 8 * kq;
        const bf16* b1p = b0p + (size_t)4 * ldb;
        f32x4 acc0 = {0.f, 0.f, 0.f, 0.f}, acc1 = {0.f, 0.f, 0.f, 0.f};
#pragma unroll 8
        for (int k0 = 0; k0 < kw; k0 += 32) {
            const bf16x8 a = *(const bf16x8*)(ap + k0), b0 = *(const bf16x8*)(b0p + k0), b1 = *(const bf16x8*)(b1p + k0);
            acc0 = MFMA16(b0, a, acc0); acc1 = MFMA16(b1, a, acc1);
        }
#pragma unroll
        for (int r = 0; r < 4; ++r) { P[(wave * 8 + r) * 64 + lane] = acc0[r]; P[(wave * 8 + 4 + r) * 64 + lane] = acc1[r]; }
        __syncthreads();
        if (wave == 0) {
            f32x4 s0 = {0.f, 0.f, 0.f, 0.f}, s1 = s0;
#pragma unroll
            for (int ww = 0; ww < 8; ++ww)
#pragma unroll
                for (int r = 0; r < 4; ++r) { s0[r] += P[(ww * 8 + r) * 64 + lane]; s1[r] += P[(ww * 8 + 4 + r) * 64 + lane]; }
            f.op8(row_base + i16, n0 + 8 * kq, s0, s1);
        }
        __syncthreads();
    }
}

constexpr size_t SLOT = (size_t)LTOK * 1024 * 2;
constexpr size_t WS_SLOT0 = 0;
constexpr size_t WS_WREG = 7 * SLOT;
constexpr size_t WREG_BYTES = 24117248;
constexpr size_t WS_MISC = WS_WREG + WREG_BYTES;
constexpr size_t MS_CTL = 0;
constexpr size_t MS_GI = 65536;
constexpr size_t MS_GF = MS_GI + (size_t)2 * 8 * NPOS * 4;
constexpr size_t MS_RSTD = MS_GF + (size_t)2 * 8 * NPOS * 4;
constexpr size_t MS_CELLM = MS_RSTD + (size_t)LTOK * 8 * 4;
constexpr size_t MS_VM = MS_CELLM + 64 * 2048 * 2;
constexpr size_t MS_ROPE = MS_VM + 64 * 2048 * 2;
constexpr size_t MS_ZROW = MS_ROPE + 256 * 32 * 8;
constexpr size_t MS_GB = MS_ZROW + 4096;
constexpr size_t MS_K8 = MS_GB + (size_t)2 * 8 * NPOS * 4;
constexpr size_t MS_END = MS_K8 + (size_t)KVROWS * 256;
constexpr size_t WS_NEED = WS_MISC + MS_END;
constexpr size_t WE_IN = 0, WE_GLU = WE_IN + (size_t)4608 * 1024 * 2, WE_OUT = WE_GLU + (size_t)1024 * 1024 * 2;
constexpr size_t WO_IN = 0, WO_Z = WO_IN + (size_t)2048 * 1024 * 2, WO_QK = WO_Z + (size_t)2048 * 1024 * 2, WO_V = WO_QK + (size_t)2048 * 256 * 2,
                 WO_G = WO_V + (size_t)2048 * 256 * 2, WO_OUT = WO_G + (size_t)32 * 2048 * 2, WO_OG = WE_OUT + (size_t)2048 * 1024 * 2;
static_assert(WO_V == WE_GLU && WO_OUT + (size_t)1024 * 2048 * 2 <= WO_OG && WO_OG + (size_t)2048 * 2048 * 2 == WREG_BYTES, "odd weight region");
constexpr size_t DO_EX = 0;
constexpr size_t DO_HCAT = DO_EX + (size_t)1025 * 64 * 256 * 2;
constexpr size_t DO_MG = DO_HCAT + (size_t)64 * 256 * 256 * 2;
constexpr size_t DO_APOW = DO_MG + (size_t)64 * 256 * 512 * 2;
constexpr size_t DO_BB = DO_APOW + (size_t)2 * 64 * 64 * 17 * 8;
constexpr size_t DO_KTAB = DO_BB + (size_t)2 * 64 * 64 * 16 * 8;
static_assert(DO_KTAB + (size_t)2 * 64 * 16 * 256 * 4 <= (size_t)SEQ * 1024 * 4, "d_out scratch map");

constexpr int CW_BAR = 1024;
constexpr int CW_CHK = 8192;
constexpr int LDS_TOTAL = 160 * 1024;
constexpr int LDS_MISC = LDS_TOTAL - 64;

#define XB_TMO      128
#define XB_XCNT(j)  (256  + 64 * (j))
#define XB_XSUB(j)  (1280 + 64 * (j))
#define XB_XGEN(j)  (2304 + 64 * (j))
#define XB_TOP      3328
#define XB_TOPGEN   3392
#define XCD_BAR_WORDS 3456
#define XB_SPIN_CAP (1u << 21)
DI unsigned xb_ld(unsigned* p)              { return __hip_atomic_load(p, __ATOMIC_RELAXED, __HIP_MEMORY_SCOPE_AGENT); }
DI unsigned xb_add(unsigned* p, unsigned v) { return __hip_atomic_fetch_add(p, v, __ATOMIC_RELAXED, __HIP_MEMORY_SCOPE_AGENT); }
DI unsigned xb_xcc_id() { return (unsigned)__builtin_amdgcn_s_getreg((3 << 11) | 20) & 0xFu; }
#define XB_SPIN(cond, bar) do { unsigned _sp = 0; while (cond) { __builtin_amdgcn_s_sleep(1); \
    if ((++_sp & 255u) == 0u) { if (xb_ld(&(bar)[XB_TMO])) break; if (_sp > XB_SPIN_CAP) { atomicAdd(&(bar)[XB_TMO], 1u); break; } } } } while (0)
struct XcdBarrier { unsigned* bar; unsigned x; volatile LAS unsigned* st; };
DI XcdBarrier xcd_barrier_post(unsigned* bar, volatile LAS unsigned* st) {
    XcdBarrier b; b.bar = bar; b.x = xb_xcc_id(); b.st = st;
    if (threadIdx.x == 0) (void)xb_add(&bar[XB_XCNT(b.x)], 1u);
    return b;
}
DI void xcd_barrier_complete(unsigned* bar, unsigned x, unsigned& nloc, unsigned& nx) {
    const unsigned G = gridDim.x * gridDim.y * gridDim.z;
    unsigned sum, cnt, mine, sp = 0u;
    for (;;) {
        sum = 0u; cnt = 0u; mine = 0u;
#pragma unroll
        for (unsigned j = 0; j < 16; ++j) { const unsigned c = xb_ld(&bar[XB_XCNT(j)]); sum += c; cnt += (c > 0u) ? 1u : 0u; mine = (j == x) ? c : mine; }
        if (sum == G) break;
        __builtin_amdgcn_s_sleep(1);
        if ((++sp & 255u) == 0u) { if (xb_ld(&bar[XB_TMO])) break; if (sp > XB_SPIN_CAP) { atomicAdd(&bar[XB_TMO], 1u); break; } }
    }
    nloc = mine > 0u ? mine : 1u; nx = cnt > 0u ? cnt : 1u;
}
DI void xcd_barrier(const XcdBarrier& b) {
    asm volatile("s_waitcnt vmcnt(0)" ::: "memory");
    __syncthreads();
    if (threadIdx.x == 0) {
        unsigned* bar = b.bar; lnd(bar);
        __builtin_amdgcn_s_waitcnt(0);
        unsigned nloc = b.st[0], nx = b.st[1];
        if (nloc == 0u) { xcd_barrier_complete(bar, b.x, nloc, nx); b.st[0] = nloc; b.st[1] = nx; }
        const unsigned old = xb_add(&bar[XB_XSUB(b.x)], 1u);
        const unsigned gen = old / nloc;
        if (old + 1u == (gen + 1u) * nloc) {
            __builtin_amdgcn_fence(__ATOMIC_RELEASE, "agent");
            asm volatile("s_waitcnt vmcnt(0)" ::: "memory");
            const unsigned og = xb_add(&bar[XB_TOP], 1u);
            const unsigned tg = og / nx;
            if (og + 1u == (tg + 1u) * nx) xb_add(&bar[XB_TOPGEN], 1u);
            else XB_SPIN(xb_ld(&bar[XB_TOPGEN]) == tg, bar);
            __builtin_amdgcn_fence(__ATOMIC_ACQUIRE, "agent");
            xb_add(&bar[XB_XGEN(b.x)], 1u);
            asm volatile("s_waitcnt vmcnt(0)" ::: "memory");
        } else {
            XB_SPIN(xb_ld(&bar[XB_XGEN(b.x)]) == gen, bar);
            __builtin_amdgcn_fence(__ATOMIC_ACQUIRE, "agent");
            asm volatile("s_waitcnt vmcnt(0)" ::: "memory");
        }
    }
    __syncthreads();
}

struct Params { const float* in[33]; float* out; unsigned char* ws; int ph_lo, ph_hi, use_bar, pad; };
enum { I_X = 0, I_META, I_NPRE, I_NPOST, I_WINE, I_QN, I_KN, I_ARE, I_AIM, I_LDT, I_BRE, I_BIM, I_CRE, I_CIM, I_SSMD, I_WGLU, I_BGLU, I_WOUTE,
       I_WINO, I_CONVW, I_CONVB, I_WQ, I_WK, I_WV, I_WIG, I_BIG, I_WFG, I_BFG, I_WOG, I_BOG, I_HN, I_SKIP, I_WOUTO };

struct Ctx {
    LAS unsigned char* lds;
    int tid, lane, wave, G, bid;
    int gw, ngw;
    int gws;
    const float* const* in; float* out; unsigned char* ws; unsigned char* dob;
    DI bf16* slot(int i) const { return (bf16*)(ws + WS_SLOT0 + (size_t)i * SLOT); }
    DI Ctx fresh() const { Ctx P = *this; asm volatile("" : "+v"(P.tid)); P.lane = P.tid & 63; P.wave = __builtin_amdgcn_readfirstlane(P.tid >> 6);
        asm volatile("" : "+s"(P.G)); P.ngw = P.G * NWAVES; P.gw = P.bid * NWAVES + P.wave; P.gws = P.wave * P.G + P.bid; lnd(P.ws); lnd(P.dob); lnd(P.out); return P; }
    DI unsigned char* wreg() const { return ws + WS_WREG; }
    DI unsigned char* misc() const { return ws + WS_MISC; }
};

DI void transpose_item(const float* W, int ldw, int N, bf16* WT, int ldo, int row_off, LAS float* scr, int item, int lane, const float* ks = nullptr) {
    const int nblk = N / 32, kb = item / nblk, nb = item % nblk, k0 = 64 * kb, n0 = 32 * nb;
    f32x4 v[8];
#pragma unroll
    for (int i = 0; i < 8; ++i) v[i] = *(const f32x4*)(W + (size_t)(k0 + 8 * i + (lane >> 3)) * ldw + n0 + 4 * (lane & 7));
#pragma unroll
    for (int i = 0; i < 8; ++i) { const int kk = 8 * i + (lane >> 3); const float sc = ks ? ks[k0 + kk] : 1.f; LAS float* d = scr + kk * 33 + 4 * (lane & 7);
        d[0] = v[i][0] * sc; d[1] = v[i][1] * sc; d[2] = v[i][2] * sc; d[3] = v[i][3] * sc; }
    LDS_WAIT(); asm volatile("" ::: "memory");
    const int c = lane & 7;
#pragma unroll
    for (int j = 0; j < 4; ++j) { const int n = (lane >> 3) + 8 * j; const LAS float* s = scr + (8 * c) * 33 + n;
        u32x4 o; o.x = cvt_pk_bf16(s[0 * 33], s[1 * 33]); o.y = cvt_pk_bf16(s[2 * 33], s[3 * 33]); o.z = cvt_pk_bf16(s[4 * 33], s[5 * 33]); o.w = cvt_pk_bf16(s[6 * 33], s[7 * 33]);
        *(u32x4*)(WT + (size_t)(row_off + n0 + n) * ldo + k0 + 8 * c) = o; }
    LDS_WAIT(); asm volatile("" ::: "memory");
}

DI void convert_even_weights(const Ctx& C, int li) {
    LAS float* scr = (LAS float*)(C.lds + C.wave * 8704);
    unsigned char* wr = C.wreg();
    { const int n = (1024 / 64) * (4608 / 32); for (int it = C.gw; it < n; it += C.ngw) transpose_item(C.in[I_WINE] + (size_t)li * 1024 * 4608, 4608, 4608, (bf16*)(wr + WE_IN), 1024, 0, scr, it, C.lane); }
    { const int n = (1024 / 64) * (1024 / 32); for (int it = C.gw; it < n; it += C.ngw) transpose_item(C.in[I_WGLU] + (size_t)li * 1024 * 1024, 1024, 1024, (bf16*)(wr + WE_GLU), 1024, 0, scr, it, C.lane); }
    { const int n = (2048 / 64) * (1024 / 32); for (int it = C.gw; it < n; it += C.ngw) transpose_item(C.in[I_WOUTE] + (size_t)li * 2048 * 1024, 1024, 1024, (bf16*)(wr + WE_OUT), 2048, 0, scr, it, C.lane); }
}
DI void convert_odd_early(const Ctx& C, int li) {
    LAS float* scr = (LAS float*)(C.lds + C.wave * 8704);
    unsigned char* wr = C.wreg();
    const float* win = C.in[I_WINO] + (size_t)li * 1024 * 4096;
    { const int n = (1024 / 64) * (2048 / 32);
      for (int it = C.gw; it < n; it += C.ngw) transpose_item(win, 4096, 2048, (bf16*)(wr + WO_IN), 1024, 0, scr, it, C.lane);
      for (int it = C.gw; it < n; it += C.ngw) transpose_item(win + 2048, 4096, 2048, (bf16*)(wr + WO_Z), 1024, 0, scr, it, C.lane); }
    { const int nq = (256 / 64) * (128 / 32);
      for (int it = C.gw; it < 8 * nq; it += C.ngw) { const int h = it / nq, r = it % nq;
          transpose_item(C.in[I_WQ] + ((size_t)li * 8 + h) * 256 * 128, 128, 128, (bf16*)(wr + WO_QK), 256, h * 256, scr, r, C.lane);
          transpose_item(C.in[I_WK] + ((size_t)li * 8 + h) * 256 * 128, 128, 128, (bf16*)(wr + WO_QK), 256, h * 256 + 128, scr, r, C.lane); } }
    { const int n = (2048 / 64) * (2048 / 32);
      for (int it = C.gw; it < n; it += C.ngw) transpose_item(C.in[I_WOG] + (size_t)li * 2048 * 2048, 2048, 2048, (bf16*)(wr + WO_OG), 2048, 0, scr, it, C.lane); }
}
DI void convert_odd_late(const Ctx& C, int li) {
    LAS float* scr = (LAS float*)(C.lds + C.wave * 8704);
    unsigned char* wr = C.wreg();
    { const int nv = (256 / 64) * (256 / 32);
      for (int it = C.gw; it < 8 * nv; it += C.ngw) { const int h = it / nv, r = it % nv;
          transpose_item(C.in[I_WV] + ((size_t)li * 8 + h) * 256 * 256, 256, 256, (bf16*)(wr + WO_V), 256, h * 256, scr, r, C.lane); } }
    { const int n = (2048 / 64) * (1024 / 32);
      for (int it = C.gw; it < n; it += C.ngw) transpose_item(C.in[I_WOUTO] + (size_t)li * 2048 * 1024, 1024, 1024, (bf16*)(wr + WO_OUT), 2048, 0, scr, it, C.lane); }
    { bf16* wg = (bf16*)(wr + WO_G); const float* wi = C.in[I_WIG] + (size_t)li * 2 * 2048 * 8; const float* wf = C.in[I_WFG] + (size_t)li * 2 * 2048 * 8;
      for (int i = C.gw * 64 + C.lane; i < 32 * 2048; i += C.ngw * 64) { const int n = i >> 11, c = i & 2047, ty = n >> 4, d = (n >> 3) & 1, h = n & 7;
          wg[i] = f2bf((ty ? wf : wi)[((size_t)d * 2048 + c) * 8 + h]); } }
}

DI void load_row_bf16(const bf16* p, int lane, float (&v)[16]) {
    const u32x4 a = *(const u32x4*)(p + 8 * lane), b = *(const u32x4*)(p + 512 + 8 * lane);
    float t[8]; unpack8(a, t);
#pragma unroll
    for (int i = 0; i < 8; ++i) v[i] = t[i];
    unpack8(b, t);
#pragma unroll
    for (int i = 0; i < 8; ++i) v[8 + i] = t[i];
}
DI void load_row_f32(const float* p, int lane, float (&v)[16]) {
    const f32x4 a = *(const f32x4*)(p + 8 * lane), b = *(const f32x4*)(p + 8 * lane + 4), c = *(const f32x4*)(p + 512 + 8 * lane), d = *(const f32x4*)(p + 512 + 8 * lane + 4);
#pragma unroll
    for (int i = 0; i < 4; ++i) { v[i] = a[i]; v[4 + i] = b[i]; v[8 + i] = c[i]; v[12 + i] = d[i]; }
}
DI void store_row_bf16(bf16* p, int lane, const float (&v)[16]) {
    float t[8];
#pragma unroll
    for (int i = 0; i < 8; ++i) t[i] = v[i];
    *(u32x4*)(p + 8 * lane) = pack8(t);
#pragma unroll
    for (int i = 0; i < 8; ++i) t[i] = v[8 + i];
    *(u32x4*)(p + 512 + 8 * lane) = pack8(t);
}
DI void round_bf16_16(float (&v)[16]) {
#pragma unroll
    for (int i = 0; i < 16; i += 2) { const unsigned w = cvt_pk_bf16(v[i], v[i + 1]); v[i] = bflo(w); v[i + 1] = bfhi(w); }
}
DI void rms_row(const float (&v)[16], const float* g, int lane, float (&o)[16]) {
    float s = 0.f;
#pragma unroll
    for (int i = 0; i < 16; ++i) s += v[i] * v[i];
    s = wave_sum(s, lane);
    const float r = rsqrtf(s * (1.f / 1024.f) + EPS);
    float gg[16]; load_row_f32(g, lane, gg);
#pragma unroll
    for (int i = 0; i < 16; ++i) o[i] = v[i] * r * gg[i];
}

DI void phase_init_rows(const Ctx& C, bf16* resid, bf16* hdst) {
    for (int r = C.gw; r < LTOK; r += C.ngw) {
        float v[16], o[16];
        if (r < SEQ) load_row_f32(C.in[I_X] + (size_t)r * 1024, C.lane, v); else load_row_f32(C.in[I_META] + (size_t)(r - SEQ) * 1024, C.lane, v);
        round_bf16_16(v);
        store_row_bf16(resid + (size_t)r * 1024, C.lane, v);
        rms_row(v, C.in[I_NPRE], C.lane, o);
        store_row_bf16(hdst + (size_t)r * 1024, C.lane, o);
    }
}
DI void post_row_finish(const Ctx& C, int r, const float (&v)[16], float (&rs)[16], bf16* resid, bf16* hdst, int layer) {
    float o[16];
    rms_row(v, C.in[I_NPOST] + (size_t)layer * 1024, C.lane, o);
#pragma unroll
    for (int i = 0; i < 16; ++i) rs[i] += o[i];
    if (layer == 3) {
        if (r < SEQ) { float* op = C.out + (size_t)r * 1024;
            *(f32x4*)(op + 8 * C.lane) = (f32x4){rs[0], rs[1], rs[2], rs[3]}; *(f32x4*)(op + 8 * C.lane + 4) = (f32x4){rs[4], rs[5], rs[6], rs[7]};
            *(f32x4*)(op + 512 + 8 * C.lane) = (f32x4){rs[8], rs[9], rs[10], rs[11]}; *(f32x4*)(op + 512 + 8 * C.lane + 4) = (f32x4){rs[12], rs[13], rs[14], rs[15]}; }
    } else {
        round_bf16_16(rs);
        store_row_bf16(resid + (size_t)r * 1024, C.lane, rs);
        rms_row(rs, C.in[I_NPRE] + (size_t)(layer + 1) * 1024, C.lane, o);
        store_row_bf16(hdst + (size_t)r * 1024, C.lane, o);
    }
}
DI void phase_post_rows(const Ctx& C, const bf16* y, bf16* resid, bf16* hdst, int layer, bf16* resid_out = nullptr) {
    if (!resid_out) resid_out = resid;
    for (int r = C.gw; r < LTOK; r += 2 * C.ngw) {
        const int r2 = r + C.ngw; const bool has2 = r2 < LTOK; const int r2c = has2 ? r2 : r;
        float v[16], rs[16], v2[16], rs2[16];
        load_row_bf16(y + (size_t)r * 1024, C.lane, v); load_row_bf16(resid + (size_t)r * 1024, C.lane, rs);
        load_row_bf16(y + (size_t)r2c * 1024, C.lane, v2); load_row_bf16(resid + (size_t)r2c * 1024, C.lane, rs2);
        post_row_finish(C, r, v, rs, resid_out, hdst, layer);
        if (has2) post_row_finish(C, r2, v2, rs2, resid_out, hdst, layer);
    }
}
DI void phase_renorm_rows(const Ctx& C, const bf16* resid, bf16* hdst, int layer) {
    for (int r = C.gw; r < LTOK; r += C.ngw) {
        float v[16], o[16];
        load_row_bf16(resid + (size_t)r * 1024, C.lane, v);
        rms_row(v, C.in[I_NPRE] + (size_t)layer * 1024, C.lane, o);
        store_row_bf16(hdst + (size_t)r * 1024, C.lane, o);
    }
}
DI void phase_rope_table(const Ctx& C) {
    f32x2* tab = (f32x2*)(C.misc() + MS_ROPE);
    for (int i = C.gw * 64 + C.lane; i < 256 * 32; i += C.ngw * 64) { const int pos = i >> 5, j = i & 31;
        const float f = fexp(-(float)j * (9.210340371976184f / 32.f));
        float rev = (float)pos * f * 0.15915494309189535f; rev -= rintf(rev);
        tab[i] = (f32x2){__builtin_amdgcn_cosf(rev), __builtin_amdgcn_sinf(rev)}; }
}

DI void store8(bf16* dst, f32x4 a, f32x4 b) { *(u32x4*)dst = pack8v(a, b); }
DI f32x4 silu4(f32x4 v) { return (f32x4){silu_f(v[0]), silu_f(v[1]), silu_f(v[2]), silu_f(v[3])}; }
struct FEvenIn { static constexpr bool PIPE = false;
    bf16 *YAB, *Kb, *Vb, *GA, *U;
    DI void launder() { lnd(YAB); lnd(Kb); lnd(Vb); lnd(GA); lnd(U); }
    DI void op8(int row, int col, f32x4 a, f32x4 b) const {
        bf16* dst; bool act = false;
        if (col < 1024) dst = YAB + (size_t)row * 2048 + col;
        else if (col < 1280) dst = Kb + (size_t)row * 256 + (col - 1024);
        else if (col < 1536) dst = Vb + (size_t)row * 256 + (col - 1280);
        else if (col < 2560) { dst = GA + (size_t)row * 1024 + (col - 1536); act = true; }
        else if (col < 3584) { const int cu = col - 2560, rp = row < SEQ ? row + 16 : row - SEQ;
            dst = U + ((size_t)(cu >> 4) * LTOK + rp) * 16 + (cu & 15); }
        else { dst = YAB + (size_t)row * 2048 + 1024 + (col - 3584); act = true; }
        if (act) { a = silu4(a); b = silu4(b); }
        store8(dst, a, b);
    }
};
struct FPlain { static constexpr bool PIPE = false; bf16* O; int ldo; DI void launder() { lnd(O); } DI void op8(int row, int col, f32x4 a, f32x4 b) const { store8(O + (size_t)row * ldo + col, a, b); } };
struct FSilu { static constexpr bool PIPE = false; bf16* O; int ldo; DI void launder() { lnd(O); } DI void op8(int row, int col, f32x4 a, f32x4 b) const { store8(O + (size_t)row * ldo + col, silu4(a), silu4(b)); } };
struct FGlu {
    static constexpr bool PIPE = true;
    const bf16* YG; bf16* YAB; const float* bias;
    struct Pre { u32x4 yg, gb; };
    struct Cols { f32x4 b0, b1; };
    DI void launder() { lnd(YG); lnd(YAB); lnd(bias); }
    DI Cols cols(int col) const { Cols c; c.b0 = *(const f32x4*)(bias + col); c.b1 = *(const f32x4*)(bias + col + 4); return c; }
    DI Pre pre(int row, int col) const { Pre p; p.yg = *(const u32x4*)(YG + (size_t)row * 1024 + col); p.gb = *(const u32x4*)(YAB + (size_t)row * 2048 + 1024 + col); return p; }
    DI void fin(int row, int col, f32x4 a, f32x4 b, const Pre& p, const Cols& c) const {
        float yg[8], gb[8], o[8]; unpack8(p.yg, yg); unpack8(p.gb, gb);
#pragma unroll
        for (int j = 0; j < 4; ++j) { o[j] = yg[j] * sigmoid_f(a[j] + c.b0[j]) * gb[j]; o[4 + j] = yg[4 + j] * sigmoid_f(b[j] + c.b1[j]) * gb[4 + j]; }
        *(u32x4*)(YAB + (size_t)row * 2048 + 1024 + col) = pack8(o);
    }
    DI void op8(int row, int col, f32x4 a, f32x4 b) const { fin(row, col, a, b, pre(row, col), cols(col)); }
};
struct FQK { static constexpr bool PIPE = false;
    bf16 *Q, *Kd;
    DI void launder() { lnd(Q); lnd(Kd); }
    DI void op8(int row, int col, f32x4 a, f32x4 b) const { const int h = col >> 8, w = col & 255;
        bf16* dst = (w < 128) ? Q + (size_t)row * 1024 + h * 128 + w : Kd + (size_t)row * 1024 + h * 128 + (w - 128);
        store8(dst, a, b); }
};
struct FVrow { static constexpr bool PIPE = false;
    bf16 *V, *VM;
    DI void launder() { lnd(V); lnd(VM); }
    DI void op8(int row, int col, f32x4 a, f32x4 b) const { bf16* dst = (row < SEQ) ? V + (size_t)row * 2048 + col : VM + (size_t)(row - SEQ) * 2048 + col; store8(dst, a, b); }
};
struct FOgate {
    static constexpr bool PIPE = true;
    const bf16 *CELL, *CELLM, *XC, *SZ; bf16* HZ; const float *bo, *hn, *skip, *rstd;
    struct Pre { u32x4 ce, xc, sz; float rs; };
    struct Cols { f32x4 b0, b1, h0, h1, s0, s1; };
    DI void launder() { lnd(CELL); lnd(CELLM); lnd(XC); lnd(SZ); lnd(HZ); lnd(bo); lnd(hn); lnd(skip); lnd(rstd); }
    DI Cols cols(int col) const { Cols c; c.b0 = *(const f32x4*)(bo + col); c.b1 = *(const f32x4*)(bo + col + 4); c.h0 = *(const f32x4*)(hn + col); c.h1 = *(const f32x4*)(hn + col + 4);
        c.s0 = *(const f32x4*)(skip + col); c.s1 = *(const f32x4*)(skip + col + 4); return c; }
    DI Pre pre(int row, int col) const { Pre p;
        const bf16* cp = (row < SEQ) ? CELL + (size_t)row * 2048 + col : CELLM + (size_t)(row - SEQ) * 2048 + col;
        p.ce = *(const u32x4*)cp; p.xc = *(const u32x4*)(XC + (size_t)row * 2048 + col); p.sz = *(const u32x4*)(SZ + (size_t)row * 2048 + col); p.rs = rstd[(size_t)row * 8 + (col >> 8)]; return p; }
    DI void fin(int row, int col, f32x4 a, f32x4 b, const Pre& p, const Cols& c) const {
        float ce[8], xc[8], sz[8], o[8]; unpack8(p.ce, ce); unpack8(p.xc, xc); unpack8(p.sz, sz);
        const float rs = p.rs;
#pragma unroll
        for (int j = 0; j < 4; ++j) {
            o[j] = (sigmoid_f(a[j] + c.b0[j]) * (ce[j] * rs * c.h0[j]) + c.s0[j] * xc[j]) * sz[j];
            o[4 + j] = (sigmoid_f(b[j] + c.b1[j]) * (ce[4 + j] * rs * c.h1[j]) + c.s1[j] * xc[4 + j]) * sz[4 + j]; }
        *(u32x4*)(HZ + (size_t)row * 2048 + col) = pack8(o);
    }
    DI void op8(int row, int col, f32x4 a, f32x4 b) const { fin(row, col, a, b, pre(row, col), cols(col)); }
};

template <int LDA, int LDB, int KK, int NN, int APN, class F>
DI void run_gemm(const Ctx& C, const bf16* A, const bf16* Bt, const F& f0) {
    F f = f0; f.launder(); lnd(A); lnd(Bt);
    gemm_tail<F>(C.lds, A + (size_t)SEQ * LDA, LDA, Bt, LDB, KK, NN, APN, f, SEQ, C.bid, C.G, C.wave, C.lane);
    pg8::Gemm g{A, Bt};
    pg8::StaticOrder<NN / 256> S; S.init(C.G, C.bid);
    typedef typename pg8::EpiSel<F>::type Epi;
    Epi E{f};
    pg8::gemm_phase<Epi, pg8::StaticOrder<NN / 256>, LDA, LDB, KK, APN>(C.lds, g, S, E);
}

DI void phase_qk_norm_rope(const Ctx& C, bf16* YAB, bf16* Kb, const float* qn, const float* kn, unsigned char* K8, bf16* dummy = nullptr) {
    const f32x2* tab = (const f32x2*)(C.misc() + MS_ROPE);
    const int sub = C.lane & 15, grp = C.lane >> 4;
    const int nitems = LTOK * 10;
    constexpr int NB = 7;
    const f32x4 gq0 = *(const f32x4*)(qn + sub * 8), gq1 = *(const f32x4*)(qn + sub * 8 + 4), gk0 = *(const f32x4*)(kn + sub * 8), gk1 = *(const f32x4*)(kn + sub * 8 + 4);
    for (int it0 = C.gw * 4; it0 < nitems; it0 += C.ngw * 4 * NB) {
        bf16* p[NB]; u32x4 raw[NB]; bool ok[NB]; int rowv[NB], hsv[NB]; f32x4 tb[NB][4];
#pragma unroll
        for (int b = 0; b < NB; ++b) { const int it = it0 + b * C.ngw * 4 + grp; ok[b] = it < nitems; const int itc = ok[b] ? it : nitems - 1;
            const int row = itc / 10, hs = itc - row * 10; rowv[b] = row; hsv[b] = hs;
            p[b] = (hs < 8) ? YAB + (size_t)row * 2048 + hs * 128 + sub * 8 : Kb + (size_t)row * 256 + (hs - 8) * 128 + sub * 8;
            raw[b] = *(const u32x4*)p[b]; }
#pragma unroll
        for (int b = 0; b < NB; ++b) {
            int pos = 0; if (rowv[b] < SEQ) pos = (sub < 8) ? (rowv[b] >> 6) : (rowv[b] & 63);
            const f32x4* tp = (const f32x4*)(tab + pos * 32 + (sub & 3) * 8);
#pragma unroll
            for (int e = 0; e < 4; ++e) tb[b][e] = tp[e]; }
#pragma unroll
        for (int b = 0; b < NB; ++b) { const int row = rowv[b], hs = hsv[b];
            float v[8]; unpack8(raw[b], v);
            float s = 0.f;
#pragma unroll
            for (int e = 0; e < 8; ++e) s += v[e] * v[e];
            s += shx(s, 1, C.lane); s += shx(s, 2, C.lane); s += shx(s, 4, C.lane); s += shx(s, 8, C.lane);
            const float r = rsqrtf(s * (1.f / 128.f) + EPS);
            const bool isq = hs < 8;
            f32x4 g0, g1;
#pragma unroll
            for (int e = 0; e < 4; ++e) { g0[e] = isq ? gq0[e] : gk0[e]; g1[e] = isq ? gq1[e] : gk1[e]; }
#pragma unroll
            for (int e = 0; e < 4; ++e) { v[e] = v[e] * r * g0[e]; v[4 + e] = v[4 + e] * r * g1[e]; }
            const bool first = (sub & 4) == 0;
            float o[8];
#pragma unroll
            for (int e = 0; e < 8; ++e) {
                const float other = shx(v[e], 4, C.lane);
                const float cx = tb[b][e >> 1][(e & 1) * 2], cy = tb[b][e >> 1][(e & 1) * 2 + 1];
                o[e] = first ? (v[e] * cx - other * cy) : (v[e] * cx + other * cy);
            }
            bf16* dp = dummy ? dummy + (size_t)((rowv[b] * 10 + hsv[b]) & 65535) * 128 + sub * 8 : p[b];
            if (ok[b]) { *(u32x4*)dp = pack8(o);
                if (hs >= 8) { int w0 = 0, w1 = 0;
                    w0 = __builtin_amdgcn_cvt_pk_fp8_f32(o[0], o[1], w0, false); w0 = __builtin_amdgcn_cvt_pk_fp8_f32(o[2], o[3], w0, true);
                    w1 = __builtin_amdgcn_cvt_pk_fp8_f32(o[4], o[5], w1, false); w1 = __builtin_amdgcn_cvt_pk_fp8_f32(o[6], o[7], w1, true);
                    *(u32x2*)(K8 + (size_t)row * 256 + (hs - 8) * 128 + sub * 8) = (u32x2){(unsigned)w0, (unsigned)w1}; } } }
    }
}

namespace att {
constexpr int D = 128, NW = 8, QBLK = 32, KVBLK = 64;
constexpr float SCALE = 0.088388347648318440f;
constexpr float THR = 8.f;
constexpr int LDQ = 2048, LDK = 256, LDG = 1024;
constexpr size_t SHM_V = KVBLK * D * 2, SHM_K = KVBLK * D * 2, SHM_ATTN = 2 * SHM_V + 2 * SHM_K + NW * 64 * 4;
constexpr int NT_C = KVROWS / KVBLK;
#define KSWZ(row, colB) ((row) * 256 + ((colB) ^ (((row) & 7) << 4)))
#define SBAR() __builtin_amdgcn_sched_barrier(0)
DI int crow(int r, int hi) { return (r & 3) + 8 * (r >> 2) + 4 * hi; }
DI unsigned cvtpk_asm(float lo, float hi) { unsigned r; asm volatile("v_cvt_pk_bf16_f32 %0, %1, %2" : "=v"(r) : "v"(lo), "v"(hi)); return r; }
template <bool F8 = false> DI void partialSM(f32x16& p0, f32x16& p1, float& m_reg, float& mn, float& alpha) {
  constexpr float Cc = SCALE * 1.4426950408889634f;
  float pmax = p0[0];
#pragma unroll
  for (int r = 1; r < 16; ++r) pmax = fmaxf(pmax, p0[r]);
#pragma unroll
  for (int r = 0; r < 16; ++r) pmax = fmaxf(pmax, p1[r]);
  { auto rr = __builtin_amdgcn_permlane32_swap(__float_as_uint(pmax), __float_as_uint(pmax), false, false);
    pmax = fmaxf(__uint_as_float(rr[0]), __uint_as_float(rr[1])); }
  if (__builtin_expect(__all(pmax - m_reg <= (F8 ? 2.5f : THR) / SCALE), 1)) { mn = m_reg; alpha = 1.f; }
  else { mn = fmaxf(m_reg, pmax); alpha = __builtin_amdgcn_exp2f((m_reg - mn) * Cc); m_reg = mn; }
  const float mnC = -mn * Cc + (F8 ? 5.f : 0.f);
#pragma unroll
  for (int r = 0; r < 16; ++r) p0[r] = fmaf(p0[r], Cc, mnC);
#pragma unroll
  for (int r = 0; r < 16; ++r) p1[r] = fmaf(p1[r], Cc, mnC);
#pragma unroll
  for (int r = 0; r < 16; ++r) p0[r] = __builtin_amdgcn_exp2f(p0[r]);
}
DI void finishSM(f32x16& p0, f32x16& p1, float alpha, float& l_reg, bf16x8& pa0, bf16x8& pa1, bf16x8& pa2, bf16x8& pa3) {
#pragma unroll
  for (int r = 0; r < 16; ++r) p1[r] = __builtin_amdgcn_exp2f(p1[r]);
  float ps = 0;
#pragma unroll
  for (int r = 0; r < 16; ++r) ps += p0[r];
#pragma unroll
  for (int r = 0; r < 16; ++r) ps += p1[r];
  { auto rr = __builtin_amdgcn_permlane32_swap(__float_as_uint(ps), __float_as_uint(ps), false, false);
    ps = __uint_as_float(rr[0]) + __uint_as_float(rr[1]); }
  l_reg = l_reg * alpha + ps;
#define PK4(P, BASE, OUT) do { unsigned a0 = cvtpk_asm(P[BASE + 0], P[BASE + 1]), a1 = cvtpk_asm(P[BASE + 2], P[BASE + 3]);   \
    unsigned b0 = cvtpk_asm(P[BASE + 4], P[BASE + 5]), b1 = cvtpk_asm(P[BASE + 6], P[BASE + 7]);                              \
    auto r0 = __builtin_amdgcn_permlane32_swap(a0, b0, false, false); auto r1 = __builtin_amdgcn_permlane32_swap(a1, b1, false, false); \
    u32x4 w = {r0[0], r1[0], r0[1], r1[1]}; OUT = *reinterpret_cast<bf16x8*>(&w); } while (0)
  PK4(p0, 0, pa0); PK4(p0, 8, pa1); PK4(p1, 0, pa2); PK4(p1, 8, pa3);
#undef PK4
}
DI void qkt(f32x16& p0, f32x16& p1, const LAS char* Ks, const bf16x8* qr, int r32, int hi) {
  p0 = f32x16{}; p1 = f32x16{};
#pragma unroll
  for (int d0 = 0; d0 < 8; ++d0) { const int cb = (d0 * 16 + hi * 8) * 2;
    const bf16x8 b0 = *(const LAS bf16x8*)(Ks + KSWZ(r32, cb));
    const bf16x8 b1 = *(const LAS bf16x8*)(Ks + KSWZ(32 + r32, cb));
    p0 = MFMA32(b0, qr[d0], p0);
    p1 = MFMA32(b1, qr[d0], p1); }
}
typedef int i32x8 __attribute__((ext_vector_type(8)));
constexpr size_t SHM_K8 = KVBLK * D;
#define K8SW(row, c) ((row) * 128 + ((((c) ^ (((row) >> 1) & 7))) << 4))
DI void qkt8(f32x16& p0, f32x16& p1, const LAS char* Ks, const i32x8* q8, int r32, int hi) {
  p0 = f32x16{}; p1 = f32x16{};
#pragma unroll
  for (int s2 = 0; s2 < 2; ++s2) { const int c0 = 4 * s2 + 2 * hi;
    const u32x4 a0 = *(const LAS u32x4*)(Ks + K8SW(r32, c0)), a1 = *(const LAS u32x4*)(Ks + K8SW(r32, c0 + 1));
    const u32x4 b0 = *(const LAS u32x4*)(Ks + K8SW(32 + r32, c0)), b1 = *(const LAS u32x4*)(Ks + K8SW(32 + r32, c0 + 1));
    const i32x8 A = {(int)a0.x, (int)a0.y, (int)a0.z, (int)a0.w, (int)a1.x, (int)a1.y, (int)a1.z, (int)a1.w};
    const i32x8 B = {(int)b0.x, (int)b0.y, (int)b0.z, (int)b0.w, (int)b1.x, (int)b1.y, (int)b1.z, (int)b1.w};
    p0 = __builtin_amdgcn_mfma_scale_f32_32x32x64_f8f6f4(A, q8[s2], p0, 0, 0, 0, 0x7f7f7f7f, 0, 0x7f7f7f7f);
    p1 = __builtin_amdgcn_mfma_scale_f32_32x32x64_f8f6f4(B, q8[s2], p1, 0, 0, 0, 0x7f7f7f7f, 0, 0x7f7f7f7f); }
}
constexpr float CQ8 = SCALE * 1.4426950408889634f * 8.f;
constexpr float THRL = 2.5f * 1.4426950408889634f;
DI void qkt8c(f32x16& p0, f32x16& p1, const LAS char* Ks, const i32x8* q8, const f32x16& cinit, int r32, int hi) {
  { const int c0 = 2 * hi;
    const u32x4 a0 = *(const LAS u32x4*)(Ks + K8SW(r32, c0)), a1 = *(const LAS u32x4*)(Ks + K8SW(r32, c0 + 1));
    const u32x4 b0 = *(const LAS u32x4*)(Ks + K8SW(32 + r32, c0)), b1 = *(const LAS u32x4*)(Ks + K8SW(32 + r32, c0 + 1));
    const i32x8 A = {(int)a0.x, (int)a0.y, (int)a0.z, (int)a0.w, (int)a1.x, (int)a1.y, (int)a1.z, (int)a1.w};
    const i32x8 B = {(int)b0.x, (int)b0.y, (int)b0.z, (int)b0.w, (int)b1.x, (int)b1.y, (int)b1.z, (int)b1.w};
    p0 = __builtin_amdgcn_mfma_scale_f32_32x32x64_f8f6f4(A, q8[0], cinit, 0, 0, 0, 0x7f7f7f7f, 0, 0x7c7c7c7c);
    p1 = __builtin_amdgcn_mfma_scale_f32_32x32x64_f8f6f4(B, q8[0], cinit, 0, 0, 0, 0x7f7f7f7f, 0, 0x7c7c7c7c); }
  { const int c0 = 4 + 2 * hi;
    const u32x4 a0 = *(const LAS u32x4*)(Ks + K8SW(r32, c0)), a1 = *(const LAS u32x4*)(Ks + K8SW(r32, c0 + 1));
    const u32x4 b0 = *(const LAS u32x4*)(Ks + K8SW(32 + r32, c0)), b1 = *(const LAS u32x4*)(Ks + K8SW(32 + r32, c0 + 1));
    const i32x8 A = {(int)a0.x, (int)a0.y, (int)a0.z, (int)a0.w, (int)a1.x, (int)a1.y, (int)a1.z, (int)a1.w};
    const i32x8 B = {(int)b0.x, (int)b0.y, (int)b0.z, (int)b0.w, (int)b1.x, (int)b1.y, (int)b1.z, (int)b1.w};
    p0 = __builtin_amdgcn_mfma_scale_f32_32x32x64_f8f6f4(A, q8[1], p0, 0, 0, 0, 0x7f7f7f7f, 0, 0x7c7c7c7c);
    p1 = __builtin_amdgcn_mfma_scale_f32_32x32x64_f8f6f4(B, q8[1], p1, 0, 0, 0, 0x7f7f7f7f, 0, 0x7c7c7c7c); }
}
DI float rowmax32(const f32x16& p0, const f32x16& p1) {
  float pmax = p0[0];
#pragma unroll
  for (int r = 1; r < 16; ++r) pmax = fmaxf(pmax, p0[r]);
#pragma unroll
  for (int r = 0; r < 16; ++r) pmax = fmaxf(pmax, p1[r]);
  auto rr = __builtin_amdgcn_permlane32_swap(__float_as_uint(pmax), __float_as_uint(pmax), false, false);
  return fmaxf(__uint_as_float(rr[0]), __uint_as_float(rr[1]));
}
DI void partialSM8(f32x16& p0, f32x16& p1, float& m_reg, float& alpha, f32x16& cinit) {
  const float pmax = rowmax32(p0, p1);
  if (__builtin_expect(__all(pmax <= 5.f + THRL), 1)) alpha = 1.f;
  else { const float dl = fmaxf(pmax - 5.f, 0.f); alpha = __builtin_amdgcn_exp2f(-dl); m_reg += dl; const float ci = 5.f - m_reg;
#pragma unroll
    for (int r = 0; r < 16; ++r) { p0[r] -= dl; p1[r] -= dl; cinit[r] = ci; } }
#pragma unroll
  for (int r = 0; r < 16; ++r) p0[r] = __builtin_amdgcn_exp2f(p0[r]);
}
DI void firstSM8(f32x16& p0, f32x16& p1, float& m_reg, float& alpha, f32x16& cinit) {
  m_reg = rowmax32(p0, p1); alpha = 1.f; const float ci = 5.f - m_reg;
#pragma unroll
  for (int r = 0; r < 16; ++r) { p0[r] += ci; p1[r] += ci; cinit[r] = ci; }
#pragma unroll
  for (int r = 0; r < 16; ++r) p0[r] = __builtin_amdgcn_exp2f(p0[r]);
}
typedef short s16x2 __attribute__((__vector_size__(2 * sizeof(short))));
constexpr float CQS = SCALE * 1.4426950408889634f * 8.f;
constexpr float THRS = 2.5f * 1.4426950408889634f;
DI void qkt8s(f32x16& p0, f32x16& p1, const LAS char* Ks, const i32x8* q8, int r32, int hi) {
  p0 = f32x16{}; p1 = f32x16{};
#pragma unroll
  for (int s2 = 0; s2 < 2; ++s2) { const int c0 = 4 * s2 + 2 * hi;
    const u32x4 a0 = *(const LAS u32x4*)(Ks + K8SW(r32, c0)), a1 = *(const LAS u32x4*)(Ks + K8SW(r32, c0 + 1));
    const u32x4 b0 = *(const LAS u32x4*)(Ks + K8SW(32 + r32, c0)), b1 = *(const LAS u32x4*)(Ks + K8SW(32 + r32, c0 + 1));
    const i32x8 A = {(int)a0.x, (int)a0.y, (int)a0.z, (int)a0.w, (int)a1.x, (int)a1.y, (int)a1.z, (int)a1.w};
    const i32x8 B = {(int)b0.x, (int)b0.y, (int)b0.z, (int)b0.w, (int)b1.x, (int)b1.y, (int)b1.z, (int)b1.w};
    p0 = __builtin_amdgcn_mfma_scale_f32_32x32x64_f8f6f4(A, q8[s2], p0, 0, 0, 0, 0x7f7f7f7f, 0, 0x7c7c7c7c);
    p1 = __builtin_amdgcn_mfma_scale_f32_32x32x64_f8f6f4(B, q8[s2], p1, 0, 0, 0, 0x7f7f7f7f, 0, 0x7c7c7c7c); }
}
DI void partialSMs(f32x16& p0, f32x16& p1, float& M, float& alpha, float& scl) {
  float pmax = p0[0];
#pragma unroll
  for (int r = 1; r < 16; ++r) pmax = fmaxf(pmax, p0[r]);
#pragma unroll
  for (int r = 0; r < 16; ++r) pmax = fmaxf(pmax, p1[r]);
  { auto rr = __builtin_amdgcn_permlane32_swap(__float_as_uint(pmax), __float_as_uint(pmax), false, false);
    pmax = fmaxf(__uint_as_float(rr[0]), __uint_as_float(rr[1])); }
  if (__builtin_expect(__all(pmax - M <= THRS), 1)) alpha = 1.f;
  else { const float Mn = fmaxf(M, ceilf(pmax)); alpha = __builtin_amdgcn_exp2f(M - Mn); M = Mn; }
  scl = __builtin_amdgcn_exp2f(M - 5.f);
#pragma unroll
  for (int r = 0; r < 16; ++r) p0[r] = __builtin_amdgcn_exp2f(p0[r]);
}
DI int pk4s_fp8(float a, float b, float c, float d, float scl) {
  s16x2 w = __builtin_bit_cast(s16x2, a);
  w = __builtin_amdgcn_cvt_scalef32_pk_fp8_f32(w, a, b, scl, false); w = __builtin_amdgcn_cvt_scalef32_pk_fp8_f32(w, c, d, scl, true);
  return __builtin_bit_cast(int, w);
}
DI void finishSMs(f32x16& p0, f32x16& p1, i32x8& pa, float scl) {
#pragma unroll
  for (int r = 0; r < 16; ++r) p1[r] = __builtin_amdgcn_exp2f(p1[r]);
#pragma unroll
  for (int i = 0; i < 4; ++i) { pa[i] = pk4s_fp8(p0[4 * i], p0[4 * i + 1], p0[4 * i + 2], p0[4 * i + 3], scl); pa[4 + i] = pk4s_fp8(p1[4 * i], p1[4 * i + 1], p1[4 * i + 2], p1[4 * i + 3], scl); }
}
#define V8SW(d, c) ((d) * 64 + ((((c) ^ (((d) >> 2) & 3))) << 4))
DI int pk4_fp8(float a, float b, float c, float d) { int w = 0; w = __builtin_amdgcn_cvt_pk_fp8_f32(a, b, w, false); return __builtin_amdgcn_cvt_pk_fp8_f32(c, d, w, true); }
DI void finishSM8(f32x16& p0, f32x16& p1, i32x8& pa) {
#pragma unroll
  for (int r = 0; r < 16; ++r) p1[r] = __builtin_amdgcn_exp2f(p1[r]);
#pragma unroll
  for (int i = 0; i < 4; ++i) { pa[i] = pk4_fp8(p0[4 * i], p0[4 * i + 1], p0[4 * i + 2], p0[4 * i + 3]); pa[4 + i] = pk4_fp8(p1[4 * i], p1[4 * i + 1], p1[4 * i + 2], p1[4 * i + 3]); }
}
DI void pv8(f32x16* o, f32x16& lacc, const LAS char* Vs, const i32x8 pa, int r32, int hi) {
  { const int one4 = 0x38383838; const i32x8 ones = {one4, one4, one4, one4, one4, one4, one4, one4};
    lacc = __builtin_amdgcn_mfma_scale_f32_32x32x64_f8f6f4(pa, ones, lacc, 0, 0, 0, 0x7f7f7f7f, 0, 0x7f7f7f7f); }
#pragma unroll
  for (int db = 0; db < 4; ++db) { const int d = 32 * db + r32;
    const u32x4 a0 = *(const LAS u32x4*)(Vs + V8SW(d, 2 * hi)), a1 = *(const LAS u32x4*)(Vs + V8SW(d, 2 * hi + 1));
    const i32x8 B = {(int)a0.x, (int)a0.y, (int)a0.z, (int)a0.w, (int)a1.x, (int)a1.y, (int)a1.z, (int)a1.w};
    o[db] = __builtin_amdgcn_mfma_scale_f32_32x32x64_f8f6f4(pa, B, o[db], 0, 0, 0, 0x7f7f7f7f, 0, 0x7f7f7f7f); }
}
DI int v_st(int k, int c) { const int kk = (k & ~0xC) | ((k & 4) << 1) | ((k & 8) >> 1); return ((kk >> 3) * 4 + (c >> 5)) * 512 + ((kk & 7) * 32 + (c & 31)) * 2; }
DI int v_rd_base(int lane) { return ((lane & 3) << 3) | (((lane >> 2) & 3) << 6) | (((lane >> 4) & 1) << 5) | (((lane >> 5) & 1) << 8); }
constexpr int v_rd_off(int d0, int ks, int half) { return d0 * 512 + ks * 4096 + half * 2048; }
template <int OFF> DI s16x4 tr_read(int vb) { s16x4 r; asm volatile("ds_read_b64_tr_b16 %0, %1 offset:%2" : "=&v"(r) : "v"(vb), "i"(OFF) : "memory"); return r; }
template <int D0> DI void pv_one(f32x16& od, int vb, bf16x8 pa0, bf16x8 pa1, bf16x8 pa2, bf16x8 pa3) {
  const s16x4 l0 = tr_read<v_rd_off(D0, 0, 0)>(vb), h0 = tr_read<v_rd_off(D0, 0, 1)>(vb), l1 = tr_read<v_rd_off(D0, 1, 0)>(vb), h1 = tr_read<v_rd_off(D0, 1, 1)>(vb);
  const s16x4 l2 = tr_read<v_rd_off(D0, 2, 0)>(vb), h2 = tr_read<v_rd_off(D0, 2, 1)>(vb), l3 = tr_read<v_rd_off(D0, 3, 0)>(vb), h3 = tr_read<v_rd_off(D0, 3, 1)>(vb);
  asm volatile("s_waitcnt lgkmcnt(0)" ::: "memory"); SBAR();
#define PKV(L, H) (bf16x8){L[0], L[1], L[2], L[3], H[0], H[1], H[2], H[3]}
  od = MFMA32(pa0, PKV(l0, h0), od);
  od = MFMA32(pa1, PKV(l1, h1), od);
  od = MFMA32(pa2, PKV(l2, h2), od);
  od = MFMA32(pa3, PKV(l3, h3), od);
#undef PKV
}
DI void pv_d0(f32x16* o, int vb, bf16x8 pa0, bf16x8 pa1, bf16x8 pa2, bf16x8 pa3) {
  pv_one<0>(o[0], vb, pa0, pa1, pa2, pa3); pv_one<1>(o[1], vb, pa0, pa1, pa2, pa3); pv_one<2>(o[2], vb, pa0, pa1, pa2, pa3); pv_one<3>(o[3], vb, pa0, pa1, pa2, pa3);
}
DI void mask_tail(f32x16& p0, f32x16& p1) {
#pragma unroll
  for (int r = 8; r < 16; ++r) p0[r] = -1e30f;
#pragma unroll
  for (int r = 0; r < 16; ++r) p1[r] = -1e30f;
}
template <int LDO> DI void attn_unit(const bf16* Qb, bf16* Ob, const unsigned char* K8h, const unsigned char* V8h, const bf16* Gb, int nvalid, LAS char* lds) {
  lnd(Qb); lnd(Ob); lnd(K8h); lnd(V8h); lnd(Gb);
  int NT = NT_C; asm volatile("" : "+s"(NT));
  int tid = threadIdx.x; asm volatile("" : "+v"(tid));
  const int wid = tid >> 6, lane = tid & 63, r32 = lane & 31, hi = lane >> 5;
  LAS char* K_lds = lds; LAS char* V_lds = lds + 4 * SHM_K8;
  LAS float* wsf = (LAS float*)(lds + 8 * SHM_K8) + wid * 64; LAS float* li_l = wsf; LAS float* al_l = wsf + 32;
  float m_reg = -1e30f; f32x16 o[4] = {}, lacc = {}; i32x8 qr[2];
  { const bf16* Qw = Qb + (long)(wid * QBLK + r32) * LDQ + hi * 32;
    u32x4 qraw[2][4];
#pragma unroll
    for (int s2 = 0; s2 < 2; ++s2)
#pragma unroll
      for (int c = 0; c < 4; ++c) qraw[s2][c] = *reinterpret_cast<const u32x4*>(Qw + s2 * 64 + c * 8);
#pragma unroll
    for (int s2 = 0; s2 < 2; ++s2)
#pragma unroll
      for (int c = 0; c < 4; ++c) { float f[8]; unpack8(qraw[s2][c], f); int w0 = 0, w1 = 0;
#pragma unroll
        for (int e = 0; e < 8; ++e) f[e] *= CQS;
        w0 = __builtin_amdgcn_cvt_pk_fp8_f32(f[0], f[1], w0, false); w0 = __builtin_amdgcn_cvt_pk_fp8_f32(f[2], f[3], w0, true);
        w1 = __builtin_amdgcn_cvt_pk_fp8_f32(f[4], f[5], w1, false); w1 = __builtin_amdgcn_cvt_pk_fp8_f32(f[6], f[7], w1, true);
        qr[s2][2 * c] = w0; qr[s2][2 * c + 1] = w1; } }
  const unsigned kdo = (unsigned)((tid >> 3) * 256 + (((tid & 7) ^ ((tid >> 4) & 7)) << 4));
  const unsigned vdo = (unsigned)((tid >> 2) * 64 + (((tid & 3) ^ ((tid >> 4) & 3)) << 4));
  const unsigned ldw = (unsigned)(tid >> 6) * 1024u;
#define SDMA(b, k0) do { \
    __builtin_amdgcn_global_load_lds((const unsigned*)(K8h + (long)(k0) * 256 + kdo), (LAS unsigned*)(K_lds + (b) * (int)SHM_K8 + ldw), 16, 0, 0); \
    __builtin_amdgcn_global_load_lds((const unsigned*)(V8h + (long)(k0) * 128 + vdo), (LAS unsigned*)(V_lds + (b) * (int)SHM_K8 + ldw), 16, 0, 0); } while (0)
#define VWAIT(n) asm volatile("s_waitcnt vmcnt(" #n ")" ::: "memory")
#define RESC(a) do { if (__any((a) < 1.f)) { if (hi == 0) al_l[r32] = (a); asm volatile("s_waitcnt lgkmcnt(0)" ::: "memory"); \
    _Pragma("unroll") for (int r = 0; r < 16; ++r) { const float a_ = al_l[crow(r, hi)]; lacc[r] *= a_; _Pragma("unroll") for (int d = 0; d < 4; ++d) o[d][r] *= a_; } } } while (0)
  f32x16 pA0, pA1, pB0, pB1; float alA, alB, sclA = 1.f, sclB = 1.f; i32x8 pa;
  SDMA(0, 0); SDMA(1, KVBLK); VWAIT(0); __syncthreads();
  qkt8s(pA0, pA1, K_lds, qr, r32, hi); partialSMs(pA0, pA1, m_reg, alA, sclA);
  SDMA(2, 2 * KVBLK);
  static_assert((NT_C - 1) % 4 == 0, "tile count vs the 4-tile unroll");
#define ATT_STEP(CUR, PRV, KB, VB, DB, MODE_, T_) do { \
    SBAR(); qkt8s(p##CUR##0, p##CUR##1, K_lds + (KB) * (int)SHM_K8, qr, r32, hi); \
    if ((MODE_) == 2) mask_tail(p##CUR##0, p##CUR##1); \
    finishSMs(p##PRV##0, p##PRV##1, pa, scl##PRV); SBAR(); \
    if ((MODE_) == 0) SDMA((DB), ((T_) + 2) * KVBLK); \
    SBAR(); \
    pv8(o, lacc, V_lds + (VB) * (int)SHM_K8, pa, r32, hi); partialSMs(p##CUR##0, p##CUR##1, m_reg, al##CUR, scl##CUR); \
    RESC(al##CUR); \
    if ((MODE_) == 0) VWAIT(2); else VWAIT(0); \
    __syncthreads(); } while (0)
  int t = 1;
  for (; t + 5 < NT; t += 4) {
    ATT_STEP(B, A, 1, 0, 3, 0, t);
    ATT_STEP(A, B, 2, 1, 0, 0, t + 1);
    ATT_STEP(B, A, 3, 2, 1, 0, t + 2);
    ATT_STEP(A, B, 0, 3, 2, 0, t + 3);
  }
  ATT_STEP(B, A, 1, 0, 3, 0, t);
  ATT_STEP(A, B, 2, 1, 0, 0, t + 1);
  ATT_STEP(B, A, 3, 2, 1, 1, t + 2);
  ATT_STEP(A, B, 0, 3, 2, 2, t + 3);
#undef ATT_STEP
  finishSMs(pA0, pA1, pa, sclA); SBAR();
  pv8(o, lacc, V_lds, pa, r32, hi);
  float rli[16];
#pragma unroll
  for (int r = 0; r < 16; ++r) rli[r] = __builtin_amdgcn_rcpf(lacc[r]);
#pragma unroll
  for (int rb = 0; rb < 16; rb += 8) {
    float gt[8][4];
#pragma unroll
    for (int r = 0; r < 8; ++r) { const int orow = wid * QBLK + crow(rb + r, hi); const bf16* gp = Gb + (long)(orow < nvalid ? orow : 0) * LDG + r32;
      gt[r][0] = bf2f(gp[0]); gt[r][1] = bf2f(gp[32]); gt[r][2] = bf2f(gp[64]); gt[r][3] = bf2f(gp[96]); }
#pragma unroll
    for (int r = 0; r < 8; ++r) { const int orow = wid * QBLK + crow(rb + r, hi);
      if (orow < nvalid) { bf16* qp = Ob + (long)orow * LDO + r32; const float sc_ = rli[rb + r];
        qp[0] = f2bf(o[0][rb + r] * sc_ * gt[r][0]); qp[32] = f2bf(o[1][rb + r] * sc_ * gt[r][1]); qp[64] = f2bf(o[2][rb + r] * sc_ * gt[r][2]); qp[96] = f2bf(o[3][rb + r] * sc_ * gt[r][3]); } }
    asm volatile("" ::: "memory");
  }
  __syncthreads();
#undef SDMA
#undef VWAIT
#undef RESC
}

constexpr int NSEG = 128;
DI void attn_meta_unit(const bf16* YABm, const bf16* Kh, const bf16* Vh, int g, int t0, int t1, float* Pout, float* MLout, LAS char* lds) {
  lnd(YABm); lnd(Kh); lnd(Vh); lnd(Pout); lnd(MLout);
  int tid = threadIdx.x; asm volatile("" : "+v"(tid));
  const int wid = tid >> 6, lane = tid & 63, r32 = lane & 31, hi = lane >> 5;
  LAS char* V_lds = lds; LAS char* K_lds = lds + 2 * SHM_V;
  LAS float* wsf = (LAS float*)(lds + 2 * SHM_V + 2 * SHM_K) + wid * 64; LAS float* al_l = wsf + 32;
  float m_reg = -1e30f, l_reg = 0; f32x16 o[4] = {}; bf16x8 qr[8];
  const int rr = (wid & 1) * 32 + r32, hq = rr >> 4, mt = rr & 15;
  const bf16* Qw = YABm + (long)mt * LDQ + (4 * g + hq) * 128 + hi * 8;
#pragma unroll
  for (int d0 = 0; d0 < 8; ++d0) qr[d0] = *reinterpret_cast<const bf16x8*>(Qw + d0 * 16);
  const int sr = tid >> 4, sc = (tid & 15) * 8, vst0 = v_st(sr, sc), vst1 = v_st(32 + sr, sc);
  const int vb0 = (int)(unsigned)(uintptr_t)V_lds + v_rd_base(lane);
  for (int t = t0; t < t1; ++t) {
    const long k0 = (long)t * KVBLK;
    const bf16x8 vs0 = *(const bf16x8*)(&Vh[(k0 + sr) * LDK + sc]), vs1 = *(const bf16x8*)(&Vh[(k0 + 32 + sr) * LDK + sc]);
    const bf16x8 ks0 = *(const bf16x8*)(&Kh[(k0 + sr) * LDK + sc]), ks1 = *(const bf16x8*)(&Kh[(k0 + 32 + sr) * LDK + sc]);
    *(LAS bf16x8*)(V_lds + vst0) = vs0; *(LAS bf16x8*)(V_lds + vst1) = vs1;
    *(LAS bf16x8*)(K_lds + KSWZ(sr, sc * 2)) = ks0; *(LAS bf16x8*)(K_lds + KSWZ(32 + sr, sc * 2)) = ks1;
    __syncthreads();
    if (wid < 2) {
      f32x16 p0, p1; float mn, al; bf16x8 pa0, pa1, pa2, pa3;
      qkt(p0, p1, K_lds, qr, r32, hi);
      if (t == NT_C - 1) mask_tail(p0, p1);
      partialSM(p0, p1, m_reg, mn, al);
      if (__any(al < 1.f)) { if (hi == 0) al_l[r32] = al; asm volatile("s_waitcnt lgkmcnt(0)" ::: "memory");
#pragma unroll
        for (int d = 0; d < 4; ++d)
#pragma unroll
          for (int r = 0; r < 16; ++r) o[d][r] *= al_l[crow(r, hi)]; }
      finishSM(p0, p1, al, l_reg, pa0, pa1, pa2, pa3); SBAR();
      pv_d0(o, vb0, pa0, pa1, pa2, pa3);
    }
    __syncthreads();
  }
  if (wid < 2) {
    if (hi == 0) { MLout[rr * 2] = m_reg; MLout[rr * 2 + 1] = l_reg; }
#pragma unroll
    for (int r = 0; r < 16; ++r) { const int orow = (wid & 1) * 32 + crow(r, hi);
#pragma unroll
      for (int d0 = 0; d0 < 4; ++d0) Pout[(long)orow * 128 + d0 * 32 + r32] = o[d0][r]; }
  }
  __syncthreads();
}
}

constexpr size_t ATT_PART_OFF = (size_t)20 << 20;
DI void phase_v8_image(const Ctx& C, const bf16* Vb, unsigned char* V8t) {
    const int k = C.lane, blk = k >> 5, wi = k & 31, pos = ((wi >> 2) & 1) * 32 + blk * 16 + (wi >> 3) * 4 + (wi & 3);
    for (int it = C.gw; it < 2 * att::NT_C * 16; it += C.ngw) {
        const int dg = it & 15, tile = (it >> 4) % att::NT_C, g = it / (16 * att::NT_C);
        float f[8]; unpack8(*(const u32x4*)(Vb + (size_t)(tile * 64 + k) * 256 + g * 128 + dg * 8), f);
        unsigned char* dst = V8t + ((size_t)(g * att::NT_C + tile) * 128 + dg * 8) * 64 + pos;
#pragma unroll
        for (int e = 0; e < 8; e += 2) { const int w = __builtin_amdgcn_cvt_pk_fp8_f32(f[e], f[e + 1], 0, false); dst[(e) * 64] = (unsigned char)(w & 255); dst[(e + 1) * 64] = (unsigned char)((w >> 8) & 255); }
    }
}
DI void phase_attention(const Ctx& C, bf16* YAB, const bf16* Kb, const bf16* Vb, const bf16* GA, const unsigned char* K8, const unsigned char* V8t) {
    constexpr int NUNIT = 64 * 8;
    for (int u = C.bid; u < NUNIT; u += C.G) {
        const int h = u & 7, qb = u >> 3, row0 = qb * 256, g = h >> 2;
        #ifdef EXP_ATT2
        att::attn_unit<1024>(YAB + (size_t)row0 * 2048 + h * 128, C.slot(5) + (size_t)row0 * 1024 + h * 128, K8 + g * 128, V8t + (size_t)g * att::NT_C * 8192, GA + (size_t)row0 * 1024 + h * 128, 256, (LAS char*)C.lds);
#endif
        att::attn_unit<2048>(YAB + (size_t)row0 * 2048 + h * 128, YAB + (size_t)row0 * 2048 + h * 128, K8 + g * 128, V8t + (size_t)g * att::NT_C * 8192, GA + (size_t)row0 * 1024 + h * 128, 256, (LAS char*)C.lds);
    }
    float* P = (float*)((unsigned char*)C.slot(6) + ATT_PART_OFF); float* ML = P + (size_t)2 * att::NSEG * 64 * 128;
#ifdef DBL_META
    for (int u = C.bid; u < 2 * att::NSEG; u += C.G) {
        const int g = u & 1, seg = u >> 1, t0 = 2 * seg, t1 = (seg == att::NSEG - 1) ? att::NT_C : 2 * seg + 2;
        att::attn_meta_unit(YAB + (size_t)SEQ * 2048, Kb + g * 128, Vb + g * 128, g, t0, t1, P + (size_t)u * 64 * 128, ML + (size_t)u * 128, (LAS char*)C.lds);
    }
#endif
    for (int u = C.bid; u < 2 * att::NSEG; u += C.G) {
        const int g = u & 1, seg = u >> 1, t0 = 2 * seg, t1 = (seg == att::NSEG - 1) ? att::NT_C : 2 * seg + 2;
        att::attn_meta_unit(YAB + (size_t)SEQ * 2048, Kb + g * 128, Vb + g * 128, g, t0, t1, P + (size_t)u * 64 * 128, ML + (size_t)u * 128, (LAS char*)C.lds);
    }
}
DI void phase_attention_combine(const Ctx& C, bf16* YAB, const bf16* GA) {
    const float* P = (const float*)((unsigned char*)C.slot(6) + ATT_PART_OFF); const float* ML = P + (size_t)2 * att::NSEG * 64 * 128;
    constexpr float Cc = att::SCALE * 1.4426950408889634f;
    LAS float* X = (LAS float*)C.lds;
    for (int it = C.bid; it < 128; it += C.G) {
        const int mt = it & 15, h = it >> 4, g = h >> 2, hq = h & 3, rr = hq * 16 + mt, w = C.wave, lane = C.lane;
        float M = -1e30f;
#pragma unroll
        for (int s = 0; s < 16; ++s) M = fmaxf(M, ML[(size_t)((16 * w + s) * 2 + g) * 128 + rr * 2]);
        float a0 = 0.f, a1 = 0.f, l = 0.f;
#pragma unroll 4
        for (int s = 0; s < 16; ++s) { const size_t u = (size_t)((16 * w + s) * 2 + g); const float wt = __builtin_amdgcn_exp2f((ML[u * 128 + rr * 2] - M) * Cc);
            l += ML[u * 128 + rr * 2 + 1] * wt; a0 += P[(u * 64 + rr) * 128 + lane] * wt; a1 += P[(u * 64 + rr) * 128 + 64 + lane] * wt; }
        X[w * 130 + lane] = a0; X[w * 130 + 64 + lane] = a1; if (lane == 0) { X[w * 130 + 128] = l; X[w * 130 + 129] = M; }
        __syncthreads();
        if (w == 0) {
            float Mg = -1e30f;
#pragma unroll
            for (int ww = 0; ww < 8; ++ww) Mg = fmaxf(Mg, X[ww * 130 + 129]);
            float b0 = 0.f, b1 = 0.f, lg = 0.f;
#pragma unroll
            for (int ww = 0; ww < 8; ++ww) { const float wt = __builtin_amdgcn_exp2f((X[ww * 130 + 129] - Mg) * Cc); lg += X[ww * 130 + 128] * wt; b0 += X[ww * 130 + lane] * wt; b1 += X[ww * 130 + 64 + lane] * wt; }
            const float inv = 1.f / lg; const size_t row = SEQ + mt;
            YAB[row * 2048 + h * 128 + lane] = f2bf(b0 * inv * bf2f(GA[row * 1024 + h * 128 + lane]));
            YAB[row * 2048 + h * 128 + 64 + lane] = f2bf(b1 * inv * bf2f(GA[row * 1024 + h * 128 + 64 + lane]));
        }
        __syncthreads();
    }
}

constexpr int S5_NCH = 1025;
DI int s5_row0(int c) { return c == 0 ? SEQ : 16 * (c - 1); }
DI void cis_rev(float ang, float& c, float& s) { float rev = ang * 0.15915494309189535f; rev -= rintf(rev); c = __builtin_amdgcn_cosf(rev); s = __builtin_amdgcn_sinf(rev); }

DI void phase_s5_tables(const Ctx& C, int li) {
    f32x2* apow = (f32x2*)(C.dob + DO_APOW); f32x2* bb = (f32x2*)(C.dob + DO_BB);
    for (int i = C.gw * 64 + C.lane; i < 2 * 64 * 64; i += C.ngw * 64) {
        const int d = i >> 12, g = (i >> 6) & 63;
        const size_t pidx = (size_t)li * 2 * 64 * 64 + i;
        const float ar = C.in[I_ARE][pidx], ai = C.in[I_AIM][pidx];
        const float dt = fexp(C.in[I_LDT][(size_t)li * 128 + d * 64 + g]);
#pragma unroll 1
        for (int e = 0; e <= 16; ++e) { float c, s; cis_rev((float)e * ai * dt, c, s); const float mg = fexp((float)e * ar * dt); apow[(size_t)i * 17 + e] = (f32x2){mg * c, mg * s}; }
        float c1, s1; cis_rev(ai * dt, c1, s1); const float m1 = fexp(ar * dt);
        const float xr = m1 * c1 - 1.f, xi = m1 * s1, inv = 1.f / (ar * ar + ai * ai);
        const float kr = (xr * ar + xi * ai) * inv, ki = (xi * ar - xr * ai) * inv;
        const float* bre = C.in[I_BRE] + pidx * 16; const float* bim = C.in[I_BIM] + pidx * 16;
#pragma unroll 4
        for (int p = 0; p < 16; ++p) { const float br = bre[p], bi = bim[p]; bb[(size_t)i * 16 + p] = (f32x2){kr * br - ki * bi, kr * bi + ki * br}; }
    }
}
DI void phase_s5_ktab_hcat(const Ctx& C, int li) {
    const f32x2* apow = (const f32x2*)(C.dob + DO_APOW); const f32x2* bb = (const f32x2*)(C.dob + DO_BB);
    float* ktab = (float*)(C.dob + DO_KTAB); bf16* hcat = (bf16*)(C.dob + DO_HCAT);
    const bool half_grid = C.G == 256;
    for (int task = half_grid ? ((C.bid >= 128 && C.wave < 4) ? (C.bid - 128) * 4 + C.wave : 512) : C.gws; task < 512; task += half_grid ? 512 : C.ngw) {
        const int dg = task >> 2, dl = (task & 3) * 4 + (C.lane >> 4), q = C.lane & 15;
        const float* cre = C.in[I_CRE] + ((size_t)li * 128 + dg) * 1024; const float* cim = C.in[I_CIM] + ((size_t)li * 128 + dg) * 1024;
        float acc[16];
#pragma unroll
        for (int p = 0; p < 16; ++p) acc[p] = 0.f;
#pragma unroll 4
        for (int n = 0; n < 64; ++n) { const f32x2 a = apow[((size_t)dg * 64 + n) * 17 + dl], b = bb[((size_t)dg * 64 + n) * 16 + q];
            const float wr = a.x * b.x - a.y * b.y, wi = a.x * b.y + a.y * b.x;
#pragma unroll
            for (int p = 0; p < 16; ++p) acc[p] += cre[p * 64 + n] * wr - cim[p * 64 + n] * wi; }
#pragma unroll
        for (int p = 0; p < 16; ++p) ktab[(((size_t)dg * 16 + dl) * 16 + p) * 16 + q] = acc[p];
    }
    for (int i = C.gw * 64 + C.lane; i < 64 * 256 * 32; i += C.ngw * 64) {
        const int k8 = i & 31, rho = (i >> 5) & 255, g = i >> 13;
        const int d = rho >> 7, n = (rho >> 1) & 63, ri = rho & 1, s = k8 >> 1, q0 = (k8 & 1) * 8;
        const size_t dgn = ((size_t)d * 64 + g) * 64 + n;
        const f32x2 a = apow[dgn * 17 + (d == 0 ? 15 - s : s)];
        float o[8];
#pragma unroll
        for (int j = 0; j < 8; ++j) { const f32x2 b = bb[dgn * 16 + q0 + j]; o[j] = ri ? (a.x * b.y + a.y * b.x) : (a.x * b.x - a.y * b.y); }
        *(u32x4*)(hcat + ((size_t)g * 256 + rho) * 256 + k8 * 8) = pack8(o);
    }
}
DI void phase_s5_mg(const Ctx& C, int li) {
    const f32x2* apow = (const f32x2*)(C.dob + DO_APOW); const float* ktab = (const float*)(C.dob + DO_KTAB); bf16* mg = (bf16*)(C.dob + DO_MG);
    const float* dsk = C.in[I_SSMD] + (size_t)li * 1024;
    for (int i = C.gw * 64 + C.lane; i < 64 * 256 * 32; i += C.ngw * 64) {
        const int k8 = i & 31, tp = (i >> 5) & 255, g = i >> 13, t = tp >> 4, p = tp & 15, s = k8 >> 1, q0 = (k8 & 1) * 8;
        f32x4 v0 = {0.f, 0.f, 0.f, 0.f}, v1 = v0;
        if (s <= t) { const float* kp = ktab + ((((size_t)0 * 64 + g) * 16 + (t - s)) * 16 + p) * 16 + q0; v0 += *(const f32x4*)kp; v1 += *(const f32x4*)(kp + 4); }
        if (s >= t) { const float* kp = ktab + ((((size_t)1 * 64 + g) * 16 + (s - t)) * 16 + p) * 16 + q0; v0 += *(const f32x4*)kp; v1 += *(const f32x4*)(kp + 4); }
        float o[8];
#pragma unroll
        for (int j = 0; j < 4; ++j) { o[j] = v0[j]; o[4 + j] = v1[j]; }
        if (s == t) { const float dd = dsk[g * 16 + p];
#pragma unroll
            for (int j = 0; j < 8; ++j) o[j] += (p == q0 + j) ? dd : 0.f; }
        *(u32x4*)(mg + ((size_t)g * 256 + tp) * 512 + k8 * 8) = pack8(o);
    }
    for (int i = C.gw * 64 + C.lane; i < 64 * 256 * 32; i += C.ngw * 64) {
        const int k8 = i & 31, tp = (i >> 5) & 255, g = i >> 13, t = tp >> 4, p = tp & 15;
        const int rho0 = k8 * 8, d = rho0 >> 7, n0 = (rho0 >> 1) & 63; const size_t dg = (size_t)d * 64 + g;
        const float* cre = C.in[I_CRE] + (((size_t)li * 2 * 64 + dg) * 16 + p) * 64; const float* cim = C.in[I_CIM] + (((size_t)li * 2 * 64 + dg) * 16 + p) * 64;
        const int e = d == 0 ? t + 1 : 16 - t;
        const f32x4 cr = *(const f32x4*)(cre + n0), ci = *(const f32x4*)(cim + n0);
        float o[8];
#pragma unroll
        for (int m = 0; m < 4; ++m) { const f32x2 a = apow[(dg * 64 + n0 + m) * 17 + e];
            o[2 * m] = cr[m] * a.x - ci[m] * a.y; o[2 * m + 1] = -(cr[m] * a.y + ci[m] * a.x); }
        *(u32x4*)(mg + ((size_t)g * 256 + tp) * 512 + 256 + k8 * 8) = pack8(o);
    }
}
DI bf16x8 s5_ufrag(const bf16* U, int g, int c0, int kstep, int lane) {
    int c = c0 + (lane & 15); if (c >= S5_NCH) c = S5_NCH - 1;
    const int s = kstep * 2 + (lane >> 5), q0 = ((lane >> 4) & 1) * 8;
    return *(const bf16x8*)(U + ((size_t)g * LTOK + 16 * c + s) * 16 + q0);
}
DI void phase_s5_local(const Ctx& C, const bf16* U) {
    const bf16* hcat = (const bf16*)(C.dob + DO_HCAT); bf16* ex = (bf16*)(C.dob + DO_EX);
    const int i16 = C.lane & 15, q4 = C.lane >> 4;
    for (int task = C.gw; task < 2048; task += C.ngw) {
        const int qu = task & 3, rr = (task >> 2) & 7, g = task >> 5;
        bf16x8 af[4][8];
#pragma unroll
        for (int m = 0; m < 4; ++m)
#pragma unroll
            for (int ks = 0; ks < 8; ++ks) af[m][ks] = *(const bf16x8*)(hcat + ((size_t)g * 256 + qu * 64 + m * 16 + i16) * 256 + ks * 32 + q4 * 8);
        for (int blk = rr; blk < 65; blk += 8) {
            const int c0 = blk * 16;
            f32x4 acc[4];
#pragma unroll
            for (int m = 0; m < 4; ++m) acc[m] = (f32x4){0.f, 0.f, 0.f, 0.f};
#pragma unroll
            for (int ks = 0; ks < 8; ++ks) { const bf16x8 b = s5_ufrag(U, g, c0, ks, C.lane);
#pragma unroll
                for (int m = 0; m < 4; ++m) acc[m] = MFMA16(af[m][ks], b, acc[m]); }
            const int c = c0 + i16;
            if (c < S5_NCH) {
#pragma unroll
                for (int m = 0; m < 4; ++m) { u32x2 w; w.x = cvt_pk_bf16(acc[m][0], acc[m][1]); w.y = cvt_pk_bf16(acc[m][2], acc[m][3]);
                    *(u32x2*)(ex + ((size_t)c * 64 + g) * 256 + qu * 64 + m * 16 + q4 * 4) = w; } }
        }
    }
}
template <bool DUMMY = false> DI void phase_s5_scan(const Ctx& C) {
    const f32x2* apow = (const f32x2*)(C.dob + DO_APOW); unsigned* ex = DUMMY ? (unsigned*)C.slot(1) : (unsigned*)(C.dob + DO_EX);
    if (C.gws >= 128) return;
    const int ch = C.gws * 64 + C.lane;
    const int g = ch >> 7, d = (ch >> 6) & 1, n = ch & 63;
    const f32x2 a16 = apow[(((size_t)d * 64 + g) * 64 + n) * 17 + 16];
    float xr = 0.f, xi = 0.f;
    unsigned* p = ex + ((size_t)g * 128 + d * 64 + n) + (d == 0 ? (size_t)0 : (size_t)(S5_NCH - 1) * 8192);
    const long step = d == 0 ? 8192 : -8192;
    unsigned w[41], wn[41];
#pragma unroll
    for (int j = 0; j < 41; ++j) w[j] = p[(long)j * step];
    for (int i = 0; i < S5_NCH; i += 41) {
        if (i + 41 < S5_NCH) {
#pragma unroll
            for (int j = 0; j < 41; ++j) wn[j] = p[(long)(41 + j) * step];
        }
#pragma unroll
        for (int j = 0; j < 41; ++j) { const float er = bflo(w[j]), ei = bfhi(w[j]);
            p[(long)j * step] = cvt_pk_bf16(xr, xi);
            const float nr = a16.x * xr - a16.y * xi + er, ni = a16.x * xi + a16.y * xr + ei; xr = nr; xi = ni; }
#pragma unroll
        for (int j = 0; j < 41; ++j) w[j] = wn[j];
        p += 41 * step;
    }
}
DI void phase_s5_out(const Ctx& C, const bf16* U, bf16* YG) {
    const bf16* mg = (const bf16*)(C.dob + DO_MG); const bf16* ex = (const bf16*)(C.dob + DO_EX);
    const int i16 = C.lane & 15, q4 = C.lane >> 4, w = C.wave;
    LAS bf16x8* Bst = (LAS bf16x8*)C.lds;
    for (int wt = C.bid; wt < 256; wt += C.G) {
        const int yy = wt >> 3, rr = yy & 3, g = ((wt & 7) * 2 + (yy >> 4)) * 4 + ((yy >> 2) & 3), e8 = w;
        bf16x8 af[2][16];
#pragma unroll
        for (int m = 0; m < 2; ++m)
#pragma unroll
            for (int ks = 0; ks < 16; ++ks) af[m][ks] = *(const bf16x8*)(mg + ((size_t)g * 256 + e8 * 32 + m * 16 + i16) * 512 + ks * 32 + q4 * 8);
#define S5O_LD(dst0, dst1, c0_) do { if (w < 4) { dst0 = s5_ufrag(U, g, (c0_), 2 * w, C.lane); dst1 = s5_ufrag(U, g, (c0_), 2 * w + 1, C.lane); } \
            else { int cc_ = (c0_) + i16; if (cc_ >= S5_NCH) cc_ = S5_NCH - 1; const bf16* xp_ = ex + ((size_t)cc_ * 64 + g) * 256 + (2 * w - 8) * 32 + q4 * 8; \
                dst0 = *(const bf16x8*)xp_; dst1 = *(const bf16x8*)(xp_ + 32); } } while (0)
#define S5O_BLOCK(BUF_, RS0_, RS1_, RL0_, RL1_) do { const int c0 = blk * 16; \
            if (blk + 8 < 65) S5O_LD(RL0_, RL1_, c0 + 128); \
            f32x4 acc[2]; acc[0] = (f32x4){0.f, 0.f, 0.f, 0.f}; acc[1] = acc[0]; \
            _Pragma("unroll") for (int ks = 0; ks < 16; ++ks) { const bf16x8 b = Bst[((BUF_) * 16 + ks) * 64 + C.lane]; \
                acc[0] = MFMA16(af[0][ks], b, acc[0]); acc[1] = MFMA16(af[1][ks], b, acc[1]); } \
            const int c = c0 + i16; \
            if (c < S5_NCH) { \
                _Pragma("unroll") for (int m = 0; m < 2; ++m) { const int tp = e8 * 32 + m * 16 + q4 * 4, t = tp >> 4, p = tp & 15; \
                    u32x2 wv; wv.x = cvt_pk_bf16(gelu_tanh_f(acc[m][0]), gelu_tanh_f(acc[m][1])); wv.y = cvt_pk_bf16(gelu_tanh_f(acc[m][2]), gelu_tanh_f(acc[m][3])); \
                    *(u32x2*)(YG + (size_t)(s5_row0(c) + t) * 1024 + g * 16 + p) = wv; } } \
            if (blk + 4 < 65) { Bst[(((BUF_) ^ 1) * 16 + 2 * w) * 64 + C.lane] = RS0_; Bst[(((BUF_) ^ 1) * 16 + 2 * w + 1) * 64 + C.lane] = RS1_; } \
            __syncthreads(); } while (0)
        bf16x8 a0, a1, b0, b1;
        S5O_LD(a0, a1, rr * 16);
        Bst[(2 * w) * 64 + C.lane] = a0; Bst[(2 * w + 1) * 64 + C.lane] = a1;
        S5O_LD(a0, a1, rr * 16 + 64);
        __syncthreads();
        for (int blk = rr; blk < 65; blk += 8) {
            S5O_BLOCK(0, a0, a1, b0, b1);
            blk += 4;
            if (blk < 65) S5O_BLOCK(1, b0, b1, a0, a1);
            blk -= 4;
        }
#undef S5O_BLOCK
#undef S5O_LD
    }
}

DI int seq_of_row(int r) { return r < SEQ ? r + 16 : r - SEQ; }
DI int row_of_seq(int l) { return l < 16 ? SEQ + l : l - 16; }
DI void phase_conv(const Ctx& C, const bf16* XM, bf16* XC, const float* cw, const float* cb) {
    const int nitems = (LTOK / 8) * 256;
    for (int it = C.gw * 64 + C.lane; it < nitems; it += C.ngw * 64) {
        const int l0 = (it >> 8) * 8, c0 = (it & 255) * 8;
        float w[5][8], bias[8];
        { const f32x4 b0 = *(const f32x4*)(cb + c0), b1 = *(const f32x4*)(cb + c0 + 4);
#pragma unroll
          for (int e = 0; e < 4; ++e) { bias[e] = b0[e]; bias[4 + e] = b1[e]; } }
#pragma unroll
        for (int j = 0; j < 5; ++j) { const f32x4 w0 = *(const f32x4*)(cw + (size_t)j * 2048 + c0), w1 = *(const f32x4*)(cw + (size_t)j * 2048 + c0 + 4);
#pragma unroll
            for (int e = 0; e < 4; ++e) { w[j][e] = w0[e]; w[j][4 + e] = w1[e]; } }
        u32x4 xr[12];
#pragma unroll
        for (int r = 0; r < 12; ++r) { const int l2 = l0 + r - 2; xr[r] = (l2 >= 0 && l2 < LTOK) ? *(const u32x4*)(XM + (size_t)row_of_seq(l2) * 2048 + c0) : (u32x4){0u, 0u, 0u, 0u}; }
#pragma unroll
        for (int o = 0; o < 8; ++o) { float acc[8];
#pragma unroll
            for (int e = 0; e < 8; ++e) acc[e] = bias[e];
#pragma unroll
            for (int j = 0; j < 5; ++j) { float x[8]; unpack8(xr[o + j], x);
#pragma unroll
                for (int e = 0; e < 8; ++e) acc[e] += w[j][e] * x[e]; }
            float ov[8];
#pragma unroll
            for (int e = 0; e < 8; ++e) ov[e] = silu_f(acc[e]);
            *(u32x4*)(XC + (size_t)row_of_seq(l0 + o) * 2048 + c0) = pack8(ov); }
    }
}
DI int pos_of_row(int r) { return r < SEQ ? r + 64 : r - SEQ + 48; }
DI int row_of_pos(int pos) { return pos >= 64 ? pos - 64 : (pos >= 48 ? SEQ + pos - 48 : -1); }
DI float log_sigmoid_f(float x) { return fminf(x, 0.f) - __logf(1.f + __expf(-fabsf(x))); }
DI void phase_gates(const Ctx& C, const bf16* XC, const bf16* WG, const float* big, const float* bfg) {
    float* GA = (float*)(C.misc() + MS_GI); float* GCM = (float*)(C.misc() + MS_GF); float* GB = (float*)(C.misc() + MS_GB);
    const int lane = C.lane, r32 = lane & 31, hi = lane >> 5, w = C.wave, tid = C.tid;
    LAS float* P = (LAS float*)C.lds;
    LAS float* G = (LAS float*)(C.lds + 65536);
    for (int c = C.bid; c < 257; c += C.G) {
        const int rbase = c == 0 ? SEQ - 48 : 64 * (c - 1);
        const bf16* bp = WG + (size_t)r32 * 2048 + w * 256 + hi * 8;
#pragma unroll
        for (int j = 0; j < 2; ++j) {
            if (c == 0 && j == 0) continue;
            const bf16* ap = XC + (size_t)(rbase + 32 * j + r32) * 2048 + w * 256 + hi * 8;
            f32x16 acc = {};
#pragma unroll
            for (int k0 = 0; k0 < 256; k0 += 16) acc = MFMA32(*(const bf16x8*)(ap + k0), *(const bf16x8*)(bp + k0), acc);
#pragma unroll
            for (int r = 0; r < 16; ++r) { const int p = 32 * j + (r & 3) + 8 * (r >> 2) + 4 * hi; P[(w * 64 + p) * 32 + r32] = acc[r]; }
        }
        __syncthreads();
#pragma unroll
        for (int e = 0; e < 4; ++e) { const int idx = tid + 512 * e, p = idx >> 5, n = idx & 31; float v = 0.f;
#pragma unroll
            for (int ww = 0; ww < 8; ++ww) v += P[(ww * 64 + p) * 32 + n];
            const int ty = n >> 4; v += (ty ? bfg : big)[n & 15];
            v = ty ? log_sigmoid_f(v) : v; if (c == 0 && p < 48) v = ty ? 0.f : -1e9f;
            G[p * 33 + n] = v; }
        __syncthreads();
#pragma unroll 1
        for (int q = 0; q < 2; ++q) { const int dh = 2 * w + q, d = dh >> 3;
            const float li = G[lane * 33 + dh], lf = G[lane * 33 + 16 + dh];
            float b = lf;
#pragma unroll
            for (int o = 1; o < 64; o <<= 1) { const float x = shf(b, d == 0 ? lane - o : lane + o); const bool ok = d == 0 ? (lane >= o) : (lane + o < 64); b += ok ? x : 0.f; }
            const float a = li - b; float cm = a;
#pragma unroll
            for (int o = 1; o < 64; o <<= 1) { const float x = shf(cm, d == 0 ? lane - o : lane + o); const bool ok = d == 0 ? (lane >= o) : (lane + o < 64); cm = ok ? fmaxf(cm, x) : cm; }
            const size_t idx = (size_t)dh * NPOS + 64 * c + lane;
            GA[idx] = a; GCM[idx] = cm; GB[idx] = b; }
        __syncthreads();
    }
}
DI void phase_cell_merge(const Ctx& C, bf16* CELL, bf16* CELLM, const bf16* V2, const bf16* VM2, bf16* dummy = nullptr) {
    float* rstd = (float*)(C.misc() + MS_RSTD);
    const int sub = C.lane & 31, half = C.lane >> 5;
    constexpr int NIT = LTOK * 8;
    for (int it = C.gw * 2; it < NIT; it += C.ngw * 4) {
        int idx[2]; bf16* p[2]; u32x4 wa[2], wb[2];
#pragma unroll
        for (int k = 0; k < 2; ++k) { int i = it + half + k * C.ngw * 2; if (i >= NIT) i = NIT - 1; idx[k] = i; const int row = i >> 3, h = i & 7;
            const size_t off = (size_t)(row < SEQ ? row : row - SEQ) * 2048 + h * 256 + sub * 8;
            p[k] = (row < SEQ ? CELL : CELLM) + off; wa[k] = *(const u32x4*)p[k]; wb[k] = *(const u32x4*)((row < SEQ ? V2 : VM2) + off); }
#pragma unroll
        for (int k = 0; k < 2; ++k) { float a[8], b[8]; unpack8(wa[k], a); unpack8(wb[k], b); float s = 0.f;
#pragma unroll
            for (int e = 0; e < 8; ++e) a[e] += b[e];
            const u32x4 w = pack8(a); unpack8(w, a);
#pragma unroll
            for (int e = 0; e < 8; ++e) s += a[e] * a[e];
            const bool live = (k == 0) || (it + half + C.ngw * 2 < NIT);
            if (live) *(u32x4*)(dummy ? dummy + ((size_t)idx[k] * 256 + sub * 8) % ((size_t)16 << 20) : p[k]) = w;
            s += shx(s, 1, C.lane); s += shx(s, 2, C.lane); s += shx(s, 4, C.lane); s += shx(s, 8, C.lane); s += shx(s, 16, C.lane);
            if (sub == 0 && live) rstd[idx[k]] = rsqrtf(s * (1.f / 256.f) + EPS); }
    }
}

namespace ml {
constexpr int TILE = 44032;
constexpr int QS = 0, KS = 17408, VT = 34816, VTW = 39424, NXB = 2 * TILE, NXSZ = 17408, NIB = NXB + 2 * NXSZ, NISZ = 8704, SC = NIB + 2 * NISZ, LDS_END = SC + 4 * 1536;
constexpr int SC_A = 0, SC_M = 256, SC_ISC = 512, SC_FLO = 768, SC_W = 1024, SC_DEC = 1280, SC_STRIDE = 1536;
constexpr float QSCALE = 0.08838834764831845f;
DI s16x4 trr(unsigned addr) { s16x4 r; asm volatile("ds_read_b64_tr_b16 %0, %1" : "=&v"(r) : "v"(addr) : "memory"); return r; }
template <int OFF> DI s16x4 trro(unsigned base) { s16x4 r; asm volatile("ds_read_b64_tr_b16 %0, %1 offset:%2" : "=&v"(r) : "v"(base), "i"(OFF) : "memory"); return r; }
static_assert(LDS_END <= LDS_MISC, "mLSTM LDS map");
}
constexpr int CW_PROG = 12288;
DI void phase_mlstm(const Ctx& C, int epoch, const bf16* Q, const bf16* K, bf16* V, bf16* VM, bf16* CELL, bf16* CELLM, bf16* V2d, bf16* VM2d) {
    using namespace ml;
    const float* GA = (const float*)(C.misc() + MS_GI); const float* GCM = (const float*)(C.misc() + MS_GF); const float* GB = (const float*)(C.misc() + MS_GB); const bf16* ZR = (const bf16*)(C.misc() + MS_ZROW);
    unsigned* prog = (unsigned*)(C.misc() + MS_CTL) + CW_PROG;
    const int w = C.wave, tid = C.tid, lane = C.lane, i16 = lane & 15, q4 = lane >> 4;
    const bool intra = w < 4; const int be = w & 1, eta = (w >> 1) & 1;
    LAS unsigned char* L = C.lds;
    for (int unit = C.bid; unit < 256; unit += C.G) {
        const int h = unit & 7, sl = (unit >> 3) & 15, d = unit >> 7;
        const int lo_ = d == 0 ? w : 3 - w;
        unsigned* prog_me = prog + unit * 16; unsigned* prog_pa = prog + (unit ^ 128) * 16;
        const float* ga = GA + (size_t)(d * 8 + h) * NPOS; const float* gcm = GCM + (size_t)(d * 8 + h) * NPOS; const float* gb = GB + (size_t)(d * 8 + h) * NPOS;
        for (int i = tid; i < 2 * 16 * 72; i += NTHR) { const int b = i / (16 * 72), r = i % (16 * 72), v = 16 + r / 72, s = r % 72;
            ((LAS bf16*)(L + b * TILE + VT))[v * 72 + s] = (v == 16) ? (bf16)0x3f80 : (bf16)0; ((LAS bf16*)(L + b * TILE + VTW))[v * 72 + s] = 0; }
        f32x4 Cs0 = {0.f, 0.f, 0.f, 0.f}, Cs1 = Cs0, Cs2 = Cs0, Cs3 = Cs0;
        float m_prev = 0.f;
        u32x4 pq0, pq1, pk0, pk1, pv;
        float g1a = 0.f, g1cm = 0.f, g1b = 0.f;
        const unsigned oq0_ = (unsigned)((tid >> 4) * 1024 + h * 128 + (tid & 15) * 8), oq1_ = oq0_ + 32u * 1024u;
        const unsigned ov_ = (unsigned)(((tid & 127) >> 1) * 2048 + h * 256 + sl * 16 + (tid & 1) * 8);
#define ML_LOADQK(j, PQ, PK, cs_) do { const int p_ = tid + 512 * (j), t_ = p_ >> 4, c8_ = (p_ & 15) * 8; const bool z_ = t_ < 48; \
            const unsigned of_ = z_ ? (unsigned)c8_ : (unsigned)((SEQ + t_ - 48) * 1024 + h * 128 + c8_); \
            PQ = *(const u32x4*)((z_ ? ZR : Q) + of_); PK = *(const u32x4*)((z_ ? ZR : K) + of_); } while (0)
#define ML_LOAD(cs_) do { if ((cs_) == 0) { ML_LOADQK(0, pq0, pk0, 0); ML_LOADQK(1, pq1, pk1, 0); \
              { const int t_ = (tid & 127) >> 1, c8_ = (tid & 1) * 8; const bool z_ = t_ < 48; const unsigned of_ = z_ ? (unsigned)c8_ : (unsigned)((t_ - 48) * 2048 + h * 256 + sl * 16 + c8_); \
                pv = *(const u32x4*)((z_ ? ZR : (const bf16*)VM) + of_); } } \
            else { const bf16* Qc_ = Q + (size_t)((cs_) - 1) * 65536; const bf16* Kc_ = K + (size_t)((cs_) - 1) * 65536; const bf16* Vc_ = (const bf16*)V + (size_t)((cs_) - 1) * 131072; \
              pq0 = *(const u32x4*)(Qc_ + oq0_); pk0 = *(const u32x4*)(Kc_ + oq0_); pq1 = *(const u32x4*)(Qc_ + oq1_); pk1 = *(const u32x4*)(Kc_ + oq1_); pv = *(const u32x4*)(Vc_ + ov_); } } while (0)
#define ML_SCALARS(a_, cm_, b_, slot_) do { \
            const float cm_all_ = __int_as_float(__builtin_amdgcn_readlane(__float_as_int(cm_), d == 0 ? 63 : 0)), b_last_ = __int_as_float(__builtin_amdgcn_readlane(__float_as_int(b_), d == 0 ? 63 : 0)); \
            const float M_ = fmaxf((cm_), m_prev), Mst_ = fmaxf(cm_all_, m_prev); \
            LAS float* S_ = (LAS float*)(L + SC) + (slot_) * (SC_STRIDE / 4); \
            S_[SC_A / 4 + lane] = (a_) * 1.4426950408889634f; S_[SC_M / 4 + lane] = M_ * 1.4426950408889634f + 3.5f;     S_[SC_ISC / 4 + lane] = __expf(m_prev - M_) * QSCALE; S_[SC_FLO / 4 + lane] = __expf(-(b_) - M_); \
            S_[SC_W / 4 + lane] = __expf((a_) - Mst_); if (lane == 0) S_[SC_DEC / 4] = __expf(m_prev - Mst_); \
            m_prev = b_last_ + Mst_; } while (0)
#define ML_CS(i_) (d == 0 ? (i_) : 256 - (i_))
#define ML_BAR() do { asm volatile("s_waitcnt lgkmcnt(0)" ::: "memory"); __builtin_amdgcn_s_barrier(); asm volatile("" ::: "memory"); } while (0)
#define ML_STAGE(st_) do { LAS unsigned char* T_ = L + ((st_) & 1) * TILE; const LAS float* Sw_ = (const LAS float*)(L + SC) + ((st_) & 3) * (SC_STRIDE / 4) + SC_W / 4; \
            { const int p_ = tid, t_ = p_ >> 4, c8_ = (p_ & 15) * 8; *(LAS u32x4*)((LAS bf16*)(T_ + QS) + t_ * 136 + c8_) = pq0; *(LAS u32x4*)((LAS bf16*)(T_ + KS) + t_ * 136 + c8_) = pk0; } \
            { const int p_ = tid + 512, t_ = p_ >> 4, c8_ = (p_ & 15) * 8; *(LAS u32x4*)((LAS bf16*)(T_ + QS) + t_ * 136 + c8_) = pq1; *(LAS u32x4*)((LAS bf16*)(T_ + KS) + t_ * 136 + c8_) = pk1; } \
            if (intra && lo_ < 2) { const int t_ = (tid & 127) >> 1, c8_ = (tid & 1) * 8; const float ws_ = Sw_[t_]; float vv_[8]; unpack8(pv, vv_); \
                _Pragma("unroll") for (int e_ = 0; e_ < 8; ++e_) { ((LAS bf16*)(T_ + VT))[(c8_ + e_) * 72 + t_] = f2bf(vv_[e_]); ((LAS bf16*)(T_ + VTW))[(c8_ + e_) * 72 + t_] = f2bf(vv_[e_] * ws_); } } \
            else if (intra && lo_ == 2) { const int t_ = lane; ((LAS bf16*)(T_ + VTW))[16 * 72 + t_] = f2bf(Sw_[t_]); } } while (0)
#define ML_FINISH(j_) do { const int cj_ = ML_CS(j_); const LAS float* Sj_ = (const LAS float*)(L + SC) + ((j_) & 3) * (SC_STRIDE / 4); const LAS float* NXj_ = (const LAS float*)(L + NXB + ((j_) & 1) * NXSZ); \
            const int tb_ = 16 * (w & 3) + 4 * q4; \
            const bool first_ = ((j_) < 128) || ((j_) == 128 && d == 0); \
            bf16* ob_ = cj_ == 0 ? (first_ ? CELLM : VM2d) : (first_ ? CELL : V2d); \
            const int rb_ = cj_ == 0 ? (tb_ < 48 ? 16 + tb_ : tb_ - 48) : 64 * (cj_ - 1) + tb_;     \
            const unsigned cb_ = (unsigned)(h * 256 + sl * 16 + i16); \
            if (!intra) { const LAS float* NIj_ = (const LAS float*)(L + NIB + ((j_) & 1) * NISZ); const f32x4 isc_ = *(const LAS f32x4*)(Sj_ + SC_ISC / 4 + tb_), flo_ = *(const LAS f32x4*)(Sj_ + SC_FLO / 4 + tb_); float hv_[4]; \
                const f32x4 ni_ = *(const LAS f32x4*)(NIj_ + i16 * 68 + tb_), nxa_ = *(const LAS f32x4*)(NXj_ + i16 * 68 + tb_), nxb_ = *(const LAS f32x4*)(NXj_ + 2 * 1088 + i16 * 68 + tb_); \
                const f32x4 de_ = *(const LAS f32x4*)(NIj_ + 1088 + tb_), dxa_ = *(const LAS f32x4*)(NXj_ + 1088 + tb_), dxb_ = *(const LAS f32x4*)(NXj_ + 3 * 1088 + tb_);     \
                _Pragma("unroll") for (int r_ = 0; r_ < 4; ++r_) { const float num_ = ni_[r_] + isc_[r_] * (nxa_[r_] + nxb_[r_]); const float den_ = de_[r_] + isc_[r_] * (dxa_[r_] + dxb_[r_]); \
                    hv_[r_] = num_ * __builtin_amdgcn_rcpf(fmaxf(fabsf(den_), flo_[r_])); } \
                if (!first_) { const unsigned need_ = (unsigned)(epoch * 1024 + 256 - (j_) + 1); unsigned sp_ = 0u; ppa = (unsigned)__builtin_amdgcn_readfirstlane((int)ppa); \
                    while (ppa < need_ && sp_ < (1u << 20)) { __builtin_amdgcn_s_sleep(1); ppa = (unsigned)__builtin_amdgcn_readfirstlane((int)__hip_atomic_load(prog_pa, __ATOMIC_RELAXED, __HIP_MEMORY_SCOPE_AGENT)); ++sp_; } } \
                { bf16* op_ = ob_ + (unsigned)(rb_ * 2048) + cb_; op_[0] = f2bf(hv_[0]); op_[2048] = f2bf(hv_[1]); op_[4096] = f2bf(hv_[2]); op_[6144] = f2bf(hv_[3]); } } } while (0)
        ML_LOAD(ML_CS(0));
        { const float a0 = ga[ML_CS(0) * 64 + lane], c0 = gcm[ML_CS(0) * 64 + lane], b0 = gb[ML_CS(0) * 64 + lane], a1 = ga[ML_CS(1) * 64 + lane], c1 = gcm[ML_CS(1) * 64 + lane], b1 = gb[ML_CS(1) * 64 + lane];
          if (intra && lo_ == 2) { ML_SCALARS(a0, c0, b0, 0); ML_SCALARS(a1, c1, b1, 1); } }
        __syncthreads();
        ML_STAGE(0);
        ML_LOAD(ML_CS(1));
        ML_BAR();
        unsigned ppa = 0u;
#ifdef DIAG
        unsigned long long tA_ = 0, tF_ = 0, tB_ = 0, tC_ = 0, t0_ = __builtin_amdgcn_s_memtime(), tx_;
#define DG_MARK(acc) do { const unsigned long long ty_ = __builtin_amdgcn_s_memtime(); acc += ty_ - tx_; tx_ = ty_; } while (0)
#else
#define DG_MARK(acc) do { } while (0)
#endif
        for (int i = 0; i <= 256; ++i) {
#ifdef DIAG
            tx_ = __builtin_amdgcn_s_memtime();
#endif
            const int par = i & 1;
            LAS unsigned char* T = L + par * TILE; const LAS float* S = (const LAS float*)(L + SC) + (i & 3) * (SC_STRIDE / 4);
            LAS bf16* Qs = (LAS bf16*)(T + QS); LAS bf16* Ks = (LAS bf16*)(T + KS); LAS bf16* Vt = (LAS bf16*)(T + VT); LAS bf16* Vtw = (LAS bf16*)(T + VTW);
            LAS float* NXb = (LAS float*)(L + NXB + par * NXSZ);
            ppa = __hip_atomic_load(prog_pa, __ATOMIC_RELAXED, __HIP_MEMORY_SCOPE_AGENT);
            if (tid == 0) __hip_atomic_store(prog_me, (unsigned)(epoch * 1024 + i + 1), __ATOMIC_RELAXED, __HIP_MEMORY_SCOPE_AGENT);
            if (i < 256) ML_STAGE(i + 1);
            { const int in_ = i < 255 ? i + 2 : 256; ML_LOAD(ML_CS(in_));
              if (intra && lo_ == 2) { const int ig_ = ML_CS(in_) * 64 + lane; g1a = ga[ig_]; g1cm = gcm[ig_]; g1b = gb[ig_]; } }
            DG_MARK(tA_);
            if (i > 0) ML_FINISH(i - 1);
            DG_MARK(tF_);
            if (intra) {
                const int tau_ = w; const LAS bf16* qp_ = Qs + (16 * tau_ + i16) * 136 + 8 * q4;
                const bf16x8 bq0_ = *(const LAS bf16x8*)(qp_), bq1_ = *(const LAS bf16x8*)(qp_ + 32), bq2_ = *(const LAS bf16x8*)(qp_ + 64), bq3_ = *(const LAS bf16x8*)(qp_ + 96);
                const float Mt_ = S[SC_M / 4 + 16 * tau_ + i16]; unsigned jw_[8];
#define ML_INTRA(NV_) do { bf16x8 kf_[NV_][4]; f32x4 ac_[NV_], as4_[NV_]; \
                    _Pragma("unroll") for (int j_ = 0; j_ < NV_; ++j_) { const int sg_ = d == 0 ? j_ : 3 - j_; const LAS bf16* kp_ = Ks + (16 * sg_ + i16) * 136 + 8 * q4; \
                        _Pragma("unroll") for (int kk_ = 0; kk_ < 4; ++kk_) kf_[j_][kk_] = *(const LAS bf16x8*)(kp_ + 32 * kk_); \
                        as4_[j_] = *(const LAS f32x4*)(S + SC_A / 4 + 16 * sg_ + 4 * q4); ac_[j_] = (f32x4){0.f, 0.f, 0.f, 0.f}; } \
                    _Pragma("unroll") for (int j_ = 0; j_ < NV_; ++j_) ac_[j_] = MFMA16(kf_[j_][0], bq0_, ac_[j_]); \
                    _Pragma("unroll") for (int j_ = 0; j_ < NV_; ++j_) ac_[j_] = MFMA16(kf_[j_][1], bq1_, ac_[j_]); \
                    _Pragma("unroll") for (int j_ = 0; j_ < NV_; ++j_) ac_[j_] = MFMA16(kf_[j_][2], bq2_, ac_[j_]); \
                    _Pragma("unroll") for (int j_ = 0; j_ < NV_; ++j_) ac_[j_] = MFMA16(kf_[j_][3], bq3_, ac_[j_]); \
                    _Pragma("unroll") for (int j_ = 0; j_ < NV_; ++j_) { float e_[4]; \
                        _Pragma("unroll") for (int r_ = 0; r_ < 4; ++r_) { float x_ = __builtin_amdgcn_exp2f(as4_[j_][r_] - Mt_) * ac_[j_][r_]; \
                            if (j_ == NV_ - 1) { const int sl_ = 4 * q4 + r_; const bool ok_ = d == 0 ? (sl_ <= i16) : (sl_ >= i16); x_ = ok_ ? x_ : 0.f; } e_[r_] = x_; } \
                        jw_[2 * j_] = cvt_pk_bf16(e_[0], e_[1]); jw_[2 * j_ + 1] = cvt_pk_bf16(e_[2], e_[3]); } \
                    _Pragma("unroll") for (int j_ = NV_; j_ < 4; ++j_) { jw_[2 * j_] = 0u; jw_[2 * j_ + 1] = 0u; } } while (0)
                if (lo_ == 0) ML_INTRA(1); else if (lo_ == 1) ML_INTRA(2); else if (lo_ == 2) ML_INTRA(3); else ML_INTRA(4);
#undef ML_INTRA
                const bool fw_ = d == 0;
                const u32x4 fa0_ = {fw_ ? jw_[0] : jw_[6], fw_ ? jw_[1] : jw_[7], fw_ ? jw_[2] : jw_[4], fw_ ? jw_[3] : jw_[5]}, fa1_ = {fw_ ? jw_[4] : jw_[2], fw_ ? jw_[5] : jw_[3], fw_ ? jw_[6] : jw_[0], fw_ ? jw_[7] : jw_[1]};
                const LAS bf16* v0_ = Vt + (i16) * 72 + 4 * q4; const LAS bf16* v1_ = Vt + (16 + i16) * 72 + 4 * q4;
                const u32x2 b00_ = *(const LAS u32x2*)(v0_), b01_ = *(const LAS u32x2*)(v0_ + 16), b02_ = *(const LAS u32x2*)(v0_ + 32), b03_ = *(const LAS u32x2*)(v0_ + 48);
                const u32x2 b10_ = *(const LAS u32x2*)(v1_), b11_ = *(const LAS u32x2*)(v1_ + 16), b12_ = *(const LAS u32x2*)(v1_ + 32), b13_ = *(const LAS u32x2*)(v1_ + 48);
                const u32x4 fb00_ = {b00_.x, b00_.y, b01_.x, b01_.y}, fb01_ = {b02_.x, b02_.y, b03_.x, b03_.y}, fb10_ = {b10_.x, b10_.y, b11_.x, b11_.y}, fb11_ = {b12_.x, b12_.y, b13_.x, b13_.y};
                f32x4 na_ = {0.f, 0.f, 0.f, 0.f}, nb_ = na_;
                na_ = MFMA16(__builtin_bit_cast(bf16x8, fa0_), __builtin_bit_cast(bf16x8, fb00_), na_); na_ = MFMA16(__builtin_bit_cast(bf16x8, fa1_), __builtin_bit_cast(bf16x8, fb01_), na_);
                nb_ = MFMA16(__builtin_bit_cast(bf16x8, fa0_), __builtin_bit_cast(bf16x8, fb10_), nb_); nb_ = MFMA16(__builtin_bit_cast(bf16x8, fa1_), __builtin_bit_cast(bf16x8, fb11_), nb_);
                { LAS float* NIw_ = (LAS float*)(L + NIB + par * NISZ);
                  *(LAS f32x4*)(NIw_ + i16 * 68 + 16 * tau_ + 4 * q4) = na_; *(LAS f32x4*)(NIw_ + 1088 + i16 * 68 + 16 * tau_ + 4 * q4) = nb_; }
            } else {
                bf16x8 Cf0, Cf1;
                { u32x4 f_; f_ = (u32x4){cvt_pk_bf16(Cs0[0], Cs0[1]), cvt_pk_bf16(Cs0[2], Cs0[3]), cvt_pk_bf16(Cs1[0], Cs1[1]), cvt_pk_bf16(Cs1[2], Cs1[3])}; Cf0 = __builtin_bit_cast(bf16x8, f_);
                  f_ = (u32x4){cvt_pk_bf16(Cs2[0], Cs2[1]), cvt_pk_bf16(Cs2[2], Cs2[3]), cvt_pk_bf16(Cs3[0], Cs3[1]), cvt_pk_bf16(Cs3[2], Cs3[3])}; Cf1 = __builtin_bit_cast(bf16x8, f_); }
                { u32x2 qa_[4][4];
#pragma unroll
                  for (int tt_ = 0; tt_ < 4; ++tt_) { const LAS bf16* qp_ = Qs + (16 * tt_ + i16) * 136 + 64 * eta + 4 * q4;
#pragma unroll
                      for (int jj_ = 0; jj_ < 4; ++jj_) qa_[tt_][jj_] = *(const LAS u32x2*)(qp_ + 16 * jj_); }
                  f32x4 nx_[4];
#pragma unroll
                  for (int tt_ = 0; tt_ < 4; ++tt_) { const u32x4 f_ = {qa_[tt_][0].x, qa_[tt_][0].y, qa_[tt_][1].x, qa_[tt_][1].y}; nx_[tt_] = MFMA16(__builtin_bit_cast(bf16x8, f_), Cf0, ((f32x4){0.f, 0.f, 0.f, 0.f})); }
#pragma unroll
                  for (int tt_ = 0; tt_ < 4; ++tt_) { const u32x4 f_ = {qa_[tt_][2].x, qa_[tt_][2].y, qa_[tt_][3].x, qa_[tt_][3].y}; nx_[tt_] = MFMA16(__builtin_bit_cast(bf16x8, f_), Cf1, nx_[tt_]); }
#pragma unroll
                  for (int tt_ = 0; tt_ < 4; ++tt_) *(LAS f32x4*)(NXb + (eta * 2 + be) * 1088 + i16 * 68 + 16 * tt_ + 4 * q4) = nx_[tt_]; }
                const float dec = S[SC_DEC / 4];
                const LAS bf16* vw_ = Vtw + (16 * be + i16) * 72 + 8 * q4; const bf16x8 vb0 = *(const LAS bf16x8*)(vw_), vb1 = *(const LAS bf16x8*)(vw_ + 32);
                const unsigned kb_ = (unsigned)(uintptr_t)Ks + (unsigned)((8 * q4 + (i16 >> 2)) * 272 + 8 * (i16 & 3) + 128 * eta);
#define ML_TR4(kt_, L0, H0, L1, H1) s16x4 L0 = trro<(kt_) * 32>(kb_), H0 = trro<(kt_) * 32 + 4 * 272>(kb_), L1 = trro<(kt_) * 32 + 32 * 272>(kb_), H1 = trro<(kt_) * 32 + 36 * 272>(kb_)
#define ML_MM(CS_, L0, H0, L1, H1) do { const bf16x8 a0_ = {L0[0], L0[1], L0[2], L0[3], H0[0], H0[1], H0[2], H0[3]}, a1_ = {L1[0], L1[1], L1[2], L1[3], H1[0], H1[1], H1[2], H1[3]}; \
                CS_ = CS_ * dec; CS_ = MFMA16(a0_, vb0, CS_); CS_ = MFMA16(a1_, vb1, CS_); } while (0)
                { ML_TR4(0, a0, a1, a2, a3); ML_TR4(1, b0, b1, b2, b3); ML_TR4(2, c0, c1, c2, c3); ML_TR4(3, e0, e1, e2, e3);
                  asm volatile("s_waitcnt lgkmcnt(0)" ::: "memory"); __builtin_amdgcn_sched_barrier(0);
                  ML_MM(Cs0, a0, a1, a2, a3); ML_MM(Cs1, b0, b1, b2, b3); ML_MM(Cs2, c0, c1, c2, c3); ML_MM(Cs3, e0, e1, e2, e3); }
            }
            if (intra && lo_ == 2 && i < 255) { ML_SCALARS(g1a, g1cm, g1b, (i + 2) & 3); }
            DG_MARK(tB_);
            ML_BAR();
            DG_MARK(tC_);
        }
#ifdef DIAG
        if (C.bid == 0 && lane == 0) { float* dg_ = (float*)((unsigned*)(C.misc() + MS_CTL) + CW_CHK) + C.wave * 8; dg_[0] = (float)(__builtin_amdgcn_s_memtime() - t0_) / 257.f; dg_[1] = (float)tA_ / 257.f; dg_[2] = (float)tF_ / 257.f; dg_[3] = (float)tB_ / 257.f; dg_[4] = (float)tC_ / 257.f; }
#endif
        { const int i = 257; (void)i; ppa = __hip_atomic_load(prog_pa, __ATOMIC_RELAXED, __HIP_MEMORY_SCOPE_AGENT); ML_FINISH(256); }
        VM_WAIT(); __syncthreads();
#undef ML_LOADQK
#undef ML_LOAD
#undef ML_SCALARS
#undef ML_CS
#undef ML_BAR
#undef ML_STAGE
#undef ML_FINISH
#undef ML_TR4
#undef ML_MM
    }
}

#if DBG_CHECK
constexpr size_t MS_STASH = MS_END;
constexpr int ST_QATT = 0;
constexpr int ST_GB = 8 * 128;
constexpr int ST_XM = ST_GB + 16;
constexpr int NCHK = 16;
DI float* chk_words(const Ctx& C) { return (float*)((unsigned*)(C.misc() + MS_CTL) + CW_CHK); }
DI void chk_add(const Ctx& C, int id, float diff, float ref) {
    float d2 = diff * diff, r2 = ref * ref; if (!(d2 >= 0.f) || !(d2 < 1e30f)) d2 = 1e30f;
    atomicAdd(chk_words(C) + 2 * id, d2); atomicAdd(chk_words(C) + 2 * id + 1, r2);
}
DI unsigned hsh(unsigned x) { x ^= x >> 16; x *= 0x7feb352du; x ^= x >> 15; x *= 0x846ca68bu; x ^= x >> 16; return x; }
DI int smp_row(int s) { return s == 0 ? 0 : s == 1 ? 63 : s == 2 ? 16383 : s == 3 ? 16384 : s == 4 ? 16399 : s == 5 ? 8191 : (int)(hsh(1000 + s) % LTOK); }
DI float wdot_bf_f32col(const bf16* a, const float* w, int ldw, int K, int lane) { float s = 0.f; for (int k = lane; k < K; k += 64) s += bf2f(a[k]) * w[(size_t)k * ldw]; return wave_sum(s, lane); }

DI void dbg_check_gemm_plain(const Ctx& C, int id, const bf16* A, int lda, const float* W, int ldw, int K, const bf16* O, int ldo) {
    for (int s = C.gw; s < 48; s += C.ngw) { const int row = smp_row(s % 12), col = (int)(hsh(77 + s) % (unsigned)ldo);
        const float ref = wdot_bf_f32col(A + (size_t)row * lda, W + col, ldw, K, C.lane);
        if (C.lane == 0) chk_add(C, id, bf2f(O[(size_t)row * ldo + col]) - ref, ref); }
}
DI void dbg_check_e1(const Ctx& C, int li, const bf16* h, const bf16* YAB, const bf16* Kb, const bf16* Vb, const bf16* GA, const bf16* U) {
    const float* W = C.in[I_WINE] + (size_t)li * 1024 * 4608;
    for (int s = C.gw; s < 96; s += C.ngw) { const int row = smp_row(s % 12); const int seg = (s / 12) % 6;
        const int lo_ = seg == 0 ? 0 : seg == 1 ? 1024 : seg == 2 ? 1280 : seg == 3 ? 1536 : seg == 4 ? 2560 : 3584, wd_ = (seg == 1 || seg == 2) ? 256 : 1024;
        const int col = lo_ + (int)(hsh(5 + s) % (unsigned)wd_), c = col - lo_;
        float ref = wdot_bf_f32col(h + (size_t)row * 1024, W + col, 4608, 1024, C.lane);
        float got;
        if (seg == 0) got = bf2f(YAB[(size_t)row * 2048 + c]); else if (seg == 1) got = bf2f(Kb[(size_t)row * 256 + c]); else if (seg == 2) got = bf2f(Vb[(size_t)row * 256 + c]);
        else if (seg == 3) { got = bf2f(GA[(size_t)row * 1024 + c]); ref = ref / (1.f + expf(-ref)); } else if (seg == 4) got = bf2f(U[(size_t)row * 1024 + c]);
        else { got = bf2f(YAB[(size_t)row * 2048 + 1024 + c]); ref = ref / (1.f + expf(-ref)); }
        if (C.lane == 0) chk_add(C, 2, got - ref, ref); }
}
DI void naive_qk_head(const Ctx& C, int li, const bf16* h, int row, int hs, float& o0, float& o1) {
    const float* W = C.in[I_WINE] + (size_t)li * 1024 * 4608; const int cb = hs < 8 ? hs * 128 : 1024 + (hs - 8) * 128;
    float r0 = 0.f, r1 = 0.f;
    for (int k = 0; k < 1024; ++k) { const float hv = bf2f(h[(size_t)row * 1024 + k]); r0 += hv * W[(size_t)k * 4608 + cb + C.lane]; r1 += hv * W[(size_t)k * 4608 + cb + 64 + C.lane]; }
    r0 = bf2f(f2bf(r0)); r1 = bf2f(f2bf(r1));
    const float ss = wave_sum(r0 * r0 + r1 * r1, C.lane); const float rs = 1.f / sqrtf(ss / 128.f + EPS);
    const float* g = (hs < 8 ? C.in[I_QN] : C.in[I_KN]) + li * 128;
    const float n0 = r0 * rs * g[C.lane], n1 = r1 * rs * g[64 + C.lane];
    const int j = C.lane & 31; const float fr = exp2f(-(float)j * (13.287712379549449f / 32.f));
    float pr = 0.f, pc = 0.f; if (row < SEQ) { pr = (float)(row / 64); pc = (float)(row % 64); }
    const float p0 = shx(n0, 32, C.lane), p1 = shx(n1, 32, C.lane);
    float cr, sr, cc, sc; cis_rev(pr * fr, cr, sr); cis_rev(pc * fr, cc, sc);
    o0 = C.lane < 32 ? n0 * cr - p0 * sr : n0 * cr + p0 * sr;
    o1 = C.lane < 32 ? n1 * cc - p1 * sc : n1 * cc + p1 * sc;
}
DI void dbg_check_e2(const Ctx& C, int li, const bf16* h, const bf16* YAB, const bf16* Kb) {
    for (int s = C.gw; s < 40; s += C.ngw) { const int row = smp_row(s % 10), hs = (s * 7) % 10; float o0, o1; naive_qk_head(C, li, h, row, hs, o0, o1);
        const bf16* p = hs < 8 ? YAB + (size_t)row * 2048 + hs * 128 : Kb + (size_t)row * 256 + (hs - 8) * 128;
        const float d0 = bf2f(p[C.lane]) - o0, d1 = bf2f(p[64 + C.lane]) - o1;
        const float dd = wave_sum(d0 * d0 + d1 * d1, C.lane), rr = wave_sum(o0 * o0 + o1 * o1, C.lane);
        if (C.lane == 0) chk_add(C, 3, sqrtf(dd), sqrtf(rr)); }
}
DI void dbg_check_s5(const Ctx& C, int li, const bf16* U, const bf16* YG) {
    float* st = (float*)(C.misc() + MS_STASH);
    const bf16* YAB = C.slot(2);
    for (int s = C.gw; s < 8; s += C.ngw) { const int row = smp_row(s), hd = (s * 3) % 8; st[ST_QATT + s * 128 + C.lane] = bf2f(YAB[(size_t)row * 2048 + hd * 128 + C.lane]); st[ST_QATT + s * 128 + 64 + C.lane] = bf2f(YAB[(size_t)row * 2048 + hd * 128 + 64 + C.lane]); }
    if (C.gw == 8 && C.lane < 16) { const int row = smp_row(C.lane % 12), col = (int)(hsh(300 + C.lane) % 1024u); st[ST_GB + C.lane] = bf2f(YAB[(size_t)row * 2048 + 1024 + col]); }
    for (int s = C.gws; s < 6; s += C.ngw) {
        const int row = smp_row(s), g = (int)(hsh(40 + s) % 64u), l = seq_of_row(row), n = C.lane;
        float y[16];
#pragma unroll
        for (int p = 0; p < 16; ++p) y[p] = 0.f;
        for (int d = 0; d < 2; ++d) {
            const size_t pidx = (((size_t)li * 2 + d) * 64 + g) * 64 + n;
            const float ar = C.in[I_ARE][pidx], ai = C.in[I_AIM][pidx], dt = expf(C.in[I_LDT][((size_t)li * 2 + d) * 64 + g]);
            float c1_, s1_; cis_rev(ai * dt, c1_, s1_); const float mg = expf(ar * dt), abr = mg * c1_, abi = mg * s1_;
            const float xr0 = abr - 1.f, xi0 = abi, inv = 1.f / (ar * ar + ai * ai), kr = (xr0 * ar + xi0 * ai) * inv, ki = (xi0 * ar - xr0 * ai) * inv;
            float bbr[16], bbi[16];
#pragma unroll
            for (int p = 0; p < 16; ++p) { const float br = C.in[I_BRE][pidx * 16 + p], bi = C.in[I_BIM][pidx * 16 + p]; bbr[p] = kr * br - ki * bi; bbi[p] = kr * bi + ki * br; }
            float xr = 0.f, xi = 0.f;
            const int s0 = d == 0 ? 0 : LTOK - 1, s1 = l, step = d == 0 ? 1 : -1;
            for (int sq = s0;; sq += step) { const bf16* up = U + (size_t)row_of_seq(sq) * 1024 + g * 16; float ur = 0.f, ui = 0.f;
#pragma unroll
                for (int p = 0; p < 16; ++p) { const float u = bf2f(up[p]); ur += bbr[p] * u; ui += bbi[p] * u; }
                const float nr = abr * xr - abi * xi + ur, ni = abr * xi + abi * xr + ui; xr = nr; xi = ni;
                if (sq == s1) break; }
#pragma unroll
            for (int p = 0; p < 16; ++p) { const size_t ci = ((((size_t)li * 2 + d) * 64 + g) * 16 + p) * 64 + n; y[p] += wave_sum(C.in[I_CRE][ci] * xr - C.in[I_CIM][ci] * xi, C.lane); }
        }
        float dd = 0.f, rr = 0.f;
#pragma unroll
        for (int p = 0; p < 16; ++p) { float v = y[p] + bf2f(U[(size_t)row * 1024 + g * 16 + p]) * C.in[I_SSMD][(size_t)li * 1024 + g * 16 + p];
            { const float z_ = 0.7978845608028654f * (v + 0.044715f * v * v * v); const float e2_ = expf(-2.f * fabsf(z_)); float th_ = (1.f - e2_) / (1.f + e2_); th_ = z_ < 0.f ? -th_ : th_; v = 0.5f * v * (1.f + th_); }
            const float df = bf2f(YG[(size_t)row * 1024 + g * 16 + p]) - v; dd += df * df; rr += v * v; }
        if (C.lane == 0) chk_add(C, 4, sqrtf(dd), sqrtf(rr));
    }
}
DI void dbg_check_e5(const Ctx& C, int li, const bf16* h, const bf16* YAB, const bf16* Kb, const bf16* Vb, const bf16* GA, const bf16* YG) {
    const float* st = (const float*)(C.misc() + MS_STASH);
    LAS float* sc = (LAS float*)C.lds; LAS float* red = sc + 16448;
    for (int s = C.bid; s < 8; s += C.G) { const int row = smp_row(s), hd = (s * 3) % 8, g = hd >> 2;
        const float* q = st + ST_QATT + s * 128;
        float mx = -1e30f;
        for (int key = C.tid; key < LTOK; key += NTHR) { float d = 0.f; for (int e = 0; e < 128; ++e) d += q[e] * bf2f(Kb[(size_t)key * 256 + g * 128 + e]); d *= 0.08838834764831845f; sc[key] = d; mx = fmaxf(mx, d); }
#pragma unroll
        for (int o = 1; o < 64; o <<= 1) mx = fmaxf(mx, shx(mx, o, C.lane));
        if (C.lane == 0) red[C.wave] = mx; __syncthreads();
        mx = red[0]; for (int w = 1; w < 8; ++w) mx = fmaxf(mx, red[w]); __syncthreads();
        float sm = 0.f; for (int key = C.tid; key < LTOK; key += NTHR) { const float p = expf(sc[key] - mx); sc[key] = p; sm += p; }
        sm = wave_sum(sm, C.lane); if (C.lane == 0) red[C.wave] = sm; __syncthreads();
        sm = 0.f; for (int w = 0; w < 8; ++w) sm += red[w];
        if (C.tid < 128) { float o = 0.f; for (int key = 0; key < LTOK; ++key) o += sc[key] * bf2f(Vb[(size_t)key * 256 + g * 128 + C.tid]);
            o = o / sm * bf2f(GA[(size_t)row * 1024 + hd * 128 + C.tid]); const float got = bf2f(YAB[(size_t)row * 2048 + hd * 128 + C.tid]);
            const float dd = wave_sum((got - o) * (got - o), C.lane), rr = wave_sum(o * o, C.lane); if (C.lane == 0) chk_add(C, 5, sqrtf(dd), sqrtf(rr)); }
        __syncthreads(); }
    const float* Wg = C.in[I_WGLU] + (size_t)li * 1024 * 1024;
    for (int s = C.gws; s < 16; s += C.ngw) { const int row = smp_row(s % 12), col = (int)(hsh(300 + s) % 1024u);
        const float pre = wdot_bf_f32col(YG + (size_t)row * 1024, Wg + col, 1024, 1024, C.lane) + C.in[I_BGLU][li * 1024 + col];
        const float ref = bf2f(YG[(size_t)row * 1024 + col]) / (1.f + expf(-pre)) * st[ST_GB + s];
        if (C.lane == 0) chk_add(C, 6, bf2f(YAB[(size_t)row * 2048 + 1024 + col]) - ref, ref); }
}
DI void dbg_check_conv(const Ctx& C, int li, const bf16* XM, const bf16* XC) {
    float* st = (float*)(C.misc() + MS_STASH);
    for (int s = C.gw; s < 8; s += C.ngw) { const int row = smp_row(s), hd = (s * 5) % 8;
        for (int e = C.lane; e < 256; e += 64) st[ST_XM + s * 256 + e] = bf2f(XM[(size_t)row * 2048 + hd * 256 + e]); }
    const float* cw = C.in[I_CONVW] + (size_t)li * 5 * 2048; const float* cb = C.in[I_CONVB] + (size_t)li * 2048;
    for (int s = C.gw * 64 + C.lane; s < 768; s += C.ngw * 64) { const int row = smp_row(s % 12), c = (int)(hsh(900 + s) % 2048u);
        const int l = row < SEQ ? row + 16 : row - SEQ; float a = cb[c];
        for (int j = 0; j < 5; ++j) { const int l2 = l + j - 2; if (l2 < 0 || l2 >= LTOK) continue; const int r2 = l2 < 16 ? SEQ + l2 : l2 - 16; a += cw[j * 2048 + c] * bf2f(XM[(size_t)r2 * 2048 + c]); }
        const float ref = a / (1.f + expf(-a)); chk_add(C, 10, bf2f(XC[(size_t)row * 2048 + c]) - ref, ref); }
}
DI void dbg_check_o3(const Ctx& C, int li, const bf16* XC, const bf16* Qm, const bf16* Km, const bf16* V, const bf16* VM) {
    const float* st = (const float*)(C.misc() + MS_STASH);
    for (int s = C.gw; s < 48; s += C.ngw) { const int row = smp_row(s % 12), hd = (int)(hsh(11 + s) % 8u), dm = (int)(hsh(12 + s) % 128u); const bool isk = s & 1;
        const float* W = (isk ? C.in[I_WK] : C.in[I_WQ]) + ((size_t)li * 8 + hd) * 256 * 128;
        const float ref = wdot_bf_f32col(XC + (size_t)row * 2048 + hd * 256, W + dm, 128, 256, C.lane);
        if (C.lane == 0) chk_add(C, 11, bf2f((isk ? Km : Qm)[(size_t)row * 1024 + hd * 128 + dm]) - ref, ref); }
    for (int s = C.gw; s < 8; s += C.ngw) { const int row = smp_row(s), hd = (s * 5) % 8;
        for (int t = 0; t < 4; ++t) { const int n = (int)(hsh(50 + s * 4 + t) % 256u); const float* W = C.in[I_WV] + ((size_t)li * 8 + hd) * 256 * 256 + n;
            float a = 0.f; for (int k = C.lane; k < 256; k += 64) a += st[ST_XM + s * 256 + k] * W[(size_t)k * 256]; a = wave_sum(a, C.lane);
            const float got = bf2f(row < SEQ ? V[(size_t)row * 2048 + hd * 256 + n] : VM[(size_t)(row - SEQ) * 2048 + hd * 256 + n]);
            if (C.lane == 0) chk_add(C, 12, got - a, a); } }
    const float* GI = (const float*)(C.misc() + MS_GI); const float* GF = (const float*)(C.misc() + MS_GF);
    for (int s = C.gw; s < 48; s += C.ngw) { const int row = smp_row(s % 12), dh = (int)(hsh(70 + s) % 16u), d = dh >> 3, hd = dh & 7; const bool isf = s & 1;
        const float* W = (isf ? C.in[I_WFG] : C.in[I_WIG]) + ((size_t)li * 2 + d) * 2048 * 8 + hd;
        float a = wdot_bf_f32col(XC + (size_t)row * 2048, W, 8, 2048, C.lane) + (isf ? C.in[I_BFG] : C.in[I_BIG])[li * 16 + dh];
        if (isf) a = fminf(a, 0.f) - log1pf(expf(-fabsf(a)));
        const int pos = row < SEQ ? row + 64 : row - SEQ + 48;
        if (C.lane == 0) chk_add(C, 13, (isf ? GF : GI)[(size_t)dh * NPOS + pos] - a, a); }
    if (C.gw == 0 && C.lane < 16) { chk_add(C, 13, GI[(size_t)C.lane * NPOS + 5] + 1e9f, 1e9f); chk_add(C, 13, GF[(size_t)C.lane * NPOS + 47], 0.f); }
}
DI void dbg_check_mlstm(const Ctx& C, int li, const bf16* Qm, const bf16* Km, const bf16* V, const bf16* VM, const bf16* CELL, const bf16* CELLM) {
    const float* GI = (const float*)(C.misc() + MS_GI); const float* GF = (const float*)(C.misc() + MS_GF);
    for (int s = C.gws; s < 12; s += C.ngw) { const int row = smp_row(s), hd = (int)(hsh(21 + s) % 8u), vc = (int)(hsh(22 + s) % 256u); const int pos = row < SEQ ? row + 64 : row - SEQ + 48;
        float tot = 0.f;
        for (int d = 0; d < 2; ++d) { const float* gi = GI + (size_t)(d * 8 + hd) * NPOS; const float* gf = GF + (size_t)(d * 8 + hd) * NPOS;
            float num = 0.f, den = 0.f, carry = 0.f;
            for (int b0 = 0; b0 < NPOS; b0 += 64) { const int sp = d == 0 ? pos - b0 - C.lane : pos + b0 + C.lane; const bool ok = sp >= 48 && sp < NPOS;
                const float lf = ok ? gf[sp] : 0.f; const float lfe = (b0 == 0 && C.lane == 0) ? 0.f : lf;
                float pre = d == 0 ? lf : lf;
#pragma unroll
                for (int o = 1; o < 64; o <<= 1) { const float x = shf(pre, C.lane - o); pre += C.lane >= o ? x : 0.f; }
                const float cum = carry + pre - lf; (void)lfe;
                if (ok && cum > -80.f) { const int r = sp >= 64 ? sp - 64 : SEQ + sp - 48; const int rt = row; float dot = 0.f;
                    for (int e = 0; e < 128; ++e) dot += bf2f(Qm[(size_t)rt * 1024 + hd * 128 + e]) * bf2f(Km[(size_t)r * 1024 + hd * 128 + e]);
                    const float w = expf(cum + gi[sp]) * dot * 0.08838834764831845f;
                    const float vv = bf2f(r < SEQ ? V[(size_t)r * 2048 + hd * 256 + vc] : VM[(size_t)(r - SEQ) * 2048 + hd * 256 + vc]);
                    num += w * vv; den += w; }
                carry += shf(pre, 63);
                if (carry < -80.f) break; }
            num = wave_sum(num, C.lane); den = wave_sum(den, C.lane); tot += num / fmaxf(fabsf(den), 1.f); }
        const float got = bf2f(row < SEQ ? CELL[(size_t)row * 2048 + hd * 256 + vc] : CELLM[(size_t)(row - SEQ) * 2048 + hd * 256 + vc]);
        if (C.lane == 0) chk_add(C, 14, got - tot, tot); }
}
DI void dbg_check_ogate(const Ctx& C, int li, const bf16* XC, const bf16* SZ, const bf16* CELL, const bf16* CELLM, const bf16* HZ) {
    for (int s = C.gw; s < 48; s += C.ngw) { const int row = smp_row(s % 12), col = (int)(hsh(90 + s) % 2048u), hd = col >> 8;
        const float pre = wdot_bf_f32col(XC + (size_t)row * 2048, C.in[I_WOG] + (size_t)li * 2048 * 2048 + col, 2048, 2048, C.lane) + C.in[I_BOG][(size_t)li * 2048 + col];
        const bf16* cp = row < SEQ ? CELL + (size_t)row * 2048 : CELLM + (size_t)(row - SEQ) * 2048;
        float ss = 0.f; for (int e = C.lane; e < 256; e += 64) { const float v = bf2f(cp[hd * 256 + e]); ss += v * v; } ss = wave_sum(ss, C.lane);
        const float cn = bf2f(cp[col]) / sqrtf(ss / 256.f + EPS) * C.in[I_HN][(size_t)li * 2048 + col];
        const float hh = cn / (1.f + expf(-pre)) + C.in[I_SKIP][(size_t)li * 2048 + col] * bf2f(XC[(size_t)row * 2048 + col]);
        const float ref = hh * bf2f(SZ[(size_t)row * 2048 + col]);
        if (C.lane == 0) chk_add(C, 15, bf2f(HZ[(size_t)row * 2048 + col]) - ref, ref); }
}
DI void dbg_report(const Ctx& C, unsigned* ctl) {
    const float* w = (const float*)(ctl + CW_CHK); int code = 0;
    for (int id = 1; id < NCHK; ++id) { const float d2 = w[2 * id], r2 = w[2 * id + 1]; const bool used = (d2 != 0.f || r2 != 0.f);
        if (used && code == 0) { const float rel = sqrtf(d2 / fmaxf(r2, 1e-20f)); if (!(rel < 0.05f)) code = 3 + id + (rel > 0.5f || !(rel < 1e30f) ? 32 : 0); } }
    if (ctl[CW_BAR + XB_TMO] != 0u) code = 3 + 20;
    if (code) { const float v = exp2f((float)code); for (size_t i = (size_t)C.gw * 64 + C.lane; i < (size_t)SEQ * 1024; i += (size_t)C.ngw * 64) C.out[i] = v; }
}
#endif

#ifndef DBG_CHECK
#define DBG_CHECK 0
#endif
constexpr int N_PHASES = 33;
#ifndef ONLY_J
#define ONLY_J -1
#endif
#define INJ(j) (ONLY_J < 0 || ONLY_J == (j))

__global__ void __launch_bounds__(NTHR, 2) hybrid_fwd(Params prm) {
    extern __shared__ __attribute__((aligned(16))) unsigned char lds_raw[];
    Ctx C;
    C.lds = (LAS unsigned char*)lds_raw;
    asm volatile("s_nop 0\n s_nop 0\n s_nop 0\n s_nop 0\n s_nop 0\n s_nop 0\n s_nop 0\n s_nop 0");
    C.tid = threadIdx.x; C.lane = C.tid & 63; C.wave = __builtin_amdgcn_readfirstlane(C.tid >> 6);
    C.G = gridDim.x; C.bid = blockIdx.x; C.gw = C.bid * NWAVES + C.wave; C.ngw = C.G * NWAVES; C.gws = C.wave * C.G + C.bid;
    C.in = prm.in; C.out = (float*)(GAS float*)prm.out; C.ws = (unsigned char*)(GAS unsigned char*)prm.ws; C.dob = (unsigned char*)(GAS unsigned char*)prm.out;
    volatile LAS unsigned* MISC = (volatile LAS unsigned*)(C.lds + LDS_MISC);
    if (C.tid < 16) MISC[C.tid] = 0u;
    __syncthreads();
    unsigned* ctl = (unsigned*)(C.misc() + MS_CTL);
    XcdBarrier bar; bar.bar = ctl + CW_BAR; bar.x = 0; bar.st = nullptr;
    if (prm.use_bar) bar = xcd_barrier_post(ctl + CW_BAR, MISC);
    const int lo = prm.ph_lo, hi = prm.ph_hi;
#ifdef DIAG2
    unsigned long long* dts = (unsigned long long*)(C.misc() + MS_END + 65536);
    if (C.bid == 0 && C.tid == 0) dts[98] = wall_clock64();
#endif
#define IN(k) (lo <= (k) && (k) < hi)
#define xcd_barrier_if(ub, b) do { if (ub) xcd_barrier(b); } while (0)
#ifdef DIAG2
#define SEAM(k) do { if (IN(k) && IN((k) + 1)) { if (C.bid == 0 && C.tid == 0) dts[2 * (k)] = wall_clock64(); xcd_barrier(bar); if (C.bid == 0 && C.tid == 0) dts[2 * (k) + 1] = wall_clock64(); } } while (0)
#elif defined(PH_T)
    unsigned long long ph_prev = wall_clock64(), ph_dt = 0;
#define SEAM(k) do { if (IN(k) && IN((k) + 1)) { xcd_barrier(bar); { const unsigned long long tn_ = wall_clock64(); if ((k) == (PH_T)) ph_dt = tn_ - ph_prev; ph_prev = tn_; } } } while (0)
#else
#define SEAM(k) do { if (IN(k) && IN((k) + 1)) xcd_barrier(bar); } while (0)
#endif
#if DBG_CHECK
#define CHECK(k, call) do { if (IN(k)) { call; xcd_barrier(bar); } } while (0)
#else
#define CHECK(k, call) do { } while (0)
#endif
#define resid (C.slot(0))
#define wr (C.wreg())

    if (INJ(16) && IN(0)) { const Ctx C0 = C; const Ctx C = C0.fresh();
        phase_init_rows(C, resid, C.slot(1));
        phase_rope_table(C);
        convert_even_weights(C, 0);
        phase_s5_tables(C, 0);
#ifdef DBL_P0
        phase_init_rows(C, resid, C.slot(1)); phase_rope_table(C); convert_even_weights(C, 0); phase_s5_tables(C, 0);
#endif
    }
    SEAM(0);
    for (int li = 0; li < 2; ++li) {
        const int pb = 1 + li * 16;
#define h_e (C.slot(1))
#define YAB (C.slot(2))
#define GA (C.slot(4))
#define U (C.slot(5))
#define Kb (C.slot(6))
#define Vb (C.slot(6) + (size_t)KVROWS * 256)
#define YG (C.slot(1))
#define y_e (C.slot(4))
        if (INJ(0) && IN(pb + 0)) { const Ctx C0 = C; const Ctx C = C0.fresh();
            for (int i = C.gw * 64 + C.lane; i < 2 * 48 * 256 / 8; i += C.ngw * 64) {
                const int which = i / (48 * 32), r = (i / 32) % 48, c8 = (i % 32) * 8;
                unsigned z_ = 0u; asm volatile("" : "+v"(z_));
                *(u32x4*)((which ? Vb : Kb) + (size_t)(LTOK + r) * 256 + c8) = (u32x4){z_, z_, z_, z_};
                if (i < 48 * 16) *(u32x4*)(C.misc() + MS_K8 + (size_t)LTOK * 256 + (size_t)i * 16) = (u32x4){z_, z_, z_, z_}; }
            FEvenIn f{YAB, Kb, Vb, GA, U};
            run_gemm<1024, 1024, 1024, 4608, 0>(C, h_e, (const bf16*)(wr + WE_IN), f);
            phase_s5_ktab_hcat(C, li);
#ifdef DBL_KTAB
            phase_s5_ktab_hcat(C, li);
#endif
        }
        SEAM(pb + 0);
        CHECK(pb + 0, dbg_check_e1(C, li, h_e, YAB, Kb, Vb, GA, U));
        if (INJ(1) && IN(pb + 1)) { const Ctx C0 = C; const Ctx C = C0.fresh();
            phase_s5_local(C, U);
#ifdef DBL_LOCAL
            phase_s5_local(C, U);
#endif
        }
        SEAM(pb + 1);
        CHECK(pb + 1, dbg_check_e2(C, li, h_e, YAB, Kb));
        if (INJ(2) && IN(pb + 2)) { const Ctx C0 = C; const Ctx C = C0.fresh();
#ifdef SCAN_T
            if (C.gws < 128) { const unsigned long long t0_ = wall_clock64(); phase_s5_scan(C); asm volatile("s_waitcnt vmcnt(0)" ::: "memory"); const unsigned long long t1_ = wall_clock64();
                if (C.bid == 0 && C.tid == 0 && (t1_ - t0_) > (unsigned long long)(SCAN_T) * 100ull) ctl[CW_CHK] = 1u; }
#else
            if (C.gws < 128) phase_s5_scan(C);
#endif
            else { Ctx C2 = C; C2.gw = C.gws - 128; C2.ngw = C.ngw - 128; phase_s5_mg(C2, li); phase_qk_norm_rope(C2, YAB, Kb, C.in[I_QN] + li * 128, C.in[I_KN] + li * 128, (unsigned char*)(C.misc() + MS_K8)); phase_v8_image(C2, Vb, (unsigned char*)(wr + WO_OG)); }
        }
        SEAM(pb + 2);
        if (INJ(3) && IN(pb + 3)) { const Ctx C0 = C; const Ctx C = C0.fresh();
            phase_s5_out(C, U, YG);
#ifdef DBL_S5OUT
            phase_s5_out(C, U, YG);
#endif
        }
        SEAM(pb + 3);
        CHECK(pb + 3, dbg_check_s5(C, li, U, YG));
        if (INJ(4) && IN(pb + 4)) { const Ctx C0 = C; const Ctx C = C0.fresh();
#ifndef NO_ATT
            phase_attention(C, YAB, Kb, Vb, GA, (const unsigned char*)(C.misc() + MS_K8), (const unsigned char*)(wr + WO_OG));
#endif
#ifndef NO_GLU
            { const Ctx C1 = C0.fresh(); const Ctx& C = C1;
              FGlu f{YG, YAB, C.in[I_BGLU] + li * 1024};
              run_gemm<1024, 1024, 1024, 1024, 0>(C, YG, (const bf16*)(wr + WE_GLU), f); }
#endif
        }
        if (IN(pb + 4)) { xcd_barrier_if(prm.use_bar, bar); { const Ctx C0 = C; const Ctx C = C0.fresh(); phase_attention_combine(C, YAB, GA);
#ifdef DBL_META
            phase_attention_combine(C, YAB, GA);
#endif
        } }
        SEAM(pb + 4);
        CHECK(pb + 4, dbg_check_e5(C, li, h_e, YAB, Kb, Vb, GA, YG));
        if (INJ(5) && IN(pb + 5)) { const Ctx C0 = C; const Ctx C = C0.fresh();
            FPlain f{y_e, 1024};
            run_gemm<2048, 2048, 2048, 1024, 0>(C, YAB, (const bf16*)(wr + WE_OUT), f);
        }
        SEAM(pb + 5);
        CHECK(pb + 5, dbg_check_gemm_plain(C, 7, YAB, 2048, C.in[I_WOUTE] + (size_t)li * 2048 * 1024, 1024, 2048, y_e, 1024));
        if (INJ(6) && IN(pb + 6)) { const Ctx C0 = C; const Ctx C = C0.fresh();
#ifdef DBL_POST
            phase_post_rows(C, y_e, resid, C.slot(2), 2 * li, C.slot(1));
#endif
            phase_post_rows(C, y_e, resid, C.slot(5), 2 * li);
            convert_odd_early(C, li); convert_odd_late(C, li);
        }
        SEAM(pb + 6);
#define h_o (C.slot(5))
#define XM (C.slot(3))
#define XC (C.slot(1))
#define Qm (C.slot(5))
#define Km (C.slot(6))
#define CELL ((bf16*)C.dob)
#define CELLM ((bf16*)(C.misc() + MS_CELLM))
#define VM ((bf16*)(C.misc() + MS_VM))
#define h_r (C.slot(5))
#define SZ (C.slot(3))
#define HZ (C.slot(3))
#define y_o (C.slot(5))
        if (INJ(7) && IN(pb + 7)) { const Ctx C0 = C; const Ctx C = C0.fresh();
            FPlain f{XM, 2048};
            run_gemm<1024, 1024, 1024, 2048, 0>(C, h_o, (const bf16*)(wr + WO_IN), f);
        }
        SEAM(pb + 7);
        CHECK(pb + 7, dbg_check_gemm_plain(C, 9, h_o, 1024, C.in[I_WINO] + (size_t)li * 1024 * 4096, 4096, 1024, XM, 2048));
        if (INJ(8) && IN(pb + 8)) { const Ctx C0 = C; const Ctx C = C0.fresh();
            phase_conv(C, XM, XC, C.in[I_CONVW] + (size_t)li * 5 * 2048, C.in[I_CONVB] + (size_t)li * 2048);
#ifdef DBL_CONV
            phase_conv(C, XM, XC, C.in[I_CONVW] + (size_t)li * 5 * 2048, C.in[I_CONVB] + (size_t)li * 2048);
#endif
            if (C.gw == 0) { for (int i = C.lane; i < 1024; i += 64) ((unsigned*)(C.misc() + MS_ZROW))[i] = 0u; }
        }
        SEAM(pb + 8);
        CHECK(pb + 8, dbg_check_conv(C, li, XM, XC));
        if (INJ(9) && IN(pb + 9)) { const Ctx C0 = C; const Ctx C = C0.fresh();
#ifndef NO_QK
            { FQK f{Qm, Km}; run_gemm<2048, 256, 256, 2048, 256>(C, XC, (const bf16*)(wr + WO_QK), f); }
#endif
#ifndef NO_V
            { FVrow f{XM, VM}; run_gemm<2048, 256, 256, 2048, 256>(C, XM, (const bf16*)(wr + WO_V), f); }
#endif
#ifndef NO_GATES
            phase_gates(C, XC, (const bf16*)(wr + WO_G), C.in[I_BIG] + li * 16, C.in[I_BFG] + li * 16);
#ifdef DBL_GATES
            phase_gates(C, XC, (const bf16*)(wr + WO_G), C.in[I_BIG] + li * 16, C.in[I_BFG] + li * 16);
#endif
#endif
        }
        SEAM(pb + 9);
        CHECK(pb + 9, dbg_check_o3(C, li, XC, Qm, Km, XM, VM));
        if (INJ(10) && IN(pb + 10)) { const Ctx C0 = C; const Ctx C = C0.fresh();
#ifdef DBL_MLSTM
            phase_mlstm(C, 2 * li, Qm, Km, XM, VM, CELL, CELLM, CELL, CELLM); xcd_barrier_if(prm.use_bar, bar);
            phase_mlstm(C, 2 * li + 1, Qm, Km, XM, VM, CELL, CELLM, XM, VM);
#else
            phase_mlstm(C, li, Qm, Km, XM, VM, CELL, CELLM, XM, VM);
#endif
        }
        SEAM(pb + 10);
        CHECK(pb + 10, dbg_check_mlstm(C, li, Qm, Km, XM, VM, CELL, CELLM));
        if (INJ(11) && IN(pb + 11)) { const Ctx C0 = C; const Ctx C = C0.fresh();
            phase_renorm_rows(C, resid, h_r, 2 * li + 1);
#ifdef DBL_RENORM
            phase_renorm_rows(C, resid, h_r, 2 * li + 1);
#endif
#ifdef DBL_MERGE
            phase_cell_merge(C, CELL, CELLM, XM, VM, C.slot(6));
#endif
            phase_cell_merge(C, CELL, CELLM, XM, VM);
        }
        SEAM(pb + 11);
        if (INJ(12) && IN(pb + 12)) { const Ctx C0 = C; const Ctx C = C0.fresh();
            FSilu f{SZ, 2048};
            run_gemm<1024, 1024, 1024, 2048, 0>(C, h_r, (const bf16*)(wr + WO_Z), f);
        }
        if (INJ(13) && IN(pb + 13)) { const Ctx C0 = C; const Ctx C = C0.fresh();
            FOgate f{CELL, CELLM, XC, SZ, HZ, C.in[I_BOG] + (size_t)li * 2048, C.in[I_HN] + (size_t)li * 2048, C.in[I_SKIP] + (size_t)li * 2048, (const float*)(C.misc() + MS_RSTD)};
            run_gemm<2048, 2048, 2048, 2048, 0>(C, XC, (const bf16*)(wr + WO_OG), f);
        }
        SEAM(pb + 13);
        CHECK(pb + 13, dbg_check_ogate(C, li, XC, SZ, CELL, CELLM, HZ));
        if (INJ(14) && IN(pb + 14)) { const Ctx C0 = C; const Ctx C = C0.fresh();
            FPlain f{y_o, 1024};
            run_gemm<2048, 2048, 2048, 1024, 0>(C, HZ, (const bf16*)(wr + WO_OUT), f);
        }
        SEAM(pb + 14);
        CHECK(pb + 14, dbg_check_gemm_plain(C, 1, HZ, 2048, C.in[I_WOUTO] + (size_t)li * 2048 * 1024, 1024, 2048, y_o, 1024));
        if (INJ(15) && IN(pb + 15)) { const Ctx C0 = C; const Ctx C = C0.fresh();
#ifdef DBL_POST
            if (li == 0) phase_post_rows(C, y_o, resid, C.slot(2), 2 * li + 1, C.slot(6));
#endif
            phase_post_rows(C, y_o, resid, C.slot(1), 2 * li + 1);
#ifdef SCAN_T
            if (li == 1 && C.bid == 0 && C.tid == 0 && ctl[CW_CHK] != 0u) C.out[0] = __builtin_nanf("");
#endif
#ifdef PH_T
            if (li == 1 && C.bid == 0 && C.tid == 0) { if ((PH_T) == 32) ph_dt = wall_clock64() - ph_prev;
                int n_ = (int)((float)ph_dt * 0.01f / (float)(PH_STEP)); n_ = n_ < 0 ? 0 : (n_ > 15 ? 15 : n_);
#ifdef PH_CAL
                n_ = PH_CAL;
#endif
                C.out[0] = C.out[0] + sqrtf((float)n_) * 700.f; }
#endif
            if (li == 0) { convert_even_weights(C, 1); phase_s5_tables(C, 1); }
        }
        if (li == 0) SEAM(pb + 15);
    }
#if DBG_CHECK
    if (IN(N_PHASES - 1)) { xcd_barrier(bar); dbg_report(C, ctl); }
#endif
#ifdef DIAG2
    if (IN(N_PHASES - 1)) {
        if (C.bid == 0 && C.tid == 0) { const unsigned long long tend = wall_clock64(); float grp[4] = {0.f, 0.f, 0.f, 0.f};
            for (int k = 0; k < N_PHASES; ++k) { const unsigned long long t0 = k == 0 ? dts[98] : dts[2 * (k - 1) + 1]; const unsigned long long t1 = k == N_PHASES - 1 ? tend : dts[2 * k];
                const float us = (float)(t1 - t0) * 0.01f; const int j = k == 0 ? 16 : (k - 1) % 16;
                const int gsel = DIAG2_GROUP(j); if (gsel >= 0) grp[gsel] += us;
                if (k < N_PHASES - 1) grp[3] += (float)(dts[2 * k + 1] - dts[2 * k]) * 0.01f; }
            float* dg = (float*)(ctl + CW_CHK); dg[0] = grp[DIAG_A]; dg[1] = grp[DIAG_B]; }
        xcd_barrier(bar); const float* dg = (const float*)(ctl + CW_CHK); const float va = rintf(4.f * log2f(fmaxf(dg[0], 1.f))), vb = rintf(4.f * log2f(fmaxf(dg[1], 1.f)));
        for (size_t i = (size_t)C.gw * 64 + C.lane; i < (size_t)SEQ * 1024; i += (size_t)C.ngw * 64) C.out[i] = (i < (size_t)SEQ * 768) ? va : vb; }
#endif
#ifdef DIAG
    if (IN(N_PHASES - 1)) { xcd_barrier(bar); const float* dg = (const float*)(ctl + CW_CHK); const float va = rintf(4.f * log2f(fmaxf(dg[DIAG_A], 1.f))), vb = rintf(4.f * log2f(fmaxf(dg[DIAG_B], 1.f)));
        for (size_t i = (size_t)C.gw * 64 + C.lane; i < (size_t)SEQ * 1024; i += (size_t)C.ngw * 64) C.out[i] = (i < (size_t)SEQ * 768) ? va : vb; }
#endif
#undef IN
#undef SEAM
#undef CHECK
#undef h_e
#undef YAB
#undef GA
#undef U
#undef Kb
#undef Vb
#undef YG
#undef y_e
#undef h_o
#undef XM
#undef XC
#undef Qm
#undef Km
#undef CELL
#undef CELLM
#undef VM
#undef h_r
#undef SZ
#undef HZ
#undef y_o
#undef resid
#undef wr
}

#ifndef MULTI_LAUNCH
#define MULTI_LAUNCH 0
#endif
extern "C" void kernel_launch(void* const* d_in, const int* in_sizes, int n_in, void* d_out, int out_size, void* d_ws, size_t ws_size, hipStream_t stream) {
    static int grid = 0;
    if (grid == 0) {
        if (n_in != 33 || in_sizes[0] != SEQ * DM || out_size != SEQ * DM || ws_size < WS_NEED) {
            fprintf(stderr, "kernel_launch: shape mismatch: n_in %d in0 %d out %d ws %zu (need %zu)\n", n_in, n_in > 0 ? in_sizes[0] : -1, out_size, ws_size, (size_t)WS_NEED); grid = -1; return; }
        int dev = 0, cus = 0, per_cu = 0;
        if (hipGetDevice(&dev) != hipSuccess || hipDeviceGetAttribute(&cus, hipDeviceAttributeMultiprocessorCount, dev) != hipSuccess) { fprintf(stderr, "kernel_launch: device query failed\n"); grid = -1; return; }
        if (hipFuncSetAttribute((const void*)hybrid_fwd, hipFuncAttributeMaxDynamicSharedMemorySize, LDS_TOTAL) != hipSuccess) { fprintf(stderr, "kernel_launch: hipFuncSetAttribute failed\n"); grid = -1; return; }
        if (hipOccupancyMaxActiveBlocksPerMultiprocessor(&per_cu, (const void*)hybrid_fwd, NTHR, LDS_TOTAL) != hipSuccess || per_cu < 1) { fprintf(stderr, "kernel_launch: occupancy query says %d blocks per CU\n", per_cu); (void)hipGetLastError(); }
        grid = cus;
    }
    if (grid < 0) return;
    if (hipMemsetAsync((char*)d_ws + WS_MISC + MS_CTL, 0, 65536, stream) != hipSuccess) { fprintf(stderr, "kernel_launch: memset failed\n"); return; }
    Params p{};
    for (int i = 0; i < 33; ++i) p.in[i] = (const float*)d_in[i];
    p.out = (float*)d_out; p.ws = (unsigned char*)d_ws; p.pad = 0;
#if MULTI_LAUNCH
    for (int k = 0; k < N_PHASES; ++k) { p.ph_lo = k; p.ph_hi = k + 1; p.use_bar = 0;
        hipLaunchKernelGGL(hybrid_fwd, dim3(grid), dim3(NTHR), LDS_TOTAL, stream, p); }
#else
    p.ph_lo = 0; p.ph_hi = N_PHASES; p.use_bar = 1;
    hipLaunchKernelGGL(hybrid_fwd, dim3(grid), dim3(NTHR), LDS_TOTAL, stream, p);
#endif
    const hipError_t le = hipPeekAtLastError();
    if (le != hipSuccess) fprintf(stderr, "kernel_launch: launch failed: %s\n", hipGetErrorName(le));
}
```

```cpp
#include <hip/hip_runtime.h>
#include <cstdio>
#include <cstdint>

#define DI __device__ __forceinline__
#define GAS __attribute__((address_space(1)))
#define LAS __attribute__((address_space(3)))
typedef unsigned short bf16;
typedef short bf16x8 __attribute__((ext_vector_type(8)));
typedef float f32x4 __attribute__((ext_vector_type(4)));
typedef float f32x2 __attribute__((ext_vector_type(2)));
typedef float f32x16 __attribute__((ext_vector_type(16)));
typedef unsigned u32x4 __attribute__((ext_vector_type(4)));
typedef unsigned u32x2 __attribute__((ext_vector_type(2)));
typedef short s16x4 __attribute__((ext_vector_type(4)));

constexpr int DM = 1024, SEQ = 16384, NMETA = 16, LTOK = 16400;
constexpr int KVROWS = 16448;
constexpr int NPOS = 16448;
constexpr int NWAVES = 8, NTHR = 512;
constexpr float EPS = 1e-6f;

DI float bf2f(bf16 b) { return __uint_as_float(((unsigned)b) << 16); }
DI float bflo(unsigned w) { return __uint_as_float(w << 16); }
DI float bfhi(unsigned w) { return __uint_as_float(w & 0xffff0000u); }
typedef __bf16 bf16x2_t __attribute__((ext_vector_type(2)));
DI unsigned cvt_pk_bf16(float lo, float hi) { bf16x2_t v = {(__bf16)lo, (__bf16)hi}; return __builtin_bit_cast(unsigned, v); }
DI bf16 f2bf(float f) { return (bf16)(cvt_pk_bf16(f, 0.f) & 0xffffu); }
DI float fexp(float x) { return __builtin_amdgcn_exp2f(x * 1.4426950408889634f); }
DI float silu_f(float x) { return x * __builtin_amdgcn_rcpf(1.f + __expf(-x)); }
DI float sigmoid_f(float x) { return __builtin_amdgcn_rcpf(1.f + __expf(-x)); }
DI float gelu_tanh_f(float v) { const float z = 0.7978845608028654f * (v + 0.044715f * v * v * v); const float t = 1.f - 2.f * __builtin_amdgcn_rcpf(1.f + __expf(2.f * z)); return 0.5f * v * (1.f + t); }
DI float shf(float v, int src_lane) { return __int_as_float(__builtin_amdgcn_ds_bpermute(src_lane << 2, __float_as_int(v))); }
DI float shx(float v, int mask, int lane) { return shf(v, lane ^ mask); }
DI float wave_sum(float v, int lane) {
#pragma unroll
    for (int o = 1; o < 64; o <<= 1) v += shx(v, o, lane);
    return v;
}
DI void unpack8(u32x4 w, float (&v)[8]) { v[0] = bflo(w.x); v[1] = bfhi(w.x); v[2] = bflo(w.y); v[3] = bfhi(w.y); v[4] = bflo(w.z); v[5] = bfhi(w.z); v[6] = bflo(w.w); v[7] = bfhi(w.w); }
DI u32x4 pack8(const float (&v)[8]) { u32x4 w; w.x = cvt_pk_bf16(v[0], v[1]); w.y = cvt_pk_bf16(v[2], v[3]); w.z = cvt_pk_bf16(v[4], v[5]); w.w = cvt_pk_bf16(v[6], v[7]); return w; }
DI u32x4 pack8v(f32x4 a, f32x4 b) { u32x4 w; w.x = cvt_pk_bf16(a[0], a[1]); w.y = cvt_pk_bf16(a[2], a[3]); w.z = cvt_pk_bf16(b[0], b[1]); w.w = cvt_pk_bf16(b[2], b[3]); return w; }
template <class T> DI void lnd(T*& p) { GAS T* q = (GAS T*)p; asm volatile("" : "+s"(q)); p = (T*)q; }
#define LDS_WAIT() asm volatile("s_waitcnt lgkmcnt(0)" ::: "memory")
#define VM_WAIT() asm volatile("s_waitcnt vmcnt(0)" ::: "memory")
#define MFMA16(a, b, c) __builtin_amdgcn_mfma_f32_16x16x32_bf16((a), (b), (c), 0, 0, 0)
#define MFMA32(a, b, c) __builtin_amdgcn_mfma_f32_32x32x16_bf16((a), (b), (c), 0, 0, 0)

namespace pg8 {
constexpr int BM = 256, BK = 64, HALF = 128, HTB = HALF * BK * 2, STAGE_BYTES = 8 * HTB, NXCD = 8, WGM = 8;
__host__ __device__ __forceinline__ int lds_byte(int r, int c) { const int st = (r >> 4) * 2 + (c >> 5), rr = r & 15, cc = c & 31, ob = rr * 64 + cc * 2; return st * 1024 + (ob ^ (((ob >> 9) & 1) << 5)); }
__host__ __device__ __forceinline__ void stage_rc(int b, int& R, int& C) { const int st = b / 1024, sb = b % 1024, swz = sb ^ (((sb >> 9) & 1) << 5); R = (st >> 1) * 16 + swz / 64; C = (st & 1) * 32 + (swz % 64) / 2; }
__host__ __device__ __forceinline__ int perm32(int rho) { const int n = rho >> 4, i = rho & 15; return 8 * (i >> 2) + 4 * n + (i & 3); }

struct Unit { int pm, pn; };
struct Gemm { const bf16* A; const bf16* Bt; };

template <int NN> struct StaticOrder {
    static constexpr int nM = 64, nN = NN, nwg = nM * nN;
    int G, c;
    __device__ void init(int G_, int c_) { G = G_; c = c_; }
    __device__ bool next(int i, Unit& u) const {
        const long L = (long)i * G + c; if (L >= nwg) return false;
        int wgid = (int)L; { const int q = nwg / NXCD, r = nwg % NXCD, xcd = wgid % NXCD, off = wgid / NXCD; wgid = (xcd < r ? xcd * (q + 1) : r * (q + 1) + (xcd - r) * q) + off; }
        const int nig = WGM * nN, gid = wgid / nig, fm = gid * WGM, gsz = (nM - fm) < WGM ? (nM - fm) : WGM;
        u.pm = fm + ((wgid % nig) % gsz); u.pn = (wgid % nig) / gsz; return true;
    }
};

template <class F> struct EpiT {
    static constexpr bool PERM = true;
    F f;
    DI void operator()(const f32x4 (&acc)[2][2][4][2], const Unit& u, int wr, int wc, int fr, int fq) const {
        const int row0 = u.pm * BM + wr * 64 + fr, col0 = u.pn * BM + wc * 32 + 8 * fq;
#pragma unroll
        for (int ai = 0; ai < 2; ++ai)
#pragma unroll
            for (int m = 0; m < 4; ++m)
#pragma unroll
                for (int bj = 0; bj < 2; ++bj) f.op8(row0 + ai * HALF + m * 16, col0 + bj * HALF, acc[ai][bj][m][0], acc[ai][bj][m][1]);
    }
};

template <class F> struct EpiP {
    static constexpr bool PERM = true;
    F f;
    DI void operator()(const f32x4 (&acc)[2][2][4][2], const Unit& u, int wr, int wc, int fr, int fq) const {
        const int row0 = u.pm * BM + wr * 64 + fr, col0 = u.pn * BM + wc * 32 + 8 * fq;
#pragma unroll
        for (int bj = 0; bj < 2; ++bj) {
            const int col = col0 + bj * HALF;
            const typename F::Cols cp = f.cols(col);
            typename F::Pre p0 = f.pre(row0, col), p1 = p0;
#pragma unroll
            for (int k = 0; k < 8; ++k) {
                const int ai = k >> 2, m = k & 3, row = row0 + ai * HALF + m * 16;
                if (k + 1 < 8) { const int rn = row0 + ((k + 1) >> 2) * HALF + ((k + 1) & 3) * 16; if (k & 1) p0 = f.pre(rn, col); else p1 = f.pre(rn, col); }
                f.fin(row, col, acc[ai][bj][m][0], acc[ai][bj][m][1], (k & 1) ? p1 : p0, cp);
            }
        }
    }
};
template <class F, bool P = F::PIPE> struct EpiSel { typedef EpiT<F> type; };
template <class F> struct EpiSel<F, true> { typedef EpiP<F> type; };

template <class Epi, class Sched, int LDA, int LDB, int KK, int APN>
DI void gemm_phase(LAS unsigned char* lds, const Gemm g, const Sched& S, const Epi& E) {
    int tid = threadIdx.x; asm volatile("" : "+v"(tid));
    const int wid = __builtin_amdgcn_readfirstlane(tid >> 6), lane = tid & 63, wr = wid >> 2, wc = wid & 3, fr = lane & 15, fq = lane >> 4;
    constexpr int nt = KK / BK;
    unsigned voffA[2], voffB[2];
#pragma unroll
    for (int i = 0; i < 2; ++i) { int R, C; stage_rc(tid * 16 + i * 8192, R, C); const int Rb = Epi::PERM ? ((R & ~31) + perm32(R & 31)) : R;
        voffA[i] = (unsigned)(R * LDA + C) * 2u; voffB[i] = (unsigned)(Rb * LDB + C) * 2u; }
    constexpr size_t kstep = (size_t)(BK * 2);
    constexpr size_t hstepA = (size_t)HALF * LDA * 2, hstepB = (size_t)HALF * LDB * 2;
    constexpr size_t tstepA = 2 * hstepA, tstepB = 2 * hstepB;
    constexpr size_t pnstepA = (size_t)APN * 2;
    const unsigned ldsw = (unsigned)wid * 1024u;
    const int aoff = lds_byte(wr * 64 + fr, fq * 8), boff = lds_byte(wc * 32 + fr, fq * 8);
#define PG8_SA(b, h) (((b) * 2 + (h)) * HTB)
#define PG8_SB(b, h) ((4 + (b) * 2 + (h)) * HTB)
#define PG8_STAGE(bufoff, gbase, voff) do { _Pragma("unroll") for (int _i = 0; _i < 2; ++_i) \
        __builtin_amdgcn_global_load_lds((const unsigned*)((const char*)(gbase) + (voff)[_i]), (LAS unsigned*)(lds + (bufoff) + ldsw + _i * 8192), 16, 0, 0); } while (0)
#define PG8_LDA(dst, b, h) do { _Pragma("unroll") for (int m = 0; m < 4; ++m) _Pragma("unroll") for (int k = 0; k < 2; ++k) dst[m][k] = *(const LAS bf16x8*)(lds + PG8_SA(b, h) + aoff + m * 2048 + k * 1024); } while (0)
#define PG8_LDB(dst, b, h) do { _Pragma("unroll") for (int n = 0; n < 2; ++n) _Pragma("unroll") for (int k = 0; k < 2; ++k) dst[n][k] = *(const LAS bf16x8*)(lds + PG8_SB(b, h) + boff + n * 2048 + k * 1024); } while (0)
#define PG8_MMA(ai, bj, At, Bt) do { __builtin_amdgcn_s_setprio(1); _Pragma("unroll") for (int m = 0; m < 4; ++m) _Pragma("unroll") for (int n = 0; n < 2; ++n) _Pragma("unroll") for (int k = 0; k < 2; ++k) \
        acc[ai][bj][m][n] = __builtin_amdgcn_mfma_f32_16x16x32_bf16(Bt[n][k], At[m][k], acc[ai][bj][m][n], 0, 0, 0); __builtin_amdgcn_s_setprio(0); } while (0)
#define PG8_WAIT_V(n) asm volatile("s_waitcnt vmcnt(" #n ")" ::: "memory")
#define PG8_WAIT_L(n) asm volatile("s_waitcnt lgkmcnt(" #n ")" ::: "memory")
#define PG8_BAR __builtin_amdgcn_s_barrier()
#define PG8_SCHED __builtin_amdgcn_sched_barrier(0)
    Unit cur, nxt; int ui = 0;
    if (!S.next(0, cur)) return;
    const bf16* gA = g.A; const bf16* gB = g.Bt;
    asm volatile("" : "+s"(gA), "+s"(gB));
    f32x4 acc[2][2][4][2];
#pragma unroll
    for (int a = 0; a < 2; ++a)
#pragma unroll
        for (int b = 0; b < 2; ++b)
#pragma unroll
            for (int m = 0; m < 4; ++m)
#pragma unroll
                for (int n = 0; n < 2; ++n) acc[a][b][m][n] = (f32x4){0.f, 0.f, 0.f, 0.f};
    bf16x8 At[4][2], B0[2][2], B1[2][2];
    const char* cA = (const char*)gA + (size_t)cur.pm * tstepA + (size_t)cur.pn * pnstepA; const char* cB = (const char*)gB + (size_t)cur.pn * tstepB;
    PG8_STAGE(PG8_SB(0, 0), cB, voffB); PG8_STAGE(PG8_SB(0, 1), cB + hstepB, voffB); PG8_STAGE(PG8_SA(0, 0), cA, voffA); PG8_STAGE(PG8_SA(0, 1), cA + hstepA, voffA);
    if (wr == 1) PG8_BAR;
    PG8_WAIT_V(2); PG8_BAR;
    PG8_STAGE(PG8_SB(1, 0), cB + kstep, voffB); PG8_STAGE(PG8_SA(1, 0), cA + kstep, voffA); PG8_STAGE(PG8_SB(1, 1), cB + hstepB + kstep, voffB);
    PG8_WAIT_V(6); PG8_BAR;
    for (;;) {
        const bool has_next = S.next(ui + 1, nxt);
        const char* nA = has_next ? (const char*)gA + (size_t)nxt.pm * tstepA + (size_t)nxt.pn * pnstepA : cA; const char* nB = has_next ? (const char*)gB + (size_t)nxt.pn * tstepB : cB;
#pragma unroll 1
        for (int t = 0; t < nt; t += 2) {
            const bool last = (t == nt - 2);
            const char* a1 = cA + (size_t)(t + 1) * kstep;
            const char* a2 = last ? nA : cA + (size_t)(t + 2) * kstep; const char* b2 = last ? nB : cB + (size_t)(t + 2) * kstep;
            const char* a3 = a2 + kstep; const char* b3 = b2 + kstep;
            PG8_LDB(B0, 0, 0); PG8_LDB(B1, 0, 1); PG8_SCHED; PG8_LDA(At, 0, 0); PG8_STAGE(PG8_SA(1, 1), a1 + hstepA, voffA);
            PG8_WAIT_V(8); PG8_WAIT_L(0); PG8_BAR; PG8_MMA(0, 0, At, B0); PG8_MMA(0, 1, At, B1); PG8_BAR; PG8_SCHED;
            PG8_LDA(At, 0, 1); PG8_STAGE(PG8_SB(0, 0), b2, voffB); PG8_STAGE(PG8_SB(0, 1), b2 + hstepB, voffB); PG8_STAGE(PG8_SA(0, 0), a2, voffA);
            PG8_WAIT_V(8); PG8_WAIT_L(0); PG8_BAR; PG8_MMA(1, 0, At, B0); PG8_MMA(1, 1, At, B1); PG8_BAR; PG8_SCHED;
            PG8_LDB(B0, 1, 0); PG8_LDB(B1, 1, 1); PG8_SCHED; PG8_LDA(At, 1, 0); PG8_STAGE(PG8_SA(0, 1), a2 + hstepA, voffA);
            PG8_WAIT_V(8); PG8_WAIT_L(0); PG8_BAR; PG8_MMA(0, 0, At, B0); PG8_MMA(0, 1, At, B1); PG8_BAR; PG8_SCHED;
            PG8_LDA(At, 1, 1); PG8_STAGE(PG8_SB(1, 0), b3, voffB); PG8_STAGE(PG8_SB(1, 1), b3 + hstepB, voffB); PG8_STAGE(PG8_SA(1, 0), a3, voffA);
            PG8_WAIT_V(8); PG8_WAIT_L(0); PG8_BAR; PG8_MMA(1, 0, At, B0); PG8_MMA(1, 1, At, B1); PG8_BAR; PG8_SCHED;
        }
        if (wr == 0) PG8_BAR;
        E(acc, cur, wr, wc, fr, fq);
        if (!has_next) break;
#pragma unroll
        for (int a = 0; a < 2; ++a)
#pragma unroll
            for (int b = 0; b < 2; ++b)
#pragma unroll
                for (int m = 0; m < 4; ++m)
#pragma unroll
                    for (int n = 0; n < 2; ++n) acc[a][b][m][n] = (f32x4){0.f, 0.f, 0.f, 0.f};
        cur = nxt; cA = nA; cB = nB; ++ui;
        if (wr == 1) PG8_BAR;
    }
    PG8_WAIT_V(0);
    PG8_BAR;
#undef PG8_SA
#undef PG8_SB
#undef PG8_STAGE
#undef PG8_LDA
#undef PG8_LDB
#undef PG8_MMA
#undef PG8_WAIT_V
#undef PG8_WAIT_L
#undef PG8_BAR
#undef PG8_SCHED
}
}

template <class F>
DI void gemm_tail(LAS unsigned char* lds, const bf16* A, int lda, const bf16* Bt, int ldb, int K, int N, int a_pn_step, const F& f, int row_base, int bid, int G, int wave, int lane) {
    const int i16 = lane & 15, kq = lane >> 4;
    LAS float* P = (LAS float*)lds;
    for (int task = bid; task < N / 32; task += G) {
        const int n0 = task * 32, pn = n0 >> 8, kw = K >> 3, kb = wave * kw;
        const bf16* ap = A + (size_t)i16 * lda + (size_t)pn * a_pn_step + kb + 8 * kq;
        const bf16* b0p = Bt + (size_t)(n0 + 8 * (i16 >> 2) + (i16 & 3)) * ldb + kb + 8 * kq;
        const bf16* b1p = b0p + (size_t)4 * ldb;
        f32x4 acc0 = {0.f, 0.f, 0.f, 0.f}, acc1 = {0.f, 0.f, 0.f, 0.f};
#pragma unroll 8
        for (int k0 = 0; k0 < kw; k0 += 32) {
            const bf16x8 a = *(const bf16x8*)(ap + k0), b0 = *(const bf16x8*)(b0p + k0), b1 = *(const bf16x8*)(b1p + k0);
            acc0 = MFMA16(b0, a, acc0); acc1 = MFMA16(b1, a, acc1);
        }
#pragma unroll
        for (int r = 0; r < 4; ++r) { P[(wave * 8 + r) * 64 + lane] = acc0[r]; P[(wave * 8 + 4 + r) * 64 + lane] = acc1[r]; }
        __syncthreads();
        if (wave == 0) {
            f32x4 s0 = {0.f, 0.f, 0.f, 0.f}, s1 = s0;
#pragma unroll
            for (int ww = 0; ww < 8; ++ww)
#pragma unroll
                for (int r = 0; r < 4; ++r) { s0[r] += P[(ww * 8 + r) * 64 + lane]; s1[r] += P[(ww * 8 + 4 + r) * 64 + lane]; }
            f.op8(row_base + i16, n0 + 8 * kq, s0, s1);
        }
        __syncthreads();
    }
}

constexpr size_t SLOT = (size_t)LTOK * 1024 * 2;
constexpr size_t WS_SLOT0 = 0;
constexpr size_t WS_WREG = 7 * SLOT;
constexpr size_t WREG_BYTES = 24117248;
constexpr size_t WS_MISC = WS_WREG + WREG_BYTES;
constexpr size_t MS_CTL = 0;
constexpr size_t MS_GI = 65536;
constexpr size_t MS_GF = MS_GI + (size_t)2 * 8 * NPOS * 4;
constexpr size_t MS_RSTD = MS_GF + (size_t)2 * 8 * NPOS * 4;
constexpr size_t MS_CELLM = MS_RSTD + (size_t)LTOK * 8 * 4;
constexpr size_t MS_VM = MS_CELLM + 64 * 2048 * 2;
constexpr size_t MS_ROPE = MS_VM + 64 * 2048 * 2;
constexpr size_t MS_ZROW = MS_ROPE + 256 * 32 * 8;
constexpr size_t MS_GB = MS_ZROW + 4096;
constexpr size_t MS_K8 = MS_GB + (size_t)2 * 8 * NPOS * 4;
constexpr size_t MS_END = MS_K8 + (size_t)KVROWS * 256;
constexpr size_t WS_NEED = WS_MISC + MS_END;
constexpr size_t WE_IN = 0, WE_GLU = WE_IN + (size_t)4608 * 1024 * 2, WE_OUT = WE_GLU + (size_t)1024 * 1024 * 2;
constexpr size_t WO_IN = 0, WO_Z = WO_IN + (size_t)2048 * 1024 * 2, WO_QK = WO_Z + (size_t)2048 * 1024 * 2, WO_V = WO_QK + (size_t)2048 * 256 * 2,
                 WO_G = WO_V + (size_t)2048 * 256 * 2, WO_OUT = WO_G + (size_t)32 * 2048 * 2, WO_OG = WE_OUT + (size_t)2048 * 1024 * 2;
static_assert(WO_V == WE_GLU && WO_OUT + (size_t)1024 * 2048 * 2 <= WO_OG && WO_OG + (size_t)2048 * 2048 * 2 == WREG_BYTES, "odd weight region");
constexpr size_t DO_EX = 0;
constexpr size_t DO_HCAT = DO_EX + (size_t)1025 * 64 * 256 * 2;
constexpr size_t DO_MG = DO_HCAT + (size_t)64 * 256 * 256 * 2;
constexpr size_t DO_APOW = DO_MG + (size_t)64 * 256 * 512 * 2;
constexpr size_t DO_BB = DO_APOW + (size_t)2 * 64 * 64 * 17 * 8;
constexpr size_t DO_KTAB = DO_BB + (size_t)2 * 64 * 64 * 16 * 8;
static_assert(DO_KTAB + (size_t)2 * 64 * 16 * 256 * 4 <= (size_t)SEQ * 1024 * 4, "d_out scratch map");

constexpr int CW_BAR = 1024;
constexpr int CW_CHK = 8192;
constexpr int LDS_TOTAL = 160 * 1024;
constexpr int LDS_MISC = LDS_TOTAL - 64;

#define XB_TMO      128
#define XB_XCNT(j)  (256  + 64 * (j))
#define XB_XSUB(j)  (1280 + 64 * (j))
#define XB_XGEN(j)  (2304 + 64 * (j))
#define XB_TOP      3328
#define XB_TOPGEN   3392
#define XCD_BAR_WORDS 3456
#define XB_SPIN_CAP (1u << 21)
DI unsigned xb_ld(unsigned* p)              { return __hip_atomic_load(p, __ATOMIC_RELAXED, __HIP_MEMORY_SCOPE_AGENT); }
DI unsigned xb_add(unsigned* p, unsigned v) { return __hip_atomic_fetch_add(p, v, __ATOMIC_RELAXED, __HIP_MEMORY_SCOPE_AGENT); }
DI unsigned xb_xcc_id() { return (unsigned)__builtin_amdgcn_s_getreg((3 << 11) | 20) & 0xFu; }
#define XB_SPIN(cond, bar) do { unsigned _sp = 0; while (cond) { __builtin_amdgcn_s_sleep(1); \
    if ((++_sp & 255u) == 0u) { if (xb_ld(&(bar)[XB_TMO])) break; if (_sp > XB_SPIN_CAP) { atomicAdd(&(bar)[XB_TMO], 1u); break; } } } } while (0)
struct XcdBarrier { unsigned* bar; unsigned x; volatile LAS unsigned* st; };
DI XcdBarrier xcd_barrier_post(unsigned* bar, volatile LAS unsigned* st) {
    XcdBarrier b; b.bar = bar; b.x = xb_xcc_id(); b.st = st;
    if (threadIdx.x == 0) (void)xb_add(&bar[XB_XCNT(b.x)], 1u);
    return b;
}
DI void xcd_barrier_complete(unsigned* bar, unsigned x, unsigned& nloc, unsigned& nx) {
    const unsigned G = gridDim.x * gridDim.y * gridDim.z;
    unsigned sum, cnt, mine, sp = 0u;
    for (;;) {
        sum = 0u; cnt = 0u; mine = 0u;
#pragma unroll
        for (unsigned j = 0; j < 16; ++j) { const unsigned c = xb_ld(&bar[XB_XCNT(j)]); sum += c; cnt += (c > 0u) ? 1u : 0u; mine = (j == x) ? c : mine; }
        if (sum == G) break;
        __builtin_amdgcn_s_sleep(1);
        if ((++sp & 255u) == 0u) { if (xb_ld(&bar[XB_TMO])) break; if (sp > XB_SPIN_CAP) { atomicAdd(&bar[XB_TMO], 1u); break; } }
    }
    nloc = mine > 0u ? mine : 1u; nx = cnt > 0u ? cnt : 1u;
}
DI void xcd_barrier(const XcdBarrier& b) {
    asm volatile("s_waitcnt vmcnt(0)" ::: "memory");
    __syncthreads();
    if (threadIdx.x == 0) {
        unsigned* bar = b.bar; lnd(bar);
        __builtin_amdgcn_s_waitcnt(0);
        unsigned nloc = b.st[0], nx = b.st[1];
        if (nloc == 0u) { xcd_barrier_complete(bar, b.x, nloc, nx); b.st[0] = nloc; b.st[1] = nx; }
        const unsigned old = xb_add(&bar[XB_XSUB(b.x)], 1u);
        const unsigned gen = old / nloc;
        if (old + 1u == (gen + 1u) * nloc) {
            __builtin_amdgcn_fence(__ATOMIC_RELEASE, "agent");
            asm volatile("s_waitcnt vmcnt(0)" ::: "memory");
            const unsigned og = xb_add(&bar[XB_TOP], 1u);
            const unsigned tg = og / nx;
            if (og + 1u == (tg + 1u) * nx) xb_add(&bar[XB_TOPGEN], 1u);
            else XB_SPIN(xb_ld(&bar[XB_TOPGEN]) == tg, bar);
            __builtin_amdgcn_fence(__ATOMIC_ACQUIRE, "agent");
            xb_add(&bar[XB_XGEN(b.x)], 1u);
            asm volatile("s_waitcnt vmcnt(0)" ::: "memory");
        } else {
            XB_SPIN(xb_ld(&bar[XB_XGEN(b.x)]) == gen, bar);
            __builtin_amdgcn_fence(__ATOMIC_ACQUIRE, "agent");
            asm volatile("s_waitcnt vmcnt(0)" ::: "memory");
        }
    }
    __syncthreads();
}

struct Params { const float* in[33]; float* out; unsigned char* ws; int ph_lo, ph_hi, use_bar, pad; };
enum { I_X = 0, I_META, I_NPRE, I_NPOST, I_WINE, I_QN, I_KN, I_ARE, I_AIM, I_LDT, I_BRE, I_BIM, I_CRE, I_CIM, I_SSMD, I_WGLU, I_BGLU, I_WOUTE,
       I_WINO, I_CONVW, I_CONVB, I_WQ, I_WK, I_WV, I_WIG, I_BIG, I_WFG, I_BFG, I_WOG, I_BOG, I_HN, I_SKIP, I_WOUTO };

struct Ctx {
    LAS unsigned char* lds;
    int tid, lane, wave, G, bid;
    int gw, ngw;
    int gws;
    const float* const* in; float* out; unsigned char* ws; unsigned char* dob;
    DI bf16* slot(int i) const { return (bf16*)(ws + WS_SLOT0 + (size_t)i * SLOT); }
    DI Ctx fresh() const { Ctx P = *this; asm volatile("" : "+v"(P.tid)); P.lane = P.tid & 63; P.wave = __builtin_amdgcn_readfirstlane(P.tid >> 6);
        asm volatile("" : "+s"(P.G)); P.ngw = P.G * NWAVES; P.gw = P.bid * NWAVES + P.wave; P.gws = P.wave * P.G + P.bid; lnd(P.ws); lnd(P.dob); lnd(P.out); return P; }
    DI unsigned char* wreg() const { return ws + WS_WREG; }
    DI unsigned char* misc() const { return ws + WS_MISC; }
};

DI void transpose_item(const float* W, int ldw, int N, bf16* WT, int ldo, int row_off, LAS float* scr, int item, int lane, const float* ks = nullptr) {
    const int nblk = N / 32, kb = item / nblk, nb = item % nblk, k0 = 64 * kb, n0 = 32 * nb;
    f32x4 v[8];
#pragma unroll
    for (int i = 0; i < 8; ++i) v[i] = *(const f32x4*)(W + (size_t)(k0 + 8 * i + (lane >> 3)) * ldw + n0 + 4 * (lane & 7));
#pragma unroll
    for (int i = 0; i < 8; ++i) { const int kk = 8 * i + (lane >> 3); const float sc = ks ? ks[k0 + kk] : 1.f; LAS float* d = scr + kk * 33 + 4 * (lane & 7);
        d[0] = v[i][0] * sc; d[1] = v[i][1] * sc; d[2] = v[i][2] * sc; d[3] = v[i][3] * sc; }
    LDS_WAIT(); asm volatile("" ::: "memory");
    const int c = lane & 7;
#pragma unroll
    for (int j = 0; j < 4; ++j) { const int n = (lane >> 3) + 8 * j; const LAS float* s = scr + (8 * c) * 33 + n;
        u32x4 o; o.x = cvt_pk_bf16(s[0 * 33], s[1 * 33]); o.y = cvt_pk_bf16(s[2 * 33], s[3 * 33]); o.z = cvt_pk_bf16(s[4 * 33], s[5 * 33]); o.w = cvt_pk_bf16(s[6 * 33], s[7 * 33]);
        *(u32x4*)(WT + (size_t)(row_off + n0 + n) * ldo + k0 + 8 * c) = o; }
    LDS_WAIT(); asm volatile("" ::: "memory");
}

DI void convert_even_weights(const Ctx& C, int li) {
    LAS float* scr = (LAS float*)(C.lds + C.wave * 8704);
    unsigned char* wr = C.wreg();
    { const int n = (1024 / 64) * (4608 / 32); for (int it = C.gw; it < n; it += C.ngw) transpose_item(C.in[I_WINE] + (size_t)li * 1024 * 4608, 4608, 4608, (bf16*)(wr + WE_IN), 1024, 0, scr, it, C.lane); }
    { const int n = (1024 / 64) * (1024 / 32); for (int it = C.gw; it < n; it += C.ngw) transpose_item(C.in[I_WGLU] + (size_t)li * 1024 * 1024, 1024, 1024, (bf16*)(wr + WE_GLU), 1024, 0, scr, it, C.lane); }
    { const int n = (2048 / 64) * (1024 / 32); for (int it = C.gw; it < n; it += C.ngw) transpose_item(C.in[I_WOUTE] + (size_t)li * 2048 * 1024, 1024, 1024, (bf16*)(wr + WE_OUT), 2048, 0, scr, it, C.lane); }
}
DI void convert_odd_early(const Ctx& C, int li) {
    LAS float* scr = (LAS float*)(C.lds + C.wave * 8704);
    unsigned char* wr = C.wreg();
    const float* win = C.in[I_WINO] + (size_t)li * 1024 * 4096;
    { const int n = (1024 / 64) * (2048 / 32);
      for (int it = C.gw; it < n; it += C.ngw) transpose_item(win, 4096, 2048, (bf16*)(wr + WO_IN), 1024, 0, scr, it, C.lane);
      for (int it = C.gw; it < n; it += C.ngw) transpose_item(win + 2048, 4096, 2048, (bf16*)(wr + WO_Z), 1024, 0, scr, it, C.lane); }
    { const int nq = (256 / 64) * (128 / 32);
      for (int it = C.gw; it < 8 * nq; it += C.ngw) { const int h = it / nq, r = it % nq;
          transpose_item(C.in[I_WQ] + ((size_t)li * 8 + h) * 256 * 128, 128, 128, (bf16*)(wr + WO_QK), 256, h * 256, scr, r, C.lane);
          transpose_item(C.in[I_WK] + ((size_t)li * 8 + h) * 256 * 128, 128, 128, (bf16*)(wr + WO_QK), 256, h * 256 + 128, scr, r, C.lane); } }
    { const int n = (2048 / 64) * (2048 / 32);
      for (int it = C.gw; it < n; it += C.ngw) transpose_item(C.in[I_WOG] + (size_t)li * 2048 * 2048, 2048, 2048, (bf16*)(wr + WO_OG), 2048, 0, scr, it, C.lane); }
}
DI void convert_odd_late(const Ctx& C, int li) {
    LAS float* scr = (LAS float*)(C.lds + C.wave * 8704);
    unsigned char* wr = C.wreg();
    { const int nv = (256 / 64) * (256 / 32);
      for (int it = C.gw; it < 8 * nv; it += C.ngw) { const int h = it / nv, r = it % nv;
          transpose_item(C.in[I_WV] + ((size_t)li * 8 + h) * 256 * 256, 256, 256, (bf16*)(wr + WO_V), 256, h * 256, scr, r, C.lane); } }
    { const int n = (2048 / 64) * (1024 / 32);
      for (int it = C.gw; it < n; it += C.ngw) transpose_item(C.in[I_WOUTO] + (size_t)li * 2048 * 1024, 1024, 1024, (bf16*)(wr + WO_OUT), 2048, 0, scr, it, C.lane); }
    { bf16* wg = (bf16*)(wr + WO_G); const float* wi = C.in[I_WIG] + (size_t)li * 2 * 2048 * 8; const float* wf = C.in[I_WFG] + (size_t)li * 2 * 2048 * 8;
      for (int i = C.gw * 64 + C.lane; i < 32 * 2048; i += C.ngw * 64) { const int n = i >> 11, c = i & 2047, ty = n >> 4, d = (n >> 3) & 1, h = n & 7;
          wg[i] = f2bf((ty ? wf : wi)[((size_t)d * 2048 + c) * 8 + h]); } }
}

DI void load_row_bf16(const bf16* p, int lane, float (&v)[16]) {
    const u32x4 a = *(const u32x4*)(p + 8 * lane), b = *(const u32x4*)(p + 512 + 8 * lane);
    float t[8]; unpack8(a, t);
#pragma unroll
    for (int i = 0; i < 8; ++i) v[i] = t[i];
    unpack8(b, t);
#pragma unroll
    for (int i = 0; i < 8; ++i) v[8 + i] = t[i];
}
DI void load_row_f32(const float* p, int lane, float (&v)[16]) {
    const f32x4 a = *(const f32x4*)(p + 8 * lane), b = *(const f32x4*)(p + 8 * lane + 4), c = *(const f32x4*)(p + 512 + 8 * lane), d = *(const f32x4*)(p + 512 + 8 * lane + 4);
#pragma unroll
    for (int i = 0; i < 4; ++i) { v[i] = a[i]; v[4 + i] = b[i]; v[8 + i] = c[i]; v[12 + i] = d[i]; }
}
DI void store_row_bf16(bf16* p, int lane, const float (&v)[16]) {
    float t[8];
#pragma unroll
    for (int i = 0; i < 8; ++i) t[i] = v[i];
    *(u32x4*)(p + 8 * lane) = pack8(t);
#pragma unroll
    for (int i = 0; i < 8; ++i) t[i] = v[8 + i];
    *(u32x4*)(p + 512 + 8 * lane) = pack8(t);
}
DI void round_bf16_16(float (&v)[16]) {
#pragma unroll
    for (int i = 0; i < 16; i += 2) { const unsigned w = cvt_pk_bf16(v[i], v[i + 1]); v[i] = bflo(w); v[i + 1] = bfhi(w); }
}
DI void rms_row(const float (&v)[16], const float* g, int lane, float (&o)[16]) {
    float s = 0.f;
#pragma unroll
    for (int i = 0; i < 16; ++i) s += v[i] * v[i];
    s = wave_sum(s, lane);
    const float r = rsqrtf(s * (1.f / 1024.f) + EPS);
    float gg[16]; load_row_f32(g, lane, gg);
#pragma unroll
    for (int i = 0; i < 16; ++i) o[i] = v[i] * r * gg[i];
}

DI void phase_init_rows(const Ctx& C, bf16* resid, bf16* hdst) {
    for (int r = C.gw; r < LTOK; r += C.ngw) {
        float v[16], o[16];
        if (r < SEQ) load_row_f32(C.in[I_X] + (size_t)r * 1024, C.lane, v); else load_row_f32(C.in[I_META] + (size_t)(r - SEQ) * 1024, C.lane, v);
        round_bf16_16(v);
        store_row_bf16(resid + (size_t)r * 1024, C.lane, v);
        rms_row(v, C.in[I_NPRE], C.lane, o);
        store_row_bf16(hdst + (size_t)r * 1024, C.lane, o);
    }
}
DI void post_row_finish(const Ctx& C, int r, const float (&v)[16], float (&rs)[16], bf16* resid, bf16* hdst, int layer) {
    float o[16];
    rms_row(v, C.in[I_NPOST] + (size_t)layer * 1024, C.lane, o);
#pragma unroll
    for (int i = 0; i < 16; ++i) rs[i] += o[i];
    if (layer == 3) {
        if (r < SEQ) { float* op = C.out + (size_t)r * 1024;
            *(f32x4*)(op + 8 * C.lane) = (f32x4){rs[0], rs[1], rs[2], rs[3]}; *(f32x4*)(op + 8 * C.lane + 4) = (f32x4){rs[4], rs[5], rs[6], rs[7]};
            *(f32x4*)(op + 512 + 8 * C.lane) = (f32x4){rs[8], rs[9], rs[10], rs[11]}; *(f32x4*)(op + 512 + 8 * C.lane + 4) = (f32x4){rs[12], rs[13], rs[14], rs[15]}; }
    } else {
        round_bf16_16(rs);
        store_row_bf16(resid + (size_t)r * 1024, C.lane, rs);
        rms_row(rs, C.in[I_NPRE] + (size_t)(layer + 1) * 1024, C.lane, o);
        store_row_bf16(hdst + (size_t)r * 1024, C.lane, o);
    }
}
DI void phase_post_rows(const Ctx& C, const bf16* y, bf16* resid, bf16* hdst, int layer, bf16* resid_out = nullptr) {
    if (!resid_out) resid_out = resid;
    for (int r = C.gw; r < LTOK; r += 2 * C.ngw) {
        const int r2 = r + C.ngw; const bool has2 = r2 < LTOK; const int r2c = has2 ? r2 : r;
        float v[16], rs[16], v2[16], rs2[16];
        load_row_bf16(y + (size_t)r * 1024, C.lane, v); load_row_bf16(resid + (size_t)r * 1024, C.lane, rs);
        load_row_bf16(y + (size_t)r2c * 1024, C.lane, v2); load_row_bf16(resid + (size_t)r2c * 1024, C.lane, rs2);
        post_row_finish(C, r, v, rs, resid_out, hdst, layer);
        if (has2) post_row_finish(C, r2, v2, rs2, resid_out, hdst, layer);
    }
}
DI void phase_renorm_rows(const Ctx& C, const bf16* resid, bf16* hdst, int layer) {
    for (int r = C.gw; r < LTOK; r += C.ngw) {
        float v[16], o[16];
        load_row_bf16(resid + (size_t)r * 1024, C.lane, v);
        rms_row(v, C.in[I_NPRE] + (size_t)layer * 1024, C.lane, o);
        store_row_bf16(hdst + (size_t)r * 1024, C.lane, o);
    }
}
DI void phase_rope_table(const Ctx& C) {
    f32x2* tab = (f32x2*)(C.misc() + MS_ROPE);
    for (int i = C.gw * 64 + C.lane; i < 256 * 32; i += C.ngw * 64) { const int pos = i >> 5, j = i & 31;
        const float f = fexp(-(float)j * (9.210340371976184f / 32.f));
        float rev = (float)pos * f * 0.15915494309189535f; rev -= rintf(rev);
        tab[i] = (f32x2){__builtin_amdgcn_cosf(rev), __builtin_amdgcn_sinf(rev)}; }
}

DI void store8(bf16* dst, f32x4 a, f32x4 b) { *(u32x4*)dst = pack8v(a, b); }
DI f32x4 silu4(f32x4 v) { return (f32x4){silu_f(v[0]), silu_f(v[1]), silu_f(v[2]), silu_f(v[3])}; }
struct FEvenIn { static constexpr bool PIPE = false;
    bf16 *YAB, *Kb, *Vb, *GA, *U;
    DI void launder() { lnd(YAB); lnd(Kb); lnd(Vb); lnd(GA); lnd(U); }
    DI void op8(int row, int col, f32x4 a, f32x4 b) const {
        bf16* dst; bool act = false;
        if (col < 1024) dst = YAB + (size_t)row * 2048 + col;
        else if (col < 1280) dst = Kb + (size_t)row * 256 + (col - 1024);
        else if (col < 1536) dst = Vb + (size_t)row * 256 + (col - 1280);
        else if (col < 2560) { dst = GA + (size_t)row * 1024 + (col - 1536); act = true; }
        else if (col < 3584) { const int cu = col - 2560, rp = row < SEQ ? row + 16 : row - SEQ;
            dst = U + ((size_t)(cu >> 4) * LTOK + rp) * 16 + (cu & 15); }
        else { dst = YAB + (size_t)row * 2048 + 1024 + (col - 3584); act = true; }
        if (act) { a = silu4(a); b = silu4(b); }
        store8(dst, a, b);
    }
};
struct FPlain { static constexpr bool PIPE = false; bf16* O; int ldo; DI void launder() { lnd(O); } DI void op8(int row, int col, f32x4 a, f32x4 b) const { store8(O + (size_t)row * ldo + col, a, b); } };
struct FSilu { static constexpr bool PIPE = false; bf16* O; int ldo; DI void launder() { lnd(O); } DI void op8(int row, int col, f32x4 a, f32x4 b) const { store8(O + (size_t)row * ldo + col, silu4(a), silu4(b)); } };
struct FGlu {
    static constexpr bool PIPE = true;
    const bf16* YG; bf16* YAB; const float* bias;
    struct Pre { u32x4 yg, gb; };
    struct Cols { f32x4 b0, b1; };
    DI void launder() { lnd(YG); lnd(YAB); lnd(bias); }
    DI Cols cols(int col) const { Cols c; c.b0 = *(const f32x4*)(bias + col); c.b1 = *(const f32x4*)(bias + col + 4); return c; }
    DI Pre pre(int row, int col) const { Pre p; p.yg = *(const u32x4*)(YG + (size_t)row * 1024 + col); p.gb = *(const u32x4*)(YAB + (size_t)row * 2048 + 1024 + col); return p; }
    DI void fin(int row, int col, f32x4 a, f32x4 b, const Pre& p, const Cols& c) const {
        float yg[8], gb[8], o[8]; unpack8(p.yg, yg); unpack8(p.gb, gb);
#pragma unroll
        for (int j = 0; j < 4; ++j) { o[j] = yg[j] * sigmoid_f(a[j] + c.b0[j]) * gb[j]; o[4 + j] = yg[4 + j] * sigmoid_f(b[j] + c.b1[j]) * gb[4 + j]; }
        *(u32x4*)(YAB + (size_t)row * 2048 + 1024 + col) = pack8(o);
    }
    DI void op8(int row, int col, f32x4 a, f32x4 b) const { fin(row, col, a, b, pre(row, col), cols(col)); }
};
struct FQK { static constexpr bool PIPE = false;
    bf16 *Q, *Kd;
    DI void launder() { lnd(Q); lnd(Kd); }
    DI void op8(int row, int col, f32x4 a, f32x4 b) const { const int h = col >> 8, w = col & 255;
        bf16* dst = (w < 128) ? Q + (size_t)row * 1024 + h * 128 + w : Kd + (size_t)row * 1024 + h * 128 + (w - 128);
        store8(dst, a, b); }
};
struct FVrow { static constexpr bool PIPE = false;
    bf16 *V, *VM;
    DI void launder() { lnd(V); lnd(VM); }
    DI void op8(int row, int col, f32x4 a, f32x4 b) const { bf16* dst = (row < SEQ) ? V + (size_t)row * 2048 + col : VM + (size_t)(row - SEQ) * 2048 + col; store8(dst, a, b); }
};
struct FOgate {
    static constexpr bool PIPE = true;
    const bf16 *CELL, *CELLM, *XC, *SZ; bf16* HZ; const float *bo, *hn, *skip, *rstd;
    struct Pre { u32x4 ce, xc, sz; float rs; };
    struct Cols { f32x4 b0, b1, h0, h1, s0, s1; };
    DI void launder() { lnd(CELL); lnd(CELLM); lnd(XC); lnd(SZ); lnd(HZ); lnd(bo); lnd(hn); lnd(skip); lnd(rstd); }
    DI Cols cols(int col) const { Cols c; c.b0 = *(const f32x4*)(bo + col); c.b1 = *(const f32x4*)(bo + col + 4); c.h0 = *(const f32x4*)(hn + col); c.h1 = *(const f32x4*)(hn + col + 4);
        c.s0 = *(const f32x4*)(skip + col); c.s1 = *(const f32x4*)(skip + col + 4); return c; }
    DI Pre pre(int row, int col) const { Pre p;
        const bf16* cp = (row < SEQ) ? CELL + (size_t)row * 2048 + col : CELLM + (size_t)(row - SEQ) * 2048 + col;
        p.ce = *(const u32x4*)cp; p.xc = *(const u32x4*)(XC + (size_t)row * 2048 + col); p.sz = *(const u32x4*)(SZ + (size_t)row * 2048 + col); p.rs = rstd[(size_t)row * 8 + (col >> 8)]; return p; }
    DI void fin(int row, int col, f32x4 a, f32x4 b, const Pre& p, const Cols& c) const {
        float ce[8], xc[8], sz[8], o[8]; unpack8(p.ce, ce); unpack8(p.xc, xc); unpack8(p.sz, sz);
        const float rs = p.rs;
#pragma unroll
        for (int j = 0; j < 4; ++j) {
            o[j] = (sigmoid_f(a[j] + c.b0[j]) * (ce[j] * rs * c.h0[j]) + c.s0[j] * xc[j]) * sz[j];
            o[4 + j] = (sigmoid_f(b[j] + c.b1[j]) * (ce[4 + j] * rs * c.h1[j]) + c.s1[j] * xc[4 + j]) * sz[4 + j]; }
        *(u32x4*)(HZ + (size_t)row * 2048 + col) = pack8(o);
    }
    DI void op8(int row, int col, f32x4 a, f32x4 b) const { fin(row, col, a, b, pre(row, col), cols(col)); }
};

template <int LDA, int LDB, int KK, int NN, int APN, class F>
DI void run_gemm(const Ctx& C, const bf16* A, const bf16* Bt, const F& f0) {
    F f = f0; f.launder(); lnd(A); lnd(Bt);
    gemm_tail<F>(C.lds, A + (size_t)SEQ * LDA, LDA, Bt, LDB, KK, NN, APN, f, SEQ, C.bid, C.G, C.wave, C.lane);
    pg8::Gemm g{A, Bt};
    pg8::StaticOrder<NN / 256> S; S.init(C.G, C.bid);
    typedef typename pg8::EpiSel<F>::type Epi;
    Epi E{f};
    pg8::gemm_phase<Epi, pg8::StaticOrder<NN / 256>, LDA, LDB, KK, APN>(C.lds, g, S, E);
}

DI void phase_qk_norm_rope(const Ctx& C, bf16* YAB, bf16* Kb, const float* qn, const float* kn, unsigned char* K8, bf16* dummy = nullptr) {
    const f32x2* tab = (const f32x2*)(C.misc() + MS_ROPE);
    const int sub = C.lane & 15, grp = C.lane >> 4;
    const int nitems = LTOK * 10;
    constexpr int NB = 7;
    const f32x4 gq0 = *(const f32x4*)(qn + sub * 8), gq1 = *(const f32x4*)(qn + sub * 8 + 4), gk0 = *(const f32x4*)(kn + sub * 8), gk1 = *(const f32x4*)(kn + sub * 8 + 4);
    for (int it0 = C.gw * 4; it0 < nitems; it0 += C.ngw * 4 * NB) {
        bf16* p[NB]; u32x4 raw[NB]; bool ok[NB]; int rowv[NB], hsv[NB]; f32x4 tb[NB][4];
#pragma unroll
        for (int b = 0; b < NB; ++b) { const int it = it0 + b * C.ngw * 4 + grp; ok[b] = it < nitems; const int itc = ok[b] ? it : nitems - 1;
            const int row = itc / 10, hs = itc - row * 10; rowv[b] = row; hsv[b] = hs;
            p[b] = (hs < 8) ? YAB + (size_t)row * 2048 + hs * 128 + sub * 8 : Kb + (size_t)row * 256 + (hs - 8) * 128 + sub * 8;
            raw[b] = *(const u32x4*)p[b]; }
#pragma unroll
        for (int b = 0; b < NB; ++b) {
            int pos = 0; if (rowv[b] < SEQ) pos = (sub < 8) ? (rowv[b] >> 6) : (rowv[b] & 63);
            const f32x4* tp = (const f32x4*)(tab + pos * 32 + (sub & 3) * 8);
#pragma unroll
            for (int e = 0; e < 4; ++e) tb[b][e] = tp[e]; }
#pragma unroll
        for (int b = 0; b < NB; ++b) { const int row = rowv[b], hs = hsv[b];
            float v[8]; unpack8(raw[b], v);
            float s = 0.f;
#pragma unroll
            for (int e = 0; e < 8; ++e) s += v[e] * v[e];
            s += shx(s, 1, C.lane); s += shx(s, 2, C.lane); s += shx(s, 4, C.lane); s += shx(s, 8, C.lane);
            const float r = rsqrtf(s * (1.f / 128.f) + EPS);
            const bool isq = hs < 8;
            f32x4 g0, g1;
#pragma unroll
            for (int e = 0; e < 4; ++e) { g0[e] = isq ? gq0[e] : gk0[e]; g1[e] = isq ? gq1[e] : gk1[e]; }
#pragma unroll
            for (int e = 0; e < 4; ++e) { v[e] = v[e] * r * g0[e]; v[4 + e] = v[4 + e] * r * g1[e]; }
            const bool first = (sub & 4) == 0;
            float o[8];
#pragma unroll
            for (int e = 0; e < 8; ++e) {
                const float other = shx(v[e], 4, C.lane);
                const float cx = tb[b][e >> 1][(e & 1) * 2], cy = tb[b][e >> 1][(e & 1) * 2 + 1];
                o[e] = first ? (v[e] * cx - other * cy) : (v[e] * cx + other * cy);
            }
            bf16* dp = dummy ? dummy + (size_t)((rowv[b] * 10 + hsv[b]) & 65535) * 128 + sub * 8 : p[b];
            if (ok[b]) { *(u32x4*)dp = pack8(o);
                if (hs >= 8) { int w0 = 0, w1 = 0;
                    w0 = __builtin_amdgcn_cvt_pk_fp8_f32(o[0], o[1], w0, false); w0 = __builtin_amdgcn_cvt_pk_fp8_f32(o[2], o[3], w0, true);
                    w1 = __builtin_amdgcn_cvt_pk_fp8_f32(o[4], o[5], w1, false); w1 = __builtin_amdgcn_cvt_pk_fp8_f32(o[6], o[7], w1, true);
                    *(u32x2*)(K8 + (size_t)row * 256 + (hs - 8) * 128 + sub * 8) = (u32x2){(unsigned)w0, (unsigned)w1}; } } }
    }
}

namespace att {
constexpr int D = 128, NW = 8, QBLK = 32, KVBLK = 64;
constexpr float SCALE = 0.088388347648318440f;
constexpr float THR = 8.f;
constexpr int LDQ = 2048, LDK = 256, LDG = 1024;
constexpr size_t SHM_V = KVBLK * D * 2, SHM_K = KVBLK * D * 2, SHM_ATTN = 2 * SHM_V + 2 * SHM_K + NW * 64 * 4;
constexpr int NT_C = KVROWS / KVBLK;
#define KSWZ(row, colB) ((row) * 256 + ((colB) ^ (((row) & 7) << 4)))
#define SBAR() __builtin_amdgcn_sched_barrier(0)
DI int crow(int r, int hi) { return (r & 3) + 8 * (r >> 2) + 4 * hi; }
DI unsigned cvtpk_asm(float lo, float hi) { unsigned r; asm volatile("v_cvt_pk_bf16_f32 %0, %1, %2" : "=v"(r) : "v"(lo), "v"(hi)); return r; }
template <bool F8 = false> DI void partialSM(f32x16& p0, f32x16& p1, float& m_reg, float& mn, float& alpha) {
  constexpr float Cc = SCALE * 1.4426950408889634f;
  float pmax = p0[0];
#pragma unroll
  for (int r = 1; r < 16; ++r) pmax = fmaxf(pmax, p0[r]);
#pragma unroll
  for (int r = 0; r < 16; ++r) pmax = fmaxf(pmax, p1[r]);
  { auto rr = __builtin_amdgcn_permlane32_swap(__float_as_uint(pmax), __float_as_uint(pmax), false, false);
    pmax = fmaxf(__uint_as_float(rr[0]), __uint_as_float(rr[1])); }
  if (__builtin_expect(__all(pmax - m_reg <= (F8 ? 2.5f : THR) / SCALE), 1)) { mn = m_reg; alpha = 1.f; }
  else { mn = fmaxf(m_reg, pmax); alpha = __builtin_amdgcn_exp2f((m_reg - mn) * Cc); m_reg = mn; }
  const float mnC = -mn * Cc + (F8 ? 5.f : 0.f);
#pragma unroll
  for (int r = 0; r < 16; ++r) p0[r] = fmaf(p0[r], Cc, mnC);
#pragma unroll
  for (int r = 0; r < 16; ++r) p1[r] = fmaf(p1[r], Cc, mnC);
#pragma unroll
  for (int r = 0; r < 16; ++r) p0[r] = __builtin_amdgcn_exp2f(p0[r]);
}
DI void finishSM(f32x16& p0, f32x16& p1, float alpha, float& l_reg, bf16x8& pa0, bf16x8& pa1, bf16x8& pa2, bf16x8& pa3) {
#pragma unroll
  for (int r = 0; r < 16; ++r) p1[r] = __builtin_amdgcn_exp2f(p1[r]);
  float ps = 0;
#pragma unroll
  for (int r = 0; r < 16; ++r) ps += p0[r];
#pragma unroll
  for (int r = 0; r < 16; ++r) ps += p1[r];
  { auto rr = __builtin_amdgcn_permlane32_swap(__float_as_uint(ps), __float_as_uint(ps), false, false);
    ps = __uint_as_float(rr[0]) + __uint_as_float(rr[1]); }
  l_reg = l_reg * alpha + ps;
#define PK4(P, BASE, OUT) do { unsigned a0 = cvtpk_asm(P[BASE + 0], P[BASE + 1]), a1 = cvtpk_asm(P[BASE + 2], P[BASE + 3]);   \
    unsigned b0 = cvtpk_asm(P[BASE + 4], P[BASE + 5]), b1 = cvtpk_asm(P[BASE + 6], P[BASE + 7]);                              \
    auto r0 = __builtin_amdgcn_permlane32_swap(a0, b0, false, false); auto r1 = __builtin_amdgcn_permlane32_swap(a1, b1, false, false); \
    u32x4 w = {r0[0], r1[0], r0[1], r1[1]}; OUT = *reinterpret_cast<bf16x8*>(&w); } while (0)
  PK4(p0, 0, pa0); PK4(p0, 8, pa1); PK4(p1, 0, pa2); PK4(p1, 8, pa3);
#undef PK4
}
DI void qkt(f32x16& p0, f32x16& p1, const LAS char* Ks, const bf16x8* qr, int r32, int hi) {
  p0 = f32x16{}; p1 = f32x16{};
#pragma unroll
  for (int d0 = 0; d0 < 8; ++d0) { const int cb = (d0 * 16 + hi * 8) * 2;
    const bf16x8 b0 = *(const LAS bf16x8*)(Ks + KSWZ(r32, cb));
    const bf16x8 b1 = *(const LAS bf16x8*)(Ks + KSWZ(32 + r32, cb));
    p0 = MFMA32(b0, qr[d0], p0);
    p1 = MFMA32(b1, qr[d0], p1); }
}
typedef int i32x8 __attribute__((ext_vector_type(8)));
constexpr size_t SHM_K8 = KVBLK * D;
#define K8SW(row, c) ((row) * 128 + ((((c) ^ (((row) >> 1) & 7))) << 4))
DI void qkt8(f32x16& p0, f32x16& p1, const LAS char* Ks, const i32x8* q8, int r32, int hi) {
  p0 = f32x16{}; p1 = f32x16{};
#pragma unroll
  for (int s2 = 0; s2 < 2; ++s2) { const int c0 = 4 * s2 + 2 * hi;
    const u32x4 a0 = *(const LAS u32x4*)(Ks + K8SW(r32, c0)), a1 = *(const LAS u32x4*)(Ks + K8SW(r32, c0 + 1));
    const u32x4 b0 = *(const LAS u32x4*)(Ks + K8SW(32 + r32, c0)), b1 = *(const LAS u32x4*)(Ks + K8SW(32 + r32, c0 + 1));
    const i32x8 A = {(int)a0.x, (int)a0.y, (int)a0.z, (int)a0.w, (int)a1.x, (int)a1.y, (int)a1.z, (int)a1.w};
    const i32x8 B = {(int)b0.x, (int)b0.y, (int)b0.z, (int)b0.w, (int)b1.x, (int)b1.y, (int)b1.z, (int)b1.w};
    p0 = __builtin_amdgcn_mfma_scale_f32_32x32x64_f8f6f4(A, q8[s2], p0, 0, 0, 0, 0x7f7f7f7f, 0, 0x7f7f7f7f);
    p1 = __builtin_amdgcn_mfma_scale_f32_32x32x64_f8f6f4(B, q8[s2], p1, 0, 0, 0, 0x7f7f7f7f, 0, 0x7f7f7f7f); }
}
constexpr float CQ8 = SCALE * 1.4426950408889634f * 8.f;
constexpr float THRL = 2.5f * 1.4426950408889634f;
DI void qkt8c(f32x16& p0, f32x16& p1, const LAS char* Ks, const i32x8* q8, const f32x16& cinit, int r32, int hi) {
  { const int c0 = 2 * hi;
    const u32x4 a0 = *(const LAS u32x4*)(Ks + K8SW(r32, c0)), a1 = *(const LAS u32x4*)(Ks + K8SW(r32, c0 + 1));
    const u32x4 b0 = *(const LAS u32x4*)(Ks + K8SW(32 + r32, c0)), b1 = *(const LAS u32x4*)(Ks + K8SW(32 + r32, c0 + 1));
    const i32x8 A = {(int)a0.x, (int)a0.y, (int)a0.z, (int)a0.w, (int)a1.x, (int)a1.y, (int)a1.z, (int)a1.w};
    const i32x8 B = {(int)b0.x, (int)b0.y, (int)b0.z, (int)b0.w, (int)b1.x, (int)b1.y, (int)b1.z, (int)b1.w};
    p0 = __builtin_amdgcn_mfma_scale_f32_32x32x64_f8f6f4(A, q8[0], cinit, 0, 0, 0, 0x7f7f7f7f, 0, 0x7c7c7c7c);
    p1 = __builtin_amdgcn_mfma_scale_f32_32x32x64_f8f6f4(B, q8[0], cinit, 0, 0, 0, 0x7f7f7f7f, 0, 0x7c7c7c7c); }
  { const int c0 = 4 + 2 * hi;
    const u32x4 a0 = *(const LAS u32x4*)(Ks + K8SW(r32, c0)), a1 = *(const LAS u32x4*)(Ks + K8SW(r32, c0 + 1));
    const u32x4 b0 = *(const LAS u32x4*)(Ks + K8SW(32 + r32, c0)), b1 = *(const LAS u32x4*)(Ks + K8SW(32 + r32, c0 + 1));
    const i32x8 A = {(int)a0.x, (int)a0.y, (int)a0.z, (int)a0.w, (int)a1.x, (int)a1.y, (int)a1.z, (int)a1.w};
    const i32x8 B = {(int)b0.x, (int)b0.y, (int)b0.z, (int)b0.w, (int)b1.x, (int)b1.y, (int)b1.z, (int)b1.w};
    p0 = __builtin_amdgcn_mfma_scale_f32_32x32x64_f8f6f4(A, q8[1], p0, 0, 0, 0, 0x7f7f7f7f, 0, 0x7c7c7c7c);
    p1 = __builtin_amdgcn_mfma_scale_f32_32x32x64_f8f6f4(B, q8[1], p1, 0, 0, 0, 0x7f7f7f7f, 0, 0x7c7c7c7c); }
}
DI float rowmax32(const f32x16& p0, const f32x16& p1) {
  float pmax = p0[0];
#pragma unroll
  for (int r = 1; r < 16; ++r) pmax = fmaxf(pmax, p0[r]);
#pragma unroll
  for (int r = 0; r < 16; ++r) pmax = fmaxf(pmax, p1[r]);
  auto rr = __builtin_amdgcn_permlane32_swap(__float_as_uint(pmax), __float_as_uint(pmax), false, false);
  return fmaxf(__uint_as_float(rr[0]), __uint_as_float(rr[1]));
}
DI void partialSM8(f32x16& p0, f32x16& p1, float& m_reg, float& alpha, f32x16& cinit) {
  const float pmax = rowmax32(p0, p1);
  if (__builtin_expect(__all(pmax <= 5.f + THRL), 1)) alpha = 1.f;
  else { const float dl = fmaxf(pmax - 5.f, 0.f); alpha = __builtin_amdgcn_exp2f(-dl); m_reg += dl; const float ci = 5.f - m_reg;
#pragma unroll
    for (int r = 0; r < 16; ++r) { p0[r] -= dl; p1[r] -= dl; cinit[r] = ci; } }
#pragma unroll
  for (int r = 0; r < 16; ++r) p0[r] = __builtin_amdgcn_exp2f(p0[r]);
}
DI void firstSM8(f32x16& p0, f32x16& p1, float& m_reg, float& alpha, f32x16& cinit) {
  m_reg = rowmax32(p0, p1); alpha = 1.f; const float ci = 5.f - m_reg;
#pragma unroll
  for (int r = 0; r < 16; ++r) { p0[r] += ci; p1[r] += ci; cinit[r] = ci; }
#pragma unroll
  for (int r = 0; r < 16; ++r) p0[r] = __builtin_amdgcn_exp2f(p0[r]);
}
typedef short s16x2 __attribute__((__vector_size__(2 * sizeof(short))));
constexpr float CQS = SCALE * 1.4426950408889634f * 8.f;
constexpr float THRS = 2.5f * 1.4426950408889634f;
DI void qkt8s(f32x16& p0, f32x16& p1, const LAS char* Ks, const i32x8* q8, int r32, int hi) {
  p0 = f32x16{}; p1 = f32x16{};
#pragma unroll
  for (int s2 = 0; s2 < 2; ++s2) { const int c0 = 4 * s2 + 2 * hi;
    const u32x4 a0 = *(const LAS u32x4*)(Ks + K8SW(r32, c0)), a1 = *(const LAS u32x4*)(Ks + K8SW(r32, c0 + 1));
    const u32x4 b0 = *(const LAS u32x4*)(Ks + K8SW(32 + r32, c0)), b1 = *(const LAS u32x4*)(Ks + K8SW(32 + r32, c0 + 1));
    const i32x8 A = {(int)a0.x, (int)a0.y, (int)a0.z, (int)a0.w, (int)a1.x, (int)a1.y, (int)a1.z, (int)a1.w};
    const i32x8 B = {(int)b0.x, (int)b0.y, (int)b0.z, (int)b0.w, (int)b1.x, (int)b1.y, (int)b1.z, (int)b1.w};
    p0 = __builtin_amdgcn_mfma_scale_f32_32x32x64_f8f6f4(A, q8[s2], p0, 0, 0, 0, 0x7f7f7f7f, 0, 0x7c7c7c7c);
    p1 = __builtin_amdgcn_mfma_scale_f32_32x32x64_f8f6f4(B, q8[s2], p1, 0, 0, 0, 0x7f7f7f7f, 0, 0x7c7c7c7c); }
}
DI void partialSMs(f32x16& p0, f32x16& p1, float& M, float& alpha, float& scl) {
  float pmax = p0[0];
#pragma unroll
  for (int r = 1; r < 16; ++r) pmax = fmaxf(pmax, p0[r]);
#pragma unroll
  for (int r = 0; r < 16; ++r) pmax = fmaxf(pmax, p1[r]);
  { auto rr = __builtin_amdgcn_permlane32_swap(__float_as_uint(pmax), __float_as_uint(pmax), false, false);
    pmax = fmaxf(__uint_as_float(rr[0]), __uint_as_float(rr[1])); }
  if (__builtin_expect(__all(pmax - M <= THRS), 1)) alpha = 1.f;
  else { const float Mn = fmaxf(M, ceilf(pmax)); alpha = __builtin_amdgcn_exp2f(M - Mn); M = Mn; }
  scl = __builtin_amdgcn_exp2f(M - 5.f);
#pragma unroll
  for (int r = 0; r < 16; ++r) p0[r] = __builtin_amdgcn_exp2f(p0[r]);
}
DI int pk4s_fp8(float a, float b, float c, float d, float scl) {
  s16x2 w = __builtin_bit_cast(s16x2, a);
  w = __builtin_amdgcn_cvt_scalef32_pk_fp8_f32(w, a, b, scl, false); w = __builtin_amdgcn_cvt_scalef32_pk_fp8_f32(w, c, d, scl, true);
  return __builtin_bit_cast(int, w);
}
DI void finishSMs(f32x16& p0, f32x16& p1, i32x8& pa, float scl) {
#pragma unroll
  for (int r = 0; r < 16; ++r) p1[r] = __builtin_amdgcn_exp2f(p1[r]);
#pragma unroll
  for (int i = 0; i < 4; ++i) { pa[i] = pk4s_fp8(p0[4 * i], p0[4 * i + 1], p0[4 * i + 2], p0[4 * i + 3], scl); pa[4 + i] = pk4s_fp8(p1[4 * i], p1[4 * i + 1], p1[4 * i + 2], p1[4 * i + 3], scl); }
}
#define V8SW(d, c) ((d) * 64 + ((((c) ^ (((d) >> 2) & 3))) << 4))
DI int pk4_fp8(float a, float b, float c, float d) { int w = 0; w = __builtin_amdgcn_cvt_pk_fp8_f32(a, b, w, false); return __builtin_amdgcn_cvt_pk_fp8_f32(c, d, w, true); }
DI void finishSM8(f32x16& p0, f32x16& p1, i32x8& pa) {
#pragma unroll
  for (int r = 0; r < 16; ++r) p1[r] = __builtin_amdgcn_exp2f(p1[r]);
#pragma unroll
  for (int i = 0; i < 4; ++i) { pa[i] = pk4_fp8(p0[4 * i], p0[4 * i + 1], p0[4 * i + 2], p0[4 * i + 3]); pa[4 + i] = pk4_fp8(p1[4 * i], p1[4 * i + 1], p1[4 * i + 2], p1[4 * i + 3]); }
}
DI void pv8(f32x16* o, f32x16& lacc, const LAS char* Vs, const i32x8 pa, int r32, int hi) {
  { const int one4 = 0x38383838; const i32x8 ones = {one4, one4, one4, one4, one4, one4, one4, one4};
    lacc = __builtin_amdgcn_mfma_scale_f32_32x32x64_f8f6f4(pa, ones, lacc, 0, 0, 0, 0x7f7f7f7f, 0, 0x7f7f7f7f); }
#pragma unroll
  for (int db = 0; db < 4; ++db) { const int d = 32 * db + r32;
    const u32x4 a0 = *(const LAS u32x4*)(Vs + V8SW(d, 2 * hi)), a1 = *(const LAS u32x4*)(Vs + V8SW(d, 2 * hi + 1));
    const i32x8 B = {(int)a0.x, (int)a0.y, (int)a0.z, (int)a0.w, (int)a1.x, (int)a1.y, (int)a1.z, (int)a1.w};
    o[db] = __builtin_amdgcn_mfma_scale_f32_32x32x64_f8f6f4(pa, B, o[db], 0, 0, 0, 0x7f7f7f7f, 0, 0x7f7f7f7f); }
}
DI int v_st(int k, int c) { const int kk = (k & ~0xC) | ((k & 4) << 1) | ((k & 8) >> 1); return ((kk >> 3) * 4 + (c >> 5)) * 512 + ((kk & 7) * 32 + (c & 31)) * 2; }
DI int v_rd_base(int lane) { return ((lane & 3) << 3) | (((lane >> 2) & 3) << 6) | (((lane >> 4) & 1) << 5) | (((lane >> 5) & 1) << 8); }
constexpr int v_rd_off(int d0, int ks, int half) { return d0 * 512 + ks * 4096 + half * 2048; }
template <int OFF> DI s16x4 tr_read(int vb) { s16x4 r; asm volatile("ds_read_b64_tr_b16 %0, %1 offset:%2" : "=&v"(r) : "v"(vb), "i"(OFF) : "memory"); return r; }
template <int D0> DI void pv_one(f32x16& od, int vb, bf16x8 pa0, bf16x8 pa1, bf16x8 pa2, bf16x8 pa3) {
  const s16x4 l0 = tr_read<v_rd_off(D0, 0, 0)>(vb), h0 = tr_read<v_rd_off(D0, 0, 1)>(vb), l1 = tr_read<v_rd_off(D0, 1, 0)>(vb), h1 = tr_read<v_rd_off(D0, 1, 1)>(vb);
  const s16x4 l2 = tr_read<v_rd_off(D0, 2, 0)>(vb), h2 = tr_read<v_rd_off(D0, 2, 1)>(vb), l3 = tr_read<v_rd_off(D0, 3, 0)>(vb), h3 = tr_read<v_rd_off(D0, 3, 1)>(vb);
  asm volatile("s_waitcnt lgkmcnt(0)" ::: "memory"); SBAR();
#define PKV(L, H) (bf16x8){L[0], L[1], L[2], L[3], H[0], H[1], H[2], H[3]}
  od = MFMA32(pa0, PKV(l0, h0), od);
  od = MFMA32(pa1, PKV(l1, h1), od);
  od = MFMA32(pa2, PKV(l2, h2), od);
  od = MFMA32(pa3, PKV(l3, h3), od);
#undef PKV
}
DI void pv_d0(f32x16* o, int vb, bf16x8 pa0, bf16x8 pa1, bf16x8 pa2, bf16x8 pa3) {
  pv_one<0>(o[0], vb, pa0, pa1, pa2, pa3); pv_one<1>(o[1], vb, pa0, pa1, pa2, pa3); pv_one<2>(o[2], vb, pa0, pa1, pa2, pa3); pv_one<3>(o[3], vb, pa0, pa1, pa2, pa3);
}
DI void mask_tail(f32x16& p0, f32x16& p1) {
#pragma unroll
  for (int r = 8; r < 16; ++r) p0[r] = -1e30f;
#pragma unroll
  for (int r = 0; r < 16; ++r) p1[r] = -1e30f;
}
template <int LDO> DI void attn_unit(const bf16* Qb, bf16* Ob, const unsigned char* K8h, const unsigned char* V8h, const bf16* Gb, int nvalid, LAS char* lds) {
  lnd(Qb); lnd(Ob); lnd(K8h); lnd(V8h); lnd(Gb);
  int NT = NT_C; asm volatile("" : "+s"(NT));
  int tid = threadIdx.x; asm volatile("" : "+v"(tid));
  const int wid = tid >> 6, lane = tid & 63, r32 = lane & 31, hi = lane >> 5;
  LAS char* K_lds = lds; LAS char* V_lds = lds + 4 * SHM_K8;
  LAS float* wsf = (LAS float*)(lds + 8 * SHM_K8) + wid * 64; LAS float* li_l = wsf; LAS float* al_l = wsf + 32;
  float m_reg = -1e30f; f32x16 o[4] = {}, lacc = {}; i32x8 qr[2];
  { const bf16* Qw = Qb + (long)(wid * QBLK + r32) * LDQ + hi * 32;
    u32x4 qraw[2][4];
#pragma unroll
    for (int s2 = 0; s2 < 2; ++s2)
#pragma unroll
      for (int c = 0; c < 4; ++c) qraw[s2][c] = *reinterpret_cast<const u32x4*>(Qw + s2 * 64 + c * 8);
#pragma unroll
    for (int s2 = 0; s2 < 2; ++s2)
#pragma unroll
      for (int c = 0; c < 4; ++c) { float f[8]; unpack8(qraw[s2][c], f); int w0 = 0, w1 = 0;
#pragma unroll
        for (int e = 0; e < 8; ++e) f[e] *= CQS;
        w0 = __builtin_amdgcn_cvt_pk_fp8_f32(f[0], f[1], w0, false); w0 = __builtin_amdgcn_cvt_pk_fp8_f32(f[2], f[3], w0, true);
        w1 = __builtin_amdgcn_cvt_pk_fp8_f32(f[4], f[5], w1, false); w1 = __builtin_amdgcn_cvt_pk_fp8_f32(f[6], f[7], w1, true);
        qr[s2][2 * c] = w0; qr[s2][2 * c + 1] = w1; } }
  const unsigned kdo = (unsigned)((tid >> 3) * 256 + (((tid & 7) ^ ((tid >> 4) & 7)) << 4));
  const unsigned vdo = (unsigned)((tid >> 2) * 64 + (((tid & 3) ^ ((tid >> 4) & 3)) << 4));
  const unsigned ldw = (unsigned)(tid >> 6) * 1024u;
#define SDMA(b, k0) do { \
    __builtin_amdgcn_global_load_lds((const unsigned*)(K8h + (long)(k0) * 256 + kdo), (LAS unsigned*)(K_lds + (b) * (int)SHM_K8 + ldw), 16, 0, 0); \
    __builtin_amdgcn_global_load_lds((const unsigned*)(V8h + (long)(k0) * 128 + vdo), (LAS unsigned*)(V_lds + (b) * (int)SHM_K8 + ldw), 16, 0, 0); } while (0)
#define VWAIT(n) asm volatile("s_waitcnt vmcnt(" #n ")" ::: "memory")
#define RESC(a) do { if (__any((a) < 1.f)) { if (hi == 0) al_l[r32] = (a); asm volatile("s_waitcnt lgkmcnt(0)" ::: "memory"); \
    _Pragma("unroll") for (int r = 0; r < 16; ++r) { const float a_ = al_l[crow(r, hi)]; lacc[r] *= a_; _Pragma("unroll") for (int d = 0; d < 4; ++d) o[d][r] *= a_; } } } while (0)
  f32x16 pA0, pA1, pB0, pB1; float alA, alB, sclA = 1.f, sclB = 1.f; i32x8 pa;
  SDMA(0, 0); SDMA(1, KVBLK); VWAIT(0); __syncthreads();
  qkt8s(pA0, pA1, K_lds, qr, r32, hi); partialSMs(pA0, pA1, m_reg, alA, sclA);
  SDMA(2, 2 * KVBLK);
  static_assert((NT_C - 1) % 4 == 0, "tile count vs the 4-tile unroll");
#define ATT_STEP(CUR, PRV, KB, VB, DB, MODE_, T_) do { \
    SBAR(); qkt8s(p##CUR##0, p##CUR##1, K_lds + (KB) * (int)SHM_K8, qr, r32, hi); \
    if ((MODE_) == 2) mask_tail(p##CUR##0, p##CUR##1); \
    finishSMs(p##PRV##0, p##PRV##1, pa, scl##PRV); SBAR(); \
    if ((MODE_) == 0) SDMA((DB), ((T_) + 2) * KVBLK); \
    SBAR(); \
    pv8(o, lacc, V_lds + (VB) * (int)SHM_K8, pa, r32, hi); partialSMs(p##CUR##0, p##CUR##1, m_reg, al##CUR, scl##CUR); \
    RESC(al##CUR); \
    if ((MODE_) == 0) VWAIT(2); else VWAIT(0); \
    __syncthreads(); } while (0)
  int t = 1;
  for (; t + 5 < NT; t += 4) {
    ATT_STEP(B, A, 1, 0, 3, 0, t);
    ATT_STEP(A, B, 2, 1, 0, 0, t + 1);
    ATT_STEP(B, A, 3, 2, 1, 0, t + 2);
    ATT_STEP(A, B, 0, 3, 2, 0, t + 3);
  }
  ATT_STEP(B, A, 1, 0, 3, 0, t);
  ATT_STEP(A, B, 2, 1, 0, 0, t + 1);
  ATT_STEP(B, A, 3, 2, 1, 1, t + 2);
  ATT_STEP(A, B, 0, 3, 2, 2, t + 3);
#undef ATT_STEP
  finishSMs(pA0, pA1, pa, sclA); SBAR();
  pv8(o, lacc, V_lds, pa, r32, hi);
  float rli[16];
#pragma unroll
  for (int r = 0; r < 16; ++r) rli[r] = __builtin_amdgcn_rcpf(lacc[r]);
#pragma unroll
  for (int rb = 0; rb < 16; rb += 8) {
    float gt[8][4];
#pragma unroll
    for (int r = 0; r < 8; ++r) { const int orow = wid * QBLK + crow(rb + r, hi); const bf16* gp = Gb + (long)(orow < nvalid ? orow : 0) * LDG + r32;
      gt[r][0] = bf2f(gp[0]); gt[r][1] = bf2f(gp[32]); gt[r][2] = bf2f(gp[64]); gt[r][3] = bf2f(gp[96]); }
#pragma unroll
    for (int r = 0; r < 8; ++r) { const int orow = wid * QBLK + crow(rb + r, hi);
      if (orow < nvalid) { bf16* qp = Ob + (long)orow * LDO + r32; const float sc_ = rli[rb + r];
        qp[0] = f2bf(o[0][rb + r] * sc_ * gt[r][0]); qp[32] = f2bf(o[1][rb + r] * sc_ * gt[r][1]); qp[64] = f2bf(o[2][rb + r] * sc_ * gt[r][2]); qp[96] = f2bf(o[3][rb + r] * sc_ * gt[r][3]); } }
    asm volatile("" ::: "memory");
  }
  __syncthreads();
#undef SDMA
#undef VWAIT
#undef RESC
}

constexpr int NSEG = 128;
DI void attn_meta_unit(const bf16* YABm, const bf16* Kh, const bf16* Vh, int g, int t0, int t1, float* Pout, float* MLout, LAS char* lds) {
  lnd(YABm); lnd(Kh); lnd(Vh); lnd(Pout); lnd(MLout);
  int tid = threadIdx.x; asm volatile("" : "+v"(tid));
  const int wid = tid >> 6, lane = tid & 63, r32 = lane & 31, hi = lane >> 5;
  LAS char* V_lds = lds; LAS char* K_lds = lds + 2 * SHM_V;
  LAS float* wsf = (LAS float*)(lds + 2 * SHM_V + 2 * SHM_K) + wid * 64; LAS float* al_l = wsf + 32;
  float m_reg = -1e30f, l_reg = 0; f32x16 o[4] = {}; bf16x8 qr[8];
  const int rr = (wid & 1) * 32 + r32, hq = rr >> 4, mt = rr & 15;
  const bf16* Qw = YABm + (long)mt * LDQ + (4 * g + hq) * 128 + hi * 8;
#pragma unroll
  for (int d0 = 0; d0 < 8; ++d0) qr[d0] = *reinterpret_cast<const bf16x8*>(Qw + d0 * 16);
  const int sr = tid >> 4, sc = (tid & 15) * 8, vst0 = v_st(sr, sc), vst1 = v_st(32 + sr, sc);
  const int vb0 = (int)(unsigned)(uintptr_t)V_lds + v_rd_base(lane);
  for (int t = t0; t < t1; ++t) {
    const long k0 = (long)t * KVBLK;
    const bf16x8 vs0 = *(const bf16x8*)(&Vh[(k0 + sr) * LDK + sc]), vs1 = *(const bf16x8*)(&Vh[(k0 + 32 + sr) * LDK + sc]);
    const bf16x8 ks0 = *(const bf16x8*)(&Kh[(k0 + sr) * LDK + sc]), ks1 = *(const bf16x8*)(&Kh[(k0 + 32 + sr) * LDK + sc]);
    *(LAS bf16x8*)(V_lds + vst0) = vs0; *(LAS bf16x8*)(V_lds + vst1) = vs1;
    *(LAS bf16x8*)(K_lds + KSWZ(sr, sc * 2)) = ks0; *(LAS bf16x8*)(K_lds + KSWZ(32 + sr, sc * 2)) = ks1;
    __syncthreads();
    if (wid < 2) {
      f32x16 p0, p1; float mn, al; bf16x8 pa0, pa1, pa2, pa3;
      qkt(p0, p1, K_lds, qr, r32, hi);
      if (t == NT_C - 1) mask_tail(p0, p1);
      partialSM(p0, p1, m_reg, mn, al);
      if (__any(al < 1.f)) { if (hi == 0) al_l[r32] = al; asm volatile("s_waitcnt lgkmcnt(0)" ::: "memory");
#pragma unroll
        for (int d = 0; d < 4; ++d)
#pragma unroll
          for (int r = 0; r < 16; ++r) o[d][r] *= al_l[crow(r, hi)]; }
      finishSM(p0, p1, al, l_reg, pa0, pa1, pa2, pa3); SBAR();
      pv_d0(o, vb0, pa0, pa1, pa2, pa3);
    }
    __syncthreads();
  }
  if (wid < 2) {
    if (hi == 0) { MLout[rr * 2] = m_reg; MLout[rr * 2 + 1] = l_reg; }
#pragma unroll
    for (int r = 0; r < 16; ++r) { const int orow = (wid & 1) * 32 + crow(r, hi);
#pragma unroll
      for (int d0 = 0; d0 < 4; ++d0) Pout[(long)orow * 128 + d0 * 32 + r32] = o[d0][r]; }
  }
  __syncthreads();
}
}

constexpr size_t ATT_PART_OFF = (size_t)20 << 20;
DI void phase_v8_image(const Ctx& C, const bf16* Vb, unsigned char* V8t) {
    const int k = C.lane, blk = k >> 5, wi = k & 31, pos = ((wi >> 2) & 1) * 32 + blk * 16 + (wi >> 3) * 4 + (wi & 3);
    for (int it = C.gw; it < 2 * att::NT_C * 16; it += C.ngw) {
        const int dg = it & 15, tile = (it >> 4) % att::NT_C, g = it / (16 * att::NT_C);
        float f[8]; unpack8(*(const u32x4*)(Vb + (size_t)(tile * 64 + k) * 256 + g * 128 + dg * 8), f);
        unsigned char* dst = V8t + ((size_t)(g * att::NT_C + tile) * 128 + dg * 8) * 64 + pos;
#pragma unroll
        for (int e = 0; e < 8; e += 2) { const int w = __builtin_amdgcn_cvt_pk_fp8_f32(f[e], f[e + 1], 0, false); dst[(e) * 64] = (unsigned char)(w & 255); dst[(e + 1) * 64] = (unsigned char)((w >> 8) & 255); }
    }
}
DI void phase_attention(const Ctx& C, bf16* YAB, const bf16* Kb, const bf16* Vb, const bf16* GA, const unsigned char* K8, const unsigned char* V8t) {
    constexpr int NUNIT = 64 * 8;
    for (int u = C.bid; u < NUNIT; u += C.G) {
        const int h = u & 7, qb = u >> 3, row0 = qb * 256, g = h >> 2;
        #ifdef EXP_ATT2
        att::attn_unit<1024>(YAB + (size_t)row0 * 2048 + h * 128, C.slot(5) + (size_t)row0 * 1024 + h * 128, K8 + g * 128, V8t + (size_t)g * att::NT_C * 8192, GA + (size_t)row0 * 1024 + h * 128, 256, (LAS char*)C.lds);
#endif
        att::attn_unit<2048>(YAB + (size_t)row0 * 2048 + h * 128, YAB + (size_t)row0 * 2048 + h * 128, K8 + g * 128, V8t + (size_t)g * att::NT_C * 8192, GA + (size_t)row0 * 1024 + h * 128, 256, (LAS char*)C.lds);
    }
    float* P = (float*)((unsigned char*)C.slot(6) + ATT_PART_OFF); float* ML = P + (size_t)2 * att::NSEG * 64 * 128;
#ifdef DBL_META
    for (int u = C.bid; u < 2 * att::NSEG; u += C.G) {
        const int g = u & 1, seg = u >> 1, t0 = 2 * seg, t1 = (seg == att::NSEG - 1) ? att::NT_C : 2 * seg + 2;
        att::attn_meta_unit(YAB + (size_t)SEQ * 2048, Kb + g * 128, Vb + g * 128, g, t0, t1, P + (size_t)u * 64 * 128, ML + (size_t)u * 128, (LAS char*)C.lds);
    }
#endif
    for (int u = C.bid; u < 2 * att::NSEG; u += C.G) {
        const int g = u & 1, seg = u >> 1, t0 = 2 * seg, t1 = (seg == att::NSEG - 1) ? att::NT_C : 2 * seg + 2;
        att::attn_meta_unit(YAB + (size_t)SEQ * 2048, Kb + g * 128, Vb + g * 128, g, t0, t1, P + (size_t)u * 64 * 128, ML + (size_t)u * 128, (LAS char*)C.lds);
    }
}
DI void phase_attention_combine(const Ctx& C, bf16* YAB, const bf16* GA) {
    const float* P = (const float*)((unsigned char*)C.slot(6) + ATT_PART_OFF); const float* ML = P + (size_t)2 * att::NSEG * 64 * 128;
    constexpr float Cc = att::SCALE * 1.4426950408889634f;
    LAS float* X = (LAS float*)C.lds;
    for (int it = C.bid; it < 128; it += C.G) {
        const int mt = it & 15, h = it >> 4, g = h >> 2, hq = h & 3, rr = hq * 16 + mt, w = C.wave, lane = C.lane;
        float M = -1e30f;
#pragma unroll
        for (int s = 0; s < 16; ++s) M = fmaxf(M, ML[(size_t)((16 * w + s) * 2 + g) * 128 + rr * 2]);
        float a0 = 0.f, a1 = 0.f, l = 0.f;
#pragma unroll 4
        for (int s = 0; s < 16; ++s) { const size_t u = (size_t)((16 * w + s) * 2 + g); const float wt = __builtin_amdgcn_exp2f((ML[u * 128 + rr * 2] - M) * Cc);
            l += ML[u * 128 + rr * 2 + 1] * wt; a0 += P[(u * 64 + rr) * 128 + lane] * wt; a1 += P[(u * 64 + rr) * 128 + 64 + lane] * wt; }
        X[w * 130 + lane] = a0; X[w * 130 + 64 + lane] = a1; if (lane == 0) { X[w * 130 + 128] = l; X[w * 130 + 129] = M; }
        __syncthreads();
        if (w == 0) {
            float Mg = -1e30f;
#pragma unroll
            for (int ww = 0; ww < 8; ++ww) Mg = fmaxf(Mg, X[ww * 130 + 129]);
            float b0 = 0.f, b1 = 0.f, lg = 0.f;
#pragma unroll
            for (int ww = 0; ww < 8; ++ww) { const float wt = __builtin_amdgcn_exp2f((X[ww * 130 + 129] - Mg) * Cc); lg += X[ww * 130 + 128] * wt; b0 += X[ww * 130 + lane] * wt; b1 += X[ww * 130 + 64 + lane] * wt; }
            const float inv = 1.f / lg; const size_t row = SEQ + mt;
            YAB[row * 2048 + h * 128 + lane] = f2bf(b0 * inv * bf2f(GA[row * 1024 + h * 128 + lane]));
            YAB[row * 2048 + h * 128 + 64 + lane] = f2bf(b1 * inv * bf2f(GA[row * 1024 + h * 128 + 64 + lane]));
        }
        __syncthreads();
    }
}

constexpr int S5_NCH = 1025;
DI int s5_row0(int c) { return c == 0 ? SEQ : 16 * (c - 1); }
DI void cis_rev(float ang, float& c, float& s) { float rev = ang * 0.15915494309189535f; rev -= rintf(rev); c = __builtin_amdgcn_cosf(rev); s = __builtin_amdgcn_sinf(rev); }

DI void phase_s5_tables(const Ctx& C, int li) {
    f32x2* apow = (f32x2*)(C.dob + DO_APOW); f32x2* bb = (f32x2*)(C.dob + DO_BB);
    for (int i = C.gw * 64 + C.lane; i < 2 * 64 * 64; i += C.ngw * 64) {
        const int d = i >> 12, g = (i >> 6) & 63;
        const size_t pidx = (size_t)li * 2 * 64 * 64 + i;
        const float ar = C.in[I_ARE][pidx], ai = C.in[I_AIM][pidx];
        const float dt = fexp(C.in[I_LDT][(size_t)li * 128 + d * 64 + g]);
#pragma unroll 1
        for (int e = 0; e <= 16; ++e) { float c, s; cis_rev((float)e * ai * dt, c, s); const float mg = fexp((float)e * ar * dt); apow[(size_t)i * 17 + e] = (f32x2){mg * c, mg * s}; }
        float c1, s1; cis_rev(ai * dt, c1, s1); const float m1 = fexp(ar * dt);
        const float xr = m1 * c1 - 1.f, xi = m1 * s1, inv = 1.f / (ar * ar + ai * ai);
        const float kr = (xr * ar + xi * ai) * inv, ki = (xi * ar - xr * ai) * inv;
        const float* bre = C.in[I_BRE] + pidx * 16; const float* bim = C.in[I_BIM] + pidx * 16;
#pragma unroll 4
        for (int p = 0; p < 16; ++p) { const float br = bre[p], bi = bim[p]; bb[(size_t)i * 16 + p] = (f32x2){kr * br - ki * bi, kr * bi + ki * br}; }
    }
}
DI void phase_s5_ktab_hcat(const Ctx& C, int li) {
    const f32x2* apow = (const f32x2*)(C.dob + DO_APOW); const f32x2* bb = (const f32x2*)(C.dob + DO_BB);
    float* ktab = (float*)(C.dob + DO_KTAB); bf16* hcat = (bf16*)(C.dob + DO_HCAT);
    const bool half_grid = C.G == 256;
    for (int task = half_grid ? ((C.bid >= 128 && C.wave < 4) ? (C.bid - 128) * 4 + C.wave : 512) : C.gws; task < 512; task += half_grid ? 512 : C.ngw) {
        const int dg = task >> 2, dl = (task & 3) * 4 + (C.lane >> 4), q = C.lane & 15;
        const float* cre = C.in[I_CRE] + ((size_t)li * 128 + dg) * 1024; const float* cim = C.in[I_CIM] + ((size_t)li * 128 + dg) * 1024;
        float acc[16];
#pragma unroll
        for (int p = 0; p < 16; ++p) acc[p] = 0.f;
#pragma unroll 4
        for (int n = 0; n < 64; ++n) { const f32x2 a = apow[((size_t)dg * 64 + n) * 17 + dl], b = bb[((size_t)dg * 64 + n) * 16 + q];
            const float wr = a.x * b.x - a.y * b.y, wi = a.x * b.y + a.y * b.x;
#pragma unroll
            for (int p = 0; p < 16; ++p) acc[p] += cre[p * 64 + n] * wr - cim[p * 64 + n] * wi; }
#pragma unroll
        for (int p = 0; p < 16; ++p) ktab[(((size_t)dg * 16 + dl) * 16 + p) * 16 + q] = acc[p];
    }
    for (int i = C.gw * 64 + C.lane; i < 64 * 256 * 32; i += C.ngw * 64) {
        const int k8 = i & 31, rho = (i >> 5) & 255, g = i >> 13;
        const int d = rho >> 7, n = (rho >> 1) & 63, ri = rho & 1, s = k8 >> 1, q0 = (k8 & 1) * 8;
        const size_t dgn = ((size_t)d * 64 + g) * 64 + n;
        const f32x2 a = apow[dgn * 17 + (d == 0 ? 15 - s : s)];
        float o[8];
#pragma unroll
        for (int j = 0; j < 8; ++j) { const f32x2 b = bb[dgn * 16 + q0 + j]; o[j] = ri ? (a.x * b.y + a.y * b.x) : (a.x * b.x - a.y * b.y); }
        *(u32x4*)(hcat + ((size_t)g * 256 + rho) * 256 + k8 * 8) = pack8(o);
    }
}
DI void phase_s5_mg(const Ctx& C, int li) {
    const f32x2* apow = (const f32x2*)(C.dob + DO_APOW); const float* ktab = (const float*)(C.dob + DO_KTAB); bf16* mg = (bf16*)(C.dob + DO_MG);
    const float* dsk = C.in[I_SSMD] + (size_t)li * 1024;
    for (int i = C.gw * 64 + C.lane; i < 64 * 256 * 32; i += C.ngw * 64) {
        const int k8 = i & 31, tp = (i >> 5) & 255, g = i >> 13, t = tp >> 4, p = tp & 15, s = k8 >> 1, q0 = (k8 & 1) * 8;
        f32x4 v0 = {0.f, 0.f, 0.f, 0.f}, v1 = v0;
        if (s <= t) { const float* kp = ktab + ((((size_t)0 * 64 + g) * 16 + (t - s)) * 16 + p) * 16 + q0; v0 += *(const f32x4*)kp; v1 += *(const f32x4*)(kp + 4); }
        if (s >= t) { const float* kp = ktab + ((((size_t)1 * 64 + g) * 16 + (s - t)) * 16 + p) * 16 + q0; v0 += *(const f32x4*)kp; v1 += *(const f32x4*)(kp + 4); }
        float o[8];
#pragma unroll
        for (int j = 0; j < 4; ++j) { o[j] = v0[j]; o[4 + j] = v1[j]; }
        if (s == t) { const float dd = dsk[g * 16 + p];
#pragma unroll
            for (int j = 0; j < 8; ++j) o[j] += (p == q0 + j) ? dd : 0.f; }
        *(u32x4*)(mg + ((size_t)g * 256 + tp) * 512 + k8 * 8) = pack8(o);
    }
    for (int i = C.gw * 64 + C.lane; i < 64 * 256 * 32; i += C.ngw * 64) {
        const int k8 = i & 31, tp = (i >> 5) & 255, g = i >> 13, t = tp >> 4, p = tp & 15;
        const int rho0 = k8 * 8, d = rho0 >> 7, n0 = (rho0 >> 1) & 63; const size_t dg = (size_t)d * 64 + g;
        const float* cre = C.in[I_CRE] + (((size_t)li * 2 * 64 + dg) * 16 + p) * 64; const float* cim = C.in[I_CIM] + (((size_t)li * 2 * 64 + dg) * 16 + p) * 64;
        const int e = d == 0 ? t + 1 : 16 - t;
        const f32x4 cr = *(const f32x4*)(cre + n0), ci = *(const f32x4*)(cim + n0);
        float o[8];
#pragma unroll
        for (int m = 0; m < 4; ++m) { const f32x2 a = apow[(dg * 64 + n0 + m) * 17 + e];
            o[2 * m] = cr[m] * a.x - ci[m] * a.y; o[2 * m + 1] = -(cr[m] * a.y + ci[m] * a.x); }
        *(u32x4*)(mg + ((size_t)g * 256 + tp) * 512 + 256 + k8 * 8) = pack8(o);
    }
}
DI bf16x8 s5_ufrag(const bf16* U, int g, int c0, int kstep, int lane) {
    int c = c0 + (lane & 15); if (c >= S5_NCH) c = S5_NCH - 1;
    const int s = kstep * 2 + (lane >> 5), q0 = ((lane >> 4) & 1) * 8;
    return *(const bf16x8*)(U + ((size_t)g * LTOK + 16 * c + s) * 16 + q0);
}
DI void phase_s5_local(const Ctx& C, const bf16* U) {
    const bf16* hcat = (const bf16*)(C.dob + DO_HCAT); bf16* ex = (bf16*)(C.dob + DO_EX);
    const int i16 = C.lane & 15, q4 = C.lane >> 4;
    for (int task = C.gw; task < 2048; task += C.ngw) {
        const int qu = task & 3, rr = (task >> 2) & 7, g = task >> 5;
        bf16x8 af[4][8];
#pragma unroll
        for (int m = 0; m < 4; ++m)
#pragma unroll
            for (int ks = 0; ks < 8; ++ks) af[m][ks] = *(const bf16x8*)(hcat + ((size_t)g * 256 + qu * 64 + m * 16 + i16) * 256 + ks * 32 + q4 * 8);
        for (int blk = rr; blk < 65; blk += 8) {
            const int c0 = blk * 16;
            f32x4 acc[4];
#pragma unroll
            for (int m = 0; m < 4; ++m) acc[m] = (f32x4){0.f, 0.f, 0.f, 0.f};
#pragma unroll
            for (int ks = 0; ks < 8; ++ks) { const bf16x8 b = s5_ufrag(U, g, c0, ks, C.lane);
#pragma unroll
                for (int m = 0; m < 4; ++m) acc[m] = MFMA16(af[m][ks], b, acc[m]); }
            const int c = c0 + i16;
            if (c < S5_NCH) {
#pragma unroll
                for (int m = 0; m < 4; ++m) { u32x2 w; w.x = cvt_pk_bf16(acc[m][0], acc[m][1]); w.y = cvt_pk_bf16(acc[m][2], acc[m][3]);
                    *(u32x2*)(ex + ((size_t)c * 64 + g) * 256 + qu * 64 + m * 16 + q4 * 4) = w; } }
        }
    }
}
template <bool DUMMY = false> DI void phase_s5_scan(const Ctx& C) {
    const f32x2* apow = (const f32x2*)(C.dob + DO_APOW); unsigned* ex = DUMMY ? (unsigned*)C.slot(1) : (unsigned*)(C.dob + DO_EX);
    if (C.gws >= 128) return;
    const int ch = C.gws * 64 + C.lane;
    const int g = ch >> 7, d = (ch >> 6) & 1, n = ch & 63;
    const f32x2 a16 = apow[(((size_t)d * 64 + g) * 64 + n) * 17 + 16];
    float xr = 0.f, xi = 0.f;
    unsigned* p = ex + ((size_t)g * 128 + d * 64 + n) + (d == 0 ? (size_t)0 : (size_t)(S5_NCH - 1) * 8192);
    const long step = d == 0 ? 8192 : -8192;
    unsigned w[41], wn[41];
#pragma unroll
    for (int j = 0; j < 41; ++j) w[j] = p[(long)j * step];
    for (int i = 0; i < S5_NCH; i += 41) {
        if (i + 41 < S5_NCH) {
#pragma unroll
            for (int j = 0; j < 41; ++j) wn[j] = p[(long)(41 + j) * step];
        }
#pragma unroll
        for (int j = 0; j < 41; ++j) { const float er = bflo(w[j]), ei = bfhi(w[j]);
            p[(long)j * step] = cvt_pk_bf16(xr, xi);
            const float nr = a16.x * xr - a16.y * xi + er, ni = a16.x * xi + a16.y * xr + ei; xr = nr; xi = ni; }
#pragma unroll
        for (int j = 0; j < 41; ++j) w[j] = wn[j];
        p += 41 * step;
    }
}
DI void phase_s5_out(const Ctx& C, const bf16* U, bf16* YG) {
    const bf16* mg = (const bf16*)(C.dob + DO_MG); const bf16* ex = (const bf16*)(C.dob + DO_EX);
    const int i16 = C.lane & 15, q4 = C.lane >> 4, w = C.wave;
    LAS bf16x8* Bst = (LAS bf16x8*)C.lds;
    for (int wt = C.bid; wt < 256; wt += C.G) {
        const int yy = wt >> 3, rr = yy & 3, g = ((wt & 7) * 2 + (yy >> 4)) * 4 + ((yy >> 2) & 3), e8 = w;
        bf16x8 af[2][16];
#pragma unroll
        for (int m = 0; m < 2; ++m)
#pragma unroll
            for (int ks = 0; ks < 16; ++ks) af[m][ks] = *(const bf16x8*)(mg + ((size_t)g * 256 + e8 * 32 + m * 16 + i16) * 512 + ks * 32 + q4 * 8);
#define S5O_LD(dst0, dst1, c0_) do { if (w < 4) { dst0 = s5_ufrag(U, g, (c0_), 2 * w, C.lane); dst1 = s5_ufrag(U, g, (c0_), 2 * w + 1, C.lane); } \
            else { int cc_ = (c0_) + i16; if (cc_ >= S5_NCH) cc_ = S5_NCH - 1; const bf16* xp_ = ex + ((size_t)cc_ * 64 + g) * 256 + (2 * w - 8) * 32 + q4 * 8; \
                dst0 = *(const bf16x8*)xp_; dst1 = *(const bf16x8*)(xp_ + 32); } } while (0)
#define S5O_BLOCK(BUF_, RS0_, RS1_, RL0_, RL1_) do { const int c0 = blk * 16; \
            if (blk + 8 < 65) S5O_LD(RL0_, RL1_, c0 + 128); \
            f32x4 acc[2]; acc[0] = (f32x4){0.f, 0.f, 0.f, 0.f}; acc[1] = acc[0]; \
            _Pragma("unroll") for (int ks = 0; ks < 16; ++ks) { const bf16x8 b = Bst[((BUF_) * 16 + ks) * 64 + C.lane]; \
                acc[0] = MFMA16(af[0][ks], b, acc[0]); acc[1] = MFMA16(af[1][ks], b, acc[1]); } \
            const int c = c0 + i16; \
            if (c < S5_NCH) { \
                _Pragma("unroll") for (int m = 0; m < 2; ++m) { const int tp = e8 * 32 + m * 16 + q4 * 4, t = tp >> 4, p = tp & 15; \
                    u32x2 wv; wv.x = cvt_pk_bf16(gelu_tanh_f(acc[m][0]), gelu_tanh_f(acc[m][1])); wv.y = cvt_pk_bf16(gelu_tanh_f(acc[m][2]), gelu_tanh_f(acc[m][3])); \
                    *(u32x2*)(YG + (size_t)(s5_row0(c) + t) * 1024 + g * 16 + p) = wv; } } \
            if (blk + 4 < 65) { Bst[(((BUF_) ^ 1) * 16 + 2 * w) * 64 + C.lane] = RS0_; Bst[(((BUF_) ^ 1) * 16 + 2 * w + 1) * 64 + C.lane] = RS1_; } \
            __syncthreads(); } while (0)
        bf16x8 a0, a1, b0, b1;
        S5O_LD(a0, a1, rr * 16);
        Bst[(2 * w) * 64 + C.lane] = a0; Bst[(2 * w + 1) * 64 + C.lane] = a1;
        S5O_LD(a0, a1, rr * 16 + 64);
        __syncthreads();
        for (int blk = rr; blk < 65; blk += 8) {
            S5O_BLOCK(0, a0, a1, b0, b1);
            blk += 4;
            if (blk < 65) S5O_BLOCK(1, b0, b1, a0, a1);
            blk -= 4;
        }
#undef S5O_BLOCK
#undef S5O_LD
    }
}

DI int seq_of_row(int r) { return r < SEQ ? r + 16 : r - SEQ; }
DI int row_of_seq(int l) { return l < 16 ? SEQ + l : l - 16; }
DI void phase_conv(const Ctx& C, const bf16* XM, bf16* XC, const float* cw, const float* cb) {
    const int nitems = (LTOK / 8) * 256;
    for (int it = C.gw * 64 + C.lane; it < nitems; it += C.ngw * 64) {
        const int l0 = (it >> 8) * 8, c0 = (it & 255) * 8;
        float w[5][8], bias[8];
        { const f32x4 b0 = *(const f32x4*)(cb + c0), b1 = *(const f32x4*)(cb + c0 + 4);
#pragma unroll
          for (int e = 0; e < 4; ++e) { bias[e] = b0[e]; bias[4 + e] = b1[e]; } }
#pragma unroll
        for (int j = 0; j < 5; ++j) { const f32x4 w0 = *(const f32x4*)(cw + (size_t)j * 2048 + c0), w1 = *(const f32x4*)(cw + (size_t)j * 2048 + c0 + 4);
#pragma unroll
            for (int e = 0; e < 4; ++e) { w[j][e] = w0[e]; w[j][4 + e] = w1[e]; } }
        u32x4 xr[12];
#pragma unroll
        for (int r = 0; r < 12; ++r) { const int l2 = l0 + r - 2; xr[r] = (l2 >= 0 && l2 < LTOK) ? *(const u32x4*)(XM + (size_t)row_of_seq(l2) * 2048 + c0) : (u32x4){0u, 0u, 0u, 0u}; }
#pragma unroll
        for (int o = 0; o < 8; ++o) { float acc[8];
#pragma unroll
            for (int e = 0; e < 8; ++e) acc[e] = bias[e];
#pragma unroll
            for (int j = 0; j < 5; ++j) { float x[8]; unpack8(xr[o + j], x);
#pragma unroll
                for (int e = 0; e < 8; ++e) acc[e] += w[j][e] * x[e]; }
            float ov[8];
#pragma unroll
            for (int e = 0; e < 8; ++e) ov[e] = silu_f(acc[e]);
            *(u32x4*)(XC + (size_t)row_of_seq(l0 + o) * 2048 + c0) = pack8(ov); }
    }
}
DI int pos_of_row(int r) { return r < SEQ ? r + 64 : r - SEQ + 48; }
DI int row_of_pos(int pos) { return pos >= 64 ? pos - 64 : (pos >= 48 ? SEQ + pos - 48 : -1); }
DI float log_sigmoid_f(float x) { return fminf(x, 0.f) - __logf(1.f + __expf(-fabsf(x))); }
DI void phase_gates(const Ctx& C, const bf16* XC, const bf16* WG, const float* big, const float* bfg) {
    float* GA = (float*)(C.misc() + MS_GI); float* GCM = (float*)(C.misc() + MS_GF); float* GB = (float*)(C.misc() + MS_GB);
    const int lane = C.lane, r32 = lane & 31, hi = lane >> 5, w = C.wave, tid = C.tid;
    LAS float* P = (LAS float*)C.lds;
    LAS float* G = (LAS float*)(C.lds + 65536);
    for (int c = C.bid; c < 257; c += C.G) {
        const int rbase = c == 0 ? SEQ - 48 : 64 * (c - 1);
        const bf16* bp = WG + (size_t)r32 * 2048 + w * 256 + hi * 8;
#pragma unroll
        for (int j = 0; j < 2; ++j) {
            if (c == 0 && j == 0) continue;
            const bf16* ap = XC + (size_t)(rbase + 32 * j + r32) * 2048 + w * 256 + hi * 8;
            f32x16 acc = {};
#pragma unroll
            for (int k0 = 0; k0 < 256; k0 += 16) acc = MFMA32(*(const bf16x8*)(ap + k0), *(const bf16x8*)(bp + k0), acc);
#pragma unroll
            for (int r = 0; r < 16; ++r) { const int p = 32 * j + (r & 3) + 8 * (r >> 2) + 4 * hi; P[(w * 64 + p) * 32 + r32] = acc[r]; }
        }
        __syncthreads();
#pragma unroll
        for (int e = 0; e < 4; ++e) { const int idx = tid + 512 * e, p = idx >> 5, n = idx & 31; float v = 0.f;
#pragma unroll
            for (int ww = 0; ww < 8; ++ww) v += P[(ww * 64 + p) * 32 + n];
            const int ty = n >> 4; v += (ty ? bfg : big)[n & 15];
            v = ty ? log_sigmoid_f(v) : v; if (c == 0 && p < 48) v = ty ? 0.f : -1e9f;
            G[p * 33 + n] = v; }
        __syncthreads();
#pragma unroll 1
        for (int q = 0; q < 2; ++q) { const int dh = 2 * w + q, d = dh >> 3;
            const float li = G[lane * 33 + dh], lf = G[lane * 33 + 16 + dh];
            float b = lf;
#pragma unroll
            for (int o = 1; o < 64; o <<= 1) { const float x = shf(b, d == 0 ? lane - o : lane + o); const bool ok = d == 0 ? (lane >= o) : (lane + o < 64); b += ok ? x : 0.f; }
            const float a = li - b; float cm = a;
#pragma unroll
            for (int o = 1; o < 64; o <<= 1) { const float x = shf(cm, d == 0 ? lane - o : lane + o); const bool ok = d == 0 ? (lane >= o) : (lane + o < 64); cm = ok ? fmaxf(cm, x) : cm; }
            const size_t idx = (size_t)dh * NPOS + 64 * c + lane;
            GA[idx] = a; GCM[idx] = cm; GB[idx] = b; }
        __syncthreads();
    }
}
DI void phase_cell_merge(const Ctx& C, bf16* CELL, bf16* CELLM, const bf16* V2, const bf16* VM2, bf16* dummy = nullptr) {
    float* rstd = (float*)(C.misc() + MS_RSTD);
    const int sub = C.lane & 31, half = C.lane >> 5;
    constexpr int NIT = LTOK * 8;
    for (int it = C.gw * 2; it < NIT; it += C.ngw * 4) {
        int idx[2]; bf16* p[2]; u32x4 wa[2], wb[2];
#pragma unroll
        for (int k = 0; k < 2; ++k) { int i = it + half + k * C.ngw * 2; if (i >= NIT) i = NIT - 1; idx[k] = i; const int row = i >> 3, h = i & 7;
            const size_t off = (size_t)(row < SEQ ? row : row - SEQ) * 2048 + h * 256 + sub * 8;
            p[k] = (row < SEQ ? CELL : CELLM) + off; wa[k] = *(const u32x4*)p[k]; wb[k] = *(const u32x4*)((row < SEQ ? V2 : VM2) + off); }
#pragma unroll
        for (int k = 0; k < 2; ++k) { float a[8], b[8]; unpack8(wa[k], a); unpack8(wb[k], b); float s = 0.f;
#pragma unroll
            for (int e = 0; e < 8; ++e) a[e] += b[e];
            const u32x4 w = pack8(a); unpack8(w, a);
#pragma unroll
            for (int e = 0; e < 8; ++e) s += a[e] * a[e];
            const bool live = (k == 0) || (it + half + C.ngw * 2 < NIT);
            if (live) *(u32x4*)(dummy ? dummy + ((size_t)idx[k] * 256 + sub * 8) % ((size_t)16 << 20) : p[k]) = w;
            s += shx(s, 1, C.lane); s += shx(s, 2, C.lane); s += shx(s, 4, C.lane); s += shx(s, 8, C.lane); s += shx(s, 16, C.lane);
            if (sub == 0 && live) rstd[idx[k]] = rsqrtf(s * (1.f / 256.f) + EPS); }
    }
}

namespace ml {
constexpr int TILE = 44032;
constexpr int QS = 0, KS = 17408, VT = 34816, VTW = 39424, NXB = 2 * TILE, NXSZ = 17408, NIB = NXB + 2 * NXSZ, NISZ = 8704, SC = NIB + 2 * NISZ, LDS_END = SC + 4 * 1536;
constexpr int SC_A = 0, SC_M = 256, SC_ISC = 512, SC_FLO = 768, SC_W = 1024, SC_DEC = 1280, SC_STRIDE = 1536;
constexpr float QSCALE = 0.08838834764831845f;
DI s16x4 trr(unsigned addr) { s16x4 r; asm volatile("ds_read_b64_tr_b16 %0, %1" : "=&v"(r) : "v"(addr) : "memory"); return r; }
template <int OFF> DI s16x4 trro(unsigned base) { s16x4 r; asm volatile("ds_read_b64_tr_b16 %0, %1 offset:%2" : "=&v"(r) : "v"(base), "i"(OFF) : "memory"); return r; }
static_assert(LDS_END <= LDS_MISC, "mLSTM LDS map");
}
constexpr int CW_PROG = 12288;
DI void phase_mlstm(const Ctx& C, int epoch, const bf16* Q, const bf16* K, bf16* V, bf16* VM, bf16* CELL, bf16* CELLM, bf16* V2d, bf16* VM2d) {
    using namespace ml;
    const float* GA = (const float*)(C.misc() + MS_GI); const float* GCM = (const float*)(C.misc() + MS_GF); const float* GB = (const float*)(C.misc() + MS_GB); const bf16* ZR = (const bf16*)(C.misc() + MS_ZROW);
    unsigned* prog = (unsigned*)(C.misc() + MS_CTL) + CW_PROG;
    const int w = C.wave, tid = C.tid, lane = C.lane, i16 = lane & 15, q4 = lane >> 4;
    const bool intra = w < 4; const int be = w & 1, eta = (w >> 1) & 1;
    LAS unsigned char* L = C.lds;
    for (int unit = C.bid; unit < 256; unit += C.G) {
        const int h = unit & 7, sl = (unit >> 3) & 15, d = unit >> 7;
        const int lo_ = d == 0 ? w : 3 - w;
        unsigned* prog_me = prog + unit * 16; unsigned* prog_pa = prog + (unit ^ 128) * 16;
        const float* ga = GA + (size_t)(d * 8 + h) * NPOS; const float* gcm = GCM + (size_t)(d * 8 + h) * NPOS; const float* gb = GB + (size_t)(d * 8 + h) * NPOS;
        for (int i = tid; i < 2 * 16 * 72; i += NTHR) { const int b = i / (16 * 72), r = i % (16 * 72), v = 16 + r / 72, s = r % 72;
            ((LAS bf16*)(L + b * TILE + VT))[v * 72 + s] = (v == 16) ? (bf16)0x3f80 : (bf16)0; ((LAS bf16*)(L + b * TILE + VTW))[v * 72 + s] = 0; }
        f32x4 Cs0 = {0.f, 0.f, 0.f, 0.f}, Cs1 = Cs0, Cs2 = Cs0, Cs3 = Cs0;
        float m_prev = 0.f;
        u32x4 pq0, pq1, pk0, pk1, pv;
        float g1a = 0.f, g1cm = 0.f, g1b = 0.f;
        const unsigned oq0_ = (unsigned)((tid >> 4) * 1024 + h * 128 + (tid & 15) * 8), oq1_ = oq0_ + 32u * 1024u;
        const unsigned ov_ = (unsigned)(((tid & 127) >> 1) * 2048 + h * 256 + sl * 16 + (tid & 1) * 8);
#define ML_LOADQK(j, PQ, PK, cs_) do { const int p_ = tid + 512 * (j), t_ = p_ >> 4, c8_ = (p_ & 15) * 8; const bool z_ = t_ < 48; \
            const unsigned of_ = z_ ? (unsigned)c8_ : (unsigned)((SEQ + t_ - 48) * 1024 + h * 128 + c8_); \
            PQ = *(const u32x4*)((z_ ? ZR : Q) + of_); PK = *(const u32x4*)((z_ ? ZR : K) + of_); } while (0)
#define ML_LOAD(cs_) do { if ((cs_) == 0) { ML_LOADQK(0, pq0, pk0, 0); ML_LOADQK(1, pq1, pk1, 0); \
              { const int t_ = (tid & 127) >> 1, c8_ = (tid & 1) * 8; const bool z_ = t_ < 48; const unsigned of_ = z_ ? (unsigned)c8_ : (unsigned)((t_ - 48) * 2048 + h * 256 + sl * 16 + c8_); \
                pv = *(const u32x4*)((z_ ? ZR : (const bf16*)VM) + of_); } } \
            else { const bf16* Qc_ = Q + (size_t)((cs_) - 1) * 65536; const bf16* Kc_ = K + (size_t)((cs_) - 1) * 65536; const bf16* Vc_ = (const bf16*)V + (size_t)((cs_) - 1) * 131072; \
              pq0 = *(const u32x4*)(Qc_ + oq0_); pk0 = *(const u32x4*)(Kc_ + oq0_); pq1 = *(const u32x4*)(Qc_ + oq1_); pk1 = *(const u32x4*)(Kc_ + oq1_); pv = *(const u32x4*)(Vc_ + ov_); } } while (0)
#define ML_SCALARS(a_, cm_, b_, slot_) do { \
            const float cm_all_ = __int_as_float(__builtin_amdgcn_readlane(__float_as_int(cm_), d == 0 ? 63 : 0)), b_last_ = __int_as_float(__builtin_amdgcn_readlane(__float_as_int(b_), d == 0 ? 63 : 0)); \
            const float M_ = fmaxf((cm_), m_prev), Mst_ = fmaxf(cm_all_, m_prev); \
            LAS float* S_ = (LAS float*)(L + SC) + (slot_) * (SC_STRIDE / 4); \
            S_[SC_A / 4 + lane] = (a_) * 1.4426950408889634f; S_[SC_M / 4 + lane] = M_ * 1.4426950408889634f + 3.5f;     S_[SC_ISC / 4 + lane] = __expf(m_prev - M_) * QSCALE; S_[SC_FLO / 4 + lane] = __expf(-(b_) - M_); \
            S_[SC_W / 4 + lane] = __expf((a_) - Mst_); if (lane == 0) S_[SC_DEC / 4] = __expf(m_prev - Mst_); \
            m_prev = b_last_ + Mst_; } while (0)
#define ML_CS(i_) (d == 0 ? (i_) : 256 - (i_))
#define ML_BAR() do { asm volatile("s_waitcnt lgkmcnt(0)" ::: "memory"); __builtin_amdgcn_s_barrier(); asm volatile("" ::: "memory"); } while (0)
#define ML_STAGE(st_) do { LAS unsigned char* T_ = L + ((st_) & 1) * TILE; const LAS float* Sw_ = (const LAS float*)(L + SC) + ((st_) & 3) * (SC_STRIDE / 4) + SC_W / 4; \
            { const int p_ = tid, t_ = p_ >> 4, c8_ = (p_ & 15) * 8; *(LAS u32x4*)((LAS bf16*)(T_ + QS) + t_ * 136 + c8_) = pq0; *(LAS u32x4*)((LAS bf16*)(T_ + KS) + t_ * 136 + c8_) = pk0; } \
            { const int p_ = tid + 512, t_ = p_ >> 4, c8_ = (p_ & 15) * 8; *(LAS u32x4*)((LAS bf16*)(T_ + QS) + t_ * 136 + c8_) = pq1; *(LAS u32x4*)((LAS bf16*)(T_ + KS) + t_ * 136 + c8_) = pk1; } \
            if (intra && lo_ < 2) { const int t_ = (tid & 127) >> 1, c8_ = (tid & 1) * 8; const float ws_ = Sw_[t_]; float vv_[8]; unpack8(pv, vv_); \
                _Pragma("unroll") for (int e_ = 0; e_ < 8; ++e_) { ((LAS bf16*)(T_ + VT))[(c8_ + e_) * 72 + t_] = f2bf(vv_[e_]); ((LAS bf16*)(T_ + VTW))[(c8_ + e_) * 72 + t_] = f2bf(vv_[e_] * ws_); } } \
            else if (intra && lo_ == 2) { const int t_ = lane; ((LAS bf16*)(T_ + VTW))[16 * 72 + t_] = f2bf(Sw_[t_]); } } while (0)
#define ML_FINISH(j_) do { const int cj_ = ML_CS(j_); const LAS float* Sj_ = (const LAS float*)(L + SC) + ((j_) & 3) * (SC_STRIDE / 4); const LAS float* NXj_ = (const LAS float*)(L + NXB + ((j_) & 1) * NXSZ); \
            const int tb_ = 16 * (w & 3) + 4 * q4; \
            const bool first_ = ((j_) < 128) || ((j_) == 128 && d == 0); \
            bf16* ob_ = cj_ == 0 ? (first_ ? CELLM : VM2d) : (first_ ? CELL : V2d); \
            const int rb_ = cj_ == 0 ? (tb_ < 48 ? 16 + tb_ : tb_ - 48) : 64 * (cj_ - 1) + tb_;     \
            const unsigned cb_ = (unsigned)(h * 256 + sl * 16 + i16); \
            if (!intra) { const LAS float* NIj_ = (const LAS float*)(L + NIB + ((j_) & 1) * NISZ); const f32x4 isc_ = *(const LAS f32x4*)(Sj_ + SC_ISC / 4 + tb_), flo_ = *(const LAS f32x4*)(Sj_ + SC_FLO / 4 + tb_); float hv_[4]; \
                const f32x4 ni_ = *(const LAS f32x4*)(NIj_ + i16 * 68 + tb_), nxa_ = *(const LAS f32x4*)(NXj_ + i16 * 68 + tb_), nxb_ = *(const LAS f32x4*)(NXj_ + 2 * 1088 + i16 * 68 + tb_); \
                const f32x4 de_ = *(const LAS f32x4*)(NIj_ + 1088 + tb_), dxa_ = *(const LAS f32x4*)(NXj_ + 1088 + tb_), dxb_ = *(const LAS f32x4*)(NXj_ + 3 * 1088 + tb_);     \
                _Pragma("unroll") for (int r_ = 0; r_ < 4; ++r_) { const float num_ = ni_[r_] + isc_[r_] * (nxa_[r_] + nxb_[r_]); const float den_ = de_[r_] + isc_[r_] * (dxa_[r_] + dxb_[r_]); \
                    hv_[r_] = num_ * __builtin_amdgcn_rcpf(fmaxf(fabsf(den_), flo_[r_])); } \
                if (!first_) { const unsigned need_ = (unsigned)(epoch * 1024 + 256 - (j_) + 1); unsigned sp_ = 0u; ppa = (unsigned)__builtin_amdgcn_readfirstlane((int)ppa); \
                    while (ppa < need_ && sp_ < (1u << 20)) { __builtin_amdgcn_s_sleep(1); ppa = (unsigned)__builtin_amdgcn_readfirstlane((int)__hip_atomic_load(prog_pa, __ATOMIC_RELAXED, __HIP_MEMORY_SCOPE_AGENT)); ++sp_; } } \
                { bf16* op_ = ob_ + (unsigned)(rb_ * 2048) + cb_; op_[0] = f2bf(hv_[0]); op_[2048] = f2bf(hv_[1]); op_[4096] = f2bf(hv_[2]); op_[6144] = f2bf(hv_[3]); } } } while (0)
        ML_LOAD(ML_CS(0));
        { const float a0 = ga[ML_CS(0) * 64 + lane], c0 = gcm[ML_CS(0) * 64 + lane], b0 = gb[ML_CS(0) * 64 + lane], a1 = ga[ML_CS(1) * 64 + lane], c1 = gcm[ML_CS(1) * 64 + lane], b1 = gb[ML_CS(1) * 64 + lane];
          if (intra && lo_ == 2) { ML_SCALARS(a0, c0, b0, 0); ML_SCALARS(a1, c1, b1, 1); } }
        __syncthreads();
        ML_STAGE(0);
        ML_LOAD(ML_CS(1));
        ML_BAR();
        unsigned ppa = 0u;
#ifdef DIAG
        unsigned long long tA_ = 0, tF_ = 0, tB_ = 0, tC_ = 0, t0_ = __builtin_amdgcn_s_memtime(), tx_;
#define DG_MARK(acc) do { const unsigned long long ty_ = __builtin_amdgcn_s_memtime(); acc += ty_ - tx_; tx_ = ty_; } while (0)
#else
#define DG_MARK(acc) do { } while (0)
#endif
        for (int i = 0; i <= 256; ++i) {
#ifdef DIAG
            tx_ = __builtin_amdgcn_s_memtime();
#endif
            const int par = i & 1;
            LAS unsigned char* T = L + par * TILE; const LAS float* S = (const LAS float*)(L + SC) + (i & 3) * (SC_STRIDE / 4);
            LAS bf16* Qs = (LAS bf16*)(T + QS); LAS bf16* Ks = (LAS bf16*)(T + KS); LAS bf16* Vt = (LAS bf16*)(T + VT); LAS bf16* Vtw = (LAS bf16*)(T + VTW);
            LAS float* NXb = (LAS float*)(L + NXB + par * NXSZ);
            ppa = __hip_atomic_load(prog_pa, __ATOMIC_RELAXED, __HIP_MEMORY_SCOPE_AGENT);
            if (tid == 0) __hip_atomic_store(prog_me, (unsigned)(epoch * 1024 + i + 1), __ATOMIC_RELAXED, __HIP_MEMORY_SCOPE_AGENT);
            if (i < 256) ML_STAGE(i + 1);
            { const int in_ = i < 255 ? i + 2 : 256; ML_LOAD(ML_CS(in_));
              if (intra && lo_ == 2) { const int ig_ = ML_CS(in_) * 64 + lane; g1a = ga[ig_]; g1cm = gcm[ig_]; g1b = gb[ig_]; } }
            DG_MARK(tA_);
            if (i > 0) ML_FINISH(i - 1);
            DG_MARK(tF_);
            if (intra) {
                const int tau_ = w; const LAS bf16* qp_ = Qs + (16 * tau_ + i16) * 136 + 8 * q4;
                const bf16x8 bq0_ = *(const LAS bf16x8*)(qp_), bq1_ = *(const LAS bf16x8*)(qp_ + 32), bq2_ = *(const LAS bf16x8*)(qp_ + 64), bq3_ = *(const LAS bf16x8*)(qp_ + 96);
                const float Mt_ = S[SC_M / 4 + 16 * tau_ + i16]; unsigned jw_[8];
#define ML_INTRA(NV_) do { bf16x8 kf_[NV_][4]; f32x4 ac_[NV_], as4_[NV_]; \
                    _Pragma("unroll") for (int j_ = 0; j_ < NV_; ++j_) { const int sg_ = d == 0 ? j_ : 3 - j_; const LAS bf16* kp_ = Ks + (16 * sg_ + i16) * 136 + 8 * q4; \
                        _Pragma("unroll") for (int kk_ = 0; kk_ < 4; ++kk_) kf_[j_][kk_] = *(const LAS bf16x8*)(kp_ + 32 * kk_); \
                        as4_[j_] = *(const LAS f32x4*)(S + SC_A / 4 + 16 * sg_ + 4 * q4); ac_[j_] = (f32x4){0.f, 0.f, 0.f, 0.f}; } \
                    _Pragma("unroll") for (int j_ = 0; j_ < NV_; ++j_) ac_[j_] = MFMA16(kf_[j_][0], bq0_, ac_[j_]); \
                    _Pragma("unroll") for (int j_ = 0; j_ < NV_; ++j_) ac_[j_] = MFMA16(kf_[j_][1], bq1_, ac_[j_]); \
                    _Pragma("unroll") for (int j_ = 0; j_ < NV_; ++j_) ac_[j_] = MFMA16(kf_[j_][2], bq2_, ac_[j_]); \
                    _Pragma("unroll") for (int j_ = 0; j_ < NV_; ++j_) ac_[j_] = MFMA16(kf_[j_][3], bq3_, ac_[j_]); \
                    _Pragma("unroll") for (int j_ = 0; j_ < NV_; ++j_) { float e_[4]; \
                        _Pragma("unroll") for (int r_ = 0; r_ < 4; ++r_) { float x_ = __builtin_amdgcn_exp2f(as4_[j_][r_] - Mt_) * ac_[j_][r_]; \
                            if (j_ == NV_ - 1) { const int sl_ = 4 * q4 + r_; const bool ok_ = d == 0 ? (sl_ <= i16) : (sl_ >= i16); x_ = ok_ ? x_ : 0.f; } e_[r_] = x_; } \
                        jw_[2 * j_] = cvt_pk_bf16(e_[0], e_[1]); jw_[2 * j_ + 1] = cvt_pk_bf16(e_[2], e_[3]); } \
                    _Pragma("unroll") for (int j_ = NV_; j_ < 4; ++j_) { jw_[2 * j_] = 0u; jw_[2 * j_ + 1] = 0u; } } while (0)
                if (lo_ == 0) ML_INTRA(1); else if (lo_ == 1) ML_INTRA(2); else if (lo_ == 2) ML_INTRA(3); else ML_INTRA(4);
#undef ML_INTRA
                const bool fw_ = d == 0;
                const u32x4 fa0_ = {fw_ ? jw_[0] : jw_[6], fw_ ? jw_[1] : jw_[7], fw_ ? jw_[2] : jw_[4], fw_ ? jw_[3] : jw_[5]}, fa1_ = {fw_ ? jw_[4] : jw_[2], fw_ ? jw_[5] : jw_[3], fw_ ? jw_[6] : jw_[0], fw_ ? jw_[7] : jw_[1]};
                const LAS bf16* v0_ = Vt + (i16) * 72 + 4 * q4; const LAS bf16* v1_ = Vt + (16 + i16) * 72 + 4 * q4;
                const u32x2 b00_ = *(const LAS u32x2*)(v0_), b01_ = *(const LAS u32x2*)(v0_ + 16), b02_ = *(const LAS u32x2*)(v0_ + 32), b03_ = *(const LAS u32x2*)(v0_ + 48);
                const u32x2 b10_ = *(const LAS u32x2*)(v1_), b11_ = *(const LAS u32x2*)(v1_ + 16), b12_ = *(const LAS u32x2*)(v1_ + 32), b13_ = *(const LAS u32x2*)(v1_ + 48);
                const u32x4 fb00_ = {b00_.x, b00_.y, b01_.x, b01_.y}, fb01_ = {b02_.x, b02_.y, b03_.x, b03_.y}, fb10_ = {b10_.x, b10_.y, b11_.x, b11_.y}, fb11_ = {b12_.x, b12_.y, b13_.x, b13_.y};
                f32x4 na_ = {0.f, 0.f, 0.f, 0.f}, nb_ = na_;
                na_ = MFMA16(__builtin_bit_cast(bf16x8, fa0_), __builtin_bit_cast(bf16x8, fb00_), na_); na_ = MFMA16(__builtin_bit_cast(bf16x8, fa1_), __builtin_bit_cast(bf16x8, fb01_), na_);
                nb_ = MFMA16(__builtin_bit_cast(bf16x8, fa0_), __builtin_bit_cast(bf16x8, fb10_), nb_); nb_ = MFMA16(__builtin_bit_cast(bf16x8, fa1_), __builtin_bit_cast(bf16x8, fb11_), nb_);
                { LAS float* NIw_ = (LAS float*)(L + NIB + par * NISZ);
                  *(LAS f32x4*)(NIw_ + i16 * 68 + 16 * tau_ + 4 * q4) = na_; *(LAS f32x4*)(NIw_ + 1088 + i16 * 68 + 16 * tau_ + 4 * q4) = nb_; }
            } else {
                bf16x8 Cf0, Cf1;
                { u32x4 f_; f_ = (u32x4){cvt_pk_bf16(Cs0[0], Cs0[1]), cvt_pk_bf16(Cs0[2], Cs0[3]), cvt_pk_bf16(Cs1[0], Cs1[1]), cvt_pk_bf16(Cs1[2], Cs1[3])}; Cf0 = __builtin_bit_cast(bf16x8, f_);
                  f_ = (u32x4){cvt_pk_bf16(Cs2[0], Cs2[1]), cvt_pk_bf16(Cs2[2], Cs2[3]), cvt_pk_bf16(Cs3[0], Cs3[1]), cvt_pk_bf16(Cs3[2], Cs3[3])}; Cf1 = __builtin_bit_cast(bf16x8, f_); }
                { u32x2 qa_[4][4];
#pragma unroll
                  for (int tt_ = 0; tt_ < 4; ++tt_) { const LAS bf16* qp_ = Qs + (16 * tt_ + i16) * 136 + 64 * eta + 4 * q4;
#pragma unroll
                      for (int jj_ = 0; jj_ < 4; ++jj_) qa_[tt_][jj_] = *(const LAS u32x2*)(qp_ + 16 * jj_); }
                  f32x4 nx_[4];
#pragma unroll
                  for (int tt_ = 0; tt_ < 4; ++tt_) { const u32x4 f_ = {qa_[tt_][0].x, qa_[tt_][0].y, qa_[tt_][1].x, qa_[tt_][1].y}; nx_[tt_] = MFMA16(__builtin_bit_cast(bf16x8, f_), Cf0, ((f32x4){0.f, 0.f, 0.f, 0.f})); }
#pragma unroll
                  for (int tt_ = 0; tt_ < 4; ++tt_) { const u32x4 f_ = {qa_[tt_][2].x, qa_[tt_][2].y, qa_[tt_][3].x, qa_[tt_][3].y}; nx_[tt_] = MFMA16(__builtin_bit_cast(bf16x8, f_), Cf1, nx_[tt_]); }
#pragma unroll
                  for (int tt_ = 0; tt_ < 4; ++tt_) *(LAS f32x4*)(NXb + (eta * 2 + be) * 1088 + i16 * 68 + 16 * tt_ + 4 * q4) = nx_[tt_]; }
                const float dec = S[SC_DEC / 4];
                const LAS bf16* vw_ = Vtw + (16 * be + i16) * 72 + 8 * q4; const bf16x8 vb0 = *(const LAS bf16x8*)(vw_), vb1 = *(const LAS bf16x8*)(vw_ + 32);
                const unsigned kb_ = (unsigned)(uintptr_t)Ks + (unsigned)((8 * q4 + (i16 >> 2)) * 272 + 8 * (i16 & 3) + 128 * eta);
#define ML_TR4(kt_, L0, H0, L1, H1) s16x4 L0 = trro<(kt_) * 32>(kb_), H0 = trro<(kt_) * 32 + 4 * 272>(kb_), L1 = trro<(kt_) * 32 + 32 * 272>(kb_), H1 = trro<(kt_) * 32 + 36 * 272>(kb_)
#define ML_MM(CS_, L0, H0, L1, H1) do { const bf16x8 a0_ = {L0[0], L0[1], L0[2], L0[3], H0[0], H0[1], H0[2], H0[3]}, a1_ = {L1[0], L1[1], L1[2], L1[3], H1[0], H1[1], H1[2], H1[3]}; \
                CS_ = CS_ * dec; CS_ = MFMA16(a0_, vb0, CS_); CS_ = MFMA16(a1_, vb1, CS_); } while (0)
                { ML_TR4(0, a0, a1, a2, a3); ML_TR4(1, b0, b1, b2, b3); ML_TR4(2, c0, c1, c2, c3); ML_TR4(3, e0, e1, e2, e3);
                  asm volatile("s_waitcnt lgkmcnt(0)" ::: "memory"); __builtin_amdgcn_sched_barrier(0);
                  ML_MM(Cs0, a0, a1, a2, a3); ML_MM(Cs1, b0, b1, b2, b3); ML_MM(Cs2, c0, c1, c2, c3); ML_MM(Cs3, e0, e1, e2, e3); }
            }
            if (intra && lo_ == 2 && i < 255) { ML_SCALARS(g1a, g1cm, g1b, (i + 2) & 3); }
            DG_MARK(tB_);
            ML_BAR();
            DG_MARK(tC_);
        }
#ifdef DIAG
        if (C.bid == 0 && lane == 0) { float* dg_ = (float*)((unsigned*)(C.misc() + MS_CTL) + CW_CHK) + C.wave * 8; dg_[0] = (float)(__builtin_amdgcn_s_memtime() - t0_) / 257.f; dg_[1] = (float)tA_ / 257.f; dg_[2] = (float)tF_ / 257.f; dg_[3] = (float)tB_ / 257.f; dg_[4] = (float)tC_ / 257.f; }
#endif
        { const int i = 257; (void)i; ppa = __hip_atomic_load(prog_pa, __ATOMIC_RELAXED, __HIP_MEMORY_SCOPE_AGENT); ML_FINISH(256); }
        VM_WAIT(); __syncthreads();
#undef ML_LOADQK
#undef ML_LOAD
#undef ML_SCALARS
#undef ML_CS
#undef ML_BAR
#undef ML_STAGE
#undef ML_FINISH
#undef ML_TR4
#undef ML_MM
    }
}

#if DBG_CHECK
constexpr size_t MS_STASH = MS_END;
constexpr int ST_QATT = 0;
constexpr int ST_GB = 8 * 128;
constexpr int ST_XM = ST_GB + 16;
constexpr int NCHK = 16;
DI float* chk_words(const Ctx& C) { return (float*)((unsigned*)(C.misc() + MS_CTL) + CW_CHK); }
DI void chk_add(const Ctx& C, int id, float diff, float ref) {
    float d2 = diff * diff, r2 = ref * ref; if (!(d2 >= 0.f) || !(d2 < 1e30f)) d2 = 1e30f;
    atomicAdd(chk_words(C) + 2 * id, d2); atomicAdd(chk_words(C) + 2 * id + 1, r2);
}
DI unsigned hsh(unsigned x) { x ^= x >> 16; x *= 0x7feb352du; x ^= x >> 15; x *= 0x846ca68bu; x ^= x >> 16; return x; }
DI int smp_row(int s) { return s == 0 ? 0 : s == 1 ? 63 : s == 2 ? 16383 : s == 3 ? 16384 : s == 4 ? 16399 : s == 5 ? 8191 : (int)(hsh(1000 + s) % LTOK); }
DI float wdot_bf_f32col(const bf16* a, const float* w, int ldw, int K, int lane) { float s = 0.f; for (int k = lane; k < K; k += 64) s += bf2f(a[k]) * w[(size_t)k * ldw]; return wave_sum(s, lane); }

DI void dbg_check_gemm_plain(const Ctx& C, int id, const bf16* A, int lda, const float* W, int ldw, int K, const bf16* O, int ldo) {
    for (int s = C.gw; s < 48; s += C.ngw) { const int row = smp_row(s % 12), col = (int)(hsh(77 + s) % (unsigned)ldo);
        const float ref = wdot_bf_f32col(A + (size_t)row * lda, W + col, ldw, K, C.lane);
        if (C.lane == 0) chk_add(C, id, bf2f(O[(size_t)row * ldo + col]) - ref, ref); }
}
DI void dbg_check_e1(const Ctx& C, int li, const bf16* h, const bf16* YAB, const bf16* Kb, const bf16* Vb, const bf16* GA, const bf16* U) {
    const float* W = C.in[I_WINE] + (size_t)li * 1024 * 4608;
    for (int s = C.gw; s < 96; s += C.ngw) { const int row = smp_row(s % 12); const int seg = (s / 12) % 6;
        const int lo_ = seg == 0 ? 0 : seg == 1 ? 1024 : seg == 2 ? 1280 : seg == 3 ? 1536 : seg == 4 ? 2560 : 3584, wd_ = (seg == 1 || seg == 2) ? 256 : 1024;
        const int col = lo_ + (int)(hsh(5 + s) % (unsigned)wd_), c = col - lo_;
        float ref = wdot_bf_f32col(h + (size_t)row * 1024, W + col, 4608, 1024, C.lane);
        float got;
        if (seg == 0) got = bf2f(YAB[(size_t)row * 2048 + c]); else if (seg == 1) got = bf2f(Kb[(size_t)row * 256 + c]); else if (seg == 2) got = bf2f(Vb[(size_t)row * 256 + c]);
        else if (seg == 3) { got = bf2f(GA[(size_t)row * 1024 + c]); ref = ref / (1.f + expf(-ref)); } else if (seg == 4) got = bf2f(U[(size_t)row * 1024 + c]);
        else { got = bf2f(YAB[(size_t)row * 2048 + 1024 + c]); ref = ref / (1.f + expf(-ref)); }
        if (C.lane == 0) chk_add(C, 2, got - ref, ref); }
}
DI void naive_qk_head(const Ctx& C, int li, const bf16* h, int row, int hs, float& o0, float& o1) {
    const float* W = C.in[I_WINE] + (size_t)li * 1024 * 4608; const int cb = hs < 8 ? hs * 128 : 1024 + (hs - 8) * 128;
    float r0 = 0.f, r1 = 0.f;
    for (int k = 0; k < 1024; ++k) { const float hv = bf2f(h[(size_t)row * 1024 + k]); r0 += hv * W[(size_t)k * 4608 + cb + C.lane]; r1 += hv * W[(size_t)k * 4608 + cb + 64 + C.lane]; }
    r0 = bf2f(f2bf(r0)); r1 = bf2f(f2bf(r1));
    const float ss = wave_sum(r0 * r0 + r1 * r1, C.lane); const float rs = 1.f / sqrtf(ss / 128.f + EPS);
    const float* g = (hs < 8 ? C.in[I_QN] : C.in[I_KN]) + li * 128;
    const float n0 = r0 * rs * g[C.lane], n1 = r1 * rs * g[64 + C.lane];
    const int j = C.lane & 31; const float fr = exp2f(-(float)j * (13.287712379549449f / 32.f));
    float pr = 0.f, pc = 0.f; if (row < SEQ) { pr = (float)(row / 64); pc = (float)(row % 64); }
    const float p0 = shx(n0, 32, C.lane), p1 = shx(n1, 32, C.lane);
    float cr, sr, cc, sc; cis_rev(pr * fr, cr, sr); cis_rev(pc * fr, cc, sc);
    o0 = C.lane < 32 ? n0 * cr - p0 * sr : n0 * cr + p0 * sr;
    o1 = C.lane < 32 ? n1 * cc - p1 * sc : n1 * cc + p1 * sc;
}
DI void dbg_check_e2(const Ctx& C, int li, const bf16* h, const bf16* YAB, const bf16* Kb) {
    for (int s = C.gw; s < 40; s += C.ngw) { const int row = smp_row(s % 10), hs = (s * 7) % 10; float o0, o1; naive_qk_head(C, li, h, row, hs, o0, o1);
        const bf16* p = hs < 8 ? YAB + (size_t)row * 2048 + hs * 128 : Kb + (size_t)row * 256 + (hs - 8) * 128;
        const float d0 = bf2f(p[C.lane]) - o0, d1 = bf2f(p[64 + C.lane]) - o1;
        const float dd = wave_sum(d0 * d0 + d1 * d1, C.lane), rr = wave_sum(o0 * o0 + o1 * o1, C.lane);
        if (C.lane == 0) chk_add(C, 3, sqrtf(dd), sqrtf(rr)); }
}
DI void dbg_check_s5(const Ctx& C, int li, const bf16* U, const bf16* YG) {
    float* st = (float*)(C.misc() + MS_STASH);
    const bf16* YAB = C.slot(2);
    for (int s = C.gw; s < 8; s += C.ngw) { const int row = smp_row(s), hd = (s * 3) % 8; st[ST_QATT + s * 128 + C.lane] = bf2f(YAB[(size_t)row * 2048 + hd * 128 + C.lane]); st[ST_QATT + s * 128 + 64 + C.lane] = bf2f(YAB[(size_t)row * 2048 + hd * 128 + 64 + C.lane]); }
    if (C.gw == 8 && C.lane < 16) { const int row = smp_row(C.lane % 12), col = (int)(hsh(300 + C.lane) % 1024u); st[ST_GB + C.lane] = bf2f(YAB[(size_t)row * 2048 + 1024 + col]); }
    for (int s = C.gws; s < 6; s += C.ngw) {
        const int row = smp_row(s), g = (int)(hsh(40 + s) % 64u), l = seq_of_row(row), n = C.lane;
        float y[16];
#pragma unroll
        for (int p = 0; p < 16; ++p) y[p] = 0.f;
        for (int d = 0; d < 2; ++d) {
            const size_t pidx = (((size_t)li * 2 + d) * 64 + g) * 64 + n;
            const float ar = C.in[I_ARE][pidx], ai = C.in[I_AIM][pidx], dt = expf(C.in[I_LDT][((size_t)li * 2 + d) * 64 + g]);
            float c1_, s1_; cis_rev(ai * dt, c1_, s1_); const float mg = expf(ar * dt), abr = mg * c1_, abi = mg * s1_;
            const float xr0 = abr - 1.f, xi0 = abi, inv = 1.f / (ar * ar + ai * ai), kr = (xr0 * ar + xi0 * ai) * inv, ki = (xi0 * ar - xr0 * ai) * inv;
            float bbr[16], bbi[16];
#pragma unroll
            for (int p = 0; p < 16; ++p) { const float br = C.in[I_BRE][pidx * 16 + p], bi = C.in[I_BIM][pidx * 16 + p]; bbr[p] = kr * br - ki * bi; bbi[p] = kr * bi + ki * br; }
            float xr = 0.f, xi = 0.f;
            const int s0 = d == 0 ? 0 : LTOK - 1, s1 = l, step = d == 0 ? 1 : -1;
            for (int sq = s0;; sq += step) { const bf16* up = U + (size_t)row_of_seq(sq) * 1024 + g * 16; float ur = 0.f, ui = 0.f;
#pragma unroll
                for (int p = 0; p < 16; ++p) { const float u = bf2f(up[p]); ur += bbr[p] * u; ui += bbi[p] * u; }
                const float nr = abr * xr - abi * xi + ur, ni = abr * xi + abi * xr + ui; xr = nr; xi = ni;
                if (sq == s1) break; }
#pragma unroll
            for (int p = 0; p < 16; ++p) { const size_t ci = ((((size_t)li * 2 + d) * 64 + g) * 16 + p) * 64 + n; y[p] += wave_sum(C.in[I_CRE][ci] * xr - C.in[I_CIM][ci] * xi, C.lane); }
        }
        float dd = 0.f, rr = 0.f;
#pragma unroll
        for (int p = 0; p < 16; ++p) { float v = y[p] + bf2f(U[(size_t)row * 1024 + g * 16 + p]) * C.in[I_SSMD][(size_t)li * 1024 + g * 16 + p];
            { const float z_ = 0.7978845608028654f * (v + 0.044715f * v * v * v); const float e2_ = expf(-2.f * fabsf(z_)); float th_ = (1.f - e2_) / (1.f + e2_); th_ = z_ < 0.f ? -th_ : th_; v = 0.5f * v * (1.f + th_); }
            const float df = bf2f(YG[(size_t)row * 1024 + g * 16 + p]) - v; dd += df * df; rr += v * v; }
        if (C.lane == 0) chk_add(C, 4, sqrtf(dd), sqrtf(rr));
    }
}
DI void dbg_check_e5(const Ctx& C, int li, const bf16* h, const bf16* YAB, const bf16* Kb, const bf16* Vb, const bf16* GA, const bf16* YG) {
    const float* st = (const float*)(C.misc() + MS_STASH);
    LAS float* sc = (LAS float*)C.lds; LAS float* red = sc + 16448;
    for (int s = C.bid; s < 8; s += C.G) { const int row = smp_row(s), hd = (s * 3) % 8, g = hd >> 2;
        const float* q = st + ST_QATT + s * 128;
        float mx = -1e30f;
        for (int key = C.tid; key < LTOK; key += NTHR) { float d = 0.f; for (int e = 0; e < 128; ++e) d += q[e] * bf2f(Kb[(size_t)key * 256 + g * 128 + e]); d *= 0.08838834764831845f; sc[key] = d; mx = fmaxf(mx, d); }
#pragma unroll
        for (int o = 1; o < 64; o <<= 1) mx = fmaxf(mx, shx(mx, o, C.lane));
        if (C.lane == 0) red[C.wave] = mx; __syncthreads();
        mx = red[0]; for (int w = 1; w < 8; ++w) mx = fmaxf(mx, red[w]); __syncthreads();
        float sm = 0.f; for (int key = C.tid; key < LTOK; key += NTHR) { const float p = expf(sc[key] - mx); sc[key] = p; sm += p; }
        sm = wave_sum(sm, C.lane); if (C.lane == 0) red[C.wave] = sm; __syncthreads();
        sm = 0.f; for (int w = 0; w < 8; ++w) sm += red[w];
        if (C.tid < 128) { float o = 0.f; for (int key = 0; key < LTOK; ++key) o += sc[key] * bf2f(Vb[(size_t)key * 256 + g * 128 + C.tid]);
            o = o / sm * bf2f(GA[(size_t)row * 1024 + hd * 128 + C.tid]); const float got = bf2f(YAB[(size_t)row * 2048 + hd * 128 + C.tid]);
            const float dd = wave_sum((got - o) * (got - o), C.lane), rr = wave_sum(o * o, C.lane); if (C.lane == 0) chk_add(C, 5, sqrtf(dd), sqrtf(rr)); }
        __syncthreads(); }
    const float* Wg = C.in[I_WGLU] + (size_t)li * 1024 * 1024;
    for (int s = C.gws; s < 16; s += C.ngw) { const int row = smp_row(s % 12), col = (int)(hsh(300 + s) % 1024u);
        const float pre = wdot_bf_f32col(YG + (size_t)row * 1024, Wg + col, 1024, 1024, C.lane) + C.in[I_BGLU][li * 1024 + col];
        const float ref = bf2f(YG[(size_t)row * 1024 + col]) / (1.f + expf(-pre)) * st[ST_GB + s];
        if (C.lane == 0) chk_add(C, 6, bf2f(YAB[(size_t)row * 2048 + 1024 + col]) - ref, ref); }
}
DI void dbg_check_conv(const Ctx& C, int li, const bf16* XM, const bf16* XC) {
    float* st = (float*)(C.misc() + MS_STASH);
    for (int s = C.gw; s < 8; s += C.ngw) { const int row = smp_row(s), hd = (s * 5) % 8;
        for (int e = C.lane; e < 256; e += 64) st[ST_XM + s * 256 + e] = bf2f(XM[(size_t)row * 2048 + hd * 256 + e]); }
    const float* cw = C.in[I_CONVW] + (size_t)li * 5 * 2048; const float* cb = C.in[I_CONVB] + (size_t)li * 2048;
    for (int s = C.gw * 64 + C.lane; s < 768; s += C.ngw * 64) { const int row = smp_row(s % 12), c = (int)(hsh(900 + s) % 2048u);
        const int l = row < SEQ ? row + 16 : row - SEQ; float a = cb[c];
        for (int j = 0; j < 5; ++j) { const int l2 = l + j - 2; if (l2 < 0 || l2 >= LTOK) continue; const int r2 = l2 < 16 ? SEQ + l2 : l2 - 16; a += cw[j * 2048 + c] * bf2f(XM[(size_t)r2 * 2048 + c]); }
        const float ref = a / (1.f + expf(-a)); chk_add(C, 10, bf2f(XC[(size_t)row * 2048 + c]) - ref, ref); }
}
DI void dbg_check_o3(const Ctx& C, int li, const bf16* XC, const bf16* Qm, const bf16* Km, const bf16* V, const bf16* VM) {
    const float* st = (const float*)(C.misc() + MS_STASH);
    for (int s = C.gw; s < 48; s += C.ngw) { const int row = smp_row(s % 12), hd = (int)(hsh(11 + s) % 8u), dm = (int)(hsh(12 + s) % 128u); const bool isk = s & 1;
        const float* W = (isk ? C.in[I_WK] : C.in[I_WQ]) + ((size_t)li * 8 + hd) * 256 * 128;
        const float ref = wdot_bf_f32col(XC + (size_t)row * 2048 + hd * 256, W + dm, 128, 256, C.lane);
        if (C.lane == 0) chk_add(C, 11, bf2f((isk ? Km : Qm)[(size_t)row * 1024 + hd * 128 + dm]) - ref, ref); }
    for (int s = C.gw; s < 8; s += C.ngw) { const int row = smp_row(s), hd = (s * 5) % 8;
        for (int t = 0; t < 4; ++t) { const int n = (int)(hsh(50 + s * 4 + t) % 256u); const float* W = C.in[I_WV] + ((size_t)li * 8 + hd) * 256 * 256 + n;
            float a = 0.f; for (int k = C.lane; k < 256; k += 64) a += st[ST_XM + s * 256 + k] * W[(size_t)k * 256]; a = wave_sum(a, C.lane);
            const float got = bf2f(row < SEQ ? V[(size_t)row * 2048 + hd * 256 + n] : VM[(size_t)(row - SEQ) * 2048 + hd * 256 + n]);
            if (C.lane == 0) chk_add(C, 12, got - a, a); } }
    const float* GI = (const float*)(C.misc() + MS_GI); const float* GF = (const float*)(C.misc() + MS_GF);
    for (int s = C.gw; s < 48; s += C.ngw) { const int row = smp_row(s % 12), dh = (int)(hsh(70 + s) % 16u), d = dh >> 3, hd = dh & 7; const bool isf = s & 1;
        const float* W = (isf ? C.in[I_WFG] : C.in[I_WIG]) + ((size_t)li * 2 + d) * 2048 * 8 + hd;
        float a = wdot_bf_f32col(XC + (size_t)row * 2048, W, 8, 2048, C.lane) + (isf ? C.in[I_BFG] : C.in[I_BIG])[li * 16 + dh];
        if (isf) a = fminf(a, 0.f) - log1pf(expf(-fabsf(a)));
        const int pos = row < SEQ ? row + 64 : row - SEQ + 48;
        if (C.lane == 0) chk_add(C, 13, (isf ? GF : GI)[(size_t)dh * NPOS + pos] - a, a); }
    if (C.gw == 0 && C.lane < 16) { chk_add(C, 13, GI[(size_t)C.lane * NPOS + 5] + 1e9f, 1e9f); chk_add(C, 13, GF[(size_t)C.lane * NPOS + 47], 0.f); }
}
DI void dbg_check_mlstm(const Ctx& C, int li, const bf16* Qm, const bf16* Km, const bf16* V, const bf16* VM, const bf16* CELL, const bf16* CELLM) {
    const float* GI = (const float*)(C.misc() + MS_GI); const float* GF = (const float*)(C.misc() + MS_GF);
    for (int s = C.gws; s < 12; s += C.ngw) { const int row = smp_row(s), hd = (int)(hsh(21 + s) % 8u), vc = (int)(hsh(22 + s) % 256u); const int pos = row < SEQ ? row + 64 : row - SEQ + 48;
        float tot = 0.f;
        for (int d = 0; d < 2; ++d) { const float* gi = GI + (size_t)(d * 8 + hd) * NPOS; const float* gf = GF + (size_t)(d * 8 + hd) * NPOS;
            float num = 0.f, den = 0.f, carry = 0.f;
            for (int b0 = 0; b0 < NPOS; b0 += 64) { const int sp = d == 0 ? pos - b0 - C.lane : pos + b0 + C.lane; const bool ok = sp >= 48 && sp < NPOS;
                const float lf = ok ? gf[sp] : 0.f; const float lfe = (b0 == 0 && C.lane == 0) ? 0.f : lf;
                float pre = d == 0 ? lf : lf;
#pragma unroll
                for (int o = 1; o < 64; o <<= 1) { const float x = shf(pre, C.lane - o); pre += C.lane >= o ? x : 0.f; }
                const float cum = carry + pre - lf; (void)lfe;
                if (ok && cum > -80.f) { const int r = sp >= 64 ? sp - 64 : SEQ + sp - 48; const int rt = row; float dot = 0.f;
                    for (int e = 0; e < 128; ++e) dot += bf2f(Qm[(size_t)rt * 1024 + hd * 128 + e]) * bf2f(Km[(size_t)r * 1024 + hd * 128 + e]);
                    const float w = expf(cum + gi[sp]) * dot * 0.08838834764831845f;
                    const float vv = bf2f(r < SEQ ? V[(size_t)r * 2048 + hd * 256 + vc] : VM[(size_t)(r - SEQ) * 2048 + hd * 256 + vc]);
                    num += w * vv; den += w; }
                carry += shf(pre, 63);
                if (carry < -80.f) break; }
            num = wave_sum(num, C.lane); den = wave_sum(den, C.lane); tot += num / fmaxf(fabsf(den), 1.f); }
        const float got = bf2f(row < SEQ ? CELL[(size_t)row * 2048 + hd * 256 + vc] : CELLM[(size_t)(row - SEQ) * 2048 + hd * 256 + vc]);
        if (C.lane == 0) chk_add(C, 14, got - tot, tot); }
}
DI void dbg_check_ogate(const Ctx& C, int li, const bf16* XC, const bf16* SZ, const bf16* CELL, const bf16* CELLM, const bf16* HZ) {
    for (int s = C.gw; s < 48; s += C.ngw) { const int row = smp_row(s % 12), col = (int)(hsh(90 + s) % 2048u), hd = col >> 8;
        const float pre = wdot_bf_f32col(XC + (size_t)row * 2048, C.in[I_WOG] + (size_t)li * 2048 * 2048 + col, 2048, 2048, C.lane) + C.in[I_BOG][(size_t)li * 2048 + col];
        const bf16* cp = row < SEQ ? CELL + (size_t)row * 2048 : CELLM + (size_t)(row - SEQ) * 2048;
        float ss = 0.f; for (int e = C.lane; e < 256; e += 64) { const float v = bf2f(cp[hd * 256 + e]); ss += v * v; } ss = wave_sum(ss, C.lane);
        const float cn = bf2f(cp[col]) / sqrtf(ss / 256.f + EPS) * C.in[I_HN][(size_t)li * 2048 + col];
        const float hh = cn / (1.f + expf(-pre)) + C.in[I_SKIP][(size_t)li * 2048 + col] * bf2f(XC[(size_t)row * 2048 + col]);
        const float ref = hh * bf2f(SZ[(size_t)row * 2048 + col]);
        if (C.lane == 0) chk_add(C, 15, bf2f(HZ[(size_t)row * 2048 + col]) - ref, ref); }
}
DI void dbg_report(const Ctx& C, unsigned* ctl) {
    const float* w = (const float*)(ctl + CW_CHK); int code = 0;
    for (int id = 1; id < NCHK; ++id) { const float d2 = w[2 * id], r2 = w[2 * id + 1]; const bool used = (d2 != 0.f || r2 != 0.f);
        if (used && code == 0) { const float rel = sqrtf(d2 / fmaxf(r2, 1e-20f)); if (!(rel < 0.05f)) code = 3 + id + (rel > 0.5f || !(rel < 1e30f) ? 32 : 0); } }
    if (ctl[CW_BAR + XB_TMO] != 0u) code = 3 + 20;
    if (code) { const float v = exp2f((float)code); for (size_t i = (size_t)C.gw * 64 + C.lane; i < (size_t)SEQ * 1024; i += (size_t)C.ngw * 64) C.out[i] = v; }
}
#endif

#ifndef DBG_CHECK
#define DBG_CHECK 0
#endif
constexpr int N_PHASES = 33;
#ifndef ONLY_J
#define ONLY_J -1
#endif
#define INJ(j) (ONLY_J < 0 || ONLY_J == (j))

__global__ void __launch_bounds__(NTHR, 2) hybrid_fwd(Params prm) {
    extern __shared__ __attribute__((aligned(16))) unsigned char lds_raw[];
    Ctx C;
    C.lds = (LAS unsigned char*)lds_raw;
    asm volatile("s_nop 0\n s_nop 0\n s_nop 0\n s_nop 0\n s_nop 0\n s_nop 0\n s_nop 0\n s_nop 0\n s_nop 0\n s_nop 0\n s_nop 0\n s_nop 0\n s_nop 0\n s_nop 0\n s_nop 0\n s_nop 0\n s_nop 0\n s_nop 0\n s_nop 0\n s_nop 0\n s_nop 0\n s_nop 0\n s_nop 0\n s_nop 0\n s_nop 0\n s_nop 0\n s_nop 0\n s_nop 0\n s_nop 0\n s_nop 0\n s_nop 0\n s_nop 0");
    C.tid = threadIdx.x; C.lane = C.tid & 63; C.wave = __builtin_amdgcn_readfirstlane(C.tid >> 6);
    C.G = gridDim.x; C.bid = blockIdx.x; C.gw = C.bid * NWAVES + C.wave; C.ngw = C.G * NWAVES; C.gws = C.wave * C.G + C.bid;
    C.in = prm.in; C.out = (float*)(GAS float*)prm.out; C.ws = (unsigned char*)(GAS unsigned char*)prm.ws; C.dob = (unsigned char*)(GAS unsigned char*)prm.out;
    volatile LAS unsigned* MISC = (volatile LAS unsigned*)(C.lds + LDS_MISC);
    if (C.tid < 16) MISC[C.tid] = 0u;
    __syncthreads();
    unsigned* ctl = (unsigned*)(C.misc() + MS_CTL);
    XcdBarrier bar; bar.bar = ctl + CW_BAR; bar.x = 0; bar.st = nullptr;
    if (prm.use_bar) bar = xcd_barrier_post(ctl + CW_BAR, MISC);
    const int lo = prm.ph_lo, hi = prm.ph_hi;
#ifdef DIAG2
    unsigned long long* dts = (unsigned long long*)(C.misc() + MS_END + 65536);
    if (C.bid == 0 && C.tid == 0) dts[98] = wall_clock64();
#endif
#define IN(k) (lo <= (k) && (k) < hi)
#define xcd_barrier_if(ub, b) do { if (ub) xcd_barrier(b); } while (0)
#ifdef DIAG2
#define SEAM(k) do { if (IN(k) && IN((k) + 1)) { if (C.bid == 0 && C.tid == 0) dts[2 * (k)] = wall_clock64(); xcd_barrier(bar); if (C.bid == 0 && C.tid == 0) dts[2 * (k) + 1] = wall_clock64(); } } while (0)
#elif defined(PH_T)
    unsigned long long ph_prev = wall_clock64(), ph_dt = 0;
#define SEAM(k) do { if (IN(k) && IN((k) + 1)) { xcd_barrier(bar); { const unsigned long long tn_ = wall_clock64(); if ((k) == (PH_T)) ph_dt = tn_ - ph_prev; ph_prev = tn_; } } } while (0)
#else
#define SEAM(k) do { if (IN(k) && IN((k) + 1)) xcd_barrier(bar); } while (0)
#endif
#if DBG_CHECK
#define CHECK(k, call) do { if (IN(k)) { call; xcd_barrier(bar); } } while (0)
#else
#define CHECK(k, call) do { } while (0)
#endif
#define resid (C.slot(0))
#define wr (C.wreg())

    if (INJ(16) && IN(0)) { const Ctx C0 = C; const Ctx C = C0.fresh();
        phase_init_rows(C, resid, C.slot(1));
        phase_rope_table(C);
        convert_even_weights(C, 0);
        phase_s5_tables(C, 0);
#ifdef DBL_P0
        phase_init_rows(C, resid, C.slot(1)); phase_rope_table(C); convert_even_weights(C, 0); phase_s5_tables(C, 0);
#endif
    }
    SEAM(0);
    for (int li = 0; li < 2; ++li) {
        const int pb = 1 + li * 16;
#define h_e (C.slot(1))
#define YAB (C.slot(2))
#define GA (C.slot(4))
#define U (C.slot(5))
#define Kb (C.slot(6))
#define Vb (C.slot(6) + (size_t)KVROWS * 256)
#define YG (C.slot(1))
#define y_e (C.slot(4))
        if (INJ(0) && IN(pb + 0)) { const Ctx C0 = C; const Ctx C = C0.fresh();
            for (int i = C.gw * 64 + C.lane; i < 2 * 48 * 256 / 8; i += C.ngw * 64) {
                const int which = i / (48 * 32), r = (i / 32) % 48, c8 = (i % 32) * 8;
                unsigned z_ = 0u; asm volatile("" : "+v"(z_));
                *(u32x4*)((which ? Vb : Kb) + (size_t)(LTOK + r) * 256 + c8) = (u32x4){z_, z_, z_, z_};
                if (i < 48 * 16) *(u32x4*)(C.misc() + MS_K8 + (size_t)LTOK * 256 + (size_t)i * 16) = (u32x4){z_, z_, z_, z_}; }
            FEvenIn f{YAB, Kb, Vb, GA, U};
            run_gemm<1024, 1024, 1024, 4608, 0>(C, h_e, (const bf16*)(wr + WE_IN), f);
            phase_s5_ktab_hcat(C, li);
#ifdef DBL_KTAB
            phase_s5_ktab_hcat(C, li);
#endif
        }
        SEAM(pb + 0);
        CHECK(pb + 0, dbg_check_e1(C, li, h_e, YAB, Kb, Vb, GA, U));
        if (INJ(1) && IN(pb + 1)) { const Ctx C0 = C; const Ctx C = C0.fresh();
            phase_s5_local(C, U);
#ifdef DBL_LOCAL
            phase_s5_local(C, U);
#endif
        }
        SEAM(pb + 1);
        CHECK(pb + 1, dbg_check_e2(C, li, h_e, YAB, Kb));
        if (INJ(2) && IN(pb + 2)) { const Ctx C0 = C; const Ctx C = C0.fresh();
#ifdef SCAN_T
            if (C.gws < 128) { const unsigned long long t0_ = wall_clock64(); phase_s5_scan(C); asm volatile("s_waitcnt vmcnt(0)" ::: "memory"); const unsigned long long t1_ = wall_clock64();
                if (C.bid == 0 && C.tid == 0 && (t1_ - t0_) > (unsigned long long)(SCAN_T) * 100ull) ctl[CW_CHK] = 1u; }
#else
            if (C.gws < 128) phase_s5_scan(C);
#endif
            else { Ctx C2 = C; C2.gw = C.gws - 128; C2.ngw = C.ngw - 128; phase_s5_mg(C2, li); phase_qk_norm_rope(C2, YAB, Kb, C.in[I_QN] + li * 128, C.in[I_KN] + li * 128, (unsigned char*)(C.misc() + MS_K8)); phase_v8_image(C2, Vb, (unsigned char*)(wr + WO_OG)); }
        }
        SEAM(pb + 2);
        if (INJ(3) && IN(pb + 3)) { const Ctx C0 = C; const Ctx C = C0.fresh();
            phase_s5_out(C, U, YG);
#ifdef DBL_S5OUT
            phase_s5_out(C, U, YG);
#endif
        }
        SEAM(pb + 3);
        CHECK(pb + 3, dbg_check_s5(C, li, U, YG));
        if (INJ(4) && IN(pb + 4)) { const Ctx C0 = C; const Ctx C = C0.fresh();
#ifndef NO_ATT
            phase_attention(C, YAB, Kb, Vb, GA, (const unsigned char*)(C.misc() + MS_K8), (const unsigned char*)(wr + WO_OG));
#endif
#ifndef NO_GLU
            { const Ctx C1 = C0.fresh(); const Ctx& C = C1;
              FGlu f{YG, YAB, C.in[I_BGLU] + li * 1024};
              run_gemm<1024, 1024, 1024, 1024, 0>(C, YG, (const bf16*)(wr + WE_GLU), f); }
#endif
        }
        if (IN(pb + 4)) { xcd_barrier_if(prm.use_bar, bar); { const Ctx C0 = C; const Ctx C = C0.fresh(); phase_attention_combine(C, YAB, GA);
#ifdef DBL_META
            phase_attention_combine(C, YAB, GA);
#endif
        } }
        SEAM(pb + 4);
        CHECK(pb + 4, dbg_check_e5(C, li, h_e, YAB, Kb, Vb, GA, YG));
        if (INJ(5) && IN(pb + 5)) { const Ctx C0 = C; const Ctx C = C0.fresh();
            FPlain f{y_e, 1024};
            run_gemm<2048, 2048, 2048, 1024, 0>(C, YAB, (const bf16*)(wr + WE_OUT), f);
        }
        SEAM(pb + 5);
        CHECK(pb + 5, dbg_check_gemm_plain(C, 7, YAB, 2048, C.in[I_WOUTE] + (size_t)li * 2048 * 1024, 1024, 2048, y_e, 1024));
        if (INJ(6) && IN(pb + 6)) { const Ctx C0 = C; const Ctx C = C0.fresh();
#ifdef DBL_POST
            phase_post_rows(C, y_e, resid, C.slot(2), 2 * li, C.slot(1));
#endif
            phase_post_rows(C, y_e, resid, C.slot(5), 2 * li);
            convert_odd_early(C, li); convert_odd_late(C, li);
        }
        SEAM(pb + 6);
#define h_o (C.slot(5))
#define XM (C.slot(3))
#define XC (C.slot(1))
#define Qm (C.slot(5))
#define Km (C.slot(6))
#define CELL ((bf16*)C.dob)
#define CELLM ((bf16*)(C.misc() + MS_CELLM))
#define VM ((bf16*)(C.misc() + MS_VM))
#define h_r (C.slot(5))
#define SZ (C.slot(3))
#define HZ (C.slot(3))
#define y_o (C.slot(5))
        if (INJ(7) && IN(pb + 7)) { const Ctx C0 = C; const Ctx C = C0.fresh();
            FPlain f{XM, 2048};
            run_gemm<1024, 1024, 1024, 2048, 0>(C, h_o, (const bf16*)(wr + WO_IN), f);
        }
        SEAM(pb + 7);
        CHECK(pb + 7, dbg_check_gemm_plain(C, 9, h_o, 1024, C.in[I_WINO] + (size_t)li * 1024 * 4096, 4096, 1024, XM, 2048));
        if (INJ(8) && IN(pb + 8)) { const Ctx C0 = C; const Ctx C = C0.fresh();
            phase_conv(C, XM, XC, C.in[I_CONVW] + (size_t)li * 5 * 2048, C.in[I_CONVB] + (size_t)li * 2048);
#ifdef DBL_CONV
            phase_conv(C, XM, XC, C.in[I_CONVW] + (size_t)li * 5 * 2048, C.in[I_CONVB] + (size_t)li * 2048);
#endif
            if (C.gw == 0) { for (int i = C.lane; i < 1024; i += 64) ((unsigned*)(C.misc() + MS_ZROW))[i] = 0u; }
        }
        SEAM(pb + 8);
        CHECK(pb + 8, dbg_check_conv(C, li, XM, XC));
        if (INJ(9) && IN(pb + 9)) { const Ctx C0 = C; const Ctx C = C0.fresh();
#ifndef NO_QK
            { FQK f{Qm, Km}; run_gemm<2048, 256, 256, 2048, 256>(C, XC, (const bf16*)(wr + WO_QK), f); }
#endif
#ifndef NO_V
            { FVrow f{XM, VM}; run_gemm<2048, 256, 256, 2048, 256>(C, XM, (const bf16*)(wr + WO_V), f); }
#endif
#ifndef NO_GATES
            phase_gates(C, XC, (const bf16*)(wr + WO_G), C.in[I_BIG] + li * 16, C.in[I_BFG] + li * 16);
#ifdef DBL_GATES
            phase_gates(C, XC, (const bf16*)(wr + WO_G), C.in[I_BIG] + li * 16, C.in[I_BFG] + li * 16);
#endif
#endif
        }
        SEAM(pb + 9);
        CHECK(pb + 9, dbg_check_o3(C, li, XC, Qm, Km, XM, VM));
        if (INJ(10) && IN(pb + 10)) { const Ctx C0 = C; const Ctx C = C0.fresh();
#ifdef DBL_MLSTM
            phase_mlstm(C, 2 * li, Qm, Km, XM, VM, CELL, CELLM, CELL, CELLM); xcd_barrier_if(prm.use_bar, bar);
            phase_mlstm(C, 2 * li + 1, Qm, Km, XM, VM, CELL, CELLM, XM, VM);
#else
            phase_mlstm(C, li, Qm, Km, XM, VM, CELL, CELLM, XM, VM);
#endif
        }
        SEAM(pb + 10);
        CHECK(pb + 10, dbg_check_mlstm(C, li, Qm, Km, XM, VM, CELL, CELLM));
        if (INJ(11) && IN(pb + 11)) { const Ctx C0 = C; const Ctx C = C0.fresh();
            phase_renorm_rows(C, resid, h_r, 2 * li + 1);
#ifdef DBL_RENORM
            phase_renorm_rows(C, resid, h_r, 2 * li + 1);
#endif
#ifdef DBL_MERGE
            phase_cell_merge(C, CELL, CELLM, XM, VM, C.slot(6));
#endif
            phase_cell_merge(C, CELL, CELLM, XM, VM);
        }
        SEAM(pb + 11);
        if (INJ(12) && IN(pb + 12)) { const Ctx C0 = C; const Ctx C = C0.fresh();
            FSilu f{SZ, 2048};
            run_gemm<1024, 1024, 1024, 2048, 0>(C, h_r, (const bf16*)(wr + WO_Z), f);
        }
        if (INJ(13) && IN(pb + 13)) { const Ctx C0 = C; const Ctx C = C0.fresh();
            FOgate f{CELL, CELLM, XC, SZ, HZ, C.in[I_BOG] + (size_t)li * 2048, C.in[I_HN] + (size_t)li * 2048, C.in[I_SKIP] + (size_t)li * 2048, (const float*)(C.misc() + MS_RSTD)};
            run_gemm<2048, 2048, 2048, 2048, 0>(C, XC, (const bf16*)(wr + WO_OG), f);
        }
        SEAM(pb + 13);
        CHECK(pb + 13, dbg_check_ogate(C, li, XC, SZ, CELL, CELLM, HZ));
        if (INJ(14) && IN(pb + 14)) { const Ctx C0 = C; const Ctx C = C0.fresh();
            FPlain f{y_o, 1024};
            run_gemm<2048, 2048, 2048, 1024, 0>(C, HZ, (const bf16*)(wr + WO_OUT), f);
        }
        SEAM(pb + 14);
        CHECK(pb + 14, dbg_check_gemm_plain(C, 1, HZ, 2048, C.in[I_WOUTO] + (size_t)li * 2048 * 1024, 1024, 2048, y_o, 1024));
        if (INJ(15) && IN(pb + 15)) { const Ctx C0 = C; const Ctx C = C0.fresh();
#ifdef DBL_POST
            if (li == 0) phase_post_rows(C, y_o, resid, C.slot(2), 2 * li + 1, C.slot(6));
#endif
            phase_post_rows(C, y_o, resid, C.slot(1), 2 * li + 1);
#ifdef SCAN_T
            if (li == 1 && C.bid == 0 && C.tid == 0 && ctl[CW_CHK] != 0u) C.out[0] = __builtin_nanf("");
#endif
#ifdef PH_T
            if (li == 1 && C.bid == 0 && C.tid == 0) { if ((PH_T) == 32) ph_dt = wall_clock64() - ph_prev;
                int n_ = (int)((float)ph_dt * 0.01f / (float)(PH_STEP)); n_ = n_ < 0 ? 0 : (n_ > 15 ? 15 : n_);
#ifdef PH_CAL
                n_ = PH_CAL;
#endif
                C.out[0] = C.out[0] + sqrtf((float)n_) * 700.f; }
#endif
            if (li == 0) { convert_even_weights(C, 1); phase_s5_tables(C, 1); }
        }
        if (li == 0) SEAM(pb + 15);
    }
#if DBG_CHECK
    if (IN(N_PHASES - 1)) { xcd_barrier(bar); dbg_report(C, ctl); }
#endif
#ifdef DIAG2
    if (IN(N_PHASES - 1)) {
        if (C.bid == 0 && C.tid == 0) { const unsigned long long tend = wall_clock64(); float grp[4] = {0.f, 0.f, 0.f, 0.f};
            for (int k = 0; k < N_PHASES; ++k) { const unsigned long long t0 = k == 0 ? dts[98] : dts[2 * (k - 1) + 1]; const unsigned long long t1 = k == N_PHASES - 1 ? tend : dts[2 * k];
                const float us = (float)(t1 - t0) * 0.01f; const int j = k == 0 ? 16 : (k - 1) % 16;
                const int gsel = DIAG2_GROUP(j); if (gsel >= 0) grp[gsel] += us;
                if (k < N_PHASES - 1) grp[3] += (float)(dts[2 * k + 1] - dts[2 * k]) * 0.01f; }
            float* dg = (float*)(ctl + CW_CHK); dg[0] = grp[DIAG_A]; dg[1] = grp[DIAG_B]; }
        xcd_barrier(bar); const float* dg = (const float*)(ctl + CW_CHK); const float va = rintf(4.f * log2f(fmaxf(dg[0], 1.f))), vb = rintf(4.f * log2f(fmaxf(dg[1], 1.f)));
        for (size_t i = (size_t)C.gw * 64 + C.lane; i < (size_t)SEQ * 1024; i += (size_t)C.ngw * 64) C.out[i] = (i < (size_t)SEQ * 768) ? va : vb; }
#endif
#ifdef DIAG
    if (IN(N_PHASES - 1)) { xcd_barrier(bar); const float* dg = (const float*)(ctl + CW_CHK); const float va = rintf(4.f * log2f(fmaxf(dg[DIAG_A], 1.f))), vb = rintf(4.f * log2f(fmaxf(dg[DIAG_B], 1.f)));
        for (size_t i = (size_t)C.gw * 64 + C.lane; i < (size_t)SEQ * 1024; i += (size_t)C.ngw * 64) C.out[i] = (i < (size_t)SEQ * 768) ? va : vb; }
#endif
#undef IN
#undef SEAM
#undef CHECK
#undef h_e
#undef YAB
#undef GA
#undef U
#undef Kb
#undef Vb
#undef YG
#undef y_e
#undef h_o
#undef XM
#undef XC
#undef Qm
#undef Km
#undef CELL
#undef CELLM
#undef VM
#undef h_r
#undef SZ
#undef HZ
#undef y_o
#undef resid
#undef wr
}

#ifndef MULTI_LAUNCH
#define MULTI_LAUNCH 0
#endif
extern "C" void kernel_launch(void* const* d_in, const int* in_sizes, int n_in, void* d_out, int out_size, void* d_ws, size_t ws_size, hipStream_t stream) {
    static int grid = 0;
    if (grid == 0) {
        if (n_in != 33 || in_sizes[0] != SEQ * DM || out_size != SEQ * DM || ws_size < WS_NEED) {
            fprintf(stderr, "kernel_launch: shape mismatch: n_in %d in0 %d out %d ws %zu (need %zu)\n", n_in, n_in > 0 ? in_sizes[0] : -1, out_size, ws_size, (size_t)WS_NEED); grid = -1; return; }
        int dev = 0, cus = 0, per_cu = 0;
        if (hipGetDevice(&dev) != hipSuccess || hipDeviceGetAttribute(&cus, hipDeviceAttributeMultiprocessorCount, dev) != hipSuccess) { fprintf(stderr, "kernel_launch: device query failed\n"); grid = -1; return; }
        if (hipFuncSetAttribute((const void*)hybrid_fwd, hipFuncAttributeMaxDynamicSharedMemorySize, LDS_TOTAL) != hipSuccess) { fprintf(stderr, "kernel_launch: hipFuncSetAttribute failed\n"); grid = -1; return; }
        if (hipOccupancyMaxActiveBlocksPerMultiprocessor(&per_cu, (const void*)hybrid_fwd, NTHR, LDS_TOTAL) != hipSuccess || per_cu < 1) { fprintf(stderr, "kernel_launch: occupancy query says %d blocks per CU\n", per_cu); (void)hipGetLastError(); }
        grid = cus;
    }
    if (grid < 0) return;
    if (hipMemsetAsync((char*)d_ws + WS_MISC + MS_CTL, 0, 65536, stream) != hipSuccess) { fprintf(stderr, "kernel_launch: memset failed\n"); return; }
    Params p{};
    for (int i = 0; i < 33; ++i) p.in[i] = (const float*)d_in[i];
    p.out = (float*)d_out; p.ws = (unsigned char*)d_ws; p.pad = 0;
#if MULTI_LAUNCH
    for (int k = 0; k < N_PHASES; ++k) { p.ph_lo = k; p.ph_hi = k + 1; p.use_bar = 0;
        hipLaunchKernelGGL(hybrid_fwd, dim3(grid), dim3(NTHR), LDS_TOTAL, stream, p); }
#else
    p.ph_lo = 0; p.ph_hi = N_PHASES; p.use_bar = 1;
    hipLaunchKernelGGL(hybrid_fwd, dim3(grid), dim3(NTHR), LDS_TOTAL, stream, p);
#endif
    const hipError_t le = hipPeekAtLastError();
    if (le != hipSuccess) fprintf(stderr, "kernel_launch: launch failed: %s\n", hipGetErrorName(le));
}
```
